# Optimizing an MI355X kernel written in HIP

```python
import jax, jax.numpy as jnp
from jax import lax
import numpy as np

D_MODEL = 1024
BATCH = 8
SEQ = 2048
DEPTH = 4

N_MIXERS = 3
RMS_EPS = 1e-6
RW_HEAD = 64
RW_HEADS = D_MODEL // RW_HEAD
RW_DECAY_LORA = 64
RW_AAA_LORA = 64
RW_GATE_LORA = 128
RW_LNX_EPS = 64e-5
RW_N_MIX = 6
SC_WIDTH = 3
LRU_WIDTH = D_MODEL
LRU_HEADS = 4
LRU_BLOCK = LRU_WIDTH // LRU_HEADS
LRU_CONV = 4
LRU_C = 8.0
N_EXPERTS = 16
EXPERT_FF = 2 * D_MODEL
CAPACITY_FACTOR = 2
N_LAYERS_A = (DEPTH + N_MIXERS - 1) // N_MIXERS
N_LAYERS_B = (DEPTH + N_MIXERS - 2) // N_MIXERS
N_LAYERS_C = DEPTH // N_MIXERS

kernel_name = "hybrid_rwkv7_shortconv_rglru_ecmoe_encoder"


def rms_norm(x, g):
    xf = x.astype(jnp.float32)
    y = xf * lax.rsqrt(jnp.mean(xf * xf, axis=-1, keepdims=True) + RMS_EPS)
    return (y * g.astype(jnp.float32)).astype(x.dtype)


def centred_shift(x):
    prev = jnp.pad(x[:, :-1], ((0, 0), (1, 0), (0, 0)))
    nxt = jnp.pad(x[:, 1:], ((0, 0), (0, 1), (0, 0)))
    return 0.5 * (prev + nxt)


def depthwise_conv(x, w, pad_left, pad_right):
    return lax.conv_general_dilated(
        x, w.astype(x.dtype)[:, None, :], window_strides=(1,),
        padding=[(pad_left, pad_right)], dimension_numbers=('NWC', 'WIO', 'NWC'),
        feature_group_count=x.shape[-1])


def rwkv7_scan(r, w, k, v, kk, a, reverse):
    bsz, _, nh, n = r.shape

    def step(state, inp):
        r_t, w_t, k_t, v_t, kk_t, a_t = inp
        sa = jnp.einsum('bhvk,bhk->bhv', state, kk_t)
        state = (state * w_t[:, :, None, :]
                 - sa[..., None] * (kk_t * a_t)[:, :, None, :]
                 + v_t[..., None] * k_t[:, :, None, :])
        return state, jnp.einsum('bhvk,bhk->bhv', state, r_t)

    xs = tuple(jnp.moveaxis(t, 1, 0) for t in (r, w, k, v, kk, a))
    s0 = jnp.zeros((bsz, nh, n, n), jnp.float32)
    _, ys = lax.scan(step, s0, xs, reverse=reverse)
    return jnp.moveaxis(ys, 0, 1)


def rwkv7_mixer(h, mu, w_in, w0, w1, w2, a0, a1, a2, g1, g2, k_k, k_a, r_k, lnx_g, lnx_b, w_out):
    bsz, seq, d = h.shape
    f32 = jnp.float32
    xx = centred_shift(h) - h
    xm = h[None] + xx[None] * mu[:, None, None, :]
    r, k, v = jnp.einsum('pbsd,pde->pbse', xm[:3], w_in)
    x_w, x_a, x_g = xm[3], xm[4], xm[5]
    lora_w = jnp.einsum('zbsr,zrd->zbsd', jnp.tanh(jnp.einsum('bsd,zdr->zbsr', x_w, w1)), w2)
    w_log = -jax.nn.softplus(-(w0[:, None, None, :] + lora_w).astype(f32)) - 0.5
    decay = jnp.exp(-jnp.exp(w_log))
    lora_a = jnp.einsum('zbsr,zrd->zbsd', jnp.einsum('bsd,zdr->zbsr', x_a, a1), a2)
    a = jax.nn.sigmoid((a0[:, None, None, :] + lora_a).astype(f32))
    g = jnp.einsum('bsr,rd->bsd', jax.nn.sigmoid(jnp.einsum('bsd,dr->bsr', x_g, g1)), g2)

    def heads(t):
        return t.reshape(t.shape[:-1] + (RW_HEADS, RW_HEAD))

    r_h = heads(r.astype(f32))
    v_h = heads(v.astype(f32))
    kk = heads((k * k_k).astype(f32))
    kk = kk / jnp.maximum(jnp.sqrt(jnp.sum(kk * kk, axis=-1, keepdims=True)), 1e-12)
    k_dir = heads(k.astype(f32)[None] * (1.0 + (a - 1.0) * k_a.astype(f32)))
    a_h = heads(a)
    decay_h = heads(decay)
    y = (rwkv7_scan(r_h, decay_h[0], k_dir[0], v_h, kk, a_h[0], reverse=False)
         + rwkv7_scan(r_h, decay_h[1], k_dir[1], v_h, kk, a_h[1], reverse=True))
    mean = jnp.mean(y, axis=-1, keepdims=True)
    var = jnp.mean(jnp.square(y - mean), axis=-1, keepdims=True)
    y = ((y - mean) * lax.rsqrt(var + RW_LNX_EPS)).reshape(bsz, seq, d)
    y = y * lnx_g.astype(f32) + lnx_b.astype(f32)
    bonus = jnp.sum(r_h[None] * k_dir * r_k.astype(f32), axis=-1, keepdims=True) * v_h[None]
    y = y + jnp.sum(bonus, axis=0).reshape(bsz, seq, d)
    return jnp.einsum('bsd,de->bse', y.astype(h.dtype) * g, w_out)


def short_conv_mixer(h, w_in, conv_w, w_out):
    bcu = jnp.einsum('bsd,de->bse', h, w_in)
    b_gate, c_gate, u = jnp.split(bcu, 3, axis=-1)
    z = depthwise_conv(c_gate * u, conv_w, 1, 1)
    return jnp.einsum('bse,ed->bsd', b_gate * z, w_out)


def linear_scan(a, b):
    def combine(e1, e2):
        a1, b1 = e1
        a2, b2 = e2
        return a1 * a2, a2 * b1 + b2
    _, hs = lax.associative_scan(combine, (a, b), axis=1)
    return hs


def rglru_mixer(h, w_in, conv_w, conv_b, w_a, b_a, w_x, b_x, lam, w_out):
    bsz, seq, _ = h.shape
    f32 = jnp.float32
    gu = jnp.einsum('bsd,de->bse', h, w_in)
    gate, u = jnp.split(gu, 2, axis=-1)
    gate = jax.nn.gelu(gate)
    u = depthwise_conv(u, conv_w, 2, 1) + conv_b
    uh = u.reshape(bsz, seq, LRU_HEADS, LRU_BLOCK)
    r_gate = jax.nn.sigmoid((jnp.einsum('bshi,zhij->zbshj', uh, w_a).reshape(2, bsz, seq, LRU_WIDTH)
                             + b_a[:, None, None, :]).astype(f32))
    i_gate = jax.nn.sigmoid((jnp.einsum('bshi,zhij->zbshj', uh, w_x).reshape(2, bsz, seq, LRU_WIDTH)
                             + b_x[:, None, None, :]).astype(f32))
    log_a = -LRU_C * r_gate * jax.nn.softplus(-lam.astype(f32))[:, None, None, :]
    a = jnp.exp(log_a)
    b = jnp.sqrt(-jnp.expm1(2.0 * log_a)) * (i_gate * u.astype(f32)[None])
    h_fwd = linear_scan(a[0], b[0])
    h_bwd = jnp.flip(linear_scan(jnp.flip(a[1], axis=1), jnp.flip(b[1], axis=1)), axis=1)
    y = (h_fwd + h_bwd).astype(h.dtype) * gate
    return jnp.einsum('bse,ed->bsd', y, w_out)


def expert_choice_moe(h, router_w, w_gate, w_up, w_down):
    bsz, seq, _ = h.shape
    cap = CAPACITY_FACTOR * seq // N_EXPERTS
    logits = jnp.einsum('bsd,de->bse', h, router_w).astype(jnp.float32)
    aff = jax.nn.softmax(logits, axis=-1)
    gates, idx = lax.top_k(jnp.swapaxes(aff, 1, 2), cap)
    bidx = jnp.arange(bsz)[:, None, None]
    xin = h[bidx, idx]
    hid = (jax.nn.silu(jnp.einsum('becd,edf->becf', xin, w_gate))
           * jnp.einsum('becd,edf->becf', xin, w_up))
    yexp = jnp.einsum('becf,efd->becd', hid, w_down) * gates[..., None].astype(h.dtype)
    return jnp.zeros_like(h).at[bidx, idx].add(yexp)


def setup_inputs(seed: int = 0) -> dict:
    key = jax.random.key(seed)
    keys = iter(jax.random.split(key, 48))
    f32 = jnp.float32
    D, E, F = D_MODEL, N_EXPERTS, EXPERT_FF

    def nrm(shape, scale):
        return scale * jax.random.normal(next(keys), shape, f32)

    def uni(shape, lo, hi):
        return jax.random.uniform(next(keys), shape, f32, minval=lo, maxval=hi)

    inp = {}
    inp['x'] = nrm((BATCH, SEQ, D), 1.0)
    inp['norm_mix_g'] = 1.0 + nrm((DEPTH, D), 0.02)
    inp['norm_ffn_g'] = 1.0 + nrm((DEPTH, D), 0.02)
    inp['router_w'] = nrm((DEPTH, D, E), D ** -0.5)
    inp['exp_w_gate'] = nrm((DEPTH, E, D, F), D ** -0.5)
    inp['exp_w_up'] = nrm((DEPTH, E, D, F), D ** -0.5)
    inp['exp_w_down'] = nrm((DEPTH, E, F, D), F ** -0.5)
    inp['final_norm_g'] = 1.0 + nrm((D,), 0.02)
    inp['rw_mu'] = uni((N_LAYERS_A, RW_N_MIX, D), 0.0, 1.0)
    inp['rw_w_in'] = nrm((N_LAYERS_A, 3, D, D), D ** -0.5)
    inp['rw_w0'] = uni((N_LAYERS_A, 2, D), -7.0, 0.0)
    inp['rw_w1'] = nrm((N_LAYERS_A, 2, D, RW_DECAY_LORA), D ** -0.5)
    inp['rw_w2'] = nrm((N_LAYERS_A, 2, RW_DECAY_LORA, D), 0.1 * RW_DECAY_LORA ** -0.5)
    inp['rw_a0'] = nrm((N_LAYERS_A, 2, D), 0.5)
    inp['rw_a1'] = nrm((N_LAYERS_A, 2, D, RW_AAA_LORA), D ** -0.5)
    inp['rw_a2'] = nrm((N_LAYERS_A, 2, RW_AAA_LORA, D), 0.1 * RW_AAA_LORA ** -0.5)
    inp['rw_g1'] = nrm((N_LAYERS_A, D, RW_GATE_LORA), D ** -0.5)
    inp['rw_g2'] = nrm((N_LAYERS_A, RW_GATE_LORA, D), RW_GATE_LORA ** -0.5)
    inp['rw_k_k'] = 0.85 + nrm((N_LAYERS_A, D), 0.02)
    inp['rw_k_a'] = 1.0 + nrm((N_LAYERS_A, D), 0.02)
    inp['rw_r_k'] = nrm((N_LAYERS_A, RW_HEADS, RW_HEAD), 0.1)
    inp['rw_lnx_g'] = 1.0 + nrm((N_LAYERS_A, D), 0.02)
    inp['rw_lnx_b'] = nrm((N_LAYERS_A, D), 0.02)
    inp['rw_w_out'] = nrm((N_LAYERS_A, D, D), D ** -0.5)
    inp['sc_w_in'] = nrm((N_LAYERS_B, D, 3 * D), D ** -0.5)
    inp['sc_conv_w'] = nrm((N_LAYERS_B, SC_WIDTH, D), SC_WIDTH ** -0.5)
    inp['sc_w_out'] = nrm((N_LAYERS_B, D, D), D ** -0.5)
    inp['lru_w_in'] = nrm((N_LAYERS_C, D, 2 * LRU_WIDTH), D ** -0.5)
    inp['lru_conv_w'] = nrm((N_LAYERS_C, LRU_CONV, LRU_WIDTH), LRU_CONV ** -0.5)
    inp['lru_conv_b'] = nrm((N_LAYERS_C, LRU_WIDTH), 0.01)
    inp['lru_w_a'] = nrm((N_LAYERS_C, 2, LRU_HEADS, LRU_BLOCK, LRU_BLOCK), LRU_BLOCK ** -0.5)
    inp['lru_b_a'] = nrm((N_LAYERS_C, 2, LRU_WIDTH), 0.01)
    inp['lru_w_x'] = nrm((N_LAYERS_C, 2, LRU_HEADS, LRU_BLOCK, LRU_BLOCK), LRU_BLOCK ** -0.5)
    inp['lru_b_x'] = nrm((N_LAYERS_C, 2, LRU_WIDTH), 0.01)
    a_c = uni((N_LAYERS_C, 2, LRU_WIDTH), 0.9, 0.999)
    s = a_c ** (1.0 / LRU_C)
    inp['lru_lambda'] = jnp.log(s) - jnp.log1p(-s)
    inp['lru_w_out'] = nrm((N_LAYERS_C, LRU_WIDTH, D), LRU_WIDTH ** -0.5)
    return inp


def reference(x, norm_mix_g, norm_ffn_g, router_w, exp_w_gate, exp_w_up, exp_w_down, final_norm_g,
              rw_mu, rw_w_in, rw_w0, rw_w1, rw_w2, rw_a0, rw_a1, rw_a2, rw_g1, rw_g2,
              rw_k_k, rw_k_a, rw_r_k, rw_lnx_g, rw_lnx_b, rw_w_out,
              sc_w_in, sc_conv_w, sc_w_out,
              lru_w_in, lru_conv_w, lru_conv_b, lru_w_a, lru_b_a, lru_w_x, lru_b_x, lru_lambda, lru_w_out):
    ia, ib, ic = 0, 0, 0
    for i in range(DEPTH):
        h = rms_norm(x, norm_mix_g[i])
        m = i % N_MIXERS
        if m == 0:
            y = rwkv7_mixer(h, rw_mu[ia], rw_w_in[ia], rw_w0[ia], rw_w1[ia], rw_w2[ia],
                            rw_a0[ia], rw_a1[ia], rw_a2[ia], rw_g1[ia], rw_g2[ia],
                            rw_k_k[ia], rw_k_a[ia], rw_r_k[ia], rw_lnx_g[ia], rw_lnx_b[ia], rw_w_out[ia])
            ia += 1
        elif m == 1:
            y = short_conv_mixer(h, sc_w_in[ib], sc_conv_w[ib], sc_w_out[ib])
            ib += 1
        else:
            y = rglru_mixer(h, lru_w_in[ic], lru_conv_w[ic], lru_conv_b[ic], lru_w_a[ic], lru_b_a[ic],
                            lru_w_x[ic], lru_b_x[ic], lru_lambda[ic], lru_w_out[ic])
            ic += 1
        x = x + y
        h = rms_norm(x, norm_ffn_g[i])
        x = x + expert_choice_moe(h, router_w[i], exp_w_gate[i], exp_w_up[i], exp_w_down[i])
    return rms_norm(x, final_norm_g)
```

```cpp
#include <hip/hip_runtime.h>
#include <stdint.h>
#include <stdio.h>

namespace {
constexpr int D = 1024, NB = 8, S = 2048, T = NB * S, DEPTH = 4, NE = 16, FF = 2048, CAP = 256, NH = 16, HD = 64;
constexpr int NTHR = 512;
constexpr float RMS_EPS = 1e-6f, LNX_EPS = 64e-5f;
typedef unsigned short bf16_t;

constexpr size_t MiB = 1u << 20;
constexpr size_t WS_CTL = 0;
constexpr size_t WS_X = 1 * MiB;
constexpr size_t WS_H = WS_X + 64 * MiB;
constexpr size_t WS_XM = WS_H + 32 * MiB;
constexpr size_t WS_RKV = WS_XM + 192 * MiB;
constexpr size_t WS_L1 = WS_RKV + 192 * MiB;
constexpr size_t WS_WD = WS_L1 + 24 * MiB;
constexpr size_t WS_AA = WS_WD + 128 * MiB;
constexpr size_t WS_GG = WS_AA + 128 * MiB;
constexpr size_t WS_YS = WS_GG + 64 * MiB;
constexpr size_t WS_YG = WS_YS + 128 * MiB;
constexpr size_t WS_UCB = WS_YG + 32 * MiB;
constexpr size_t WS_YEXP = WS_UCB + 32 * MiB;
constexpr size_t WS_AFF = WS_YEXP + 128 * MiB;
constexpr size_t WS_SLOT = WS_AFF + 1 * MiB;
constexpr size_t WS_GATE = WS_SLOT + 1 * MiB;
constexpr size_t WS_END = WS_GATE + 1 * MiB;
constexpr size_t WS_XIN = WS_XM, WS_HID = WS_XM + 64 * MiB;

struct P {
    const float* in[36];
    float* out;
    unsigned char* ws;
    int ph_lo, ph_hi;
};

enum { I_X = 0, I_NMG, I_NFG, I_RW, I_WG, I_WU, I_WDN, I_FNG, I_MU, I_WIN, I_W0, I_W1, I_W2, I_A0, I_A1, I_A2, I_G1, I_G2, I_KK, I_KA, I_RK, I_LNG, I_LNB, I_WOUT,
       I_SCIN, I_SCCW, I_SCOUT, I_LIN, I_LCW, I_LCB, I_LWA, I_LBA, I_LWX, I_LBX, I_LLAM, I_LOUT };

__device__ __forceinline__ float bf2f(bf16_t v) { return __uint_as_float((unsigned)v << 16); }
__device__ __forceinline__ bf16_t f2bf(float f) { unsigned u = __float_as_uint(f); u += 0x7FFFu + ((u >> 16) & 1u); return (bf16_t)(u >> 16); }
__device__ __forceinline__ void bf4_to_f(uint2 u, float* f) { f[0] = __uint_as_float(u.x << 16); f[1] = __uint_as_float(u.x & 0xffff0000u); f[2] = __uint_as_float(u.y << 16); f[3] = __uint_as_float(u.y & 0xffff0000u); }
__device__ __forceinline__ uint2 f4_to_bf(float a, float b, float c, float d) { return make_uint2((unsigned)f2bf(a) | ((unsigned)f2bf(b) << 16), (unsigned)f2bf(c) | ((unsigned)f2bf(d) << 16)); }
__device__ __forceinline__ float wave_sum(float v) { for (int o = 32; o >= 1; o >>= 1) v += __shfl_xor(v, o); return v; }
__device__ __forceinline__ float quad_sum(float v) { v += __shfl_xor(v, 1); v += __shfl_xor(v, 2); return v; }
__device__ __forceinline__ float sigmoidf_(float x) { return 1.0f / (1.0f + __expf(-x)); }
__device__ __forceinline__ float softplusf_(float y) { return fmaxf(y, 0.f) + log1pf(__expf(-fabsf(y))); }
__device__ __forceinline__ float gelu_tanh(float x) { const float u = 0.7978845608028654f * (x + 0.044715f * x * x * x); return 0.5f * x * (1.0f + tanhf(u)); }

__device__ __forceinline__ void ph_norm(const P& p, const float* xin, float* xout, bool combine, const float* gamma, bf16_t* hout, const float* router_w, float* fout, float* lds) {
    const int tid = threadIdx.x, lane = tid & 63, wave = tid >> 6;
    if (router_w) {
        for (int i = tid; i < D * NE; i += NTHR) { const int d = i >> 4, e = i & 15; lds[e * D + d] = router_w[i]; }
        __syncthreads();
    }
    const float* yexp = (const float*)(p.ws + WS_YEXP); const int* slot = (const int*)(p.ws + WS_SLOT);
    float* aff = (float*)(p.ws + WS_AFF);
    for (int tok = blockIdx.x * 8 + wave; tok < T; tok += gridDim.x * 8) {
        const int b = tok / S, s = tok % S;
        float4 x[4];
#pragma unroll
        for (int i = 0; i < 4; ++i) x[i] = ((const float4*)(xin + (size_t)tok * D))[i * 64 + lane];
        if (combine) {
            for (int e = 0; e < NE; ++e) {
                const int sl = slot[tok * NE + e];
                if (sl >= 0) {
                    const float4* row = (const float4*)(yexp + ((size_t)(e * NB + b) * CAP + sl) * D);
#pragma unroll
                    for (int i = 0; i < 4; ++i) { const float4 r = row[i * 64 + lane]; x[i].x += r.x; x[i].y += r.y; x[i].z += r.z; x[i].w += r.w; }
                }
            }
        }
        if (xout) {
#pragma unroll
            for (int i = 0; i < 4; ++i) ((float4*)(xout + (size_t)tok * D))[i * 64 + lane] = x[i];
        }
        float ss = 0.f;
#pragma unroll
        for (int i = 0; i < 4; ++i) ss += x[i].x * x[i].x + x[i].y * x[i].y + x[i].z * x[i].z + x[i].w * x[i].w;
        ss = wave_sum(ss);
        const float rstd = 1.0f / sqrtf(ss * (1.0f / D) + RMS_EPS);
        float4 h[4];
#pragma unroll
        for (int i = 0; i < 4; ++i) {
            const float4 g = ((const float4*)gamma)[i * 64 + lane];
            h[i].x = x[i].x * rstd * g.x; h[i].y = x[i].y * rstd * g.y; h[i].z = x[i].z * rstd * g.z; h[i].w = x[i].w * rstd * g.w;
        }
        if (hout) {
#pragma unroll
            for (int i = 0; i < 4; ++i) ((uint2*)(hout + (size_t)tok * D))[i * 64 + lane] = f4_to_bf(h[i].x, h[i].y, h[i].z, h[i].w);
        }
        if (fout) {
#pragma unroll
            for (int i = 0; i < 4; ++i) ((float4*)(fout + (size_t)tok * D))[i * 64 + lane] = h[i];
        }
        if (router_w) {
            float mylg = -3.0e38f;
#pragma unroll 1
            for (int e = 0; e < NE; ++e) {
                float a = 0.f;
#pragma unroll
                for (int i = 0; i < 4; ++i) { const float4 w = ((const float4*)(lds + e * D))[i * 64 + lane]; a += h[i].x * w.x + h[i].y * w.y + h[i].z * w.z + h[i].w * w.w; }
                a = wave_sum(a);
                if (lane == e) mylg = a;
            }
            float mx = mylg;
#pragma unroll
            for (int o = 1; o < 16; o <<= 1) mx = fmaxf(mx, __shfl_xor(mx, o));
            const float mine = (lane < NE) ? __expf(mylg - mx) : 0.f;
            float sum = mine;
#pragma unroll
            for (int o = 1; o < 16; o <<= 1) sum += __shfl_xor(sum, o);
            if (lane < NE) aff[((size_t)b * NE + lane) * S + s] = mine / sum;
        }
    }
}

__device__ __forceinline__ void ph_xm(const P& p, const float* mu) {
    const int tid = threadIdx.x, lane = tid & 63, wave = tid >> 6;
    const bf16_t* H = (const bf16_t*)(p.ws + WS_H); bf16_t* XM = (bf16_t*)(p.ws + WS_XM);
    for (int tok = blockIdx.x * 8 + wave; tok < T; tok += gridDim.x * 8) {
        const int s = tok % S;
#pragma unroll
        for (int i = 0; i < 4; ++i) {
            const int c4 = i * 64 + lane;
            float hc[4], hp[4] = {0.f, 0.f, 0.f, 0.f}, hn[4] = {0.f, 0.f, 0.f, 0.f};
            bf4_to_f(((const uint2*)(H + (size_t)tok * D))[c4], hc);
            if (s > 0) bf4_to_f(((const uint2*)(H + (size_t)(tok - 1) * D))[c4], hp);
            if (s < S - 1) bf4_to_f(((const uint2*)(H + (size_t)(tok + 1) * D))[c4], hn);
            float xx[4];
#pragma unroll
            for (int j = 0; j < 4; ++j) xx[j] = 0.5f * (hp[j] + hn[j]) - hc[j];
#pragma unroll
            for (int q = 0; q < 6; ++q) {
                const float4 m = ((const float4*)(mu + q * D))[c4];
                ((uint2*)(XM + ((size_t)q * T + tok) * D))[c4] = f4_to_bf(hc[0] + xx[0] * m.x, hc[1] + xx[1] * m.y, hc[2] + xx[2] * m.z, hc[3] + xx[3] * m.w);
            }
        }
    }
}

struct EpiG {
    float* C; bf16_t* Cb; const float* bias; const float* rowscale; int ldc; int coloff; int mode;
    __device__ __forceinline__ void operator()(int m, int n, float v, float v2) const {
        const size_t o = (size_t)m * ldc + coloff + n;
        switch (mode) {
            case 0: C[o] = v; break;
            case 1: C[o] = tanhf(v); break;
            case 2: C[o] = sigmoidf_(v + (bias ? bias[n] : 0.f)); break;
            case 3: { const float x = v + bias[n]; const float wl = -softplusf_(-x) - 0.5f; C[o] = __expf(-__expf(wl)); } break;
            case 4: C[o] += v; break;
            case 5: Cb[o] = f2bf(v * sigmoidf_(v) * v2); break;
            case 6: C[o] = v * rowscale[m]; break;
        }
    }
};

template <bool A_BF16, bool DUAL>
__device__ __forceinline__ void gemm_tile_naive(const void* Aptr, size_t lda, const float* W, const float* W2, size_t ldw, int K, int m0, int n0, float* lds, const EpiG& epi) {
    float (*As)[132] = (float (*)[132])lds;
    float (*Bs)[64] = (float (*)[64])(lds + 16 * 132);
    float (*Bs2)[64] = (float (*)[64])(lds + 16 * 132 + 16 * 64);
    const int tid = threadIdx.x, ty = tid >> 4, tx = tid & 15;
    float acc[4][4], acc2[4][4];
#pragma unroll
    for (int i = 0; i < 4; ++i)
#pragma unroll
        for (int j = 0; j < 4; ++j) { acc[i][j] = 0.f; acc2[i][j] = 0.f; }
    const int am = tid >> 2, ak = (tid & 3) * 4;
    const int bk = (tid & 255) >> 4, bn = (tid & 15) * 4;
    for (int k0 = 0; k0 < K; k0 += 16) {
        float a[4];
        if (A_BF16) { const uint2 u = *(const uint2*)((const bf16_t*)Aptr + (size_t)(m0 + am) * lda + k0 + ak); bf4_to_f(u, a); }
        else { const float4 v = *(const float4*)((const float*)Aptr + (size_t)(m0 + am) * lda + k0 + ak); a[0] = v.x; a[1] = v.y; a[2] = v.z; a[3] = v.w; }
        float4 bv = make_float4(0.f, 0.f, 0.f, 0.f);
        if (tid < 256) bv = *(const float4*)(W + (size_t)(k0 + bk) * ldw + n0 + bn);
        else if (DUAL) bv = *(const float4*)(W2 + (size_t)(k0 + bk) * ldw + n0 + bn);
        __syncthreads();
#pragma unroll
        for (int j = 0; j < 4; ++j) As[ak + j][am] = a[j];
        if (tid < 256) *(float4*)&Bs[bk][bn] = bv; else if (DUAL) *(float4*)&Bs2[bk][bn] = bv;
        __syncthreads();
#pragma unroll
        for (int k = 0; k < 16; ++k) {
            const float4 av = *(const float4*)&As[k][ty * 4]; const float4 b4 = *(const float4*)&Bs[k][tx * 4];
            const float aa[4] = {av.x, av.y, av.z, av.w}, bb[4] = {b4.x, b4.y, b4.z, b4.w};
#pragma unroll
            for (int i = 0; i < 4; ++i)
#pragma unroll
                for (int j = 0; j < 4; ++j) acc[i][j] += aa[i] * bb[j];
            if (DUAL) {
                const float4 c4 = *(const float4*)&Bs2[k][tx * 4]; const float cc[4] = {c4.x, c4.y, c4.z, c4.w};
#pragma unroll
                for (int i = 0; i < 4; ++i)
#pragma unroll
                    for (int j = 0; j < 4; ++j) acc2[i][j] += aa[i] * cc[j];
            }
        }
    }
    __syncthreads();
#pragma unroll
    for (int i = 0; i < 4; ++i)
#pragma unroll
        for (int j = 0; j < 4; ++j) epi(m0 + ty * 4 + i, n0 + tx * 4 + j, acc[i][j], acc2[i][j]);
}

struct Job { const void* A; const float* W; const float* W2; int lda, ldw, M, N, K, a_bf16; EpiG epi; };
__device__ __forceinline__ int job_units(const Job& j) { return (j.M / 128) * (j.N / 64); }
template <bool A_BF16, bool DUAL>
__device__ __forceinline__ void run_unit_t(const Job& j, int u, float* lds) {
    const int nn = j.N / 64, m0 = (u / nn) * 128, n0 = (u % nn) * 64;
    gemm_tile_naive<A_BF16, DUAL>(j.A, j.lda, j.W, j.W2, j.ldw, j.K, m0, n0, lds, j.epi);
}
__device__ __forceinline__ EpiG mk_epi(float* C, int ldc, int coloff, int mode, const float* bias = nullptr, bf16_t* Cb = nullptr, const float* rs = nullptr) {
    EpiG e; e.C = C; e.Cb = Cb; e.bias = bias; e.rowscale = rs; e.ldc = ldc; e.coloff = coloff; e.mode = mode; return e;
}
__device__ __forceinline__ Job mk_job(const void* A, int lda, int a_bf16, const float* W, int ldw, int M, int N, int K, EpiG e, const float* W2 = nullptr) {
    Job j; j.A = A; j.W = W; j.W2 = W2; j.lda = lda; j.ldw = ldw; j.M = M; j.N = N; j.K = K; j.a_bf16 = a_bf16; j.epi = e; return j;
}

constexpr int SCH = 32;
__device__ __forceinline__ void ph_scan(const P& p, int ia, float* lds) {
    const int tid = threadIdx.x, lane = tid & 63;
    const float* RKV = (const float*)(p.ws + WS_RKV); const float* WDp = (const float*)(p.ws + WS_WD); const float* AAp = (const float*)(p.ws + WS_AA);
    float* YS = (float*)(p.ws + WS_YS);
    const float* k_k = p.in[I_KK] + ia * D; const float* k_a = p.in[I_KA] + ia * D;
    float* vkk = lds;
    float* vw = vkk + SCH * 64; float* vb = vw + SCH * 64; float* vkd = vb + SCH * 64; float* vr = vkd + SCH * 64; float* vv = vr + SCH * 64; float* ybuf = vv + SCH * 64;
    for (int unit = blockIdx.x; unit < NB * NH * 2; unit += gridDim.x) {
        const int z = unit & 1, h = (unit >> 1) % NH, b = unit / (2 * NH);
        const int vrow = tid >> 2, q = tid & 3;
        float St[16];
#pragma unroll
        for (int j = 0; j < 16; ++j) St[j] = 0.f;
        for (int c = 0; c < S / SCH; ++c) {
#pragma unroll
            for (int jj = 0; jj < SCH * 64 / NTHR; ++jj) {
                const int idx = tid + jj * NTHR, i = idx >> 6, k = idx & 63;
                const int step = c * SCH + i, t = z ? (S - 1 - step) : step;
                const size_t o = ((size_t)b * S + t) * D + h * HD + k;
                const float rk = RKV[o], kv = RKV[(size_t)T * D + o], vvv = RKV[2 * (size_t)T * D + o];
                const float wv = WDp[(size_t)z * T * D + o], av = AAp[(size_t)z * T * D + o];
                const float kkr = kv * k_k[h * HD + k];
                const float ss = wave_sum(kkr * kkr);
                const float kkn = kkr / fmaxf(sqrtf(ss), 1e-12f);
                vkk[idx] = kkn; vw[idx] = wv; vb[idx] = kkn * av; vkd[idx] = kv * (1.0f + (av - 1.0f) * k_a[h * HD + k]); vr[idx] = rk; vv[idx] = vvv;
            }
            __syncthreads();
            if (tid < 256) {
                for (int i = 0; i < SCH; ++i) {
                    const float* pk = vkk + i * 64 + q * 16; const float* pw = vw + i * 64 + q * 16; const float* pb = vb + i * 64 + q * 16;
                    const float* pd = vkd + i * 64 + q * 16; const float* pr = vr + i * 64 + q * 16;
                    const float vval = vv[i * 64 + vrow];
                    float sa = 0.f;
#pragma unroll
                    for (int j = 0; j < 16; ++j) sa += St[j] * pk[j];
                    sa = quad_sum(sa);
                    float y = 0.f;
#pragma unroll
                    for (int j = 0; j < 16; ++j) { St[j] = St[j] * pw[j] - sa * pb[j] + vval * pd[j]; y += St[j] * pr[j]; }
                    y = quad_sum(y);
                    if (q == 0) ybuf[i * 64 + vrow] = y;
                }
            }
            __syncthreads();
#pragma unroll
            for (int jj = 0; jj < SCH * 64 / NTHR; ++jj) {
                const int idx = tid + jj * NTHR, i = idx >> 6, k = idx & 63;
                const int step = c * SCH + i, t = z ? (S - 1 - step) : step;
                YS[(size_t)z * T * D + ((size_t)b * S + t) * D + h * HD + k] = ybuf[idx];
            }
        }
        __syncthreads();
    }
    (void)lane;
}

__device__ __forceinline__ void ph_rwkv_post(const P& p, int ia) {
    const int tid = threadIdx.x, lane = tid & 63, wave = tid >> 6;
    const float* RKV = (const float*)(p.ws + WS_RKV); const float* AAp = (const float*)(p.ws + WS_AA); const float* GG = (const float*)(p.ws + WS_GG);
    const float* YS = (const float*)(p.ws + WS_YS); bf16_t* YG = (bf16_t*)(p.ws + WS_YG);
    const float* k_a = p.in[I_KA] + ia * D; const float* r_k = p.in[I_RK] + ia * D; const float* lg = p.in[I_LNG] + ia * D; const float* lb = p.in[I_LNB] + ia * D;
    for (int tok = blockIdx.x * 8 + wave; tok < T; tok += gridDim.x * 8) {
        const size_t o = (size_t)tok * D + lane * 16;
        float y[16], r[16], k[16], v[16], a0[16], a1[16];
#pragma unroll
        for (int j = 0; j < 4; ++j) {
            const float4 y0 = ((const float4*)(YS + o))[j], y1 = ((const float4*)(YS + (size_t)T * D + o))[j];
            y[4 * j] = y0.x + y1.x; y[4 * j + 1] = y0.y + y1.y; y[4 * j + 2] = y0.z + y1.z; y[4 * j + 3] = y0.w + y1.w;
            const float4 rr = ((const float4*)(RKV + o))[j], kk = ((const float4*)(RKV + (size_t)T * D + o))[j], vv = ((const float4*)(RKV + 2 * (size_t)T * D + o))[j];
            r[4 * j] = rr.x; r[4 * j + 1] = rr.y; r[4 * j + 2] = rr.z; r[4 * j + 3] = rr.w;
            k[4 * j] = kk.x; k[4 * j + 1] = kk.y; k[4 * j + 2] = kk.z; k[4 * j + 3] = kk.w;
            v[4 * j] = vv.x; v[4 * j + 1] = vv.y; v[4 * j + 2] = vv.z; v[4 * j + 3] = vv.w;
            const float4 p0 = ((const float4*)(AAp + o))[j], p1 = ((const float4*)(AAp + (size_t)T * D + o))[j];
            a0[4 * j] = p0.x; a0[4 * j + 1] = p0.y; a0[4 * j + 2] = p0.z; a0[4 * j + 3] = p0.w;
            a1[4 * j] = p1.x; a1[4 * j + 1] = p1.y; a1[4 * j + 2] = p1.z; a1[4 * j + 3] = p1.w;
        }
        float sm = 0.f;
#pragma unroll
        for (int j = 0; j < 16; ++j) sm += y[j];
        const float mean = quad_sum(sm) * (1.0f / 64.0f);
        float sv = 0.f;
#pragma unroll
        for (int j = 0; j < 16; ++j) { const float d = y[j] - mean; sv += d * d; }
        const float rstd = 1.0f / sqrtf(quad_sum(sv) * (1.0f / 64.0f) + LNX_EPS);
        float d0 = 0.f, d1 = 0.f;
#pragma unroll
        for (int j = 0; j < 16; ++j) {
            const int c = lane * 16 + j; const float ka = k_a[c], rk = r_k[c];
            d0 += r[j] * (k[j] * (1.0f + (a0[j] - 1.0f) * ka)) * rk;
            d1 += r[j] * (k[j] * (1.0f + (a1[j] - 1.0f) * ka)) * rk;
        }
        const float bon = quad_sum(d0) + quad_sum(d1);
        float outv[16];
#pragma unroll
        for (int j = 0; j < 16; ++j) { const int c = lane * 16 + j; outv[j] = ((y[j] - mean) * rstd * lg[c] + lb[c] + bon * v[j]) * GG[o + j]; }
#pragma unroll
        for (int j = 0; j < 4; ++j) ((uint2*)(YG + o))[j] = f4_to_bf(outv[4 * j], outv[4 * j + 1], outv[4 * j + 2], outv[4 * j + 3]);
    }
}

__device__ __forceinline__ void ph_sc_mid(const P& p) {
    const int tid = threadIdx.x, lane = tid & 63, wave = tid >> 6;
    const float* BCU = (const float*)(p.ws + WS_RKV); bf16_t* BZ = (bf16_t*)(p.ws + WS_YG); const float* cw = p.in[I_SCCW];
    for (int tok = blockIdx.x * 8 + wave; tok < T; tok += gridDim.x * 8) {
        const int s = tok % S;
#pragma unroll
        for (int i = 0; i < 4; ++i) {
            const int c4 = i * 64 + lane;
            float z[4] = {0.f, 0.f, 0.f, 0.f};
#pragma unroll
            for (int j = 0; j < 3; ++j) {
                const int ss = s + j - 1;
                if (ss >= 0 && ss < S) {
                    const size_t ro = (size_t)(tok + j - 1) * (3 * D);
                    const float4 c = ((const float4*)(BCU + ro + D))[c4], u = ((const float4*)(BCU + ro + 2 * D))[c4], w = ((const float4*)(cw + j * D))[c4];
                    z[0] += w.x * c.x * u.x; z[1] += w.y * c.y * u.y; z[2] += w.z * c.z * u.z; z[3] += w.w * c.w * u.w;
                }
            }
            const float4 bg = ((const float4*)(BCU + (size_t)tok * (3 * D)))[c4];
            ((uint2*)(BZ + (size_t)tok * D))[c4] = f4_to_bf(bg.x * z[0], bg.y * z[1], bg.z * z[2], bg.w * z[3]);
        }
    }
}

__device__ __forceinline__ void ph_lru_conv(const P& p) {
    const int tid = threadIdx.x, lane = tid & 63, wave = tid >> 6;
    const float* GU = (const float*)(p.ws + WS_RKV); float* UC = (float*)(p.ws + WS_GG); bf16_t* UCB = (bf16_t*)(p.ws + WS_UCB);
    const float* cw = p.in[I_LCW]; const float* cb = p.in[I_LCB];
    for (int tok = blockIdx.x * 8 + wave; tok < T; tok += gridDim.x * 8) {
        const int s = tok % S;
#pragma unroll
        for (int i = 0; i < 4; ++i) {
            const int c4 = i * 64 + lane;
            float4 acc = ((const float4*)cb)[c4];
#pragma unroll
            for (int j = 0; j < 4; ++j) {
                const int ss = s + j - 2;
                if (ss >= 0 && ss < S) {
                    const float4 u = ((const float4*)(GU + (size_t)(tok + j - 2) * (2 * D) + D))[c4], w = ((const float4*)(cw + j * D))[c4];
                    acc.x += w.x * u.x; acc.y += w.y * u.y; acc.z += w.z * u.z; acc.w += w.w * u.w;
                }
            }
            ((float4*)(UC + (size_t)tok * D))[c4] = acc;
            ((uint2*)(UCB + (size_t)tok * D))[c4] = f4_to_bf(acc.x, acc.y, acc.z, acc.w);
        }
    }
}

__device__ __forceinline__ void ph_lru_scan(const P& p, float* lds) {
    const int tid = threadIdx.x;
    const float* RG = (const float*)(p.ws + WS_WD); const float* IG = (const float*)(p.ws + WS_AA); const float* UC = (const float*)(p.ws + WS_GG);
    float* HS = (float*)(p.ws + WS_YS);
    float* segP = lds; float* segH = lds + 512;
    const int ch = tid & 31, seg = tid >> 5;
    for (int unit = blockIdx.x; unit < NB * 2 * 32; unit += gridDim.x) {
        const int cg = unit & 31, z = (unit >> 5) & 1, b = unit >> 6;
        const int c = cg * 32 + ch;
        const float sp = softplusf_(-p.in[I_LLAM][z * D + c]);
        const float* rg = RG + (size_t)z * T * D; const float* ig = IG + (size_t)z * T * D;
        float Pm = 1.f, h = 0.f;
        for (int i = seg * 128; i < seg * 128 + 128; ++i) {
            const int t = z ? (S - 1 - i) : i; const size_t o = ((size_t)b * S + t) * D + c;
            const float la = -8.0f * rg[o] * sp; const float a = __expf(la); const float bb = sqrtf(-expm1f(2.0f * la)) * (ig[o] * UC[o]);
            h = a * h + bb; Pm *= a;
        }
        segP[seg * 32 + ch] = Pm; segH[seg * 32 + ch] = h;
        __syncthreads();
        float carry = 0.f;
        for (int s2 = 0; s2 < seg; ++s2) carry = segP[s2 * 32 + ch] * carry + segH[s2 * 32 + ch];
        h = carry;
        for (int i = seg * 128; i < seg * 128 + 128; ++i) {
            const int t = z ? (S - 1 - i) : i; const size_t o = ((size_t)b * S + t) * D + c;
            const float la = -8.0f * rg[o] * sp; const float a = __expf(la); const float bb = sqrtf(-expm1f(2.0f * la)) * (ig[o] * UC[o]);
            h = a * h + bb;
            HS[(size_t)z * T * D + o] = h;
        }
        __syncthreads();
    }
}

__device__ __forceinline__ void ph_lru_post(const P& p) {
    const int tid = threadIdx.x, lane = tid & 63, wave = tid >> 6;
    const float* GU = (const float*)(p.ws + WS_RKV); const float* HS = (const float*)(p.ws + WS_YS); bf16_t* YL = (bf16_t*)(p.ws + WS_YG);
    for (int tok = blockIdx.x * 8 + wave; tok < T; tok += gridDim.x * 8) {
#pragma unroll
        for (int i = 0; i < 4; ++i) {
            const int c4 = i * 64 + lane;
            const float4 g = ((const float4*)(GU + (size_t)tok * (2 * D)))[c4];
            const float4 h0 = ((const float4*)(HS + (size_t)tok * D))[c4], h1 = ((const float4*)(HS + (size_t)T * D + (size_t)tok * D))[c4];
            ((uint2*)(YL + (size_t)tok * D))[c4] = f4_to_bf((h0.x + h1.x) * gelu_tanh(g.x), (h0.y + h1.y) * gelu_tanh(g.y), (h0.z + h1.z) * gelu_tanh(g.z), (h0.w + h1.w) * gelu_tanh(g.w));
        }
    }
}

__device__ __forceinline__ int block_sum_i(int v, int* wsum  ) {
    const int lane = threadIdx.x & 63, wave = threadIdx.x >> 6;
    for (int o = 32; o >= 1; o >>= 1) v += __shfl_xor(v, o);
    if (lane == 0) wsum[wave] = v;
    __syncthreads();
    int tot = 0;
#pragma unroll
    for (int w = 0; w < 8; ++w) tot += wsum[w];
    return tot;
}
__device__ __forceinline__ int block_excl_scan_i(int v, int* wsum  , int& total) {
    const int lane = threadIdx.x & 63, wave = threadIdx.x >> 6;
    int inc = v;
    for (int o = 1; o < 64; o <<= 1) { const int t = __shfl_up(inc, o); if (lane >= o) inc += t; }
    if (lane == 63) wsum[wave] = inc;
    __syncthreads();
    int base = 0, tot = 0;
#pragma unroll
    for (int w = 0; w < 8; ++w) { const int x = wsum[w]; if (w < wave) base += x; tot += x; }
    total = tot;
    return base + inc - v;
}
__device__ __forceinline__ void ph_topk(const P& p, float* ldsf) {
    const int tid = threadIdx.x, lane = tid & 63, wave = tid >> 6;
    int* ldsi = (int*)ldsf;
    int* wsum = ldsi;
    int* idx_l = ldsi + 64;
    const float* aff = (const float*)(p.ws + WS_AFF); int* slot = (int*)(p.ws + WS_SLOT); float* gate = (float*)(p.ws + WS_GATE);
    const bf16_t* HF = (const bf16_t*)(p.ws + WS_H); bf16_t* XIN = (bf16_t*)(p.ws + WS_XIN);
    for (int unit = blockIdx.x; unit < NB * NE; unit += gridDim.x) {
        const int e = unit % NE, b = unit / NE;
        const float4 v4 = ((const float4*)(aff + ((size_t)b * NE + e) * S))[tid];
        const unsigned v[4] = {__float_as_uint(v4.x), __float_as_uint(v4.y), __float_as_uint(v4.z), __float_as_uint(v4.w)};
        unsigned thr = 0u;
        for (int bit = 31; bit >= 0; --bit) {
            const unsigned cand = thr | (1u << bit);
            const int cnt = (int)(v[0] >= cand) + (int)(v[1] >= cand) + (int)(v[2] >= cand) + (int)(v[3] >= cand);
            const int tot = block_sum_i(cnt, wsum + (bit & 1) * 8);
            if (tot >= CAP) thr = cand;
        }
        int g4 = 0, e4 = 0;
#pragma unroll
        for (int j = 0; j < 4; ++j) { g4 += (int)(v[j] > thr); e4 += (int)(v[j] == thr); }
        const int ngt = block_sum_i(g4, wsum + 16);
        const int need_eq = CAP - ngt;
        int toteq; const int eqbase = block_excl_scan_i(e4, wsum + 24, toteq);
        int sel[4], nsel = 0, er = eqbase;
#pragma unroll
        for (int j = 0; j < 4; ++j) { const bool gt = v[j] > thr, eq = v[j] == thr; sel[j] = (gt || (eq && er < need_eq)) ? 1 : 0; er += eq ? 1 : 0; nsel += sel[j]; }
        __syncthreads();
        int totsel; int cpos = block_excl_scan_i(nsel, wsum, totsel);
#pragma unroll
        for (int j = 0; j < 4; ++j) {
            const int t = tid * 4 + j;
            if (sel[j]) {
                if (cpos < CAP) { idx_l[cpos] = t; gate[((size_t)e * NB + b) * CAP + cpos] = __uint_as_float(v[j]); slot[((size_t)b * S + t) * NE + e] = cpos; }
                else slot[((size_t)b * S + t) * NE + e] = -1;
                ++cpos;
            } else slot[((size_t)b * S + t) * NE + e] = -1;
        }
        __syncthreads();
        for (int c = wave; c < CAP; c += 8) {
            const uint4* src = (const uint4*)(HF + ((size_t)b * S + idx_l[c]) * D);
            uint4* dst = (uint4*)(XIN + (((size_t)e * NB + b) * CAP + c) * D);
            dst[lane] = src[lane]; dst[lane + 64] = src[lane + 64];
        }
        __syncthreads();
    }
}

constexpr int PH_PER_LAYER = 16, PH_FINAL = 1 + DEPTH * PH_PER_LAYER, PH_TOTAL = PH_FINAL + 1;

#define IN(k) (lo <= (k) && (k) < hi)
template <int L>
__device__ __forceinline__ void run_layer(const P& p, float* lds, const int lo, const int hi) {
    constexpr int m = L % 3, base = 1 + L * PH_PER_LAYER, ia = L / 3;
    float* X = (float*)(p.ws + WS_X); bf16_t* H = (bf16_t*)(p.ws + WS_H);
    bf16_t* XM = (bf16_t*)(p.ws + WS_XM); float* RKV = (float*)(p.ws + WS_RKV); float* L1 = (float*)(p.ws + WS_L1);
    float* WDp = (float*)(p.ws + WS_WD); float* AAp = (float*)(p.ws + WS_AA); float* GG = (float*)(p.ws + WS_GG);
    bf16_t* YG = (bf16_t*)(p.ws + WS_YG); bf16_t* UCB = (bf16_t*)(p.ws + WS_UCB);
    bf16_t* XIN = (bf16_t*)(p.ws + WS_XIN); bf16_t* HID = (bf16_t*)(p.ws + WS_HID); float* YEXP = (float*)(p.ws + WS_YEXP); float* GATE = (float*)(p.ws + WS_GATE);
        if (IN(base + 0)) ph_norm(p, L == 0 ? p.in[I_X] : X, X, L > 0, p.in[I_NMG] + L * D, H, nullptr, nullptr, lds);
        if (m == 0) {
            if (IN(base + 1)) ph_xm(p, p.in[I_MU] + ia * 6 * D);
            if (IN(base + 2)) {
                for (int u = blockIdx.x; u < 3 * 2048 + 4 * 128 + 256; u += gridDim.x) {
                    Job j; int r = u;
                    if (r < 3 * 2048) { const int q = r / 2048; r -= q * 2048; j = mk_job(XM + (size_t)q * T * D, D, 1, p.in[I_WIN] + ((size_t)ia * 3 + q) * D * D, D, T, D, D, mk_epi(RKV + (size_t)q * T * D, D, 0, 0)); }
                    else if (r < 3 * 2048 + 4 * 128) { r -= 3 * 2048; const int jj = r / 128, z = jj & 1, isa = jj >> 1; r -= jj * 128;
                        j = mk_job(XM + (size_t)(3 + isa) * T * D, D, 1, p.in[isa ? I_A1 : I_W1] + ((size_t)ia * 2 + z) * D * 64, 64, T, 64, D, mk_epi(L1, 384, isa * 128 + z * 64, isa ? 0 : 1)); }
                    else { r -= 3 * 2048 + 4 * 128; j = mk_job(XM + (size_t)5 * T * D, D, 1, p.in[I_G1] + (size_t)ia * D * 128, 128, T, 128, D, mk_epi(L1, 384, 256, 2)); }
                    run_unit_t<true, false>(j, r, lds);
                }
            }
            if (IN(base + 3)) {
                for (int u = blockIdx.x; u < 5 * 2048; u += gridDim.x) {
                    const int jj = u / 2048, r = u - jj * 2048; Job j;
                    if (jj < 2) j = mk_job(L1 + jj * 64, 384, 0, p.in[I_W2] + ((size_t)ia * 2 + jj) * 64 * D, D, T, D, 64, mk_epi(WDp + (size_t)jj * T * D, D, 0, 3, p.in[I_W0] + ((size_t)ia * 2 + jj) * D));
                    else if (jj < 4) { const int z = jj - 2; j = mk_job(L1 + 128 + z * 64, 384, 0, p.in[I_A2] + ((size_t)ia * 2 + z) * 64 * D, D, T, D, 64, mk_epi(AAp + (size_t)z * T * D, D, 0, 2, p.in[I_A0] + ((size_t)ia * 2 + z) * D)); }
                    else j = mk_job(L1 + 256, 384, 0, p.in[I_G2] + (size_t)ia * 128 * D, D, T, D, 128, mk_epi(GG, D, 0, 0));
                    run_unit_t<false, false>(j, r, lds);
                }
            }
            if (IN(base + 4)) ph_scan(p, ia, lds);
            if (IN(base + 5)) ph_rwkv_post(p, ia);
            if (IN(base + 6)) { const Job j = mk_job(YG, D, 1, p.in[I_WOUT] + (size_t)ia * D * D, D, T, D, D, mk_epi(X, D, 0, 4)); for (int u = blockIdx.x; u < job_units(j); u += gridDim.x) run_unit_t<true, false>(j, u, lds); }
        } else if (m == 1) {
            if (IN(base + 1)) { const Job j = mk_job(H, D, 1, p.in[I_SCIN], 3 * D, T, 3 * D, D, mk_epi(RKV, 3 * D, 0, 0)); for (int u = blockIdx.x; u < job_units(j); u += gridDim.x) run_unit_t<true, false>(j, u, lds); }
            if (IN(base + 2)) ph_sc_mid(p);
            if (IN(base + 3)) { const Job j = mk_job(YG, D, 1, p.in[I_SCOUT], D, T, D, D, mk_epi(X, D, 0, 4)); for (int u = blockIdx.x; u < job_units(j); u += gridDim.x) run_unit_t<true, false>(j, u, lds); }
        } else {
            if (IN(base + 1)) { const Job j = mk_job(H, D, 1, p.in[I_LIN], 2 * D, T, 2 * D, D, mk_epi(RKV, 2 * D, 0, 0)); for (int u = blockIdx.x; u < job_units(j); u += gridDim.x) run_unit_t<true, false>(j, u, lds); }
            if (IN(base + 2)) ph_lru_conv(p);
            if (IN(base + 3)) {
                for (int u = blockIdx.x; u < 16 * 512; u += gridDim.x) {
                    const int jj = u / 512, r = u - jj * 512, g = jj >> 3, z = (jj >> 2) & 1, h = jj & 3;
                    const Job j = mk_job(UCB + h * 256, D, 1, p.in[g ? I_LWX : I_LWA] + ((size_t)z * 4 + h) * 256 * 256, 256, T, 256, 256,
                                         mk_epi((g ? AAp : WDp) + (size_t)z * T * D, D, h * 256, 2, p.in[g ? I_LBX : I_LBA] + z * D + h * 256));
                    run_unit_t<true, false>(j, r, lds);
                }
            }
            if (IN(base + 4)) ph_lru_scan(p, lds);
            if (IN(base + 5)) ph_lru_post(p);
            if (IN(base + 6)) { const Job j = mk_job(YG, D, 1, p.in[I_LOUT], D, T, D, D, mk_epi(X, D, 0, 4)); for (int u = blockIdx.x; u < job_units(j); u += gridDim.x) run_unit_t<true, false>(j, u, lds); }
        }
        if (IN(base + 7)) ph_norm(p, X, nullptr, false, p.in[I_NFG] + L * D, H, p.in[I_RW] + (size_t)L * D * NE, nullptr, lds);
        if (IN(base + 8)) ph_topk(p, lds);
        if (IN(base + 9)) {
            for (int u = blockIdx.x; u < NE * (NB * CAP / 128) * (FF / 64); u += gridDim.x) {
                const int per = (NB * CAP / 128) * (FF / 64), e = u / per;
                Job j = mk_job(XIN + (size_t)e * NB * CAP * D, D, 1, p.in[I_WG] + ((size_t)L * NE + e) * D * FF, FF, NB * CAP, FF, D, mk_epi(nullptr, FF, 0, 5, nullptr, HID + (size_t)e * NB * CAP * FF),
                               p.in[I_WU] + ((size_t)L * NE + e) * D * FF);
                run_unit_t<true, true>(j, u % per, lds);
            }
        }
        if (IN(base + 10)) {
            for (int u = blockIdx.x; u < NE * (NB * CAP / 128) * (D / 64); u += gridDim.x) {
                const int per = (NB * CAP / 128) * (D / 64), e = u / per;
                Job j = mk_job(HID + (size_t)e * NB * CAP * FF, FF, 1, p.in[I_WDN] + ((size_t)L * NE + e) * FF * D, D, NB * CAP, D, FF,
                               mk_epi(YEXP + (size_t)e * NB * CAP * D, D, 0, 6, nullptr, nullptr, GATE + (size_t)e * NB * CAP));
                run_unit_t<true, false>(j, u % per, lds);
            }
        }
}

__global__ void __launch_bounds__(NTHR, 2) mega(P p) {
    extern __shared__ __attribute__((aligned(16))) unsigned char lds_raw[];
    float* lds = (float*)lds_raw;
    const int lo = p.ph_lo, hi = p.ph_hi;
    run_layer<0>(p, lds, lo, hi);
    run_layer<1>(p, lds, lo, hi);
    run_layer<2>(p, lds, lo, hi);
    run_layer<3>(p, lds, lo, hi);
    if (IN(PH_FINAL)) ph_norm(p, (const float*)(p.ws + WS_X), nullptr, true, p.in[I_FNG], nullptr, nullptr, p.out, lds);
}
#undef IN

constexpr int LDS_BYTES = 64 * 1024 + 16 * 1024;
}

extern "C" void kernel_launch(void* const* d_in, const int* in_sizes, int n_in, void* d_out, int out_size, void* d_ws, size_t ws_size, hipStream_t stream) {
    static int ready = 0;
    if (!ready) {
        if (n_in != 36 || out_size != T * D || ws_size < WS_END) { fprintf(stderr, "kernel_launch: unexpected problem (n_in %d out %d ws %zu need %zu)\n", n_in, out_size, ws_size, (size_t)WS_END); ready = -1; return; }
        if (hipFuncSetAttribute((const void*)mega, hipFuncAttributeMaxDynamicSharedMemorySize, LDS_BYTES) != hipSuccess) { fprintf(stderr, "kernel_launch: hipFuncSetAttribute failed\n"); ready = -1; return; }
        ready = 1;
    }
    if (ready < 0) return;
    (void)in_sizes;
    P p{};
    for (int i = 0; i < 36; ++i) p.in[i] = (const float*)d_in[i];
    p.out = (float*)d_out; p.ws = (unsigned char*)d_ws;
    for (int L = 0; L < DEPTH; ++L) {
        const int m = L % 3, base = 1 + L * PH_PER_LAYER;
        const int nmix = (m == 1) ? 4 : 7;
        for (int k = 0; k < nmix; ++k) { p.ph_lo = base + k; p.ph_hi = base + k + 1; hipLaunchKernelGGL(mega, dim3(256), dim3(NTHR), LDS_BYTES, stream, p); }
        for (int k = 7; k <= 10; ++k) { p.ph_lo = base + k; p.ph_hi = base + k + 1; hipLaunchKernelGGL(mega, dim3(256), dim3(NTHR), LDS_BYTES, stream, p); }
    }
    p.ph_lo = PH_FINAL; p.ph_hi = PH_FINAL + 1; hipLaunchKernelGGL(mega, dim3(256), dim3(NTHR), LDS_BYTES, stream, p);
}
```

```cpp
#include <hip/hip_runtime.h>
#include <stdint.h>
#include <stdio.h>

namespace {
constexpr int D = 1024, NB = 8, S = 2048, T = NB * S, DEPTH = 4, NE = 16, FF = 2048, CAP = 256, NH = 16, HD = 64;
constexpr int NTHR = 512;
constexpr float RMS_EPS = 1e-6f, LNX_EPS = 64e-5f;
typedef unsigned short bf16_t;

constexpr size_t MiB = 1u << 20;
constexpr size_t WS_CTL = 0;
constexpr size_t WS_X = 1 * MiB;
constexpr size_t WS_H = WS_X + 64 * MiB;
constexpr size_t WS_XM = WS_H + 32 * MiB;
constexpr size_t WS_RKV = WS_XM + 192 * MiB;
constexpr size_t WS_L1 = WS_RKV + 192 * MiB;
constexpr size_t WS_WD = WS_L1 + 24 * MiB;
constexpr size_t WS_AA = WS_WD + 128 * MiB;
constexpr size_t WS_GG = WS_AA + 128 * MiB;
constexpr size_t WS_YS = WS_GG + 64 * MiB;
constexpr size_t WS_YG = WS_YS + 128 * MiB;
constexpr size_t WS_UCB = WS_YG + 32 * MiB;
constexpr size_t WS_YEXP = WS_UCB + 32 * MiB;
constexpr size_t WS_AFF = WS_YEXP + 128 * MiB;
constexpr size_t WS_SLOT = WS_AFF + 1 * MiB;
constexpr size_t WS_GATE = WS_SLOT + 1 * MiB;
constexpr size_t WS_END = WS_GATE + 1 * MiB;
constexpr size_t WS_XIN = WS_XM, WS_HID = WS_XM + 64 * MiB;

struct P {
    const float* in[36];
    float* out;
    unsigned char* ws;
    int ph_lo, ph_hi;
};

enum { I_X = 0, I_NMG, I_NFG, I_RW, I_WG, I_WU, I_WDN, I_FNG, I_MU, I_WIN, I_W0, I_W1, I_W2, I_A0, I_A1, I_A2, I_G1, I_G2, I_KK, I_KA, I_RK, I_LNG, I_LNB, I_WOUT,
       I_SCIN, I_SCCW, I_SCOUT, I_LIN, I_LCW, I_LCB, I_LWA, I_LBA, I_LWX, I_LBX, I_LLAM, I_LOUT };

__device__ __forceinline__ float bf2f(bf16_t v) { return __uint_as_float((unsigned)v << 16); }
__device__ __forceinline__ bf16_t f2bf(float f) { unsigned u = __float_as_uint(f); u += 0x7FFFu + ((u >> 16) & 1u); return (bf16_t)(u >> 16); }
__device__ __forceinline__ void bf4_to_f(uint2 u, float* f) { f[0] = __uint_as_float(u.x << 16); f[1] = __uint_as_float(u.x & 0xffff0000u); f[2] = __uint_as_float(u.y << 16); f[3] = __uint_as_float(u.y & 0xffff0000u); }
__device__ __forceinline__ uint2 f4_to_bf(float a, float b, float c, float d) { return make_uint2((unsigned)f2bf(a) | ((unsigned)f2bf(b) << 16), (unsigned)f2bf(c) | ((unsigned)f2bf(d) << 16)); }
__device__ __forceinline__ float wave_sum(float v) { for (int o = 32; o >= 1; o >>= 1) v += __shfl_xor(v, o); return v; }
__device__ __forceinline__ float quad_sum(float v) { v += __shfl_xor(v, 1); v += __shfl_xor(v, 2); return v; }
__device__ __forceinline__ float sigmoidf_(float x) { return 1.0f / (1.0f + __expf(-x)); }
__device__ __forceinline__ float softplusf_(float y) { return fmaxf(y, 0.f) + log1pf(__expf(-fabsf(y))); }
__device__ __forceinline__ float gelu_tanh(float x) { const float u = 0.7978845608028654f * (x + 0.044715f * x * x * x); return 0.5f * x * (1.0f + tanhf(u)); }

__device__ __forceinline__ void ph_norm(const P& p, const float* xin, float* xout, bool combine, const float* gamma, bf16_t* hout, const float* router_w, float* fout, float* lds) {
    const int tid = threadIdx.x, lane = tid & 63, wave = tid >> 6;
    if (router_w) {
        for (int i = tid; i < D * NE; i += NTHR) { const int d = i >> 4, e = i & 15; lds[e * D + d] = router_w[i]; }
        __syncthreads();
    }
    const float* yexp = (const float*)(p.ws + WS_YEXP); const int* slot = (const int*)(p.ws + WS_SLOT);
    float* aff = (float*)(p.ws + WS_AFF);
    for (int tok = blockIdx.x * 8 + wave; tok < T; tok += gridDim.x * 8) {
        const int b = tok / S, s = tok % S;
        float4 x[4];
#pragma unroll
        for (int i = 0; i < 4; ++i) x[i] = ((const float4*)(xin + (size_t)tok * D))[i * 64 + lane];
        if (combine) {
            for (int e = 0; e < NE; ++e) {
                const int sl = slot[tok * NE + e];
                if (sl >= 0) {
                    const float4* row = (const float4*)(yexp + ((size_t)(e * NB + b) * CAP + sl) * D);
#pragma unroll
                    for (int i = 0; i < 4; ++i) { const float4 r = row[i * 64 + lane]; x[i].x += r.x; x[i].y += r.y; x[i].z += r.z; x[i].w += r.w; }
                }
            }
        }
        if (xout) {
#pragma unroll
            for (int i = 0; i < 4; ++i) ((float4*)(xout + (size_t)tok * D))[i * 64 + lane] = x[i];
        }
        float ss = 0.f;
#pragma unroll
        for (int i = 0; i < 4; ++i) ss += x[i].x * x[i].x + x[i].y * x[i].y + x[i].z * x[i].z + x[i].w * x[i].w;
        ss = wave_sum(ss);
        const float rstd = 1.0f / sqrtf(ss * (1.0f / D) + RMS_EPS);
        float4 h[4];
#pragma unroll
        for (int i = 0; i < 4; ++i) {
            const float4 g = ((const float4*)gamma)[i * 64 + lane];
            h[i].x = x[i].x * rstd * g.x; h[i].y = x[i].y * rstd * g.y; h[i].z = x[i].z * rstd * g.z; h[i].w = x[i].w * rstd * g.w;
        }
        if (hout) {
#pragma unroll
            for (int i = 0; i < 4; ++i) ((uint2*)(hout + (size_t)tok * D))[i * 64 + lane] = f4_to_bf(h[i].x, h[i].y, h[i].z, h[i].w);
        }
        if (fout) {
#pragma unroll
            for (int i = 0; i < 4; ++i) ((float4*)(fout + (size_t)tok * D))[i * 64 + lane] = h[i];
        }
        if (router_w) {
            float mylg = -3.0e38f;
#pragma unroll 1
            for (int e = 0; e < NE; ++e) {
                float a = 0.f;
#pragma unroll
                for (int i = 0; i < 4; ++i) { const float4 w = ((const float4*)(lds + e * D))[i * 64 + lane]; a += h[i].x * w.x + h[i].y * w.y + h[i].z * w.z + h[i].w * w.w; }
                a = wave_sum(a);
                if (lane == e) mylg = a;
            }
            float mx = mylg;
#pragma unroll
            for (int o = 1; o < 16; o <<= 1) mx = fmaxf(mx, __shfl_xor(mx, o));
            const float mine = (lane < NE) ? __expf(mylg - mx) : 0.f;
            float sum = mine;
#pragma unroll
            for (int o = 1; o < 16; o <<= 1) sum += __shfl_xor(sum, o);
            if (lane < NE) aff[((size_t)b * NE + lane) * S + s] = mine / sum;
        }
    }
}

__device__ __forceinline__ void ph_xm(const P& p, const float* mu) {
    const int tid = threadIdx.x, lane = tid & 63, wave = tid >> 6;
    const bf16_t* H = (const bf16_t*)(p.ws + WS_H); bf16_t* XM = (bf16_t*)(p.ws + WS_XM);
    for (int tok = blockIdx.x * 8 + wave; tok < T; tok += gridDim.x * 8) {
        const int s = tok % S;
#pragma unroll
        for (int i = 0; i < 4; ++i) {
            const int c4 = i * 64 + lane;
            float hc[4], hp[4] = {0.f, 0.f, 0.f, 0.f}, hn[4] = {0.f, 0.f, 0.f, 0.f};
            bf4_to_f(((const uint2*)(H + (size_t)tok * D))[c4], hc);
            if (s > 0) bf4_to_f(((const uint2*)(H + (size_t)(tok - 1) * D))[c4], hp);
            if (s < S - 1) bf4_to_f(((const uint2*)(H + (size_t)(tok + 1) * D))[c4], hn);
            float xx[4];
#pragma unroll
            for (int j = 0; j < 4; ++j) xx[j] = 0.5f * (hp[j] + hn[j]) - hc[j];
#pragma unroll
            for (int q = 0; q < 6; ++q) {
                const float4 m = ((const float4*)(mu + q * D))[c4];
                ((uint2*)(XM + ((size_t)q * T + tok) * D))[c4] = f4_to_bf(hc[0] + xx[0] * m.x, hc[1] + xx[1] * m.y, hc[2] + xx[2] * m.z, hc[3] + xx[3] * m.w);
            }
        }
    }
}

struct EpiG {
    float* C; bf16_t* Cb; const float* bias; const float* rowscale; int ldc; int coloff; int mode;
    __device__ __forceinline__ void operator()(int m, int n, float v, float v2) const {
        const size_t o = (size_t)m * ldc + coloff + n;
        switch (mode) {
            case 0: C[o] = v; break;
            case 1: C[o] = tanhf(v); break;
            case 2: C[o] = sigmoidf_(v + (bias ? bias[n] : 0.f)); break;
            case 3: { const float x = v + bias[n]; const float wl = -softplusf_(-x) - 0.5f; C[o] = __expf(-__expf(wl)); } break;
            case 4: C[o] += v; break;
            case 5: Cb[o] = f2bf(v * sigmoidf_(v) * v2); break;
            case 6: C[o] = v * rowscale[m]; break;
        }
    }
};

template <bool A_BF16, bool DUAL>
__device__ __forceinline__ void gemm_tile_naive(const void* Aptr, size_t lda, const float* W, const float* W2, size_t ldw, int K, int m0, int n0, float* lds, const EpiG& epi) {
    float (*As)[132] = (float (*)[132])lds;
    float (*Bs)[64] = (float (*)[64])(lds + 16 * 132);
    float (*Bs2)[64] = (float (*)[64])(lds + 16 * 132 + 16 * 64);
    const int tid = threadIdx.x, ty = tid >> 4, tx = tid & 15;
    float acc[4][4], acc2[4][4];
#pragma unroll
    for (int i = 0; i < 4; ++i)
#pragma unroll
        for (int j = 0; j < 4; ++j) { acc[i][j] = 0.f; acc2[i][j] = 0.f; }
    const int am = tid >> 2, ak = (tid & 3) * 4;
    const int bk = (tid & 255) >> 4, bn = (tid & 15) * 4;
    for (int k0 = 0; k0 < K; k0 += 16) {
        float a[4];
        if (A_BF16) { const uint2 u = *(const uint2*)((const bf16_t*)Aptr + (size_t)(m0 + am) * lda + k0 + ak); bf4_to_f(u, a); }
        else { const float4 v = *(const float4*)((const float*)Aptr + (size_t)(m0 + am) * lda + k0 + ak); a[0] = v.x; a[1] = v.y; a[2] = v.z; a[3] = v.w; }
        float4 bv = make_float4(0.f, 0.f, 0.f, 0.f);
        if (tid < 256) bv = *(const float4*)(W + (size_t)(k0 + bk) * ldw + n0 + bn);
        else if (DUAL) bv = *(const float4*)(W2 + (size_t)(k0 + bk) * ldw + n0 + bn);
        __syncthreads();
#pragma unroll
        for (int j = 0; j < 4; ++j) As[ak + j][am] = a[j];
        if (tid < 256) *(float4*)&Bs[bk][bn] = bv; else if (DUAL) *(float4*)&Bs2[bk][bn] = bv;
        __syncthreads();
#pragma unroll
        for (int k = 0; k < 16; ++k) {
            const float4 av = *(const float4*)&As[k][ty * 4]; const float4 b4 = *(const float4*)&Bs[k][tx * 4];
            const float aa[4] = {av.x, av.y, av.z, av.w}, bb[4] = {b4.x, b4.y, b4.z, b4.w};
#pragma unroll
            for (int i = 0; i < 4; ++i)
#pragma unroll
                for (int j = 0; j < 4; ++j) acc[i][j] += aa[i] * bb[j];
            if (DUAL) {
                const float4 c4 = *(const float4*)&Bs2[k][tx * 4]; const float cc[4] = {c4.x, c4.y, c4.z, c4.w};
#pragma unroll
                for (int i = 0; i < 4; ++i)
#pragma unroll
                    for (int j = 0; j < 4; ++j) acc2[i][j] += aa[i] * cc[j];
            }
        }
    }
    __syncthreads();
#pragma unroll
    for (int i = 0; i < 4; ++i)
#pragma unroll
        for (int j = 0; j < 4; ++j) epi(m0 + ty * 4 + i, n0 + tx * 4 + j, acc[i][j], acc2[i][j]);
}

struct Job { const void* A; const float* W; const float* W2; int lda, ldw, M, N, K, a_bf16; EpiG epi; };
__device__ __forceinline__ int job_units(const Job& j) { return (j.M / 128) * (j.N / 64); }
template <bool A_BF16, bool DUAL>
__device__ __forceinline__ void run_unit_t(const Job& j, int u, float* lds) {
    const int nn = j.N / 64, m0 = (u / nn) * 128, n0 = (u % nn) * 64;
    gemm_tile_naive<A_BF16, DUAL>(j.A, j.lda, j.W, j.W2, j.ldw, j.K, m0, n0, lds, j.epi);
}
__device__ __forceinline__ EpiG mk_epi(float* C, int ldc, int coloff, int mode, const float* bias = nullptr, bf16_t* Cb = nullptr, const float* rs = nullptr) {
    EpiG e; e.C = C; e.Cb = Cb; e.bias = bias; e.rowscale = rs; e.ldc = ldc; e.coloff = coloff; e.mode = mode; return e;
}
__device__ __forceinline__ Job mk_job(const void* A, int lda, int a_bf16, const float* W, int ldw, int M, int N, int K, EpiG e, const float* W2 = nullptr) {
    Job j; j.A = A; j.W = W; j.W2 = W2; j.lda = lda; j.ldw = ldw; j.M = M; j.N = N; j.K = K; j.a_bf16 = a_bf16; j.epi = e; return j;
}

constexpr int LDS_BYTES = 64 * 1024 + 16 * 1024;
constexpr int SCH = 32;
__device__ __forceinline__ void ph_scan(const P& p, int ia, float* lds) {
    const int tid = threadIdx.x, lane = tid & 63;
    const float* RKV = (const float*)(p.ws + WS_RKV); const float* WDp = (const float*)(p.ws + WS_WD); const float* AAp = (const float*)(p.ws + WS_AA);
    float* YS = (float*)(p.ws + WS_YS);
    const float* k_k = p.in[I_KK] + ia * D; const float* k_a = p.in[I_KA] + ia * D;
    float* vkk = lds;
    float* vw = vkk + SCH * 64; float* vb = vw + SCH * 64; float* vkd = vb + SCH * 64; float* vr = vkd + SCH * 64; float* vv = vr + SCH * 64; float* ybuf = vv + SCH * 64;
    for (int unit = blockIdx.x; unit < NB * NH * 2; unit += gridDim.x) {
        const int z = unit & 1, h = (unit >> 1) % NH, b = unit / (2 * NH);
        const int vrow = tid >> 2, q = tid & 3;
        float St[16];
#pragma unroll
        for (int j = 0; j < 16; ++j) St[j] = 0.f;
        for (int c = 0; c < S / SCH; ++c) {
#pragma unroll
            for (int jj = 0; jj < SCH * 64 / NTHR; ++jj) {
                const int idx = tid + jj * NTHR, i = idx >> 6, k = idx & 63;
                const int step = c * SCH + i, t = z ? (S - 1 - step) : step;
                const size_t o = ((size_t)b * S + t) * D + h * HD + k;
                const float rk = RKV[o], kv = RKV[(size_t)T * D + o], vvv = RKV[2 * (size_t)T * D + o];
                const float wv = WDp[(size_t)z * T * D + o], av = AAp[(size_t)z * T * D + o];
                const float kkr = kv * k_k[h * HD + k];
                const float ss = wave_sum(kkr * kkr);
                const float kkn = kkr / fmaxf(sqrtf(ss), 1e-12f);
                vkk[idx] = kkn; vw[idx] = wv; vb[idx] = kkn * av; vkd[idx] = kv * (1.0f + (av - 1.0f) * k_a[h * HD + k]); vr[idx] = rk; vv[idx] = vvv;
            }
            __syncthreads();
            if (tid < 256) {
                for (int i = 0; i < SCH; ++i) {
                    const float* pk = vkk + i * 64 + q * 16; const float* pw = vw + i * 64 + q * 16; const float* pb = vb + i * 64 + q * 16;
                    const float* pd = vkd + i * 64 + q * 16; const float* pr = vr + i * 64 + q * 16;
                    const float vval = vv[i * 64 + vrow];
                    float sa = 0.f;
#pragma unroll
                    for (int j = 0; j < 16; ++j) sa += St[j] * pk[j];
                    sa = quad_sum(sa);
                    float y = 0.f;
#pragma unroll
                    for (int j = 0; j < 16; ++j) { St[j] = St[j] * pw[j] - sa * pb[j] + vval * pd[j]; y += St[j] * pr[j]; }
                    y = quad_sum(y);
                    if (q == 0) ybuf[i * 64 + vrow] = y;
                }
            }
            __syncthreads();
#pragma unroll
            for (int jj = 0; jj < SCH * 64 / NTHR; ++jj) {
                const int idx = tid + jj * NTHR, i = idx >> 6, k = idx & 63;
                const int step = c * SCH + i, t = z ? (S - 1 - step) : step;
                YS[(size_t)z * T * D + ((size_t)b * S + t) * D + h * HD + k] = ybuf[idx];
            }
        }
        __syncthreads();
    }
    (void)lane;
}

__device__ __forceinline__ void ph_rwkv_post(const P& p, int ia) {
    const int tid = threadIdx.x, lane = tid & 63, wave = tid >> 6;
    const float* RKV = (const float*)(p.ws + WS_RKV); const float* AAp = (const float*)(p.ws + WS_AA); const float* GG = (const float*)(p.ws + WS_GG);
    const float* YS = (const float*)(p.ws + WS_YS); bf16_t* YG = (bf16_t*)(p.ws + WS_YG);
    const float* k_a = p.in[I_KA] + ia * D; const float* r_k = p.in[I_RK] + ia * D; const float* lg = p.in[I_LNG] + ia * D; const float* lb = p.in[I_LNB] + ia * D;
    for (int tok = blockIdx.x * 8 + wave; tok < T; tok += gridDim.x * 8) {
        const size_t o = (size_t)tok * D + lane * 16;
        float y[16], r[16], k[16], v[16], a0[16], a1[16];
#pragma unroll
        for (int j = 0; j < 4; ++j) {
            const float4 y0 = ((const float4*)(YS + o))[j], y1 = ((const float4*)(YS + (size_t)T * D + o))[j];
            y[4 * j] = y0.x + y1.x; y[4 * j + 1] = y0.y + y1.y; y[4 * j + 2] = y0.z + y1.z; y[4 * j + 3] = y0.w + y1.w;
            const float4 rr = ((const float4*)(RKV + o))[j], kk = ((const float4*)(RKV + (size_t)T * D + o))[j], vv = ((const float4*)(RKV + 2 * (size_t)T * D + o))[j];
            r[4 * j] = rr.x; r[4 * j + 1] = rr.y; r[4 * j + 2] = rr.z; r[4 * j + 3] = rr.w;
            k[4 * j] = kk.x; k[4 * j + 1] = kk.y; k[4 * j + 2] = kk.z; k[4 * j + 3] = kk.w;
            v[4 * j] = vv.x; v[4 * j + 1] = vv.y; v[4 * j + 2] = vv.z; v[4 * j + 3] = vv.w;
            const float4 p0 = ((const float4*)(AAp + o))[j], p1 = ((const float4*)(AAp + (size_t)T * D + o))[j];
            a0[4 * j] = p0.x; a0[4 * j + 1] = p0.y; a0[4 * j + 2] = p0.z; a0[4 * j + 3] = p0.w;
            a1[4 * j] = p1.x; a1[4 * j + 1] = p1.y; a1[4 * j + 2] = p1.z; a1[4 * j + 3] = p1.w;
        }
        float sm = 0.f;
#pragma unroll
        for (int j = 0; j < 16; ++j) sm += y[j];
        const float mean = quad_sum(sm) * (1.0f / 64.0f);
        float sv = 0.f;
#pragma unroll
        for (int j = 0; j < 16; ++j) { const float d = y[j] - mean; sv += d * d; }
        const float rstd = 1.0f / sqrtf(quad_sum(sv) * (1.0f / 64.0f) + LNX_EPS);
        float d0 = 0.f, d1 = 0.f;
#pragma unroll
        for (int j = 0; j < 16; ++j) {
            const int c = lane * 16 + j; const float ka = k_a[c], rk = r_k[c];
            d0 += r[j] * (k[j] * (1.0f + (a0[j] - 1.0f) * ka)) * rk;
            d1 += r[j] * (k[j] * (1.0f + (a1[j] - 1.0f) * ka)) * rk;
        }
        const float bon = quad_sum(d0) + quad_sum(d1);
        float outv[16];
#pragma unroll
        for (int j = 0; j < 16; ++j) { const int c = lane * 16 + j; outv[j] = ((y[j] - mean) * rstd * lg[c] + lb[c] + bon * v[j]) * GG[o + j]; }
#pragma unroll
        for (int j = 0; j < 4; ++j) ((uint2*)(YG + o))[j] = f4_to_bf(outv[4 * j], outv[4 * j + 1], outv[4 * j + 2], outv[4 * j + 3]);
    }
}

__device__ __forceinline__ void ph_sc_mid(const P& p) {
    const int tid = threadIdx.x, lane = tid & 63, wave = tid >> 6;
    const float* BCU = (const float*)(p.ws + WS_RKV); bf16_t* BZ = (bf16_t*)(p.ws + WS_YG); const float* cw = p.in[I_SCCW];
    for (int tok = blockIdx.x * 8 + wave; tok < T; tok += gridDim.x * 8) {
        const int s = tok % S;
#pragma unroll
        for (int i = 0; i < 4; ++i) {
            const int c4 = i * 64 + lane;
            float z[4] = {0.f, 0.f, 0.f, 0.f};
#pragma unroll
            for (int j = 0; j < 3; ++j) {
                const int ss = s + j - 1;
                if (ss >= 0 && ss < S) {
                    const size_t ro = (size_t)(tok + j - 1) * (3 * D);
                    const float4 c = ((const float4*)(BCU + ro + D))[c4], u = ((const float4*)(BCU + ro + 2 * D))[c4], w = ((const float4*)(cw + j * D))[c4];
                    z[0] += w.x * c.x * u.x; z[1] += w.y * c.y * u.y; z[2] += w.z * c.z * u.z; z[3] += w.w * c.w * u.w;
                }
            }
            const float4 bg = ((const float4*)(BCU + (size_t)tok * (3 * D)))[c4];
            ((uint2*)(BZ + (size_t)tok * D))[c4] = f4_to_bf(bg.x * z[0], bg.y * z[1], bg.z * z[2], bg.w * z[3]);
        }
    }
}

__device__ __forceinline__ void ph_lru_conv(const P& p) {
    const int tid = threadIdx.x, lane = tid & 63, wave = tid >> 6;
    const float* GU = (const float*)(p.ws + WS_RKV); float* UC = (float*)(p.ws + WS_GG); bf16_t* UCB = (bf16_t*)(p.ws + WS_UCB);
    const float* cw = p.in[I_LCW]; const float* cb = p.in[I_LCB];
    for (int tok = blockIdx.x * 8 + wave; tok < T; tok += gridDim.x * 8) {
        const int s = tok % S;
#pragma unroll
        for (int i = 0; i < 4; ++i) {
            const int c4 = i * 64 + lane;
            float4 acc = ((const float4*)cb)[c4];
#pragma unroll
            for (int j = 0; j < 4; ++j) {
                const int ss = s + j - 2;
                if (ss >= 0 && ss < S) {
                    const float4 u = ((const float4*)(GU + (size_t)(tok + j - 2) * (2 * D) + D))[c4], w = ((const float4*)(cw + j * D))[c4];
                    acc.x += w.x * u.x; acc.y += w.y * u.y; acc.z += w.z * u.z; acc.w += w.w * u.w;
                }
            }
            ((float4*)(UC + (size_t)tok * D))[c4] = acc;
            ((uint2*)(UCB + (size_t)tok * D))[c4] = f4_to_bf(acc.x, acc.y, acc.z, acc.w);
        }
    }
}

__device__ __forceinline__ void ph_lru_scan(const P& p, float* lds) {
    const int tid = threadIdx.x;
    const float* RG = (const float*)(p.ws + WS_WD); const float* IG = (const float*)(p.ws + WS_AA); const float* UC = (const float*)(p.ws + WS_GG);
    float* HS = (float*)(p.ws + WS_YS);
    float* segP = lds; float* segH = lds + 512;
    const int ch = tid & 31, seg = tid >> 5;
    for (int unit = blockIdx.x; unit < NB * 2 * 32; unit += gridDim.x) {
        const int cg = unit & 31, z = (unit >> 5) & 1, b = unit >> 6;
        const int c = cg * 32 + ch;
        const float sp = softplusf_(-p.in[I_LLAM][z * D + c]);
        const float* rg = RG + (size_t)z * T * D; const float* ig = IG + (size_t)z * T * D;
        float Pm = 1.f, h = 0.f;
        for (int i = seg * 128; i < seg * 128 + 128; ++i) {
            const int t = z ? (S - 1 - i) : i; const size_t o = ((size_t)b * S + t) * D + c;
            const float la = -8.0f * rg[o] * sp; const float a = __expf(la); const float bb = sqrtf(-expm1f(2.0f * la)) * (ig[o] * UC[o]);
            h = a * h + bb; Pm *= a;
        }
        segP[seg * 32 + ch] = Pm; segH[seg * 32 + ch] = h;
        __syncthreads();
        float carry = 0.f;
        for (int s2 = 0; s2 < seg; ++s2) carry = segP[s2 * 32 + ch] * carry + segH[s2 * 32 + ch];
        h = carry;
        for (int i = seg * 128; i < seg * 128 + 128; ++i) {
            const int t = z ? (S - 1 - i) : i; const size_t o = ((size_t)b * S + t) * D + c;
            const float la = -8.0f * rg[o] * sp; const float a = __expf(la); const float bb = sqrtf(-expm1f(2.0f * la)) * (ig[o] * UC[o]);
            h = a * h + bb;
            HS[(size_t)z * T * D + o] = h;
        }
        __syncthreads();
    }
}

__device__ __forceinline__ void ph_lru_post(const P& p) {
    const int tid = threadIdx.x, lane = tid & 63, wave = tid >> 6;
    const float* GU = (const float*)(p.ws + WS_RKV); const float* HS = (const float*)(p.ws + WS_YS); bf16_t* YL = (bf16_t*)(p.ws + WS_YG);
    for (int tok = blockIdx.x * 8 + wave; tok < T; tok += gridDim.x * 8) {
#pragma unroll
        for (int i = 0; i < 4; ++i) {
            const int c4 = i * 64 + lane;
            const float4 g = ((const float4*)(GU + (size_t)tok * (2 * D)))[c4];
            const float4 h0 = ((const float4*)(HS + (size_t)tok * D))[c4], h1 = ((const float4*)(HS + (size_t)T * D + (size_t)tok * D))[c4];
            ((uint2*)(YL + (size_t)tok * D))[c4] = f4_to_bf((h0.x + h1.x) * gelu_tanh(g.x), (h0.y + h1.y) * gelu_tanh(g.y), (h0.z + h1.z) * gelu_tanh(g.z), (h0.w + h1.w) * gelu_tanh(g.w));
        }
    }
}

__device__ __forceinline__ int block_sum_i(int v, int* wsum  ) {
    const int lane = threadIdx.x & 63, wave = threadIdx.x >> 6;
    for (int o = 32; o >= 1; o >>= 1) v += __shfl_xor(v, o);
    if (lane == 0) wsum[wave] = v;
    __syncthreads();
    int tot = 0;
#pragma unroll
    for (int w = 0; w < 8; ++w) tot += wsum[w];
    return tot;
}
__device__ __forceinline__ int block_excl_scan_i(int v, int* wsum  , int& total) {
    const int lane = threadIdx.x & 63, wave = threadIdx.x >> 6;
    int inc = v;
    for (int o = 1; o < 64; o <<= 1) { const int t = __shfl_up(inc, o); if (lane >= o) inc += t; }
    if (lane == 63) wsum[wave] = inc;
    __syncthreads();
    int base = 0, tot = 0;
#pragma unroll
    for (int w = 0; w < 8; ++w) { const int x = wsum[w]; if (w < wave) base += x; tot += x; }
    total = tot;
    return base + inc - v;
}
__device__ __forceinline__ void ph_topk(const P& p, float* ldsf) {
    const int tid = threadIdx.x, lane = tid & 63, wave = tid >> 6;
    int* ldsi = (int*)ldsf;
    int* wsum = ldsi;
    int* idx_l = ldsi + 64;
    const float* aff = (const float*)(p.ws + WS_AFF); int* slot = (int*)(p.ws + WS_SLOT); float* gate = (float*)(p.ws + WS_GATE);
    const bf16_t* HF = (const bf16_t*)(p.ws + WS_H); bf16_t* XIN = (bf16_t*)(p.ws + WS_XIN);
    for (int unit = blockIdx.x; unit < NB * NE; unit += gridDim.x) {
        const int e = unit % NE, b = unit / NE;
        const float4 v4 = ((const float4*)(aff + ((size_t)b * NE + e) * S))[tid];
        const unsigned v[4] = {__float_as_uint(v4.x), __float_as_uint(v4.y), __float_as_uint(v4.z), __float_as_uint(v4.w)};
        unsigned thr = 0u;
        for (int bit = 31; bit >= 0; --bit) {
            const unsigned cand = thr | (1u << bit);
            const int cnt = (int)(v[0] >= cand) + (int)(v[1] >= cand) + (int)(v[2] >= cand) + (int)(v[3] >= cand);
            const int tot = block_sum_i(cnt, wsum + (bit & 1) * 8);
            if (tot >= CAP) thr = cand;
        }
        int g4 = 0, e4 = 0;
#pragma unroll
        for (int j = 0; j < 4; ++j) { g4 += (int)(v[j] > thr); e4 += (int)(v[j] == thr); }
        const int ngt = block_sum_i(g4, wsum + 16);
        const int need_eq = CAP - ngt;
        int toteq; const int eqbase = block_excl_scan_i(e4, wsum + 24, toteq);
        int sel[4], nsel = 0, er = eqbase;
#pragma unroll
        for (int j = 0; j < 4; ++j) { const bool gt = v[j] > thr, eq = v[j] == thr; sel[j] = (gt || (eq && er < need_eq)) ? 1 : 0; er += eq ? 1 : 0; nsel += sel[j]; }
        __syncthreads();
        int totsel; int cpos = block_excl_scan_i(nsel, wsum, totsel);
#pragma unroll
        for (int j = 0; j < 4; ++j) {
            const int t = tid * 4 + j;
            if (sel[j]) {
                if (cpos < CAP) { idx_l[cpos] = t; gate[((size_t)e * NB + b) * CAP + cpos] = __uint_as_float(v[j]); slot[((size_t)b * S + t) * NE + e] = cpos; }
                else slot[((size_t)b * S + t) * NE + e] = -1;
                ++cpos;
            } else slot[((size_t)b * S + t) * NE + e] = -1;
        }
        __syncthreads();
        for (int c = wave; c < CAP; c += 8) {
            const uint4* src = (const uint4*)(HF + ((size_t)b * S + idx_l[c]) * D);
            uint4* dst = (uint4*)(XIN + (((size_t)e * NB + b) * CAP + c) * D);
            dst[lane] = src[lane]; dst[lane + 64] = src[lane + 64];
        }
        __syncthreads();
    }
}


#define XB_TMO      128
#define XB_XCNT(j)  (256  + 64 * (j))
#define XB_XSUB(j)  (1280 + 64 * (j))
#define XB_XGEN(j)  (2304 + 64 * (j))
#define XB_TOP      3328
#define XB_TOPGEN   3392
#define XCD_BAR_WORDS 3456
#define XB_SPIN_CAP (1u << 22)
#define LAS __attribute__((address_space(3)))
__device__ __forceinline__ unsigned xb_ld(unsigned* p)              { return __hip_atomic_load(p, __ATOMIC_RELAXED, __HIP_MEMORY_SCOPE_AGENT); }
__device__ __forceinline__ unsigned xb_add(unsigned* p, unsigned v) { return __hip_atomic_fetch_add(p, v, __ATOMIC_RELAXED, __HIP_MEMORY_SCOPE_AGENT); }
__device__ __forceinline__ unsigned xb_xcc_id() { return (unsigned)__builtin_amdgcn_s_getreg((3 << 11) | 20) & 0xFu; }
#define XB_SPIN(cond, bar) do { unsigned _sp = 0; while (cond) { __builtin_amdgcn_s_sleep(1); \
    if ((++_sp & 255u) == 0u) { if (xb_ld(&(bar)[XB_TMO])) break; if (_sp > XB_SPIN_CAP) { atomicAdd(&(bar)[XB_TMO], 1u); break; } } } } while (0)
struct XcdBarrier { unsigned* bar; unsigned x; volatile LAS unsigned* st; };
__device__ __forceinline__ XcdBarrier xcd_barrier_post(unsigned* bar, volatile LAS unsigned* st) {
    XcdBarrier b; b.bar = bar; b.x = xb_xcc_id(); b.st = st;
    if (threadIdx.x == 0) (void)xb_add(&bar[XB_XCNT(b.x)], 1u);
    return b;
}
__device__ __forceinline__ void xcd_barrier_complete(unsigned* bar, unsigned x, unsigned& nloc, unsigned& nx) {
    const unsigned G = gridDim.x * gridDim.y * gridDim.z;
    unsigned sum, cnt, mine, sp = 0u;
    for (;;) {
        sum = 0u; cnt = 0u; mine = 0u;
#pragma unroll
        for (unsigned j = 0; j < 16; ++j) { const unsigned c = xb_ld(&bar[XB_XCNT(j)]); sum += c; cnt += (c > 0u) ? 1u : 0u; mine = (j == x) ? c : mine; }
        if (sum == G) break;
        __builtin_amdgcn_s_sleep(1);
        if ((++sp & 255u) == 0u) { if (xb_ld(&bar[XB_TMO])) break; if (sp > XB_SPIN_CAP) { atomicAdd(&bar[XB_TMO], 1u); break; } }
    }
    nloc = mine > 0u ? mine : 1u; nx = cnt > 0u ? cnt : 1u;
}
__device__ __forceinline__ void xcd_barrier(const XcdBarrier& b) {
    asm volatile("s_waitcnt vmcnt(0)" ::: "memory");
    __syncthreads();
    if (threadIdx.x == 0) {
        unsigned* bar = b.bar;
        __builtin_amdgcn_s_waitcnt(0);
        unsigned nloc = b.st[0], nx = b.st[1];
        if (nloc == 0u) { xcd_barrier_complete(bar, b.x, nloc, nx); b.st[0] = nloc; b.st[1] = nx; }
        const unsigned old = xb_add(&bar[XB_XSUB(b.x)], 1u);
        const unsigned gen = old / nloc;
        if (old + 1u == (gen + 1u) * nloc) {
            __builtin_amdgcn_fence(__ATOMIC_RELEASE, "agent");
            asm volatile("s_waitcnt vmcnt(0)" ::: "memory");
            const unsigned og = xb_add(&bar[XB_TOP], 1u);
            const unsigned tg = og / nx;
            if (og + 1u == (tg + 1u) * nx) xb_add(&bar[XB_TOPGEN], 1u);
            else XB_SPIN(xb_ld(&bar[XB_TOPGEN]) == tg, bar);
            __builtin_amdgcn_fence(__ATOMIC_ACQUIRE, "agent");
            xb_add(&bar[XB_XGEN(b.x)], 1u);
            asm volatile("s_waitcnt vmcnt(0)" ::: "memory");
        } else {
            XB_SPIN(xb_ld(&bar[XB_XGEN(b.x)]) == gen, bar);
            __builtin_amdgcn_fence(__ATOMIC_ACQUIRE, "agent");
            asm volatile("s_waitcnt vmcnt(0)" ::: "memory");
        }
    }
    __syncthreads();
}
struct PhaseCtl { XcdBarrier bar; int lo, hi; bool did; };
__device__ __forceinline__ bool phase_enter(PhaseCtl& c, int k) {
    if (k < c.lo || k >= c.hi) return false;
    if (c.did) xcd_barrier(c.bar);
    c.did = true;
    return true;
}
constexpr int PH_PER_LAYER = 16, PH_FINAL = 1 + DEPTH * PH_PER_LAYER, PH_TOTAL = PH_FINAL + 1;

#define IN(k) phase_enter(pc, (k))
template <int L>
__device__ __forceinline__ void run_layer(const P& p, float* lds, PhaseCtl& pc) {
    constexpr int m = L % 3, base = 1 + L * PH_PER_LAYER, ia = L / 3;
    float* X = (float*)(p.ws + WS_X); bf16_t* H = (bf16_t*)(p.ws + WS_H);
    bf16_t* XM = (bf16_t*)(p.ws + WS_XM); float* RKV = (float*)(p.ws + WS_RKV); float* L1 = (float*)(p.ws + WS_L1);
    float* WDp = (float*)(p.ws + WS_WD); float* AAp = (float*)(p.ws + WS_AA); float* GG = (float*)(p.ws + WS_GG);
    bf16_t* YG = (bf16_t*)(p.ws + WS_YG); bf16_t* UCB = (bf16_t*)(p.ws + WS_UCB);
    bf16_t* XIN = (bf16_t*)(p.ws + WS_XIN); bf16_t* HID = (bf16_t*)(p.ws + WS_HID); float* YEXP = (float*)(p.ws + WS_YEXP); float* GATE = (float*)(p.ws + WS_GATE);
        if (IN(base + 0)) ph_norm(p, L == 0 ? p.in[I_X] : X, X, L > 0, p.in[I_NMG] + L * D, H, nullptr, nullptr, lds);
        if (m == 0) {
            if (IN(base + 1)) ph_xm(p, p.in[I_MU] + ia * 6 * D);
            if (IN(base + 2)) {
                for (int u = blockIdx.x; u < 3 * 2048 + 4 * 128 + 256; u += gridDim.x) {
                    Job j; int r = u;
                    if (r < 3 * 2048) { const int q = r / 2048; r -= q * 2048; j = mk_job(XM + (size_t)q * T * D, D, 1, p.in[I_WIN] + ((size_t)ia * 3 + q) * D * D, D, T, D, D, mk_epi(RKV + (size_t)q * T * D, D, 0, 0)); }
                    else if (r < 3 * 2048 + 4 * 128) { r -= 3 * 2048; const int jj = r / 128, z = jj & 1, isa = jj >> 1; r -= jj * 128;
                        j = mk_job(XM + (size_t)(3 + isa) * T * D, D, 1, p.in[isa ? I_A1 : I_W1] + ((size_t)ia * 2 + z) * D * 64, 64, T, 64, D, mk_epi(L1, 384, isa * 128 + z * 64, isa ? 0 : 1)); }
                    else { r -= 3 * 2048 + 4 * 128; j = mk_job(XM + (size_t)5 * T * D, D, 1, p.in[I_G1] + (size_t)ia * D * 128, 128, T, 128, D, mk_epi(L1, 384, 256, 2)); }
                    run_unit_t<true, false>(j, r, lds);
                }
            }
            if (IN(base + 3)) {
                for (int u = blockIdx.x; u < 5 * 2048; u += gridDim.x) {
                    const int jj = u / 2048, r = u - jj * 2048; Job j;
                    if (jj < 2) j = mk_job(L1 + jj * 64, 384, 0, p.in[I_W2] + ((size_t)ia * 2 + jj) * 64 * D, D, T, D, 64, mk_epi(WDp + (size_t)jj * T * D, D, 0, 3, p.in[I_W0] + ((size_t)ia * 2 + jj) * D));
                    else if (jj < 4) { const int z = jj - 2; j = mk_job(L1 + 128 + z * 64, 384, 0, p.in[I_A2] + ((size_t)ia * 2 + z) * 64 * D, D, T, D, 64, mk_epi(AAp + (size_t)z * T * D, D, 0, 2, p.in[I_A0] + ((size_t)ia * 2 + z) * D)); }
                    else j = mk_job(L1 + 256, 384, 0, p.in[I_G2] + (size_t)ia * 128 * D, D, T, D, 128, mk_epi(GG, D, 0, 0));
                    run_unit_t<false, false>(j, r, lds);
                }
            }
            if (IN(base + 4)) ph_scan(p, ia, lds);
            if (IN(base + 5)) ph_rwkv_post(p, ia);
            if (IN(base + 6)) { const Job j = mk_job(YG, D, 1, p.in[I_WOUT] + (size_t)ia * D * D, D, T, D, D, mk_epi(X, D, 0, 4)); for (int u = blockIdx.x; u < job_units(j); u += gridDim.x) run_unit_t<true, false>(j, u, lds); }
        } else if (m == 1) {
            if (IN(base + 1)) { const Job j = mk_job(H, D, 1, p.in[I_SCIN], 3 * D, T, 3 * D, D, mk_epi(RKV, 3 * D, 0, 0)); for (int u = blockIdx.x; u < job_units(j); u += gridDim.x) run_unit_t<true, false>(j, u, lds); }
            if (IN(base + 2)) ph_sc_mid(p);
            if (IN(base + 3)) { const Job j = mk_job(YG, D, 1, p.in[I_SCOUT], D, T, D, D, mk_epi(X, D, 0, 4)); for (int u = blockIdx.x; u < job_units(j); u += gridDim.x) run_unit_t<true, false>(j, u, lds); }
        } else {
            if (IN(base + 1)) { const Job j = mk_job(H, D, 1, p.in[I_LIN], 2 * D, T, 2 * D, D, mk_epi(RKV, 2 * D, 0, 0)); for (int u = blockIdx.x; u < job_units(j); u += gridDim.x) run_unit_t<true, false>(j, u, lds); }
            if (IN(base + 2)) ph_lru_conv(p);
            if (IN(base + 3)) {
                for (int u = blockIdx.x; u < 16 * 512; u += gridDim.x) {
                    const int jj = u / 512, r = u - jj * 512, g = jj >> 3, z = (jj >> 2) & 1, h = jj & 3;
                    const Job j = mk_job(UCB + h * 256, D, 1, p.in[g ? I_LWX : I_LWA] + ((size_t)z * 4 + h) * 256 * 256, 256, T, 256, 256,
                                         mk_epi((g ? AAp : WDp) + (size_t)z * T * D, D, h * 256, 2, p.in[g ? I_LBX : I_LBA] + z * D + h * 256));
                    run_unit_t<true, false>(j, r, lds);
                }
            }
            if (IN(base + 4)) ph_lru_scan(p, lds);
            if (IN(base + 5)) ph_lru_post(p);
            if (IN(base + 6)) { const Job j = mk_job(YG, D, 1, p.in[I_LOUT], D, T, D, D, mk_epi(X, D, 0, 4)); for (int u = blockIdx.x; u < job_units(j); u += gridDim.x) run_unit_t<true, false>(j, u, lds); }
        }
        if (IN(base + 7)) ph_norm(p, X, nullptr, false, p.in[I_NFG] + L * D, H, p.in[I_RW] + (size_t)L * D * NE, nullptr, lds);
        if (IN(base + 8)) ph_topk(p, lds);
        if (IN(base + 9)) {
            for (int u = blockIdx.x; u < NE * (NB * CAP / 128) * (FF / 64); u += gridDim.x) {
                const int per = (NB * CAP / 128) * (FF / 64), e = u / per;
                Job j = mk_job(XIN + (size_t)e * NB * CAP * D, D, 1, p.in[I_WG] + ((size_t)L * NE + e) * D * FF, FF, NB * CAP, FF, D, mk_epi(nullptr, FF, 0, 5, nullptr, HID + (size_t)e * NB * CAP * FF),
                               p.in[I_WU] + ((size_t)L * NE + e) * D * FF);
                run_unit_t<true, true>(j, u % per, lds);
            }
        }
        if (IN(base + 10)) {
            for (int u = blockIdx.x; u < NE * (NB * CAP / 128) * (D / 64); u += gridDim.x) {
                const int per = (NB * CAP / 128) * (D / 64), e = u / per;
                Job j = mk_job(HID + (size_t)e * NB * CAP * FF, FF, 1, p.in[I_WDN] + ((size_t)L * NE + e) * FF * D, D, NB * CAP, D, FF,
                               mk_epi(YEXP + (size_t)e * NB * CAP * D, D, 0, 6, nullptr, nullptr, GATE + (size_t)e * NB * CAP));
                run_unit_t<true, false>(j, u % per, lds);
            }
        }
}

__global__ void __launch_bounds__(NTHR, 2) mega(P p) {
    extern __shared__ __attribute__((aligned(16))) unsigned char lds_raw[];
    float* lds = (float*)lds_raw;
    volatile LAS unsigned* xbw = (volatile LAS unsigned*)(lds_raw + LDS_BYTES - 16);
    if (threadIdx.x == 0) { xbw[0] = 0u; xbw[1] = 0u; xbw[2] = 0u; xbw[3] = 0u; }
    __syncthreads();
    PhaseCtl pc; pc.lo = p.ph_lo; pc.hi = p.ph_hi; pc.did = false;
    pc.bar = xcd_barrier_post((unsigned*)(p.ws + WS_CTL), xbw);
    run_layer<0>(p, lds, pc);
    run_layer<1>(p, lds, pc);
    run_layer<2>(p, lds, pc);
    run_layer<3>(p, lds, pc);
    if (IN(PH_FINAL)) ph_norm(p, (const float*)(p.ws + WS_X), nullptr, true, p.in[I_FNG], nullptr, nullptr, p.out, lds);
}
#undef IN

}

extern "C" void kernel_launch(void* const* d_in, const int* in_sizes, int n_in, void* d_out, int out_size, void* d_ws, size_t ws_size, hipStream_t stream) {
    static int ready = 0, grid = 256;
    if (!ready) {
        if (n_in != 36 || out_size != T * D || ws_size < WS_END) { fprintf(stderr, "kernel_launch: unexpected problem (n_in %d out %d ws %zu need %zu)\n", n_in, out_size, ws_size, (size_t)WS_END); ready = -1; return; }
        if (hipFuncSetAttribute((const void*)mega, hipFuncAttributeMaxDynamicSharedMemorySize, LDS_BYTES) != hipSuccess) { fprintf(stderr, "kernel_launch: hipFuncSetAttribute failed\n"); ready = -1; return; }
        { int dev = 0, cus = 0; if (hipGetDevice(&dev) == hipSuccess && hipDeviceGetAttribute(&cus, hipDeviceAttributeMultiprocessorCount, dev) == hipSuccess && cus > 0) grid = cus < 256 ? cus : 256; }
        ready = 1;
    }
    if (ready < 0) return;
    (void)in_sizes;
    P p{};
    for (int i = 0; i < 36; ++i) p.in[i] = (const float*)d_in[i];
    p.out = (float*)d_out; p.ws = (unsigned char*)d_ws;
    if (hipMemsetAsync((char*)d_ws + WS_CTL, 0, XCD_BAR_WORDS * sizeof(unsigned), stream) != hipSuccess) { fprintf(stderr, "kernel_launch: memset failed\n"); return; }
    p.ph_lo = 0; p.ph_hi = PH_TOTAL;
    hipLaunchKernelGGL(mega, dim3(grid), dim3(NTHR), LDS_BYTES, stream, p);
}
```

```cpp
#include <hip/hip_runtime.h>
#include <stdint.h>
#include <stdio.h>

namespace {
constexpr int D = 1024, NB = 8, S = 2048, T = NB * S, DEPTH = 4, NE = 16, FF = 2048, CAP = 256, NH = 16, HD = 64;
constexpr int NTHR = 512;
constexpr float RMS_EPS = 1e-6f, LNX_EPS = 64e-5f;
typedef unsigned short bf16_t;

constexpr size_t MiB = 1u << 20;
constexpr size_t WS_CTL = 0;
constexpr size_t WS_X = 1 * MiB;
constexpr size_t WS_H = WS_X + 64 * MiB;
constexpr size_t WS_XM = WS_H + 32 * MiB;
constexpr size_t WS_RKV = WS_XM + 192 * MiB;
constexpr size_t WS_L1 = WS_RKV + 192 * MiB;
constexpr size_t WS_WD = WS_L1 + 24 * MiB;
constexpr size_t WS_AA = WS_WD + 128 * MiB;
constexpr size_t WS_GG = WS_AA + 128 * MiB;
constexpr size_t WS_YS = WS_GG + 64 * MiB;
constexpr size_t WS_YG = WS_YS + 128 * MiB;
constexpr size_t WS_UCB = WS_YG + 32 * MiB;
constexpr size_t WS_YEXP = WS_UCB + 32 * MiB;
constexpr size_t WS_AFF = WS_YEXP + 128 * MiB;
constexpr size_t WS_SLOT = WS_AFF + 1 * MiB;
constexpr size_t WS_GATE = WS_SLOT + 1 * MiB;
constexpr size_t WS_ACT_END = WS_GATE + 1 * MiB;
constexpr size_t WB_RW = WS_ACT_END;
constexpr size_t RW_RKV = 0, RW_L1 = 6 * MiB, RW_L2 = RW_L1 + 3 * 256 * 1024 * 2, RW_OUT = RW_L2 + 5 * 1024 * 256 * 2, RW_STRIDE = 12 * MiB;
constexpr size_t WB_SC = WB_RW + 2 * RW_STRIDE;
constexpr size_t SC_IN = 0, SC_OUT = 6 * MiB;
constexpr size_t WB_LRU = WB_SC + 8 * MiB;
constexpr size_t LRU_IN = 0, LRU_G = 4 * MiB, LRU_OUT = 6 * MiB;
constexpr size_t WB_MOE = WB_LRU + 8 * MiB;
constexpr size_t MOE_GU = 0, MOE_DN = 128 * MiB, MOE_STRIDE = 192 * MiB;
constexpr size_t WS_END = WB_MOE + 4 * MOE_STRIDE;
constexpr size_t WS_XIN = WS_XM, WS_HID = WS_XM + 64 * MiB;

struct P {
    const float* in[36];
    float* out;
    unsigned char* ws;
    int ph_lo, ph_hi;
};

enum { I_X = 0, I_NMG, I_NFG, I_RW, I_WG, I_WU, I_WDN, I_FNG, I_MU, I_WIN, I_W0, I_W1, I_W2, I_A0, I_A1, I_A2, I_G1, I_G2, I_KK, I_KA, I_RK, I_LNG, I_LNB, I_WOUT,
       I_SCIN, I_SCCW, I_SCOUT, I_LIN, I_LCW, I_LCB, I_LWA, I_LBA, I_LWX, I_LBX, I_LLAM, I_LOUT };

__device__ __forceinline__ int lane_fresh() { int l; asm volatile("v_mbcnt_lo_u32_b32 %0, -1, 0\n\tv_mbcnt_hi_u32_b32 %0, -1, %0" : "=v"(l)); return l; }
#define TID (wv * 64 + lane_fresh())
__device__ __forceinline__ float bf2f(bf16_t v) { return __uint_as_float((unsigned)v << 16); }
__device__ __forceinline__ bf16_t f2bf(float f) { unsigned u = __float_as_uint(f); u += 0x7FFFu + ((u >> 16) & 1u); return (bf16_t)(u >> 16); }
__device__ __forceinline__ void bf4_to_f(uint2 u, float* f) { f[0] = __uint_as_float(u.x << 16); f[1] = __uint_as_float(u.x & 0xffff0000u); f[2] = __uint_as_float(u.y << 16); f[3] = __uint_as_float(u.y & 0xffff0000u); }
__device__ __forceinline__ uint2 f4_to_bf(float a, float b, float c, float d) { return make_uint2((unsigned)f2bf(a) | ((unsigned)f2bf(b) << 16), (unsigned)f2bf(c) | ((unsigned)f2bf(d) << 16)); }
__device__ __forceinline__ float wave_sum(float v) { for (int o = 32; o >= 1; o >>= 1) v += __shfl_xor(v, o); return v; }
__device__ __forceinline__ float quad_sum(float v) { v += __shfl_xor(v, 1); v += __shfl_xor(v, 2); return v; }
__device__ __forceinline__ float sigmoidf_(float x) { return 1.0f / (1.0f + __expf(-x)); }
__device__ __forceinline__ float softplusf_(float y) { return fmaxf(y, 0.f) + log1pf(__expf(-fabsf(y))); }
__device__ __forceinline__ float gelu_tanh(float x) { const float u = 0.7978845608028654f * (x + 0.044715f * x * x * x); return 0.5f * x * (1.0f + tanhf(u)); }

__device__ __forceinline__ void ph_norm(const int wv, const P& p, const float* xin, float* xout, bool combine, const float* gamma, bf16_t* hout, const float* router_w, float* fout, float* lds) {
    const int tid = TID, lane = tid & 63, wave = tid >> 6;
    if (router_w) {
        for (int i = tid; i < D * NE; i += NTHR) { const int d = i >> 4, e = i & 15; lds[e * D + d] = router_w[i]; }
        __syncthreads();
    }
    const float* yexp = (const float*)(p.ws + WS_YEXP); const int* slot = (const int*)(p.ws + WS_SLOT);
    float* aff = (float*)(p.ws + WS_AFF);
    for (int tok = blockIdx.x * 8 + wave; tok < T; tok += gridDim.x * 8) {
        const int b = tok / S, s = tok % S;
        float4 x[4];
#pragma unroll
        for (int i = 0; i < 4; ++i) x[i] = ((const float4*)(xin + (size_t)tok * D))[i * 64 + lane];
        if (combine) {
            for (int e = 0; e < NE; ++e) {
                const int sl = slot[tok * NE + e];
                if (sl >= 0) {
                    const float4* row = (const float4*)(yexp + ((size_t)(e * NB + b) * CAP + sl) * D);
#pragma unroll
                    for (int i = 0; i < 4; ++i) { const float4 r = row[i * 64 + lane]; x[i].x += r.x; x[i].y += r.y; x[i].z += r.z; x[i].w += r.w; }
                }
            }
        }
        if (xout) {
#pragma unroll
            for (int i = 0; i < 4; ++i) ((float4*)(xout + (size_t)tok * D))[i * 64 + lane] = x[i];
        }
        float ss = 0.f;
#pragma unroll
        for (int i = 0; i < 4; ++i) ss += x[i].x * x[i].x + x[i].y * x[i].y + x[i].z * x[i].z + x[i].w * x[i].w;
        ss = wave_sum(ss);
        const float rstd = 1.0f / sqrtf(ss * (1.0f / D) + RMS_EPS);
        float4 h[4];
#pragma unroll
        for (int i = 0; i < 4; ++i) {
            const float4 g = ((const float4*)gamma)[i * 64 + lane];
            h[i].x = x[i].x * rstd * g.x; h[i].y = x[i].y * rstd * g.y; h[i].z = x[i].z * rstd * g.z; h[i].w = x[i].w * rstd * g.w;
        }
        if (hout) {
#pragma unroll
            for (int i = 0; i < 4; ++i) ((uint2*)(hout + (size_t)tok * D))[i * 64 + lane] = f4_to_bf(h[i].x, h[i].y, h[i].z, h[i].w);
        }
        if (fout) {
#pragma unroll
            for (int i = 0; i < 4; ++i) ((float4*)(fout + (size_t)tok * D))[i * 64 + lane] = h[i];
        }
        if (router_w) {
            float mylg = -3.0e38f;
#pragma unroll 1
            for (int e = 0; e < NE; ++e) {
                float a = 0.f;
#pragma unroll
                for (int i = 0; i < 4; ++i) { const float4 w = ((const float4*)(lds + e * D))[i * 64 + lane]; a += h[i].x * w.x + h[i].y * w.y + h[i].z * w.z + h[i].w * w.w; }
                a = wave_sum(a);
                if (lane == e) mylg = a;
            }
            float mx = mylg;
#pragma unroll
            for (int o = 1; o < 16; o <<= 1) mx = fmaxf(mx, __shfl_xor(mx, o));
            const float mine = (lane < NE) ? __expf(mylg - mx) : 0.f;
            float sum = mine;
#pragma unroll
            for (int o = 1; o < 16; o <<= 1) sum += __shfl_xor(sum, o);
            if (lane < NE) aff[((size_t)b * NE + lane) * S + s] = mine / sum;
        }
    }
}

__device__ __forceinline__ void ph_xm(const int wv, const P& p, const float* mu) {
    const int tid = TID, lane = tid & 63, wave = tid >> 6;
    const bf16_t* H = (const bf16_t*)(p.ws + WS_H); bf16_t* XM = (bf16_t*)(p.ws + WS_XM);
    for (int tok = blockIdx.x * 8 + wave; tok < T; tok += gridDim.x * 8) {
        const int s = tok % S;
#pragma unroll
        for (int i = 0; i < 4; ++i) {
            const int c4 = i * 64 + lane;
            float hc[4], hp[4] = {0.f, 0.f, 0.f, 0.f}, hn[4] = {0.f, 0.f, 0.f, 0.f};
            bf4_to_f(((const uint2*)(H + (size_t)tok * D))[c4], hc);
            if (s > 0) bf4_to_f(((const uint2*)(H + (size_t)(tok - 1) * D))[c4], hp);
            if (s < S - 1) bf4_to_f(((const uint2*)(H + (size_t)(tok + 1) * D))[c4], hn);
            float xx[4];
#pragma unroll
            for (int j = 0; j < 4; ++j) xx[j] = 0.5f * (hp[j] + hn[j]) - hc[j];
#pragma unroll
            for (int q = 0; q < 6; ++q) {
                const float4 m = ((const float4*)(mu + q * D))[c4];
                ((uint2*)(XM + ((size_t)q * T + tok) * D))[c4] = f4_to_bf(hc[0] + xx[0] * m.x, hc[1] + xx[1] * m.y, hc[2] + xx[2] * m.z, hc[3] + xx[3] * m.w);
            }
        }
    }
}

constexpr int LDS_BYTES = 128 * 1024 + 1024;
constexpr int SCH = 32;
__device__ __forceinline__ void ph_scan(const int wv, const P& p, int ia, float* lds) {
    const int tid = TID, lane = tid & 63;
    const float* RKV = (const float*)(p.ws + WS_RKV); const float* WDp = (const float*)(p.ws + WS_WD); const float* AAp = (const float*)(p.ws + WS_AA);
    float* YS = (float*)(p.ws + WS_YS);
    const float* k_k = p.in[I_KK] + ia * D; const float* k_a = p.in[I_KA] + ia * D;
    float* vkk = lds;
    float* vw = vkk + SCH * 64; float* vb = vw + SCH * 64; float* vkd = vb + SCH * 64; float* vr = vkd + SCH * 64; float* vv = vr + SCH * 64; float* ybuf = vv + SCH * 64;
    for (int unit = blockIdx.x; unit < NB * NH * 2; unit += gridDim.x) {
        const int z = unit & 1, h = (unit >> 1) % NH, b = unit / (2 * NH);
        const int vrow = tid >> 2, q = tid & 3;
        float St[16];
#pragma unroll
        for (int j = 0; j < 16; ++j) St[j] = 0.f;
        for (int c = 0; c < S / SCH; ++c) {
#pragma unroll
            for (int jj = 0; jj < SCH * 64 / NTHR; ++jj) {
                const int idx = tid + jj * NTHR, i = idx >> 6, k = idx & 63;
                const int step = c * SCH + i, t = z ? (S - 1 - step) : step;
                const size_t o = ((size_t)b * S + t) * D + h * HD + k;
                const float rk = RKV[o], kv = RKV[(size_t)T * D + o], vvv = RKV[2 * (size_t)T * D + o];
                const float wv = WDp[(size_t)z * T * D + o], av = AAp[(size_t)z * T * D + o];
                const float kkr = kv * k_k[h * HD + k];
                const float ss = wave_sum(kkr * kkr);
                const float kkn = kkr / fmaxf(sqrtf(ss), 1e-12f);
                vkk[idx] = kkn; vw[idx] = wv; vb[idx] = kkn * av; vkd[idx] = kv * (1.0f + (av - 1.0f) * k_a[h * HD + k]); vr[idx] = rk; vv[idx] = vvv;
            }
            __syncthreads();
            if (tid < 256) {
                for (int i = 0; i < SCH; ++i) {
                    const float* pk = vkk + i * 64 + q * 16; const float* pw = vw + i * 64 + q * 16; const float* pb = vb + i * 64 + q * 16;
                    const float* pd = vkd + i * 64 + q * 16; const float* pr = vr + i * 64 + q * 16;
                    const float vval = vv[i * 64 + vrow];
                    float sa = 0.f;
#pragma unroll
                    for (int j = 0; j < 16; ++j) sa += St[j] * pk[j];
                    sa = quad_sum(sa);
                    float y = 0.f;
#pragma unroll
                    for (int j = 0; j < 16; ++j) { St[j] = St[j] * pw[j] - sa * pb[j] + vval * pd[j]; y += St[j] * pr[j]; }
                    y = quad_sum(y);
                    if (q == 0) ybuf[i * 64 + vrow] = y;
                }
            }
            __syncthreads();
#pragma unroll
            for (int jj = 0; jj < SCH * 64 / NTHR; ++jj) {
                const int idx = tid + jj * NTHR, i = idx >> 6, k = idx & 63;
                const int step = c * SCH + i, t = z ? (S - 1 - step) : step;
                YS[(size_t)z * T * D + ((size_t)b * S + t) * D + h * HD + k] = ybuf[idx];
            }
        }
        __syncthreads();
    }
    (void)lane;
}

__device__ __forceinline__ void ph_rwkv_post(const int wv, const P& p, int ia) {
    const int tid = TID, lane = tid & 63, wave = tid >> 6;
    const float* RKV = (const float*)(p.ws + WS_RKV); const float* AAp = (const float*)(p.ws + WS_AA); const float* GG = (const float*)(p.ws + WS_GG);
    const float* YS = (const float*)(p.ws + WS_YS); bf16_t* YG = (bf16_t*)(p.ws + WS_YG);
    const float* k_a = p.in[I_KA] + ia * D; const float* r_k = p.in[I_RK] + ia * D; const float* lg = p.in[I_LNG] + ia * D; const float* lb = p.in[I_LNB] + ia * D;
    for (int tok = blockIdx.x * 8 + wave; tok < T; tok += gridDim.x * 8) {
        const size_t o = (size_t)tok * D + lane * 16;
        float y[16], r[16], k[16], v[16], a0[16], a1[16];
#pragma unroll
        for (int j = 0; j < 4; ++j) {
            const float4 y0 = ((const float4*)(YS + o))[j], y1 = ((const float4*)(YS + (size_t)T * D + o))[j];
            y[4 * j] = y0.x + y1.x; y[4 * j + 1] = y0.y + y1.y; y[4 * j + 2] = y0.z + y1.z; y[4 * j + 3] = y0.w + y1.w;
            const float4 rr = ((const float4*)(RKV + o))[j], kk = ((const float4*)(RKV + (size_t)T * D + o))[j], vv = ((const float4*)(RKV + 2 * (size_t)T * D + o))[j];
            r[4 * j] = rr.x; r[4 * j + 1] = rr.y; r[4 * j + 2] = rr.z; r[4 * j + 3] = rr.w;
            k[4 * j] = kk.x; k[4 * j + 1] = kk.y; k[4 * j + 2] = kk.z; k[4 * j + 3] = kk.w;
            v[4 * j] = vv.x; v[4 * j + 1] = vv.y; v[4 * j + 2] = vv.z; v[4 * j + 3] = vv.w;
            const float4 p0 = ((const float4*)(AAp + o))[j], p1 = ((const float4*)(AAp + (size_t)T * D + o))[j];
            a0[4 * j] = p0.x; a0[4 * j + 1] = p0.y; a0[4 * j + 2] = p0.z; a0[4 * j + 3] = p0.w;
            a1[4 * j] = p1.x; a1[4 * j + 1] = p1.y; a1[4 * j + 2] = p1.z; a1[4 * j + 3] = p1.w;
        }
        float sm = 0.f;
#pragma unroll
        for (int j = 0; j < 16; ++j) sm += y[j];
        const float mean = quad_sum(sm) * (1.0f / 64.0f);
        float sv = 0.f;
#pragma unroll
        for (int j = 0; j < 16; ++j) { const float d = y[j] - mean; sv += d * d; }
        const float rstd = 1.0f / sqrtf(quad_sum(sv) * (1.0f / 64.0f) + LNX_EPS);
        float d0 = 0.f, d1 = 0.f;
#pragma unroll
        for (int j = 0; j < 16; ++j) {
            const int c = lane * 16 + j; const float ka = k_a[c], rk = r_k[c];
            d0 += r[j] * (k[j] * (1.0f + (a0[j] - 1.0f) * ka)) * rk;
            d1 += r[j] * (k[j] * (1.0f + (a1[j] - 1.0f) * ka)) * rk;
        }
        const float bon = quad_sum(d0) + quad_sum(d1);
        float outv[16];
#pragma unroll
        for (int j = 0; j < 16; ++j) { const int c = lane * 16 + j; outv[j] = ((y[j] - mean) * rstd * lg[c] + lb[c] + bon * v[j]) * GG[o + j]; }
#pragma unroll
        for (int j = 0; j < 4; ++j) ((uint2*)(YG + o))[j] = f4_to_bf(outv[4 * j], outv[4 * j + 1], outv[4 * j + 2], outv[4 * j + 3]);
    }
}

__device__ __forceinline__ void ph_sc_mid(const int wv, const P& p) {
    const int tid = TID, lane = tid & 63, wave = tid >> 6;
    const float* BCU = (const float*)(p.ws + WS_RKV); bf16_t* BZ = (bf16_t*)(p.ws + WS_YG); const float* cw = p.in[I_SCCW];
    for (int tok = blockIdx.x * 8 + wave; tok < T; tok += gridDim.x * 8) {
        const int s = tok % S;
#pragma unroll
        for (int i = 0; i < 4; ++i) {
            const int c4 = i * 64 + lane;
            float z[4] = {0.f, 0.f, 0.f, 0.f};
#pragma unroll
            for (int j = 0; j < 3; ++j) {
                const int ss = s + j - 1;
                if (ss >= 0 && ss < S) {
                    const size_t ro = (size_t)(tok + j - 1) * (3 * D);
                    const float4 c = ((const float4*)(BCU + ro + D))[c4], u = ((const float4*)(BCU + ro + 2 * D))[c4], w = ((const float4*)(cw + j * D))[c4];
                    z[0] += w.x * c.x * u.x; z[1] += w.y * c.y * u.y; z[2] += w.z * c.z * u.z; z[3] += w.w * c.w * u.w;
                }
            }
            const float4 bg = ((const float4*)(BCU + (size_t)tok * (3 * D)))[c4];
            ((uint2*)(BZ + (size_t)tok * D))[c4] = f4_to_bf(bg.x * z[0], bg.y * z[1], bg.z * z[2], bg.w * z[3]);
        }
    }
}

__device__ __forceinline__ void ph_lru_conv(const int wv, const P& p) {
    const int tid = TID, lane = tid & 63, wave = tid >> 6;
    const float* GU = (const float*)(p.ws + WS_RKV); float* UC = (float*)(p.ws + WS_GG); bf16_t* UCB = (bf16_t*)(p.ws + WS_UCB);
    const float* cw = p.in[I_LCW]; const float* cb = p.in[I_LCB];
    for (int tok = blockIdx.x * 8 + wave; tok < T; tok += gridDim.x * 8) {
        const int s = tok % S;
#pragma unroll
        for (int i = 0; i < 4; ++i) {
            const int c4 = i * 64 + lane;
            float4 acc = ((const float4*)cb)[c4];
#pragma unroll
            for (int j = 0; j < 4; ++j) {
                const int ss = s + j - 2;
                if (ss >= 0 && ss < S) {
                    const float4 u = ((const float4*)(GU + (size_t)(tok + j - 2) * (2 * D) + D))[c4], w = ((const float4*)(cw + j * D))[c4];
                    acc.x += w.x * u.x; acc.y += w.y * u.y; acc.z += w.z * u.z; acc.w += w.w * u.w;
                }
            }
            ((float4*)(UC + (size_t)tok * D))[c4] = acc;
            ((uint2*)(UCB + (size_t)tok * D))[c4] = f4_to_bf(acc.x, acc.y, acc.z, acc.w);
        }
    }
}

__device__ __forceinline__ void ph_lru_scan(const int wv, const P& p, float* lds) {
    const int tid = TID;
    const float* RG = (const float*)(p.ws + WS_WD); const float* IG = (const float*)(p.ws + WS_AA); const float* UC = (const float*)(p.ws + WS_GG);
    float* HS = (float*)(p.ws + WS_YS);
    float* segP = lds; float* segH = lds + 512;
    const int ch = tid & 31, seg = tid >> 5;
    for (int unit = blockIdx.x; unit < NB * 2 * 32; unit += gridDim.x) {
        const int cg = unit & 31, z = (unit >> 5) & 1, b = unit >> 6;
        const int c = cg * 32 + ch;
        const float sp = softplusf_(-p.in[I_LLAM][z * D + c]);
        const float* rg = RG + (size_t)z * T * D; const float* ig = IG + (size_t)z * T * D;
        float Pm = 1.f, h = 0.f;
        for (int i = seg * 128; i < seg * 128 + 128; ++i) {
            const int t = z ? (S - 1 - i) : i; const size_t o = ((size_t)b * S + t) * D + c;
            const float la = -8.0f * rg[o] * sp; const float a = __expf(la); const float bb = sqrtf(-expm1f(2.0f * la)) * (ig[o] * UC[o]);
            h = a * h + bb; Pm *= a;
        }
        segP[seg * 32 + ch] = Pm; segH[seg * 32 + ch] = h;
        __syncthreads();
        float carry = 0.f;
        for (int s2 = 0; s2 < seg; ++s2) carry = segP[s2 * 32 + ch] * carry + segH[s2 * 32 + ch];
        h = carry;
        for (int i = seg * 128; i < seg * 128 + 128; ++i) {
            const int t = z ? (S - 1 - i) : i; const size_t o = ((size_t)b * S + t) * D + c;
            const float la = -8.0f * rg[o] * sp; const float a = __expf(la); const float bb = sqrtf(-expm1f(2.0f * la)) * (ig[o] * UC[o]);
            h = a * h + bb;
            HS[(size_t)z * T * D + o] = h;
        }
        __syncthreads();
    }
}

__device__ __forceinline__ void ph_lru_post(const int wv, const P& p) {
    const int tid = TID, lane = tid & 63, wave = tid >> 6;
    const float* GU = (const float*)(p.ws + WS_RKV); const float* HS = (const float*)(p.ws + WS_YS); bf16_t* YL = (bf16_t*)(p.ws + WS_YG);
    for (int tok = blockIdx.x * 8 + wave; tok < T; tok += gridDim.x * 8) {
#pragma unroll
        for (int i = 0; i < 4; ++i) {
            const int c4 = i * 64 + lane;
            const float4 g = ((const float4*)(GU + (size_t)tok * (2 * D)))[c4];
            const float4 h0 = ((const float4*)(HS + (size_t)tok * D))[c4], h1 = ((const float4*)(HS + (size_t)T * D + (size_t)tok * D))[c4];
            ((uint2*)(YL + (size_t)tok * D))[c4] = f4_to_bf((h0.x + h1.x) * gelu_tanh(g.x), (h0.y + h1.y) * gelu_tanh(g.y), (h0.z + h1.z) * gelu_tanh(g.z), (h0.w + h1.w) * gelu_tanh(g.w));
        }
    }
}

__device__ __forceinline__ int block_sum_i(const int wv, int v, int* wsum  ) {
    const int lane = lane_fresh(), wave = wv;
    for (int o = 32; o >= 1; o >>= 1) v += __shfl_xor(v, o);
    if (lane == 0) wsum[wave] = v;
    __syncthreads();
    int tot = 0;
#pragma unroll
    for (int w = 0; w < 8; ++w) tot += wsum[w];
    return tot;
}
__device__ __forceinline__ int block_excl_scan_i(const int wv, int v, int* wsum  , int& total) {
    const int lane = lane_fresh(), wave = wv;
    int inc = v;
    for (int o = 1; o < 64; o <<= 1) { const int t = __shfl_up(inc, o); if (lane >= o) inc += t; }
    if (lane == 63) wsum[wave] = inc;
    __syncthreads();
    int base = 0, tot = 0;
#pragma unroll
    for (int w = 0; w < 8; ++w) { const int x = wsum[w]; if (w < wave) base += x; tot += x; }
    total = tot;
    return base + inc - v;
}
__device__ __forceinline__ void ph_topk(const int wv, const P& p, float* ldsf) {
    const int tid = TID, lane = tid & 63, wave = tid >> 6;
    int* ldsi = (int*)ldsf;
    int* wsum = ldsi;
    int* idx_l = ldsi + 64;
    const float* aff = (const float*)(p.ws + WS_AFF); int* slot = (int*)(p.ws + WS_SLOT); float* gate = (float*)(p.ws + WS_GATE);
    const bf16_t* HF = (const bf16_t*)(p.ws + WS_H); bf16_t* XIN = (bf16_t*)(p.ws + WS_XIN);
    for (int unit = blockIdx.x; unit < NB * NE; unit += gridDim.x) {
        const int e = unit % NE, b = unit / NE;
        const float4 v4 = ((const float4*)(aff + ((size_t)b * NE + e) * S))[tid];
        const unsigned v[4] = {__float_as_uint(v4.x), __float_as_uint(v4.y), __float_as_uint(v4.z), __float_as_uint(v4.w)};
        unsigned thr = 0u;
        for (int bit = 31; bit >= 0; --bit) {
            const unsigned cand = thr | (1u << bit);
            const int cnt = (int)(v[0] >= cand) + (int)(v[1] >= cand) + (int)(v[2] >= cand) + (int)(v[3] >= cand);
            const int tot = block_sum_i(wv, cnt, wsum + (bit & 1) * 8);
            if (tot >= CAP) thr = cand;
        }
        int g4 = 0, e4 = 0;
#pragma unroll
        for (int j = 0; j < 4; ++j) { g4 += (int)(v[j] > thr); e4 += (int)(v[j] == thr); }
        const int ngt = block_sum_i(wv, g4, wsum + 16);
        const int need_eq = CAP - ngt;
        int toteq; const int eqbase = block_excl_scan_i(wv, e4, wsum + 24, toteq);
        int sel[4], nsel = 0, er = eqbase;
#pragma unroll
        for (int j = 0; j < 4; ++j) { const bool gt = v[j] > thr, eq = v[j] == thr; sel[j] = (gt || (eq && er < need_eq)) ? 1 : 0; er += eq ? 1 : 0; nsel += sel[j]; }
        __syncthreads();
        int totsel; int cpos = block_excl_scan_i(wv, nsel, wsum, totsel);
#pragma unroll
        for (int j = 0; j < 4; ++j) {
            const int t = tid * 4 + j;
            if (sel[j]) {
                if (cpos < CAP) { idx_l[cpos] = t; gate[((size_t)e * NB + b) * CAP + cpos] = __uint_as_float(v[j]); slot[((size_t)b * S + t) * NE + e] = cpos; }
                else slot[((size_t)b * S + t) * NE + e] = -1;
                ++cpos;
            } else slot[((size_t)b * S + t) * NE + e] = -1;
        }
        __syncthreads();
        for (int c = wave; c < CAP; c += 8) {
            const uint4* src = (const uint4*)(HF + ((size_t)b * S + idx_l[c]) * D);
            uint4* dst = (uint4*)(XIN + (((size_t)e * NB + b) * CAP + c) * D);
            dst[lane] = src[lane]; dst[lane + 64] = src[lane + 64];
        }
        __syncthreads();
    }
}


namespace pg8 {
#define PG8_LAS __attribute__((address_space(3)))
typedef short bf16x8 __attribute__((ext_vector_type(8)));
typedef float f32x4 __attribute__((ext_vector_type(4)));
typedef unsigned u32x4 __attribute__((ext_vector_type(4)));
typedef unsigned u32x2 __attribute__((ext_vector_type(2)));
constexpr int BM = 256, BK = 64, HALF = 128, HTB = HALF * BK * 2, STAGE_BYTES = 8 * HTB;
__device__ __forceinline__ int lds_byte(int r, int c) { const int st = (r >> 4) * 2 + (c >> 5), rr = r & 15, cc = c & 31, ob = rr * 64 + cc * 2; return st * 1024 + (ob ^ (((ob >> 9) & 1) << 5)); }
__device__ __forceinline__ void stage_rc(int b, int& R, int& C) { const int st = b / 1024, sb = b % 1024, swz = sb ^ (((sb >> 9) & 1) << 5); R = (st >> 1) * 16 + swz / 64; C = (st & 1) * 32 + (swz % 64) / 2; }
__device__ __forceinline__ int perm32(int rho) { const int n = rho >> 4, i = rho & 15; return 8 * (i >> 2) + 4 * n + (i & 3); }
struct Unit { const char* A; const char* B; int pm, pn, job; };
struct Geo { int lda, ldb, K; };
__device__ __forceinline__ unsigned cvt_pk_bf16(float lo, float hi) { unsigned r; asm volatile("v_cvt_pk_bf16_f32 %0, %1, %2" : "=v"(r) : "v"(lo), "v"(hi)); return r; }

template <class Epi, class Sched>
__device__ __forceinline__ void gemm_phase(const int wv, PG8_LAS unsigned char* lds, const Geo g, const Sched& S, const Epi& E) {
    const int tid = TID, wid = wv, lane = tid & 63, wr = wid >> 2, wc = wid & 3, fr = lane & 15, fq = lane >> 4;
    const int nt = g.K / BK;
    unsigned voffA[2], voffB[2];
#pragma unroll
    for (int i = 0; i < 2; ++i) { int R, C; stage_rc(tid * 16 + i * 8192, R, C); const int Rb = Epi::PERM ? ((R & ~31) + perm32(R & 31)) : R;
        voffA[i] = (unsigned)(R * g.lda + C) * 2u; voffB[i] = (unsigned)(Rb * g.ldb + C) * 2u; }
    const size_t kstep = (size_t)(BK * 2);
    const size_t hstepA = (size_t)HALF * g.lda * 2, hstepB = (size_t)HALF * g.ldb * 2;
    const unsigned ldsw = (unsigned)wid * 1024u;
    const int aoff = lds_byte(wr * 64 + fr, fq * 8), boff = lds_byte(wc * 32 + fr, fq * 8);
#define PG8_SA(b, h) (((b) * 2 + (h)) * HTB)
#define PG8_SB(b, h) ((4 + (b) * 2 + (h)) * HTB)
#define PG8_STAGE(bufoff, gbase, voff) do { _Pragma("unroll") for (int _i = 0; _i < 2; ++_i) \
        __builtin_amdgcn_global_load_lds((const unsigned*)((const char*)(gbase) + (voff)[_i]), (PG8_LAS unsigned*)(lds + (bufoff) + ldsw + _i * 8192), 16, 0, 0); } while (0)
#define PG8_LDA(dst, b, h) do { _Pragma("unroll") for (int m = 0; m < 4; ++m) _Pragma("unroll") for (int k = 0; k < 2; ++k) dst[m][k] = *(const PG8_LAS bf16x8*)(lds + PG8_SA(b, h) + aoff + m * 2048 + k * 1024); } while (0)
#define PG8_LDB(dst, b, h) do { _Pragma("unroll") for (int n = 0; n < 2; ++n) _Pragma("unroll") for (int k = 0; k < 2; ++k) dst[n][k] = *(const PG8_LAS bf16x8*)(lds + PG8_SB(b, h) + boff + n * 2048 + k * 1024); } while (0)
#define PG8_MMA(ai, bj, At, Bt) do { __builtin_amdgcn_s_setprio(1); _Pragma("unroll") for (int m = 0; m < 4; ++m) _Pragma("unroll") for (int n = 0; n < 2; ++n) _Pragma("unroll") for (int k = 0; k < 2; ++k) \
        acc[ai][bj][m][n] = __builtin_amdgcn_mfma_f32_16x16x32_bf16(Bt[n][k], At[m][k], acc[ai][bj][m][n], 0, 0, 0); __builtin_amdgcn_s_setprio(0); } while (0)
#define PG8_WAIT_V(n) asm volatile("s_waitcnt vmcnt(" #n ")" ::: "memory")
#define PG8_WAIT_L(n) asm volatile("s_waitcnt lgkmcnt(" #n ")" ::: "memory")
#define PG8_BAR __builtin_amdgcn_s_barrier()
#define PG8_SCHED __builtin_amdgcn_sched_barrier(0)
    Unit cur, nxt; int ui = 0;
    if (!S.next(0, cur)) return;
    f32x4 acc[2][2][4][2];
#pragma unroll
    for (int a = 0; a < 2; ++a)
#pragma unroll
        for (int b = 0; b < 2; ++b)
#pragma unroll
            for (int m = 0; m < 4; ++m)
#pragma unroll
                for (int n = 0; n < 2; ++n) acc[a][b][m][n] = (f32x4){0.f, 0.f, 0.f, 0.f};
    bf16x8 At[4][2], B0[2][2], B1[2][2];
    const char* cA = cur.A; const char* cB = cur.B;
    PG8_STAGE(PG8_SB(0, 0), cB, voffB); PG8_STAGE(PG8_SB(0, 1), cB + hstepB, voffB); PG8_STAGE(PG8_SA(0, 0), cA, voffA); PG8_STAGE(PG8_SA(0, 1), cA + hstepA, voffA);
    if (wr == 1) PG8_BAR;
    PG8_WAIT_V(2); PG8_BAR;
    PG8_STAGE(PG8_SB(1, 0), cB + kstep, voffB); PG8_STAGE(PG8_SA(1, 0), cA + kstep, voffA); PG8_STAGE(PG8_SB(1, 1), cB + hstepB + kstep, voffB);
    PG8_WAIT_V(6); PG8_BAR;
    for (;;) {
        const bool has_next = S.next(ui + 1, nxt);
        const char* nA = has_next ? nxt.A : cA; const char* nB = has_next ? nxt.B : cB;
        for (int t = 0; t < nt; t += 2) {
            const bool last = (t == nt - 2);
            const char* a1 = cA + (size_t)(t + 1) * kstep;
            const char* a2 = last ? nA : cA + (size_t)(t + 2) * kstep; const char* b2 = last ? nB : cB + (size_t)(t + 2) * kstep;
            const char* a3 = a2 + kstep; const char* b3 = b2 + kstep;
            PG8_LDB(B0, 0, 0); PG8_LDB(B1, 0, 1); PG8_SCHED; PG8_LDA(At, 0, 0); PG8_STAGE(PG8_SA(1, 1), a1 + hstepA, voffA);
            PG8_WAIT_V(8); PG8_WAIT_L(0); PG8_BAR; PG8_MMA(0, 0, At, B0); PG8_MMA(0, 1, At, B1); PG8_BAR; PG8_SCHED;
            PG8_LDA(At, 0, 1); PG8_STAGE(PG8_SB(0, 0), b2, voffB); PG8_STAGE(PG8_SB(0, 1), b2 + hstepB, voffB); PG8_STAGE(PG8_SA(0, 0), a2, voffA);
            PG8_WAIT_V(8); PG8_WAIT_L(0); PG8_BAR; PG8_MMA(1, 0, At, B0); PG8_MMA(1, 1, At, B1); PG8_BAR; PG8_SCHED;
            PG8_LDB(B0, 1, 0); PG8_LDB(B1, 1, 1); PG8_SCHED; PG8_LDA(At, 1, 0); PG8_STAGE(PG8_SA(0, 1), a2 + hstepA, voffA);
            PG8_WAIT_V(8); PG8_WAIT_L(0); PG8_BAR; PG8_MMA(0, 0, At, B0); PG8_MMA(0, 1, At, B1); PG8_BAR; PG8_SCHED;
            PG8_LDA(At, 1, 1); PG8_STAGE(PG8_SB(1, 0), b3, voffB); PG8_STAGE(PG8_SB(1, 1), b3 + hstepB, voffB); PG8_STAGE(PG8_SA(1, 0), a3, voffA);
            PG8_WAIT_V(8); PG8_WAIT_L(0); PG8_BAR; PG8_MMA(1, 0, At, B0); PG8_MMA(1, 1, At, B1); PG8_BAR; PG8_SCHED;
        }
        if (wr == 0) PG8_BAR;
        { const int le = lane_fresh(); E(acc, cur, wr, wc, le & 15, le >> 4); }
        if (!has_next) break;
#pragma unroll
        for (int a = 0; a < 2; ++a)
#pragma unroll
            for (int b = 0; b < 2; ++b)
#pragma unroll
                for (int m = 0; m < 4; ++m)
#pragma unroll
                    for (int n = 0; n < 2; ++n) acc[a][b][m][n] = (f32x4){0.f, 0.f, 0.f, 0.f};
        cur = nxt; cA = nA; cB = nB; ++ui;
        if (wr == 1) PG8_BAR;
    }
    PG8_WAIT_V(0);
    PG8_BAR;
#undef PG8_SA
#undef PG8_SB
#undef PG8_STAGE
#undef PG8_LDA
#undef PG8_LDB
#undef PG8_MMA
#undef PG8_WAIT_V
#undef PG8_WAIT_L
#undef PG8_BAR
#undef PG8_SCHED
}
}

struct SchedBase { int G, c; };
struct SchedProj : SchedBase {
    const char* XM; const char* Wrkv; const char* L1t;
    __device__ __forceinline__ bool next(int i, pg8::Unit& u) const {
        const int L = i * G + c; if (L >= 960) return false;
        if (L < 768) { u.job = L >> 8; const int r = L & 255; u.pm = r >> 2; u.pn = r & 3; u.B = Wrkv + ((size_t)u.job * 1024 + u.pn * 256) * 1024 * 2; }
        else { const int r = L - 768; u.job = 3 + r / 64; u.pm = r % 64; u.pn = 0; u.B = L1t + (size_t)(u.job - 3) * 256 * 1024 * 2; }
        u.A = XM + ((size_t)u.job * T + (size_t)u.pm * 256) * D * 2;
        return true;
    }
};
struct SchedLora2 : SchedBase {
    const char* L1b; const char* L2t;
    __device__ __forceinline__ bool next(int i, pg8::Unit& u) const {
        const int L = i * G + c; if (L >= 1280) return false;
        u.job = L >> 8; const int r = L & 255; u.pm = r >> 2; u.pn = r & 3;
        u.A = L1b + ((size_t)u.pm * 256 * 512 + (u.job == 4 ? 256 : 0)) * 2;
        u.B = L2t + ((size_t)u.job * 1024 + u.pn * 256) * 256 * 2;
        return true;
    }
};
struct SchedPlain : SchedBase {
    const char* A; const char* B; int nN, lda, ldb;
    __device__ __forceinline__ bool next(int i, pg8::Unit& u) const {
        const int L = i * G + c; if (L >= 64 * nN) return false;
        u.job = 0; u.pm = L / nN; u.pn = L % nN;
        u.A = A + (size_t)u.pm * 256 * lda * 2; u.B = B + (size_t)u.pn * 256 * ldb * 2;
        return true;
    }
};
struct SchedLruGate : SchedBase {
    const char* UCB; const char* Wg;
    __device__ __forceinline__ bool next(int i, pg8::Unit& u) const {
        const int L = i * G + c; if (L >= 1024) return false;
        u.job = L >> 6; u.pm = L & 63; u.pn = 0;
        u.A = UCB + ((size_t)u.pm * 256 * D + (u.job & 3) * 256) * 2; u.B = Wg + (size_t)u.job * 256 * 256 * 2;
        return true;
    }
};
struct SchedMoe1 : SchedBase {
    const char* XIN; const char* Wgu;
    __device__ __forceinline__ bool next(int i, pg8::Unit& u) const {
        const int L = i * G + c; if (L >= 2048) return false;
        u.job = L >> 7; const int r = L & 127; u.pm = r & 7; u.pn = r >> 3;
        u.A = XIN + ((size_t)u.job * 2048 + u.pm * 256) * D * 2; u.B = Wgu + ((size_t)u.job * 4096 + u.pn * 256) * D * 2;
        return true;
    }
};
struct SchedMoe2 : SchedBase {
    const char* HID; const char* Wdn;
    __device__ __forceinline__ bool next(int i, pg8::Unit& u) const {
        const int L = i * G + c; if (L >= 512) return false;
        u.job = L >> 5; const int r = L & 31; u.pm = r & 7; u.pn = r >> 3;
        u.A = HID + ((size_t)u.job * 2048 + u.pm * 256) * FF * 2; u.B = Wdn + ((size_t)u.job * 1024 + u.pn * 256) * FF * 2;
        return true;
    }
};

#define EPI_ARGS const pg8::f32x4 (&acc)[2][2][4][2], const pg8::Unit& u, int wr, int wc, int fr, int fq
#define EPI_ROWS for (int ai = 0; ai < 2; ++ai) _Pragma("unroll") for (int m = 0; m < 4; ++m)
#define EPI_COLS for (int bj = 0; bj < 2; ++bj) _Pragma("unroll") for (int n = 0; n < 2; ++n)
struct EpiProj {
    static constexpr bool PERM = false;
    float* RKV; bf16_t* L1b;
    __device__ __forceinline__ void operator()(EPI_ARGS) const {
        const int row0 = u.pm * 256 + wr * 64 + fr;
        if (u.job < 3) {
            float* C = RKV + (size_t)u.job * T * D; const int col0 = u.pn * 256 + wc * 32 + 4 * fq;
#pragma unroll
            EPI_ROWS { float* rowp = C + (size_t)(row0 + ai * 128 + m * 16) * D + col0;
#pragma unroll
                EPI_COLS *(pg8::f32x4*)(rowp + bj * 128 + n * 16) = acc[ai][bj][m][n]; }
        } else {
            const int col0 = (u.job - 3) * 128 + wc * 32 + 4 * fq; const int act = u.job;
#pragma unroll
            EPI_ROWS { bf16_t* rowp = L1b + (size_t)(row0 + ai * 128 + m * 16) * 512 + col0;
#pragma unroll
                for (int n = 0; n < 2; ++n) { pg8::f32x4 v = acc[ai][0][m][n];
                    if (act == 3) { v[0] = tanhf(v[0]); v[1] = tanhf(v[1]); v[2] = tanhf(v[2]); v[3] = tanhf(v[3]); }
                    else if (act == 5) { v[0] = sigmoidf_(v[0]); v[1] = sigmoidf_(v[1]); v[2] = sigmoidf_(v[2]); v[3] = sigmoidf_(v[3]); }
                    pg8::u32x2 w; w.x = pg8::cvt_pk_bf16(v[0], v[1]); w.y = pg8::cvt_pk_bf16(v[2], v[3]); *(pg8::u32x2*)(rowp + n * 16) = w;
                    if (act == 5) { pg8::u32x2 zz; zz.x = 0u; zz.y = 0u; *(pg8::u32x2*)(rowp + 128 + n * 16) = zz; } }
            }
        }
    }
};
struct EpiLora2 {
    static constexpr bool PERM = false;
    float* WD; float* AA; float* GG; const float* w0; const float* a0;
    __device__ __forceinline__ void operator()(EPI_ARGS) const {
        const int row0 = u.pm * 256 + wr * 64 + fr, col0 = u.pn * 256 + wc * 32 + 4 * fq, job = u.job;
        float* C = job < 2 ? WD + (size_t)job * T * D : (job < 4 ? AA + (size_t)(job - 2) * T * D : GG);
        const float* bias = job < 2 ? w0 + job * D : a0 + (job < 4 ? job - 2 : 0) * D;
        const float sc = job < 2 ? -0.6065306597126334f : 1.0f;
#pragma unroll
        EPI_COLS { const pg8::f32x4 bv = *(const pg8::f32x4*)(bias + col0 + bj * 128 + n * 16);
#pragma unroll
            EPI_ROWS { pg8::f32x4 v = acc[ai][bj][m][n];
                if (job < 4) { v = v + bv;
#pragma unroll
                    for (int j = 0; j < 4; ++j) v[j] = sc * sigmoidf_(v[j]);
                    if (job < 2) {
#pragma unroll
                        for (int j = 0; j < 4; ++j) v[j] = __expf(v[j]); } }
                *(pg8::f32x4*)(C + (size_t)(row0 + ai * 128 + m * 16) * D + col0 + bj * 128 + n * 16) = v; } }
    }
};
struct EpiStoreF32 {
    static constexpr bool PERM = false;
    float* C; int ldc;
    __device__ __forceinline__ void operator()(EPI_ARGS) const {
        const int row0 = u.pm * 256 + wr * 64 + fr, col0 = u.pn * 256 + wc * 32 + 4 * fq;
#pragma unroll
        EPI_ROWS { float* rowp = C + (size_t)(row0 + ai * 128 + m * 16) * ldc + col0;
#pragma unroll
            EPI_COLS *(pg8::f32x4*)(rowp + bj * 128 + n * 16) = acc[ai][bj][m][n]; }
    }
};
struct EpiAddX {
    static constexpr bool PERM = false;
    float* X;
    __device__ __forceinline__ void operator()(EPI_ARGS) const {
        const int row0 = u.pm * 256 + wr * 64 + fr, col0 = u.pn * 256 + wc * 32 + 4 * fq;
#pragma unroll
        EPI_ROWS { float* rowp = X + (size_t)(row0 + ai * 128 + m * 16) * D + col0;
#pragma unroll
            EPI_COLS { pg8::f32x4* q = (pg8::f32x4*)(rowp + bj * 128 + n * 16); *q = *q + acc[ai][bj][m][n]; } }
    }
};
struct EpiLruGate {
    static constexpr bool PERM = false;
    float* RG; float* IG; const float* ba; const float* bx;
    __device__ __forceinline__ void operator()(EPI_ARGS) const {
        const int gk = u.job >> 3, z = (u.job >> 2) & 1, h = u.job & 3;
        const int row0 = u.pm * 256 + wr * 64 + fr, col0 = h * 256 + wc * 32 + 4 * fq;
        float* C = (gk ? IG : RG) + (size_t)z * T * D; const float* bias = (gk ? bx : ba) + z * D;
#pragma unroll
        EPI_COLS { const pg8::f32x4 bv = *(const pg8::f32x4*)(bias + col0 + bj * 128 + n * 16);
#pragma unroll
            EPI_ROWS { pg8::f32x4 v = acc[ai][bj][m][n] + bv;
#pragma unroll
                for (int j = 0; j < 4; ++j) v[j] = sigmoidf_(v[j]);
                *(pg8::f32x4*)(C + (size_t)(row0 + ai * 128 + m * 16) * D + col0 + bj * 128 + n * 16) = v; } }
    }
};
struct EpiSwiglu {
    static constexpr bool PERM = true;
    bf16_t* HID;
    __device__ __forceinline__ void operator()(EPI_ARGS) const {
        bf16_t* base = HID + (size_t)u.job * 2048 * FF; const int row0 = u.pm * 256 + wr * 64 + fr, col0 = u.pn * 128 + wc * 32 + 8 * fq;
#pragma unroll
        EPI_ROWS { float o[8];
#pragma unroll
            for (int n = 0; n < 2; ++n)
#pragma unroll
                for (int j = 0; j < 4; ++j) { const float gt = acc[ai][0][m][n][j], up = acc[ai][1][m][n][j]; o[n * 4 + j] = gt * sigmoidf_(gt) * up; }
            pg8::u32x4 w; w.x = pg8::cvt_pk_bf16(o[0], o[1]); w.y = pg8::cvt_pk_bf16(o[2], o[3]); w.z = pg8::cvt_pk_bf16(o[4], o[5]); w.w = pg8::cvt_pk_bf16(o[6], o[7]);
            *(pg8::u32x4*)(base + (size_t)(row0 + ai * 128 + m * 16) * FF + col0) = w; }
    }
};
struct EpiDown {
    static constexpr bool PERM = false;
    float* YEXP; const float* GATE;
    __device__ __forceinline__ void operator()(EPI_ARGS) const {
        const int row0 = u.pm * 256 + wr * 64 + fr, col0 = u.pn * 256 + wc * 32 + 4 * fq;
        float* C = YEXP + (size_t)u.job * 2048 * D; const float* gt = GATE + (size_t)u.job * 2048;
#pragma unroll
        EPI_ROWS { const int row = row0 + ai * 128 + m * 16; const float gs = gt[row];
#pragma unroll
            EPI_COLS *(pg8::f32x4*)(C + (size_t)row * D + col0 + bj * 128 + n * 16) = acc[ai][bj][m][n] * gs; }
    }
};

struct RmId { __device__ __forceinline__ int operator()(int n) const { return n; } };
struct RmGU { int off; __device__ __forceinline__ int operator()(int n) const { return ((n >> 7) << 8) + off + (n & 127); } };
template <class RM>
__device__ __forceinline__ void tconv(const int wv, const float* W, int ldw, int K, int N, bf16_t* dst, int ldb, int koff, const RM rm, float* lds, int& rot) {
    const int tid = TID, G = gridDim.x, tn = N >> 7, ntiles = (K >> 6) * tn;
    const int lr = tid >> 5, lc = (tid & 31) * 4;
    const int sn = tid >> 3, sk = (tid & 7) * 8;
    int t = (int)(((unsigned)blockIdx.x + (unsigned)G - (unsigned)(rot % G)) % (unsigned)G);
    float4 cur[4], nx[4];
    if (t < ntiles) { const int k0 = (t / tn) << 6, n0 = (t % tn) << 7;
#pragma unroll
        for (int i = 0; i < 4; ++i) cur[i] = *(const float4*)(W + (size_t)(k0 + lr + 16 * i) * ldw + n0 + lc); }
    for (; t < ntiles; t += G) {
        const int k0 = (t / tn) << 6, n0 = (t % tn) << 7; const int t2 = t + G;
        if (t2 < ntiles) { const int k2 = (t2 / tn) << 6, n2 = (t2 % tn) << 7;
#pragma unroll
            for (int i = 0; i < 4; ++i) nx[i] = *(const float4*)(W + (size_t)(k2 + lr + 16 * i) * ldw + n2 + lc); }
        __syncthreads();
#pragma unroll
        for (int i = 0; i < 4; ++i) { float* q = lds + (lr + 16 * i) * 129 + lc; q[0] = cur[i].x; q[1] = cur[i].y; q[2] = cur[i].z; q[3] = cur[i].w; }
        __syncthreads();
#pragma unroll
        for (int i = 0; i < 2; ++i) { const int n = sn + 64 * i; float f[8];
#pragma unroll
            for (int j = 0; j < 8; ++j) f[j] = lds[(sk + j) * 129 + n];
            pg8::u32x4 w; w.x = pg8::cvt_pk_bf16(f[0], f[1]); w.y = pg8::cvt_pk_bf16(f[2], f[3]); w.z = pg8::cvt_pk_bf16(f[4], f[5]); w.w = pg8::cvt_pk_bf16(f[6], f[7]);
            *(pg8::u32x4*)(dst + (size_t)rm(n0 + n) * ldb + koff + k0 + sk) = w; }
#pragma unroll
        for (int i = 0; i < 4; ++i) cur[i] = nx[i];
    }
    rot += ntiles;
}
__device__ __forceinline__ void tconv_small(const int wv, const float* W, int K, int N, bf16_t* dst, int ldb, int noff) {
    for (int i = blockIdx.x * NTHR + TID; i < K * N; i += gridDim.x * NTHR) { const int k = i / N, n = i - k * N; dst[(size_t)(n + noff) * ldb + k] = f2bf(W[i]); }
}
__device__ __forceinline__ void zfill(const int wv, bf16_t* dst, int ldb, int r0, int r1, int c0, int c1) {
    const int w8 = (c1 - c0) >> 3, tot = (r1 - r0) * w8;
    for (int i = blockIdx.x * NTHR + TID; i < tot; i += gridDim.x * NTHR) { const int r = r0 + i / w8, c = c0 + (i % w8) * 8; *(uint4*)(dst + (size_t)r * ldb + c) = make_uint4(0u, 0u, 0u, 0u); }
}
__device__ __forceinline__ void ph_prologue(const int wv, const P& p, float* lds) {
    int rot = 0;
    unsigned char* ws = p.ws;
    for (int L = 0; L < DEPTH; ++L)
        for (int e = 0; e < NE; ++e) {
            bf16_t* gu = (bf16_t*)(ws + WB_MOE + (size_t)L * MOE_STRIDE + MOE_GU) + (size_t)e * 4096 * D;
            bf16_t* dn = (bf16_t*)(ws + WB_MOE + (size_t)L * MOE_STRIDE + MOE_DN) + (size_t)e * D * FF;
            RmGU rg; rg.off = 0; RmGU ru; ru.off = 128;
            tconv(wv, p.in[I_WG] + ((size_t)L * NE + e) * D * FF, FF, D, FF, gu, D, 0, rg, lds, rot);
            tconv(wv, p.in[I_WU] + ((size_t)L * NE + e) * D * FF, FF, D, FF, gu, D, 0, ru, lds, rot);
            tconv(wv, p.in[I_WDN] + ((size_t)L * NE + e) * FF * D, D, FF, D, dn, FF, 0, RmId(), lds, rot);
        }
    for (int ia = 0; ia < 2; ++ia) {
        unsigned char* rb = ws + WB_RW + (size_t)ia * RW_STRIDE;
        for (int q = 0; q < 3; ++q) tconv(wv, p.in[I_WIN] + ((size_t)ia * 3 + q) * D * D, D, D, D, (bf16_t*)(rb + RW_RKV) + (size_t)q * D * D, D, 0, RmId(), lds, rot);
        tconv(wv, p.in[I_WOUT] + (size_t)ia * D * D, D, D, D, (bf16_t*)(rb + RW_OUT), D, 0, RmId(), lds, rot);
        bf16_t* l1 = (bf16_t*)(rb + RW_L1);
        for (int z = 0; z < 2; ++z) { tconv_small(wv, p.in[I_W1] + ((size_t)ia * 2 + z) * D * 64, D, 64, l1, D, z * 64); tconv_small(wv, p.in[I_A1] + ((size_t)ia * 2 + z) * D * 64, D, 64, l1 + 256 * D, D, z * 64); }
        tconv(wv, p.in[I_G1] + (size_t)ia * D * 128, 128, D, 128, l1 + 2 * 256 * D, D, 0, RmId(), lds, rot);
        for (int q = 0; q < 3; ++q) zfill(wv, l1 + (size_t)q * 256 * D, D, 128, 256, 0, D);
        bf16_t* l2 = (bf16_t*)(rb + RW_L2);
        for (int z = 0; z < 2; ++z) {
            tconv(wv, p.in[I_W2] + ((size_t)ia * 2 + z) * 64 * D, D, 64, D, l2 + (size_t)z * 1024 * 256, 256, z * 64, RmId(), lds, rot);
            tconv(wv, p.in[I_A2] + ((size_t)ia * 2 + z) * 64 * D, D, 64, D, l2 + (size_t)(2 + z) * 1024 * 256, 256, 128 + z * 64, RmId(), lds, rot);
        }
        tconv(wv, p.in[I_G2] + (size_t)ia * 128 * D, D, 128, D, l2 + (size_t)4 * 1024 * 256, 256, 0, RmId(), lds, rot);
        for (int j = 0; j < 4; ++j) { const int k0 = j * 64; if (k0 > 0) zfill(wv, l2 + (size_t)j * 1024 * 256, 256, 0, 1024, 0, k0); if (k0 + 64 < 256) zfill(wv, l2 + (size_t)j * 1024 * 256, 256, 0, 1024, k0 + 64, 256); }
        zfill(wv, l2 + (size_t)4 * 1024 * 256, 256, 0, 1024, 128, 256);
    }
    tconv(wv, p.in[I_SCIN], 3 * D, D, 3 * D, (bf16_t*)(ws + WB_SC + SC_IN), D, 0, RmId(), lds, rot);
    tconv(wv, p.in[I_SCOUT], D, D, D, (bf16_t*)(ws + WB_SC + SC_OUT), D, 0, RmId(), lds, rot);
    tconv(wv, p.in[I_LIN], 2 * D, D, 2 * D, (bf16_t*)(ws + WB_LRU + LRU_IN), D, 0, RmId(), lds, rot);
    tconv(wv, p.in[I_LOUT], D, D, D, (bf16_t*)(ws + WB_LRU + LRU_OUT), D, 0, RmId(), lds, rot);
    for (int j = 0; j < 16; ++j) { const int gk = j >> 3, zh = j & 7;
        tconv(wv, p.in[gk ? I_LWX : I_LWA] + (size_t)zh * 256 * 256, 256, 256, 256, (bf16_t*)(ws + WB_LRU + LRU_G) + (size_t)j * 256 * 256, 256, 0, RmId(), lds, rot); }
}


#define XB_TMO      128
#define XB_XCNT(j)  (256  + 64 * (j))
#define XB_XSUB(j)  (1280 + 64 * (j))
#define XB_XGEN(j)  (2304 + 64 * (j))
#define XB_TOP      3328
#define XB_TOPGEN   3392
#define XCD_BAR_WORDS 3456
#define XB_SPIN_CAP (1u << 22)
#define LAS __attribute__((address_space(3)))
__device__ __forceinline__ unsigned xb_ld(unsigned* p)              { return __hip_atomic_load(p, __ATOMIC_RELAXED, __HIP_MEMORY_SCOPE_AGENT); }
__device__ __forceinline__ unsigned xb_add(unsigned* p, unsigned v) { return __hip_atomic_fetch_add(p, v, __ATOMIC_RELAXED, __HIP_MEMORY_SCOPE_AGENT); }
__device__ __forceinline__ unsigned xb_xcc_id() { return (unsigned)__builtin_amdgcn_s_getreg((3 << 11) | 20) & 0xFu; }
#define XB_SPIN(cond, bar) do { unsigned _sp = 0; while (cond) { __builtin_amdgcn_s_sleep(1); \
    if ((++_sp & 255u) == 0u) { if (xb_ld(&(bar)[XB_TMO])) break; if (_sp > XB_SPIN_CAP) { atomicAdd(&(bar)[XB_TMO], 1u); break; } } } } while (0)
struct XcdBarrier { unsigned* bar; unsigned x; volatile LAS unsigned* st; };
__device__ __forceinline__ XcdBarrier xcd_barrier_post(const int wv, unsigned* bar, volatile LAS unsigned* st) {
    XcdBarrier b; b.bar = bar; b.x = xb_xcc_id(); b.st = st;
    if (TID == 0) (void)xb_add(&bar[XB_XCNT(b.x)], 1u);
    return b;
}
__device__ __forceinline__ void xcd_barrier_complete(unsigned* bar, unsigned x, unsigned& nloc, unsigned& nx) {
    const unsigned G = gridDim.x * gridDim.y * gridDim.z;
    unsigned sum, cnt, mine, sp = 0u;
    for (;;) {
        sum = 0u; cnt = 0u; mine = 0u;
#pragma unroll
        for (unsigned j = 0; j < 16; ++j) { const unsigned c = xb_ld(&bar[XB_XCNT(j)]); sum += c; cnt += (c > 0u) ? 1u : 0u; mine = (j == x) ? c : mine; }
        if (sum == G) break;
        __builtin_amdgcn_s_sleep(1);
        if ((++sp & 255u) == 0u) { if (xb_ld(&bar[XB_TMO])) break; if (sp > XB_SPIN_CAP) { atomicAdd(&bar[XB_TMO], 1u); break; } }
    }
    nloc = mine > 0u ? mine : 1u; nx = cnt > 0u ? cnt : 1u;
}
__device__ __forceinline__ void xcd_barrier(const int wv, const XcdBarrier& b) {
    asm volatile("s_waitcnt vmcnt(0)" ::: "memory");
    __syncthreads();
    if (TID == 0) {
        unsigned* bar = b.bar;
        __builtin_amdgcn_s_waitcnt(0);
        unsigned nloc = b.st[0], nx = b.st[1];
        if (nloc == 0u) { xcd_barrier_complete(bar, b.x, nloc, nx); b.st[0] = nloc; b.st[1] = nx; }
        const unsigned old = xb_add(&bar[XB_XSUB(b.x)], 1u);
        const unsigned gen = old / nloc;
        if (old + 1u == (gen + 1u) * nloc) {
            __builtin_amdgcn_fence(__ATOMIC_RELEASE, "agent");
            asm volatile("s_waitcnt vmcnt(0)" ::: "memory");
            const unsigned og = xb_add(&bar[XB_TOP], 1u);
            const unsigned tg = og / nx;
            if (og + 1u == (tg + 1u) * nx) xb_add(&bar[XB_TOPGEN], 1u);
            else XB_SPIN(xb_ld(&bar[XB_TOPGEN]) == tg, bar);
            __builtin_amdgcn_fence(__ATOMIC_ACQUIRE, "agent");
            xb_add(&bar[XB_XGEN(b.x)], 1u);
            asm volatile("s_waitcnt vmcnt(0)" ::: "memory");
        } else {
            XB_SPIN(xb_ld(&bar[XB_XGEN(b.x)]) == gen, bar);
            __builtin_amdgcn_fence(__ATOMIC_ACQUIRE, "agent");
            asm volatile("s_waitcnt vmcnt(0)" ::: "memory");
        }
    }
    __syncthreads();
}
struct PhaseCtl { XcdBarrier bar; int lo, hi; bool did; };
__device__ __forceinline__ bool phase_enter(const int wv, PhaseCtl& c, int k) {
    if (k < c.lo || k >= c.hi) return false;
    if (c.did) xcd_barrier(wv, c.bar);
    c.did = true;
    return true;
}
constexpr int PH_PER_LAYER = 16, PH_FINAL = 1 + DEPTH * PH_PER_LAYER, PH_TOTAL = PH_FINAL + 1;

#define IN(k) phase_enter(wv, pc, (k))
template <int L>
__device__ __forceinline__ void run_layer(const int wv, const P& p, float* lds, PhaseCtl& pc) {
    constexpr int m = L % 3, base = 1 + L * PH_PER_LAYER, ia = L / 3;
    PG8_LAS unsigned char* glds = (PG8_LAS unsigned char*)lds;
    unsigned char* ws = p.ws;
    float* X = (float*)(ws + WS_X); bf16_t* H = (bf16_t*)(ws + WS_H);
    float* RKV = (float*)(ws + WS_RKV);
    float* WDp = (float*)(ws + WS_WD); float* AAp = (float*)(ws + WS_AA); float* GG = (float*)(ws + WS_GG);
    SchedBase sb; sb.G = gridDim.x; sb.c = blockIdx.x;
    if (IN(base + 0)) ph_norm(wv, p, L == 0 ? p.in[I_X] : X, X, L > 0, p.in[I_NMG] + L * D, H, nullptr, nullptr, lds);
    if constexpr (m == 0) {
        const unsigned char* rb = ws + WB_RW + (size_t)ia * RW_STRIDE;
        if (IN(base + 1)) ph_xm(wv, p, p.in[I_MU] + ia * 6 * D);
        if (IN(base + 2)) {
            SchedProj S; S.G = sb.G; S.c = sb.c; S.XM = (const char*)(ws + WS_XM); S.Wrkv = (const char*)(rb + RW_RKV); S.L1t = (const char*)(rb + RW_L1);
            EpiProj E; E.RKV = RKV; E.L1b = (bf16_t*)(ws + WS_L1);
            pg8::Geo g; g.lda = D; g.ldb = D; g.K = D;
            pg8::gemm_phase(wv, glds, g, S, E);
        }
        if (IN(base + 3)) {
            SchedLora2 S; S.G = sb.G; S.c = sb.c; S.L1b = (const char*)(ws + WS_L1); S.L2t = (const char*)(rb + RW_L2);
            EpiLora2 E; E.WD = WDp; E.AA = AAp; E.GG = GG; E.w0 = p.in[I_W0] + (size_t)ia * 2 * D; E.a0 = p.in[I_A0] + (size_t)ia * 2 * D;
            pg8::Geo g; g.lda = 512; g.ldb = 256; g.K = 256;
            pg8::gemm_phase(wv, glds, g, S, E);
        }
        if (IN(base + 4)) ph_scan(wv, p, ia, lds);
        if (IN(base + 5)) ph_rwkv_post(wv, p, ia);
        if (IN(base + 6)) {
            SchedPlain S; S.G = sb.G; S.c = sb.c; S.A = (const char*)(ws + WS_YG); S.B = (const char*)(rb + RW_OUT); S.nN = 4; S.lda = D; S.ldb = D;
            EpiAddX E; E.X = X; pg8::Geo g; g.lda = D; g.ldb = D; g.K = D;
            pg8::gemm_phase(wv, glds, g, S, E);
        }
    } else if constexpr (m == 1) {
        if (IN(base + 1)) {
            SchedPlain S; S.G = sb.G; S.c = sb.c; S.A = (const char*)H; S.B = (const char*)(ws + WB_SC + SC_IN); S.nN = 12; S.lda = D; S.ldb = D;
            EpiStoreF32 E; E.C = RKV; E.ldc = 3 * D; pg8::Geo g; g.lda = D; g.ldb = D; g.K = D;
            pg8::gemm_phase(wv, glds, g, S, E);
        }
        if (IN(base + 2)) ph_sc_mid(wv, p);
        if (IN(base + 3)) {
            SchedPlain S; S.G = sb.G; S.c = sb.c; S.A = (const char*)(ws + WS_YG); S.B = (const char*)(ws + WB_SC + SC_OUT); S.nN = 4; S.lda = D; S.ldb = D;
            EpiAddX E; E.X = X; pg8::Geo g; g.lda = D; g.ldb = D; g.K = D;
            pg8::gemm_phase(wv, glds, g, S, E);
        }
    } else {
        if (IN(base + 1)) {
            SchedPlain S; S.G = sb.G; S.c = sb.c; S.A = (const char*)H; S.B = (const char*)(ws + WB_LRU + LRU_IN); S.nN = 8; S.lda = D; S.ldb = D;
            EpiStoreF32 E; E.C = RKV; E.ldc = 2 * D; pg8::Geo g; g.lda = D; g.ldb = D; g.K = D;
            pg8::gemm_phase(wv, glds, g, S, E);
        }
        if (IN(base + 2)) ph_lru_conv(wv, p);
        if (IN(base + 3)) {
            SchedLruGate S; S.G = sb.G; S.c = sb.c; S.UCB = (const char*)(ws + WS_UCB); S.Wg = (const char*)(ws + WB_LRU + LRU_G);
            EpiLruGate E; E.RG = WDp; E.IG = AAp; E.ba = p.in[I_LBA]; E.bx = p.in[I_LBX];
            pg8::Geo g; g.lda = D; g.ldb = 256; g.K = 256;
            pg8::gemm_phase(wv, glds, g, S, E);
        }
        if (IN(base + 4)) ph_lru_scan(wv, p, lds);
        if (IN(base + 5)) ph_lru_post(wv, p);
        if (IN(base + 6)) {
            SchedPlain S; S.G = sb.G; S.c = sb.c; S.A = (const char*)(ws + WS_YG); S.B = (const char*)(ws + WB_LRU + LRU_OUT); S.nN = 4; S.lda = D; S.ldb = D;
            EpiAddX E; E.X = X; pg8::Geo g; g.lda = D; g.ldb = D; g.K = D;
            pg8::gemm_phase(wv, glds, g, S, E);
        }
    }
    if (IN(base + 7)) ph_norm(wv, p, X, nullptr, false, p.in[I_NFG] + L * D, H, p.in[I_RW] + (size_t)L * D * NE, nullptr, lds);
    if (IN(base + 8)) ph_topk(wv, p, lds);
    if (IN(base + 9)) {
        SchedMoe1 S; S.G = sb.G; S.c = sb.c; S.XIN = (const char*)(ws + WS_XIN); S.Wgu = (const char*)(ws + WB_MOE + (size_t)L * MOE_STRIDE + MOE_GU);
        EpiSwiglu E; E.HID = (bf16_t*)(ws + WS_HID); pg8::Geo g; g.lda = D; g.ldb = D; g.K = D;
        pg8::gemm_phase(wv, glds, g, S, E);
    }
    if (IN(base + 10)) {
        SchedMoe2 S; S.G = sb.G; S.c = sb.c; S.HID = (const char*)(ws + WS_HID); S.Wdn = (const char*)(ws + WB_MOE + (size_t)L * MOE_STRIDE + MOE_DN);
        EpiDown E; E.YEXP = (float*)(ws + WS_YEXP); E.GATE = (const float*)(ws + WS_GATE); pg8::Geo g; g.lda = FF; g.ldb = FF; g.K = FF;
        pg8::gemm_phase(wv, glds, g, S, E);
    }
}

__global__ void __launch_bounds__(NTHR, 2) mega(P p_unused) {
    extern __shared__ __attribute__((aligned(16))) unsigned char lds_raw[];
    const P& p = *(const P*)__builtin_amdgcn_kernarg_segment_ptr();
    float* lds = (float*)lds_raw;
    volatile LAS unsigned* xbw = (volatile LAS unsigned*)(lds_raw + LDS_BYTES - 16);
    const int wv = __builtin_amdgcn_readfirstlane((int)(threadIdx.x >> 6));
    if (threadIdx.x == 0) { xbw[0] = 0u; xbw[1] = 0u; xbw[2] = 0u; xbw[3] = 0u; }
    __syncthreads();
    PhaseCtl pc; pc.lo = p.ph_lo; pc.hi = p.ph_hi; pc.did = false;
    pc.bar = xcd_barrier_post(wv, (unsigned*)(p.ws + WS_CTL), xbw);
    if (IN(0)) ph_prologue(wv, p, lds);
    run_layer<0>(wv, p, lds, pc);
    run_layer<1>(wv, p, lds, pc);
    run_layer<2>(wv, p, lds, pc);
    run_layer<3>(wv, p, lds, pc);
    if (IN(PH_FINAL)) ph_norm(wv, p, (const float*)(p.ws + WS_X), nullptr, true, p.in[I_FNG], nullptr, nullptr, p.out, lds);
}
#undef IN

}

extern "C" void kernel_launch(void* const* d_in, const int* in_sizes, int n_in, void* d_out, int out_size, void* d_ws, size_t ws_size, hipStream_t stream) {
    static int ready = 0, grid = 256;
    if (!ready) {
        if (n_in != 36 || out_size != T * D || ws_size < WS_END) { fprintf(stderr, "kernel_launch: unexpected problem (n_in %d out %d ws %zu need %zu)\n", n_in, out_size, ws_size, (size_t)WS_END); ready = -1; return; }
        if (hipFuncSetAttribute((const void*)mega, hipFuncAttributeMaxDynamicSharedMemorySize, LDS_BYTES) != hipSuccess) { fprintf(stderr, "kernel_launch: hipFuncSetAttribute failed\n"); ready = -1; return; }
        { int dev = 0, cus = 0; if (hipGetDevice(&dev) == hipSuccess && hipDeviceGetAttribute(&cus, hipDeviceAttributeMultiprocessorCount, dev) == hipSuccess && cus > 0) grid = cus < 256 ? cus : 256; }
        ready = 1;
    }
    if (ready < 0) return;
    (void)in_sizes;
    P p{};
    for (int i = 0; i < 36; ++i) p.in[i] = (const float*)d_in[i];
    p.out = (float*)d_out; p.ws = (unsigned char*)d_ws;
    if (hipMemsetAsync((char*)d_ws + WS_CTL, 0, XCD_BAR_WORDS * sizeof(unsigned), stream) != hipSuccess) { fprintf(stderr, "kernel_launch: memset failed\n"); return; }
    p.ph_lo = 0; p.ph_hi = PH_TOTAL;
    hipLaunchKernelGGL(mega, dim3(grid), dim3(NTHR), LDS_BYTES, stream, p);
}
```

```cpp
#include <hip/hip_runtime.h>
#include <stdint.h>
#include <stdio.h>

namespace {
constexpr int D = 1024, NB = 8, S = 2048, T = NB * S, DEPTH = 4, NE = 16, FF = 2048, CAP = 256, NH = 16, HD = 64;
constexpr int NTHR = 512;
constexpr float RMS_EPS = 1e-6f, LNX_EPS = 64e-5f;
typedef unsigned short bf16_t;

constexpr size_t MiB = 1u << 20;
constexpr size_t WS_CTL = 0;
constexpr size_t WS_X = 1 * MiB;
constexpr size_t WS_H = WS_X + 64 * MiB;
constexpr size_t WS_XM = WS_H + 32 * MiB;
constexpr size_t WS_RKV = WS_XM + 192 * MiB;
constexpr size_t WS_L1 = WS_RKV + 192 * MiB;
constexpr size_t WS_WD = WS_L1 + 24 * MiB;
constexpr size_t WS_AA = WS_WD + 128 * MiB;
constexpr size_t WS_GG = WS_AA + 128 * MiB;
constexpr size_t WS_YS = WS_GG + 64 * MiB;
constexpr size_t WS_YG = WS_YS + 128 * MiB;
constexpr size_t WS_UCB = WS_YG + 32 * MiB;
constexpr size_t WS_YEXP = WS_UCB + 32 * MiB;
constexpr size_t WS_AFF = WS_YEXP + 128 * MiB;
constexpr size_t WS_SLOT = WS_AFF + 1 * MiB;
constexpr size_t WS_GATE = WS_SLOT + 1 * MiB;
constexpr size_t WS_ACT_END = WS_GATE + 1 * MiB;
constexpr size_t WB_RW = WS_ACT_END;
constexpr size_t RW_RKV = 0, RW_L1 = 6 * MiB, RW_L2 = RW_L1 + 3 * 256 * 1024 * 2, RW_OUT = RW_L2 + 5 * 1024 * 256 * 2, RW_STRIDE = 12 * MiB;
constexpr size_t WB_SC = WB_RW + 2 * RW_STRIDE;
constexpr size_t SC_IN = 0, SC_OUT = 6 * MiB;
constexpr size_t WB_LRU = WB_SC + 8 * MiB;
constexpr size_t LRU_IN = 0, LRU_G = 4 * MiB, LRU_OUT = 6 * MiB;
constexpr size_t WB_MOE = WB_LRU + 8 * MiB;
constexpr size_t MOE_GU = 0, MOE_DN = 128 * MiB, MOE_STRIDE = 192 * MiB;
constexpr size_t WS_X2 = WB_MOE + 4 * MOE_STRIDE;
constexpr size_t WS_END = WS_X2 + 64 * MiB;
constexpr size_t WS_XIN = WS_XM, WS_HID = WS_XM + 64 * MiB;

constexpr int REP_PROLOGUE = 1, REP_NORM_MIX = 1, REP_XM = 1, REP_PROJ = 1, REP_LORA2 = 1, REP_SCAN = 1, REP_RPOST = 1, REP_OUT = 1, REP_SCIN = 1, REP_SCMID = 1,
              REP_LIN = 1, REP_LCONV = 1, REP_LGATE = 1, REP_LSCAN = 1, REP_LPOST = 1, REP_NORM_FFN = 1, REP_TOPK = 1, REP_MOE1 = 1, REP_MOE2 = 1, REP_BAR = 1, REP_SA = 1, REP_SB = 1, REP_SC = 1, REP_SD = 1;
#define REPEAT(n) for (int rep_ = 0; rep_ < (n); ++rep_)
#define LASTREP(n) (rep_ == (n) - 1)
struct P {
    const float* in[36];
    float* out;
    unsigned char* ws;
    int ph_lo, ph_hi;
};

enum { I_X = 0, I_NMG, I_NFG, I_RW, I_WG, I_WU, I_WDN, I_FNG, I_MU, I_WIN, I_W0, I_W1, I_W2, I_A0, I_A1, I_A2, I_G1, I_G2, I_KK, I_KA, I_RK, I_LNG, I_LNB, I_WOUT,
       I_SCIN, I_SCCW, I_SCOUT, I_LIN, I_LCW, I_LCB, I_LWA, I_LBA, I_LWX, I_LBX, I_LLAM, I_LOUT };

__device__ __forceinline__ int lane_fresh() { int l; asm volatile("v_mbcnt_lo_u32_b32 %0, -1, 0\n\tv_mbcnt_hi_u32_b32 %0, -1, %0" : "=v"(l)); return l; }
#define TID (wv * 64 + lane_fresh())
__device__ __forceinline__ float bf2f(bf16_t v) { return __uint_as_float((unsigned)v << 16); }
__device__ __forceinline__ bf16_t f2bf(float f) { unsigned u = __float_as_uint(f); u += 0x7FFFu + ((u >> 16) & 1u); return (bf16_t)(u >> 16); }
__device__ __forceinline__ void bf4_to_f(uint2 u, float* f) { f[0] = __uint_as_float(u.x << 16); f[1] = __uint_as_float(u.x & 0xffff0000u); f[2] = __uint_as_float(u.y << 16); f[3] = __uint_as_float(u.y & 0xffff0000u); }
__device__ __forceinline__ uint2 f4_to_bf(float a, float b, float c, float d) { return make_uint2((unsigned)f2bf(a) | ((unsigned)f2bf(b) << 16), (unsigned)f2bf(c) | ((unsigned)f2bf(d) << 16)); }
__device__ __forceinline__ float wave_sum(float v) { for (int o = 32; o >= 1; o >>= 1) v += __shfl_xor(v, o); return v; }
__device__ __forceinline__ void wave_sum8(float (&v)[8]) {
#pragma unroll
    for (int o = 32; o >= 1; o >>= 1) { float t[8];
#pragma unroll
        for (int s = 0; s < 8; ++s) t[s] = __shfl_xor(v[s], o);
#pragma unroll
        for (int s = 0; s < 8; ++s) v[s] += t[s]; }
}
__device__ __forceinline__ float quad_sum(float v) { v += __shfl_xor(v, 1); v += __shfl_xor(v, 2); return v; }
__device__ __forceinline__ float sigmoidf_(float x) { return __builtin_amdgcn_rcpf(1.0f + __expf(-x)); }
__device__ __forceinline__ float tanhf_(float x) { const float e = __expf(-2.0f * fabsf(x)); const float t = (1.0f - e) * __builtin_amdgcn_rcpf(1.0f + e); return x < 0.f ? -t : t; }
__device__ __forceinline__ float softplusf_(float y) { return fmaxf(y, 0.f) + log1pf(__expf(-fabsf(y))); }
__device__ __forceinline__ float gelu_tanh(float x) { const float u = 0.7978845608028654f * (x + 0.044715f * x * x * x); return 0.5f * x * (1.0f + tanhf_(u)); }

__device__ __forceinline__ void ph_norm(const int wv, const P& p, const float* xin, float* xout, bool combine, const float* gamma, bf16_t* hout, const float* router_w, float* fout, float* lds) {
    const int tid = TID, lane = tid & 63, wave = tid >> 6;
    if (router_w) {
        for (int i = tid; i < D * NE; i += NTHR) { const int d = i >> 4, e = i & 15; lds[e * D + d] = router_w[i]; }
        __syncthreads();
    }
    const bf16_t* yexp = (const bf16_t*)(p.ws + WS_YEXP); const int* slot = (const int*)(p.ws + WS_SLOT);
    float* aff = (float*)(p.ws + WS_AFF);
    const int tstep = gridDim.x * 8; int tok = blockIdx.x * 8 + wave;
    float4 xn[4]; int sln = -1;
    if (tok < T) {
#pragma unroll
        for (int i = 0; i < 4; ++i) xn[i] = ((const float4*)(xin + (size_t)tok * D))[i * 64 + lane];
        if (combine) sln = slot[tok * NE + (lane & 15)];
    }
    for (; tok < T; tok += tstep) {
        const int b = tok / S, s = tok % S;
        float4 x[4];
#pragma unroll
        for (int i = 0; i < 4; ++i) x[i] = xn[i];
        const int slv = sln;
        if (tok + tstep < T) {
#pragma unroll
            for (int i = 0; i < 4; ++i) xn[i] = ((const float4*)(xin + (size_t)(tok + tstep) * D))[i * 64 + lane];
            if (combine) sln = slot[(tok + tstep) * NE + (lane & 15)];
        }
        if (combine) {
            unsigned msk = (unsigned)(__ballot(slv >= 0) & 0xffffull);
            while (msk) {
                const int e0 = __ffs(msk) - 1; msk &= msk - 1u;
                const int e1 = msk ? (__ffs(msk) - 1) : e0; const bool two = msk != 0u; msk &= msk - 1u;
                const int s0 = __builtin_amdgcn_readlane(slv, e0), s1 = __builtin_amdgcn_readlane(slv, e1);
                const uint2* r0 = (const uint2*)(yexp + ((size_t)(e0 * NB + b) * CAP + s0) * D); const uint2* r1 = (const uint2*)(yexp + ((size_t)(e1 * NB + b) * CAP + s1) * D);
                uint2 q0[4], q1[4];
#pragma unroll
                for (int i = 0; i < 4; ++i) { q0[i] = r0[i * 64 + lane]; q1[i] = r1[i * 64 + lane]; }
#pragma unroll
                for (int i = 0; i < 4; ++i) { float f[4]; bf4_to_f(q0[i], f); x[i].x += f[0]; x[i].y += f[1]; x[i].z += f[2]; x[i].w += f[3];
                    if (two) { bf4_to_f(q1[i], f); x[i].x += f[0]; x[i].y += f[1]; x[i].z += f[2]; x[i].w += f[3]; } }
            }
        }
        if (xout) {
#pragma unroll
            for (int i = 0; i < 4; ++i) ((float4*)(xout + (size_t)tok * D))[i * 64 + lane] = x[i];
        }
        float ss = 0.f;
#pragma unroll
        for (int i = 0; i < 4; ++i) ss += x[i].x * x[i].x + x[i].y * x[i].y + x[i].z * x[i].z + x[i].w * x[i].w;
        ss = wave_sum(ss);
        const float rstd = __builtin_amdgcn_rsqf(ss * (1.0f / D) + RMS_EPS);
        float4 h[4];
#pragma unroll
        for (int i = 0; i < 4; ++i) {
            const float4 g = ((const float4*)gamma)[i * 64 + lane];
            h[i].x = x[i].x * rstd * g.x; h[i].y = x[i].y * rstd * g.y; h[i].z = x[i].z * rstd * g.z; h[i].w = x[i].w * rstd * g.w;
        }
        if (hout) {
#pragma unroll
            for (int i = 0; i < 4; ++i) ((uint2*)(hout + (size_t)tok * D))[i * 64 + lane] = f4_to_bf(h[i].x, h[i].y, h[i].z, h[i].w);
        }
        if (fout) {
#pragma unroll
            for (int i = 0; i < 4; ++i) ((float4*)(fout + (size_t)tok * D))[i * 64 + lane] = h[i];
        }
        if (router_w) {
            float mylg = -3.0e38f;
#pragma unroll 1
            for (int eg = 0; eg < NE; eg += 8) {
                float a8[8];
#pragma unroll
                for (int j = 0; j < 8; ++j) {
                    float a = 0.f;
#pragma unroll
                    for (int i = 0; i < 4; ++i) { const float4 w = ((const float4*)(lds + (eg + j) * D))[i * 64 + lane]; a += h[i].x * w.x + h[i].y * w.y + h[i].z * w.z + h[i].w * w.w; }
                    a8[j] = a;
                }
                wave_sum8(a8);
#pragma unroll
                for (int j = 0; j < 8; ++j) if (lane == eg + j) mylg = a8[j];
            }
            float mx = mylg;
#pragma unroll
            for (int o = 1; o < 16; o <<= 1) mx = fmaxf(mx, __shfl_xor(mx, o));
            const float mine = (lane < NE) ? __expf(mylg - mx) : 0.f;
            float sum = mine;
#pragma unroll
            for (int o = 1; o < 16; o <<= 1) sum += __shfl_xor(sum, o);
            if (lane < NE) aff[((size_t)b * NE + lane) * S + s] = mine / sum;
        }
    }
}

__device__ __forceinline__ void ph_norm_xm(const int wv, const P& p, const float* xin, float* xout, bool combine, const float* gamma, const float* mu, unsigned char* lds) {
    const int tid = TID, lane = tid & 63, wave = tid >> 6;
    constexpr int HP = 2064;
    const bf16_t* yexp = (const bf16_t*)(p.ws + WS_YEXP); const int* slot = (const int*)(p.ws + WS_SLOT);
    bf16_t* XM = (bf16_t*)(p.ws + WS_XM);
    for (int unit = blockIdx.x; unit < T / 32; unit += gridDim.x) {
        const int t0 = unit * 32;
        float4 xr[5][4]; int slr[5];
#pragma unroll
        for (int j = 0; j < 5; ++j) {
            const int r = wave + 8 * j, tok = t0 - 1 + r, s = (t0 % S) - 1 + r; slr[j] = -1;
            if (r < 34 && s >= 0 && s < S) {
#pragma unroll
                for (int i = 0; i < 4; ++i) xr[j][i] = ((const float4*)(xin + (size_t)tok * D))[i * 64 + lane];
                if (combine) slr[j] = slot[tok * NE + (lane & 15)];
            } else {
#pragma unroll
                for (int i = 0; i < 4; ++i) xr[j][i] = make_float4(0.f, 0.f, 0.f, 0.f);
            }
        }
#pragma unroll
        for (int j = 0; j < 5; ++j) {
            const int r = wave + 8 * j, tok = t0 - 1 + r, s = (t0 % S) - 1 + r;
            if (r >= 34) continue;
            uint2* hrow = (uint2*)(lds + r * HP);
            if (s < 0 || s >= S) {
#pragma unroll
                for (int i = 0; i < 4; ++i) hrow[i * 64 + lane] = make_uint2(0u, 0u);
                continue;
            }
            const int b = tok / S;
            float4 x[4];
#pragma unroll
            for (int i = 0; i < 4; ++i) x[i] = xr[j][i];
            if (combine) {
                const int slv = slr[j];
                unsigned msk = (unsigned)(__ballot(slv >= 0) & 0xffffull);
                while (msk) {
                    const int e0 = __ffs(msk) - 1; msk &= msk - 1u;
                    const int e1 = msk ? (__ffs(msk) - 1) : e0; const bool two = msk != 0u; msk &= msk - 1u;
                    const int s0 = __builtin_amdgcn_readlane(slv, e0), s1 = __builtin_amdgcn_readlane(slv, e1);
                    const uint2* r0 = (const uint2*)(yexp + ((size_t)(e0 * NB + b) * CAP + s0) * D); const uint2* r1 = (const uint2*)(yexp + ((size_t)(e1 * NB + b) * CAP + s1) * D);
                    uint2 q0[4], q1[4];
#pragma unroll
                    for (int i = 0; i < 4; ++i) { q0[i] = r0[i * 64 + lane]; q1[i] = r1[i * 64 + lane]; }
#pragma unroll
                    for (int i = 0; i < 4; ++i) { float f[4]; bf4_to_f(q0[i], f); x[i].x += f[0]; x[i].y += f[1]; x[i].z += f[2]; x[i].w += f[3];
                        if (two) { bf4_to_f(q1[i], f); x[i].x += f[0]; x[i].y += f[1]; x[i].z += f[2]; x[i].w += f[3]; } }
                }
            }
            if (r >= 1 && r <= 32) {
#pragma unroll
                for (int i = 0; i < 4; ++i) ((float4*)(xout + (size_t)tok * D))[i * 64 + lane] = x[i];
            }
            float ss = 0.f;
#pragma unroll
            for (int i = 0; i < 4; ++i) ss += x[i].x * x[i].x + x[i].y * x[i].y + x[i].z * x[i].z + x[i].w * x[i].w;
            ss = wave_sum(ss);
            const float rstd = __builtin_amdgcn_rsqf(ss * (1.0f / D) + RMS_EPS);
#pragma unroll
            for (int i = 0; i < 4; ++i) {
                const float4 gq = ((const float4*)gamma)[i * 64 + lane];
                hrow[i * 64 + lane] = f4_to_bf(x[i].x * rstd * gq.x, x[i].y * rstd * gq.y, x[i].z * rstd * gq.z, x[i].w * rstd * gq.w);
            }
        }
        __syncthreads();
        for (int r = 1 + wave; r <= 32; r += 8) {
            const int tok = t0 - 1 + r;
#pragma unroll
            for (int i = 0; i < 4; ++i) {
                const int c4 = i * 64 + lane;
                float hc[4], hp[4], hn[4];
                bf4_to_f(((const uint2*)(lds + r * HP))[c4], hc); bf4_to_f(((const uint2*)(lds + (r - 1) * HP))[c4], hp); bf4_to_f(((const uint2*)(lds + (r + 1) * HP))[c4], hn);
                float xx[4];
#pragma unroll
                for (int j = 0; j < 4; ++j) xx[j] = 0.5f * (hp[j] + hn[j]) - hc[j];
#pragma unroll
                for (int q = 0; q < 6; ++q) {
                    const float4 m = ((const float4*)(mu + q * D))[c4];
                    ((uint2*)(XM + ((size_t)q * T + tok) * D))[c4] = f4_to_bf(hc[0] + xx[0] * m.x, hc[1] + xx[1] * m.y, hc[2] + xx[2] * m.z, hc[3] + xx[3] * m.w);
                }
            }
        }
        __syncthreads();
    }
}

__device__ __forceinline__ void ph_xm(const int wv, const P& p, const float* mu) {
    const int tid = TID, lane = tid & 63, wave = tid >> 6;
    const bf16_t* H = (const bf16_t*)(p.ws + WS_H); bf16_t* XM = (bf16_t*)(p.ws + WS_XM);
    for (int tok = blockIdx.x * 8 + wave; tok < T; tok += gridDim.x * 8) {
        const int s = tok % S;
#pragma unroll
        for (int i = 0; i < 4; ++i) {
            const int c4 = i * 64 + lane;
            float hc[4], hp[4] = {0.f, 0.f, 0.f, 0.f}, hn[4] = {0.f, 0.f, 0.f, 0.f};
            bf4_to_f(((const uint2*)(H + (size_t)tok * D))[c4], hc);
            if (s > 0) bf4_to_f(((const uint2*)(H + (size_t)(tok - 1) * D))[c4], hp);
            if (s < S - 1) bf4_to_f(((const uint2*)(H + (size_t)(tok + 1) * D))[c4], hn);
            float xx[4];
#pragma unroll
            for (int j = 0; j < 4; ++j) xx[j] = 0.5f * (hp[j] + hn[j]) - hc[j];
#pragma unroll
            for (int q = 0; q < 6; ++q) {
                const float4 m = ((const float4*)(mu + q * D))[c4];
                ((uint2*)(XM + ((size_t)q * T + tok) * D))[c4] = f4_to_bf(hc[0] + xx[0] * m.x, hc[1] + xx[1] * m.y, hc[2] + xx[2] * m.z, hc[3] + xx[3] * m.w);
            }
        }
    }
}

__device__ __forceinline__ void bf16x16_load(const bf16_t* p16, float* f) {
    const uint4 a = ((const uint4*)p16)[0], b = ((const uint4*)p16)[1];
    const unsigned w[8] = {a.x, a.y, a.z, a.w, b.x, b.y, b.z, b.w};
#pragma unroll
    for (int j = 0; j < 8; ++j) { f[2 * j] = __uint_as_float(w[j] << 16); f[2 * j + 1] = __uint_as_float(w[j] & 0xffff0000u); }
}
__device__ __forceinline__ void ph_rwkv_post(const int wv, const P& p, int ia) {
    const int tid = TID, lane = tid & 63, wave = tid >> 6;
    const bf16_t* RKV = (const bf16_t*)(p.ws + WS_RKV); const bf16_t* AAp = (const bf16_t*)(p.ws + WS_AA); const bf16_t* GG = (const bf16_t*)(p.ws + WS_GG);
    const bf16_t* YS = (const bf16_t*)(p.ws + WS_YS); bf16_t* YG = (bf16_t*)(p.ws + WS_YG);
    const float* k_a = p.in[I_KA] + ia * D; const float* r_k = p.in[I_RK] + ia * D; const float* lg = p.in[I_LNG] + ia * D; const float* lb = p.in[I_LNB] + ia * D;
    for (int tok = blockIdx.x * 8 + wave; tok < T; tok += gridDim.x * 8) {
        const size_t o = (size_t)tok * D + lane * 16;
        float y[16], r[16], k[16], v[16], a0[16], a1[16], gg[16];
        { float y1[16]; bf16x16_load(YS + o, y); bf16x16_load(YS + (size_t)T * D + o, y1);
#pragma unroll
          for (int j = 0; j < 16; ++j) y[j] += y1[j]; }
        bf16x16_load(RKV + o, r); bf16x16_load(RKV + (size_t)T * D + o, k); bf16x16_load(RKV + 2 * (size_t)T * D + o, v);
        bf16x16_load(AAp + o, a0); bf16x16_load(AAp + (size_t)T * D + o, a1); bf16x16_load(GG + o, gg);
        float sm = 0.f;
#pragma unroll
        for (int j = 0; j < 16; ++j) sm += y[j];
        const float mean = quad_sum(sm) * (1.0f / 64.0f);
        float sv = 0.f;
#pragma unroll
        for (int j = 0; j < 16; ++j) { const float d = y[j] - mean; sv += d * d; }
        const float rstd = 1.0f / sqrtf(quad_sum(sv) * (1.0f / 64.0f) + LNX_EPS);
        float d0 = 0.f, d1 = 0.f;
#pragma unroll
        for (int j = 0; j < 16; ++j) {
            const int c = lane * 16 + j; const float ka = k_a[c], rk = r_k[c];
            d0 += r[j] * (k[j] * (1.0f + (a0[j] - 1.0f) * ka)) * rk;
            d1 += r[j] * (k[j] * (1.0f + (a1[j] - 1.0f) * ka)) * rk;
        }
        const float bon = quad_sum(d0) + quad_sum(d1);
        float outv[16];
#pragma unroll
        for (int j = 0; j < 16; ++j) { const int c = lane * 16 + j; outv[j] = ((y[j] - mean) * rstd * lg[c] + lb[c] + bon * v[j]) * gg[j]; }
#pragma unroll
        for (int j = 0; j < 4; ++j) ((uint2*)(YG + o))[j] = f4_to_bf(outv[4 * j], outv[4 * j + 1], outv[4 * j + 2], outv[4 * j + 3]);
    }
}

__device__ __forceinline__ void ph_sc_mid(const int wv, const P& p) {
    const int tid = TID, lane = tid & 63, wave = tid >> 6;
    const bf16_t* BCU = (const bf16_t*)(p.ws + WS_RKV); bf16_t* BZ = (bf16_t*)(p.ws + WS_YG); const float* cw = p.in[I_SCCW];
    for (int tok = blockIdx.x * 8 + wave; tok < T; tok += gridDim.x * 8) {
        const int s = tok % S;
#pragma unroll
        for (int i = 0; i < 4; ++i) {
            const int c4 = i * 64 + lane;
            float z[4] = {0.f, 0.f, 0.f, 0.f};
#pragma unroll
            for (int j = 0; j < 3; ++j) {
                const int ss = s + j - 1;
                if (ss >= 0 && ss < S) {
                    const size_t ro = (size_t)(tok + j - 1) * (3 * D);
                    float c[4], u[4]; bf4_to_f(((const uint2*)(BCU + ro + D))[c4], c); bf4_to_f(((const uint2*)(BCU + ro + 2 * D))[c4], u);
                    const float4 w = ((const float4*)(cw + j * D))[c4];
                    z[0] += w.x * c[0] * u[0]; z[1] += w.y * c[1] * u[1]; z[2] += w.z * c[2] * u[2]; z[3] += w.w * c[3] * u[3];
                }
            }
            float bg[4]; bf4_to_f(((const uint2*)(BCU + (size_t)tok * (3 * D)))[c4], bg);
            ((uint2*)(BZ + (size_t)tok * D))[c4] = f4_to_bf(bg[0] * z[0], bg[1] * z[1], bg[2] * z[2], bg[3] * z[3]);
        }
    }
}

__device__ __forceinline__ void ph_lru_conv(const int wv, const P& p) {
    const int tid = TID, lane = tid & 63, wave = tid >> 6;
    const bf16_t* GU = (const bf16_t*)(p.ws + WS_RKV); float* UC = (float*)(p.ws + WS_GG); bf16_t* UCB = (bf16_t*)(p.ws + WS_UCB);
    const float* cw = p.in[I_LCW]; const float* cb = p.in[I_LCB];
    for (int tok = blockIdx.x * 8 + wave; tok < T; tok += gridDim.x * 8) {
        const int s = tok % S;
#pragma unroll
        for (int i = 0; i < 4; ++i) {
            const int c4 = i * 64 + lane;
            float4 acc = ((const float4*)cb)[c4];
#pragma unroll
            for (int j = 0; j < 4; ++j) {
                const int ss = s + j - 2;
                if (ss >= 0 && ss < S) {
                    float u[4]; bf4_to_f(((const uint2*)(GU + (size_t)(tok + j - 2) * (2 * D) + D))[c4], u); const float4 w = ((const float4*)(cw + j * D))[c4];
                    acc.x += w.x * u[0]; acc.y += w.y * u[1]; acc.z += w.z * u[2]; acc.w += w.w * u[3];
                }
            }
            ((float4*)(UC + (size_t)tok * D))[c4] = acc;
            ((uint2*)(UCB + (size_t)tok * D))[c4] = f4_to_bf(acc.x, acc.y, acc.z, acc.w);
        }
    }
}

__device__ __forceinline__ void ph_lru_scan(const int wv, const P& p, float* lds) {
    const int tid = TID;
    const bf16_t* LA = (const bf16_t*)(p.ws + WS_WD); const bf16_t* LB = (const bf16_t*)(p.ws + WS_AA);
    float* HS = (float*)(p.ws + WS_YS);
    float2* segP = (float2*)lds; float2* segH = (float2*)lds + 512;
    const int cp = tid & 31, seg = tid >> 5;
    for (int unit = blockIdx.x; unit < NB * 2 * 16; unit += gridDim.x) {
        const int cg = unit & 15, z = (unit >> 4) & 1, b = unit >> 5;
        const int c = cg * 64 + cp * 2;
        const bf16_t* la = LA + (size_t)z * T * D; const bf16_t* lb = LB + (size_t)z * T * D;
        float P0 = 0.f, P1 = 0.f, h0 = 0.f, h1 = 0.f;
#pragma unroll 8
        for (int i = seg * 128; i < seg * 128 + 128; ++i) {
            const int t = z ? (S - 1 - i) : i; const size_t o = ((size_t)b * S + t) * D + c;
            const unsigned a2 = *(const unsigned*)(la + o), b2 = *(const unsigned*)(lb + o);
            const float l0 = __uint_as_float(a2 << 16), l1 = __uint_as_float(a2 & 0xffff0000u);
            h0 = __expf(l0) * h0 + __uint_as_float(b2 << 16); h1 = __expf(l1) * h1 + __uint_as_float(b2 & 0xffff0000u);
            P0 += l0; P1 += l1;
        }
        segP[seg * 32 + cp] = make_float2(__expf(P0), __expf(P1)); segH[seg * 32 + cp] = make_float2(h0, h1);
        __syncthreads();
        float c0 = 0.f, c1 = 0.f;
        for (int s2 = 0; s2 < seg; ++s2) { const float2 pp = segP[s2 * 32 + cp], hh = segH[s2 * 32 + cp]; c0 = pp.x * c0 + hh.x; c1 = pp.y * c1 + hh.y; }
        h0 = c0; h1 = c1;
#pragma unroll 8
        for (int i = seg * 128; i < seg * 128 + 128; ++i) {
            const int t = z ? (S - 1 - i) : i; const size_t o = ((size_t)b * S + t) * D + c;
            const unsigned a2 = *(const unsigned*)(la + o), b2 = *(const unsigned*)(lb + o);
            h0 = __expf(__uint_as_float(a2 << 16)) * h0 + __uint_as_float(b2 << 16); h1 = __expf(__uint_as_float(a2 & 0xffff0000u)) * h1 + __uint_as_float(b2 & 0xffff0000u);
            *(float2*)(HS + (size_t)z * T * D + o) = make_float2(h0, h1);
        }
        __syncthreads();
    }
}

__device__ __forceinline__ void ph_lru_post(const int wv, const P& p) {
    const int tid = TID, lane = tid & 63, wave = tid >> 6;
    const bf16_t* GU = (const bf16_t*)(p.ws + WS_RKV); const float* HS = (const float*)(p.ws + WS_YS); bf16_t* YL = (bf16_t*)(p.ws + WS_YG);
    for (int tok = blockIdx.x * 8 + wave; tok < T; tok += gridDim.x * 8) {
#pragma unroll
        for (int i = 0; i < 4; ++i) {
            const int c4 = i * 64 + lane;
            float gq[4]; bf4_to_f(((const uint2*)(GU + (size_t)tok * (2 * D)))[c4], gq); const float4 g = make_float4(gq[0], gq[1], gq[2], gq[3]);
            const float4 h0 = ((const float4*)(HS + (size_t)tok * D))[c4], h1 = ((const float4*)(HS + (size_t)T * D + (size_t)tok * D))[c4];
            ((uint2*)(YL + (size_t)tok * D))[c4] = f4_to_bf((h0.x + h1.x) * gelu_tanh(g.x), (h0.y + h1.y) * gelu_tanh(g.y), (h0.z + h1.z) * gelu_tanh(g.z), (h0.w + h1.w) * gelu_tanh(g.w));
        }
    }
}

__device__ __forceinline__ int block_sum_i(const int wv, int v, int* wsum  ) {
    const int lane = lane_fresh(), wave = wv;
    v = __popcll(__ballot(v & 1)) + 2 * __popcll(__ballot(v & 2)) + 4 * __popcll(__ballot(v & 4));
    if (lane == 0) wsum[wave] = v;
    __syncthreads();
    int tot = 0;
#pragma unroll
    for (int w = 0; w < 8; ++w) tot += wsum[w];
    return tot;
}
__device__ __forceinline__ int block_excl_scan_i(const int wv, int v, int* wsum  , int& total) {
    const int lane = lane_fresh(), wave = wv;
    int inc = v;
    for (int o = 1; o < 64; o <<= 1) { const int t = __shfl_up(inc, o); if (lane >= o) inc += t; }
    if (lane == 63) wsum[wave] = inc;
    __syncthreads();
    int base = 0, tot = 0;
#pragma unroll
    for (int w = 0; w < 8; ++w) { const int x = wsum[w]; if (w < wave) base += x; tot += x; }
    total = tot;
    return base + inc - v;
}
__device__ __forceinline__ void ph_topk(const int wv, const P& p, float* ldsf) {
    const int tid = TID, lane = tid & 63, wave = tid >> 6;
    int* ldsi = (int*)ldsf;
    int* wsum = ldsi;
    int* idx_l = ldsi + 64;
    const float* aff = (const float*)(p.ws + WS_AFF); int* slot = (int*)(p.ws + WS_SLOT); float* gate = (float*)(p.ws + WS_GATE);
    const bf16_t* HF = (const bf16_t*)(p.ws + WS_H); bf16_t* XIN = (bf16_t*)(p.ws + WS_XIN);
    for (int unit2 = blockIdx.x; unit2 < 2 * NB * NE; unit2 += gridDim.x) {
        const int unit = unit2 >> 1, half = unit2 & 1;
        const int e = unit % NE, b = unit / NE;
        const float4 v4 = ((const float4*)(aff + ((size_t)b * NE + e) * S))[tid];
        const unsigned v[4] = {__float_as_uint(v4.x), __float_as_uint(v4.y), __float_as_uint(v4.z), __float_as_uint(v4.w)};
        unsigned thr = 0u;
        for (int bit = 29; bit >= 0; --bit) {
            const unsigned cand = thr | (1u << bit);
            const int cnt = (int)(v[0] >= cand) + (int)(v[1] >= cand) + (int)(v[2] >= cand) + (int)(v[3] >= cand);
            const int tot = block_sum_i(wv, cnt, wsum + (bit & 1) * 8);
            if (tot >= CAP) thr = cand;
        }
        int g4 = 0, e4 = 0;
#pragma unroll
        for (int j = 0; j < 4; ++j) { g4 += (int)(v[j] > thr); e4 += (int)(v[j] == thr); }
        const int ngt = block_sum_i(wv, g4, wsum + 16);
        const int need_eq = CAP - ngt;
        int toteq; const int eqbase = block_excl_scan_i(wv, e4, wsum + 24, toteq);
        int sel[4], nsel = 0, er = eqbase;
#pragma unroll
        for (int j = 0; j < 4; ++j) { const bool gt = v[j] > thr, eq = v[j] == thr; sel[j] = (gt || (eq && er < need_eq)) ? 1 : 0; er += eq ? 1 : 0; nsel += sel[j]; }
        __syncthreads();
        int totsel; int cpos = block_excl_scan_i(wv, nsel, wsum, totsel);
#pragma unroll
        for (int j = 0; j < 4; ++j) {
            const int t = tid * 4 + j;
            if (sel[j]) {
                if (cpos < CAP) { idx_l[cpos] = t; if (half == 0) { gate[((size_t)e * NB + b) * CAP + cpos] = __uint_as_float(v[j]); slot[((size_t)b * S + t) * NE + e] = cpos; } }
                else if (half == 0) slot[((size_t)b * S + t) * NE + e] = -1;
                ++cpos;
            } else if (half == 0) slot[((size_t)b * S + t) * NE + e] = -1;
        }
        __syncthreads();
#pragma unroll 1
        for (int cb = 0; cb < 16; cb += 4) {
            const int c = half * 128 + wave * 16 + cb;
            const uint4* s0 = (const uint4*)(HF + ((size_t)b * S + idx_l[c]) * D); const uint4* s1 = (const uint4*)(HF + ((size_t)b * S + idx_l[c + 1]) * D);
            const uint4* s2 = (const uint4*)(HF + ((size_t)b * S + idx_l[c + 2]) * D); const uint4* s3 = (const uint4*)(HF + ((size_t)b * S + idx_l[c + 3]) * D);
            const uint4 a0 = s0[lane], b0 = s0[lane + 64], a1 = s1[lane], b1 = s1[lane + 64], a2 = s2[lane], b2 = s2[lane + 64], a3 = s3[lane], b3 = s3[lane + 64];
            uint4* d0 = (uint4*)(XIN + (((size_t)e * NB + b) * CAP + c) * D);
            d0[lane] = a0; d0[lane + 64] = b0; d0[128 + lane] = a1; d0[128 + lane + 64] = b1; d0[256 + lane] = a2; d0[256 + lane + 64] = b2; d0[384 + lane] = a3; d0[384 + lane + 64] = b3;
        }
        __syncthreads();
    }
}


namespace pg8 {
#define PG8_LAS __attribute__((address_space(3)))
typedef short bf16x8 __attribute__((ext_vector_type(8)));
typedef float f32x4 __attribute__((ext_vector_type(4)));
typedef unsigned u32x4 __attribute__((ext_vector_type(4)));
typedef unsigned u32x2 __attribute__((ext_vector_type(2)));
constexpr int BM = 256, BK = 64, HALF = 128, HTB = HALF * BK * 2, STAGE_BYTES = 8 * HTB;
__device__ __forceinline__ int lds_byte(int r, int c) { const int st = (r >> 4) * 2 + (c >> 5), rr = r & 15, cc = c & 31, ob = rr * 64 + cc * 2; return st * 1024 + (ob ^ (((ob >> 9) & 1) << 5)); }
__device__ __forceinline__ void stage_rc(int b, int& R, int& C) { const int st = b / 1024, sb = b % 1024, swz = sb ^ (((sb >> 9) & 1) << 5); R = (st >> 1) * 16 + swz / 64; C = (st & 1) * 32 + (swz % 64) / 2; }
__device__ __forceinline__ int perm32(int rho) { const int n = rho >> 4, i = rho & 15; return 8 * (i >> 2) + 4 * n + (i & 3); }
struct Unit { const char* A; const char* B; int pm, pn, job; };
struct Geo { int lda, ldb, K; };
typedef float f32x2_t __attribute__((ext_vector_type(2)));
typedef __bf16 bf16x2_t __attribute__((ext_vector_type(2)));
__device__ __forceinline__ unsigned cvt_pk_bf16(float lo, float hi) { const f32x2_t v = {lo, hi}; const bf16x2_t b = __builtin_convertvector(v, bf16x2_t); return __builtin_bit_cast(unsigned, b); }

template <class Epi, class Sched>
__device__ __forceinline__ void gemm_phase(const int wv, PG8_LAS unsigned char* lds, const Geo g, const Sched& S, const Epi& E) {
    const int tid = TID, wid = wv, lane = tid & 63, wr = wid >> 2, wc = wid & 3, fr = lane & 15, fq = lane >> 4;
    const int nt = g.K / BK;
    unsigned voffA[2], voffB[2];
#pragma unroll
    for (int i = 0; i < 2; ++i) { int R, C; stage_rc(tid * 16 + i * 8192, R, C); const int Rb = Epi::PERM ? ((R & ~31) + perm32(R & 31)) : R;
        voffA[i] = (unsigned)(R * g.lda + C) * 2u; voffB[i] = (unsigned)(Rb * g.ldb + C) * 2u; }
    const size_t kstep = (size_t)(BK * 2);
    const size_t hstepA = (size_t)HALF * g.lda * 2, hstepB = (size_t)HALF * g.ldb * 2;
    const unsigned ldsw = (unsigned)wid * 1024u;
    const int aoff = lds_byte(wr * 64 + fr, fq * 8), boff = lds_byte(wc * 32 + fr, fq * 8);
#define PG8_SA(b, h) (((b) * 2 + (h)) * HTB)
#define PG8_SB(b, h) ((4 + (b) * 2 + (h)) * HTB)
#define PG8_STAGE(bufoff, gbase, voff) do { _Pragma("unroll") for (int _i = 0; _i < 2; ++_i) \
        __builtin_amdgcn_global_load_lds((const unsigned*)((const char*)(gbase) + (voff)[_i]), (PG8_LAS unsigned*)(lds + (bufoff) + ldsw + _i * 8192), 16, 0, 0); } while (0)
#define PG8_LDA(dst, b, h) do { _Pragma("unroll") for (int m = 0; m < 4; ++m) _Pragma("unroll") for (int k = 0; k < 2; ++k) dst[m][k] = *(const PG8_LAS bf16x8*)(lds + PG8_SA(b, h) + aoff + m * 2048 + k * 1024); } while (0)
#define PG8_LDB(dst, b, h) do { _Pragma("unroll") for (int n = 0; n < 2; ++n) _Pragma("unroll") for (int k = 0; k < 2; ++k) dst[n][k] = *(const PG8_LAS bf16x8*)(lds + PG8_SB(b, h) + boff + n * 2048 + k * 1024); } while (0)
#define PG8_MMA(ai, bj, At, Bt) do { __builtin_amdgcn_s_setprio(1); _Pragma("unroll") for (int m = 0; m < 4; ++m) _Pragma("unroll") for (int n = 0; n < 2; ++n) _Pragma("unroll") for (int k = 0; k < 2; ++k) \
        acc[ai][bj][m][n] = __builtin_amdgcn_mfma_f32_16x16x32_bf16(Bt[n][k], At[m][k], acc[ai][bj][m][n], 0, 0, 0); __builtin_amdgcn_s_setprio(0); } while (0)
#define PG8_WAIT_V(n) asm volatile("s_waitcnt vmcnt(" #n ")" ::: "memory")
#define PG8_WAIT_L(n) asm volatile("s_waitcnt lgkmcnt(" #n ")" ::: "memory")
#define PG8_BAR __builtin_amdgcn_s_barrier()
#define PG8_SCHED __builtin_amdgcn_sched_barrier(0)
    Unit cur, nxt; int ui = 0;
    if (!S.next(0, cur)) return;
    f32x4 acc[2][2][4][2];
#pragma unroll
    for (int a = 0; a < 2; ++a)
#pragma unroll
        for (int b = 0; b < 2; ++b)
#pragma unroll
            for (int m = 0; m < 4; ++m)
#pragma unroll
                for (int n = 0; n < 2; ++n) acc[a][b][m][n] = (f32x4){0.f, 0.f, 0.f, 0.f};
    bf16x8 At[4][2], B0[2][2], B1[2][2];
    const char* cA = cur.A; const char* cB = cur.B;
    PG8_STAGE(PG8_SB(0, 0), cB, voffB); PG8_STAGE(PG8_SB(0, 1), cB + hstepB, voffB); PG8_STAGE(PG8_SA(0, 0), cA, voffA); PG8_STAGE(PG8_SA(0, 1), cA + hstepA, voffA);
    if (wr == 1) PG8_BAR;
    PG8_WAIT_V(2); PG8_BAR;
    PG8_STAGE(PG8_SB(1, 0), cB + kstep, voffB); PG8_STAGE(PG8_SA(1, 0), cA + kstep, voffA); PG8_STAGE(PG8_SB(1, 1), cB + hstepB + kstep, voffB);
    PG8_WAIT_V(6); PG8_BAR;
    for (;;) {
        const bool has_next = S.next(ui + 1, nxt);
        const char* nA = has_next ? nxt.A : cA; const char* nB = has_next ? nxt.B : cB;
#pragma unroll 1
        for (int t = 0; t < nt; t += 2) {
            const bool last = (t == nt - 2);
            const char* a1 = cA + (size_t)(t + 1) * kstep;
            const char* a2 = last ? nA : cA + (size_t)(t + 2) * kstep; const char* b2 = last ? nB : cB + (size_t)(t + 2) * kstep;
            const char* a3 = a2 + kstep; const char* b3 = b2 + kstep;
            PG8_LDB(B0, 0, 0); PG8_LDB(B1, 0, 1); PG8_SCHED; PG8_LDA(At, 0, 0); PG8_STAGE(PG8_SA(1, 1), a1 + hstepA, voffA);
            PG8_WAIT_V(8); PG8_WAIT_L(0); PG8_BAR; PG8_MMA(0, 0, At, B0); PG8_MMA(0, 1, At, B1); PG8_BAR; PG8_SCHED;
            PG8_LDA(At, 0, 1); PG8_STAGE(PG8_SB(0, 0), b2, voffB); PG8_STAGE(PG8_SB(0, 1), b2 + hstepB, voffB); PG8_STAGE(PG8_SA(0, 0), a2, voffA);
            PG8_WAIT_V(8); PG8_WAIT_L(0); PG8_BAR; PG8_MMA(1, 0, At, B0); PG8_MMA(1, 1, At, B1); PG8_BAR; PG8_SCHED;
            PG8_LDB(B0, 1, 0); PG8_LDB(B1, 1, 1); PG8_SCHED; PG8_LDA(At, 1, 0); PG8_STAGE(PG8_SA(0, 1), a2 + hstepA, voffA);
            PG8_WAIT_V(8); PG8_WAIT_L(0); PG8_BAR; PG8_MMA(0, 0, At, B0); PG8_MMA(0, 1, At, B1); PG8_BAR; PG8_SCHED;
            PG8_LDA(At, 1, 1); PG8_STAGE(PG8_SB(1, 0), b3, voffB); PG8_STAGE(PG8_SB(1, 1), b3 + hstepB, voffB); PG8_STAGE(PG8_SA(1, 0), a3, voffA);
            PG8_WAIT_V(8); PG8_WAIT_L(0); PG8_BAR; PG8_MMA(1, 0, At, B0); PG8_MMA(1, 1, At, B1); PG8_BAR; PG8_SCHED;
        }
        if (wr == 0) PG8_BAR;
        { const int le = lane_fresh(); E(acc, cur, wr, wc, le & 15, le >> 4); }
        if (!has_next) break;
#pragma unroll
        for (int a = 0; a < 2; ++a)
#pragma unroll
            for (int b = 0; b < 2; ++b)
#pragma unroll
                for (int m = 0; m < 4; ++m)
#pragma unroll
                    for (int n = 0; n < 2; ++n) acc[a][b][m][n] = (f32x4){0.f, 0.f, 0.f, 0.f};
        cur = nxt; cA = nA; cB = nB; ++ui;
        if (wr == 1) PG8_BAR;
    }
    PG8_WAIT_V(0);
    PG8_BAR;
#undef PG8_SA
#undef PG8_SB
#undef PG8_STAGE
#undef PG8_LDA
#undef PG8_LDB
#undef PG8_MMA
#undef PG8_WAIT_V
#undef PG8_WAIT_L
#undef PG8_BAR
#undef PG8_SCHED
}
}


#define DIAGF 0
constexpr int CTL_DIAGW = 4096;
__device__ __forceinline__ void diag_flag(const P& p, bool badv, unsigned bit) {
    if (DIAGF && __any(badv)) { if (lane_fresh() == 0) atomicOr((unsigned*)(p.ws + WS_CTL) + CTL_DIAGW + 3, bit); }
}
__device__ __forceinline__ bool nonfin(float x) { return !(x == x) || fabsf(x) > 3.0e38f; }
__device__ __forceinline__ bool nonfin4(const pg8::f32x4& v) { return nonfin(v[0]) || nonfin(v[1]) || nonfin(v[2]) || nonfin(v[3]); }
namespace rs {
constexpr int P_TK = 144, P_KT = 80;
constexpr int O_KH = 0, O_RH = 4608, O_BT = 9216, O_KDT = 13824;
constexpr int O_BG = 18432, O_KDG = 23552, O_VM = 28672;
constexpr int O_B2 = 33792, O_AP = 36352, O_BP = 38912, O_NT = 41472;
constexpr int O_L = 44032;
constexpr int O_GAM = 48640;
constexpr int O_X = 48896;
constexpr int CHUNK_BYTES = 53760;
constexpr int O_SEGP = 2 * CHUNK_BYTES;
constexpr int O_YB = O_SEGP + 2048;
constexpr int YB_PITCH = 68;
static_assert(O_YB + 64 * YB_PITCH * 4 <= 128 * 1024, "scan LDS");
typedef pg8::bf16x8 bf16x8; typedef pg8::f32x4 f32x4; typedef pg8::u32x4 u32x4; typedef pg8::u32x2 u32x2;
__device__ __forceinline__ bf16x8 mk8(u32x2 lo, u32x2 hi) { u32x4 w; w.x = lo.x; w.y = lo.y; w.z = hi.x; w.w = hi.y; return __builtin_bit_cast(bf16x8, w); }
__device__ __forceinline__ bf16x8 cvt8(const f32x4& a, const f32x4& b) { u32x4 w; w.x = pg8::cvt_pk_bf16(a[0], a[1]); w.y = pg8::cvt_pk_bf16(a[2], a[3]); w.z = pg8::cvt_pk_bf16(b[0], b[1]); w.w = pg8::cvt_pk_bf16(b[2], b[3]); return __builtin_bit_cast(bf16x8, w); }
}
__device__ __forceinline__ void ph_scan2(const int wv, const P& p, int ia, unsigned char* lds, bf16_t* YS, const int moeL) {
    using namespace rs;
    const int lane = lane_fresh(), tid = wv * 64 + lane, l15 = lane & 15, g = lane >> 4;
    const bf16_t* RKV = (const bf16_t*)(p.ws + WS_RKV); const bf16_t* WDp = (const bf16_t*)(p.ws + WS_WD); const bf16_t* AAp = (const bf16_t*)(p.ws + WS_AA);
    for (int unit = blockIdx.x; unit < NB * NH * 2; unit += gridDim.x) {
        const int z = unit & 1, h = (unit >> 1) % NH, b = unit / (2 * NH);
        const float k_k = p.in[I_KK][ia * D + h * HD + lane], k_a = p.in[I_KA][ia * D + h * HD + lane];
        f32x4 S4[4];
#pragma unroll
        for (int i = 0; i < 4; ++i) S4[i] = (f32x4){0.f, 0.f, 0.f, 0.f};
        float rr[8], kx[8], vv[8], ww[8], aa[8];
#define RS_LOAD(scx) do { _Pragma("unroll") for (int s = 0; s < 8; ++s) { \
            const int step = (scx) * 64 + (wv >> 2) * 32 + (wv & 3) * 8 + s, t = z ? (S - 1 - step) : step; \
            const size_t o = ((size_t)b * S + t) * D + h * HD + lane; \
            rr[s] = bf2f(RKV[o]); kx[s] = bf2f(RKV[(size_t)T * D + o]); vv[s] = bf2f(RKV[2 * (size_t)T * D + o]); \
            ww[s] = bf2f(WDp[(size_t)z * T * D + o]); aa[s] = bf2f(AAp[(size_t)z * T * D + o]); } } while (0)
        RS_LOAD(0);
        float fz[32]; bf16_t* fdst = nullptr; bool fon = false;
#pragma unroll
        for (int r = 0; r < 32; ++r) fz[r] = 0.f;
        const bool filler = (wv >= 4 && moeL >= 0 && unit == (int)blockIdx.x && gridDim.x == 256);
#define RS_FILL_LOAD(J_) do { const int J = (J_); fon = J < NE * 3 * 1024; \
            if (fon) { const int mat = J >> 10, e = mat / 3, m = mat - 3 * e, jl = J & 1023; const float* fsrc; int fldw; \
                unsigned char* mb = p.ws + WB_MOE + (size_t)moeL * MOE_STRIDE; \
                if (m < 2) { const int nb = jl >> 5, kb = jl & 31, n = nb * 64 + lane; \
                    fsrc = p.in[m ? I_WU : I_WG] + (((size_t)moeL * NE + e) * D + kb * 32) * FF + n; fldw = FF; \
                    fdst = (bf16_t*)(mb + MOE_GU) + ((size_t)e * 4096 + ((n >> 7) << 8) + m * 128 + (n & 127)) * D + kb * 32; } \
                else { const int nb = jl >> 6, kb = jl & 63, n = nb * 64 + lane; \
                    fsrc = p.in[I_WDN] + (((size_t)moeL * NE + e) * FF + kb * 32) * D + n; fldw = D; \
                    fdst = (bf16_t*)(mb + MOE_DN) + ((size_t)e * D + n) * FF + kb * 32; } \
                _Pragma("unroll") for (int r = 0; r < 32; ++r) fz[r] = __builtin_nontemporal_load(fsrc + (size_t)r * fldw); } \
            else { _Pragma("unroll") for (int r = 0; r < 32; ++r) fz[r] = 0.f; fdst = nullptr; } } while (0)
#define RS_FILL_STORE() do { if (fon) { _Pragma("unroll") for (int c = 0; c < 4; ++c) { u32x4 w; \
            w.x = pg8::cvt_pk_bf16(fz[8 * c], fz[8 * c + 1]); w.y = pg8::cvt_pk_bf16(fz[8 * c + 2], fz[8 * c + 3]); w.z = pg8::cvt_pk_bf16(fz[8 * c + 4], fz[8 * c + 5]); w.w = pg8::cvt_pk_bf16(fz[8 * c + 6], fz[8 * c + 7]); \
            *(u32x4*)(fdst + 8 * c) = w; } } } while (0)
        for (int sc = 0; sc < S / 64; ++sc) {
            {
                const int q = wv >> 2, seg = wv & 3; unsigned char* cb = lds + q * CHUNK_BYTES;
                const int lna = lane_fresh(); const int kpos = (lna & 32) | (((lna >> 2) & 3) << 3) | (((lna >> 4) & 1) << 2) | (lna & 3);
                REPEAT(REP_SA) {
                float pl[8];
                pl[0] = ww[0];
#pragma unroll
                for (int s = 1; s < 8; ++s) pl[s] = pl[s - 1] + ww[s];
                ((float*)(lds + O_SEGP))[(q * 4 + seg) * 64 + lane] = pl[7];
                float kkn[8], ssq[8];
#pragma unroll
                for (int s = 0; s < 8; ++s) { kkn[s] = kx[s] * k_k; ssq[s] = kkn[s] * kkn[s]; }
                wave_sum8(ssq);
#pragma unroll
                for (int s = 0; s < 8; ++s) kkn[s] *= __builtin_amdgcn_rsqf(fmaxf(ssq[s], 1e-24f));
                __syncthreads();
                float prefix = 0.f, PCl = 0.f;
#pragma unroll
                for (int s2 = 0; s2 < 4; ++s2) { const float sp = ((const float*)(lds + O_SEGP))[(q * 4 + s2) * 64 + lane]; if (s2 < seg) prefix += sp; PCl += sp; }
                const float PC = __expf(PCl);
                float bgs[8], kdgs[8];
#pragma unroll
                for (int s = 0; s < 8; ++s) {
                    const int tt = seg * 8 + s;
                    const float cl = prefix + pl[s]; const float Pt = __expf(cl), Pm = __expf(cl - ww[s]), inv = __expf(-cl);
                    const float bb = kkn[s] * aa[s], kd = kx[s] * (1.0f + (aa[s] - 1.0f) * k_a);
                    const float bt = bb * inv, kdt = kd * inv;
                    const unsigned w01 = pg8::cvt_pk_bf16(kkn[s] * Pm, rr[s] * Pt), w23 = pg8::cvt_pk_bf16(bt, kdt);
                    *(bf16_t*)(cb + O_KH + tt * P_TK + kpos * 2) = (bf16_t)w01;
                    *(bf16_t*)(cb + O_RH + tt * P_TK + kpos * 2) = (bf16_t)(w01 >> 16);
                    *(bf16_t*)(cb + O_BT + tt * P_TK + kpos * 2) = (bf16_t)w23;
                    *(bf16_t*)(cb + O_KDT + tt * P_TK + kpos * 2) = (bf16_t)(w23 >> 16);
                    bgs[s] = bt * PC; kdgs[s] = kdt * PC;
                    diag_flag(p, nonfin(bt) || nonfin(kdt) || nonfin(kkn[s] * Pm) || nonfin(rr[s] * Pt) || nonfin(bgs[s]) || nonfin(kdgs[s]) || nonfin(vv[s]), 1u);
                    diag_flag(p, !(Pt > 1e-12f) || nonfin(inv), 2u);
                }
                u32x4 w;
                w.x = pg8::cvt_pk_bf16(bgs[0], bgs[1]); w.y = pg8::cvt_pk_bf16(bgs[2], bgs[3]); w.z = pg8::cvt_pk_bf16(bgs[4], bgs[5]); w.w = pg8::cvt_pk_bf16(bgs[6], bgs[7]);
                { u32x2 wl; wl.x = w.x; wl.y = w.y; u32x2 wh; wh.x = w.z; wh.y = w.w; const int pb = 16 * (seg & 1) + 4 * (seg >> 1);
                  *(u32x2*)(cb + O_BG + lane * P_KT + pb * 2) = wl; *(u32x2*)(cb + O_BG + lane * P_KT + (pb + 8) * 2) = wh; }
                w.x = pg8::cvt_pk_bf16(kdgs[0], kdgs[1]); w.y = pg8::cvt_pk_bf16(kdgs[2], kdgs[3]); w.z = pg8::cvt_pk_bf16(kdgs[4], kdgs[5]); w.w = pg8::cvt_pk_bf16(kdgs[6], kdgs[7]);
                *(u32x4*)(cb + O_KDG + lane * P_KT + seg * 16) = w;
                w.x = pg8::cvt_pk_bf16(vv[0], vv[1]); w.y = pg8::cvt_pk_bf16(vv[2], vv[3]); w.z = pg8::cvt_pk_bf16(vv[4], vv[5]); w.w = pg8::cvt_pk_bf16(vv[6], vv[7]);
                *(u32x4*)(cb + O_VM + lane * P_KT + seg * 16) = w;
                if (seg == 0) *(float*)(cb + O_GAM + lane * 4) = PC;
                }
                if (sc + 1 < S / 64) RS_LOAD(sc + 1);
            }
            __syncthreads();
            {
                const int q = wv >> 2, o = wv & 3; unsigned char* cb = lds + q * CHUNK_BYTES;
                const int lnb = lane_fresh(), l15 = lnb & 15, g = lnb >> 4;
                REPEAT(REP_SB) {
                const unsigned char* Xm = cb + ((o & 1) ? O_KDT : O_BT); const unsigned char* Ym = cb + ((o >> 1) ? O_RH : O_KH);
#pragma unroll
                for (int ti = 0; ti < 2; ++ti)
#pragma unroll
                    for (int tt = 0; tt < 2; ++tt) {
                        f32x4 acc = (f32x4){0.f, 0.f, 0.f, 0.f};
                        if (tt >= ti) {
#pragma unroll
                            for (int ks = 0; ks < 2; ++ks) {
                                const bf16x8 a = *(const bf16x8*)(Xm + (16 * ti + l15) * P_TK + (32 * ks + 8 * g) * 2);
                                const bf16x8 bq = *(const bf16x8*)(Ym + (16 * tt + l15) * P_TK + (32 * ks + 8 * g) * 2);
                                acc = __builtin_amdgcn_mfma_f32_16x16x32_bf16(a, bq, acc, 0, 0, 0);
                            }
                        }
                        const int t = 16 * tt + l15, i0 = 16 * ti + 4 * g;
#pragma unroll
                        for (int r = 0; r < 4; ++r) { const int i = i0 + r; const bool keep = (o < 2) ? (i < t) : (i <= t); if (!keep) acc[r] = 0.f; }
                        diag_flag(p, nonfin4(acc), 4u);
                        if (o == 0) *(f32x4*)(cb + O_L + t * 144 + i0 * 4) = acc;
                        else { u32x2 w; w.x = pg8::cvt_pk_bf16(acc[0], acc[1]); w.y = pg8::cvt_pk_bf16(acc[2], acc[3]);
                               if (o == 2) *(u32x2*)(cb + O_AP + t * P_KT + (8 * g + 4 * ti) * 2) = w;
                               else *(u32x2*)(cb + (o == 1 ? O_B2 : O_BP) + t * P_KT + i0 * 2) = w; }
                    }
                }
            }
            __syncthreads();
            REPEAT(REP_SC) {
            const int tid = wv * 64 + lane_fresh();
            if (tid < 64) {
                const int q = tid >> 5, d = (tid >> 4) & 1, j = tid & 15; unsigned char* cb = lds + q * CHUNK_BYTES;
                float x[16];
#pragma unroll
                for (int i = 0; i < 16; ++i) x[i] = (i == j) ? 1.f : 0.f;
                const unsigned char* Lb = cb + O_L + (16 * d) * 144 + (16 * d) * 4;
                f32x4 Lr[16][4];
#define RS_LROWS(lo, hi) do { _Pragma("unroll") for (int tl = (lo); tl < (hi); ++tl) { _Pragma("unroll") for (int c4 = 0; c4 < (tl + 3) / 4; ++c4) Lr[tl][c4] = *(const f32x4*)(Lb + tl * 144 + c4 * 16); } \
            asm volatile("s_waitcnt lgkmcnt(0)" ::: "memory"); __builtin_amdgcn_sched_barrier(0); } while (0)
#define RS_LSOLVE(lo, hi) do { _Pragma("unroll") for (int tl = (lo); tl < (hi); ++tl) { float s4[4] = {0.f, 0.f, 0.f, 0.f}; \
            _Pragma("unroll") for (int il = 0; il < tl; ++il) s4[il & 3] += Lr[tl][il >> 2][il & 3] * x[il]; \
            const float s = (s4[0] + s4[1]) + (s4[2] + s4[3]); x[tl] = (tl > j) ? -s : x[tl]; } } while (0)
                RS_LROWS(1, 10); RS_LSOLVE(1, 10);
                RS_LROWS(10, 16); RS_LSOLVE(10, 16);
#undef RS_LROWS
#undef RS_LSOLVE
#pragma unroll
                for (int tl = 0; tl < 16; ++tl) { *(float*)(cb + O_X + (16 * d + tl) * 144 + (16 * d + j) * 4) = x[tl]; diag_flag(p, nonfin(x[tl]) || fabsf(x[tl]) > 1e6f, 8u); }
            }
            if (filler) { RS_FILL_STORE(); RS_FILL_LOAD(((int)blockIdx.x * 4 + (wv - 4)) * 64 + sc * 2); }
            __syncthreads();
            {
                const int q = tid >> 8, tl = (tid >> 4) & 15, jl = tid & 15; unsigned char* cb = lds + q * CHUNK_BYTES;
                const float* Lr = (const float*)(cb + O_L + (16 + tl) * 144);
                float s = 0.f;
#pragma unroll
                for (int i = 0; i < 16; ++i) s += Lr[i] * *(const float*)(cb + O_X + i * 144 + jl * 4);
                *(float*)(cb + O_X + tl * 144 + (16 + jl) * 4) = s;
            }
            __syncthreads();
            {
                const int q = tid >> 8, tl = (tid >> 4) & 15, jl = tid & 15; unsigned char* cb = lds + q * CHUNK_BYTES;
                float s = 0.f;
#pragma unroll
                for (int i = 0; i < 16; ++i) s += *(const float*)(cb + O_X + (16 + tl) * 144 + (16 + i) * 4) * *(const float*)(cb + O_X + i * 144 + (16 + jl) * 4);
                diag_flag(p, nonfin(s), 16u);
                const int p0 = 8 * (jl >> 2) + (jl & 3), p1 = p0 + 4;
                *(bf16_t*)(cb + O_NT + (16 + tl) * P_KT + p0 * 2) = f2bf(s);
                *(bf16_t*)(cb + O_NT + tl * P_KT + p0 * 2) = f2bf(-*(const float*)(cb + O_X + tl * 144 + jl * 4));
                *(bf16_t*)(cb + O_NT + (16 + tl) * P_KT + p1 * 2) = f2bf(-*(const float*)(cb + O_X + (16 + tl) * 144 + (16 + jl) * 4));
                *(bf16_t*)(cb + O_NT + tl * P_KT + p1 * 2) = (bf16_t)0;
            }
            __syncthreads();
            }
            if (wv < 4) REPEAT(REP_SD) {
                const int lnd = lane_fresh(), l15 = lnd & 15, g = lnd >> 4;
                f32x4 St[4] = {S4[0], S4[1], S4[2], S4[3]};
#pragma unroll 1
                for (int q = 0; q < 2; ++q) {
                    const unsigned char* cb = lds + q * CHUNK_BYTES;
                    bf16x8 fKH[2][2], fRH[2][2], fB2[2], fNT[2], fAP[2], fBP[2], fBG[4], fKDG[4]; f32x4 fG[4];
                    const bf16x8 vm = *(const bf16x8*)(cb + O_VM + (16 * wv + l15) * P_KT + 16 * g);
#pragma unroll
                    for (int ct = 0; ct < 2; ++ct) {
#pragma unroll
                        for (int s = 0; s < 2; ++s) fKH[ct][s] = *(const bf16x8*)(cb + O_KH + (16 * ct + l15) * P_TK + (32 * s + 8 * g) * 2);
                        fB2[ct] = *(const bf16x8*)(cb + O_B2 + (16 * ct + l15) * P_KT + 16 * g);
                        fNT[ct] = *(const bf16x8*)(cb + O_NT + (16 * ct + l15) * P_KT + 16 * g);
                    }
                    asm volatile("s_waitcnt lgkmcnt(0)" ::: "memory");
                    __builtin_amdgcn_sched_barrier(0);
                    bf16x8 sb[2]; sb[0] = cvt8(St[0], St[1]); sb[1] = cvt8(St[2], St[3]);
                    f32x4 w2[2];
#pragma unroll
                    for (int ct = 0; ct < 2; ++ct) {
                        f32x4 acc = (f32x4){0.f, 0.f, 0.f, 0.f};
                        acc = __builtin_amdgcn_mfma_f32_16x16x32_bf16(fKH[ct][0], sb[0], acc, 0, 0, 0);
                        acc = __builtin_amdgcn_mfma_f32_16x16x32_bf16(fKH[ct][1], sb[1], acc, 0, 0, 0);
                        acc = __builtin_amdgcn_mfma_f32_16x16x32_bf16(fB2[ct], vm, acc, 0, 0, 0);
                        w2[ct] = acc;
                    }
                    __builtin_amdgcn_sched_barrier(0);
#pragma unroll
                    for (int kt = 0; kt < 4; ++kt) {
                        fG[kt] = *(const f32x4*)(cb + O_GAM + (16 * kt + 4 * g) * 4);
                        fBG[kt] = *(const bf16x8*)(cb + O_BG + (16 * kt + l15) * P_KT + 16 * g);
                        fKDG[kt] = *(const bf16x8*)(cb + O_KDG + (16 * kt + l15) * P_KT + 16 * g);
                    }
                    __builtin_amdgcn_sched_barrier(0);
                    diag_flag(p, nonfin4(w2[0]) || nonfin4(w2[1]), 32u);
                    const bf16x8 wb = cvt8(w2[0], w2[1]);
                    f32x4 u2[2];
#pragma unroll
                    for (int ct = 0; ct < 2; ++ct) u2[ct] = __builtin_amdgcn_mfma_f32_16x16x32_bf16(fNT[ct], wb, (f32x4){0.f, 0.f, 0.f, 0.f}, 0, 0, 0);
                    diag_flag(p, nonfin4(u2[0]) || nonfin4(u2[1]), 64u);
                    const bf16x8 ub = cvt8(u2[0], u2[1]);
                    __builtin_amdgcn_sched_barrier(0);
#pragma unroll
                    for (int ct = 0; ct < 2; ++ct) {
#pragma unroll
                        for (int s = 0; s < 2; ++s) fRH[ct][s] = *(const bf16x8*)(cb + O_RH + (16 * ct + l15) * P_TK + (32 * s + 8 * g) * 2);
                        fBP[ct] = *(const bf16x8*)(cb + O_BP + (16 * ct + l15) * P_KT + 16 * g);
                        fAP[ct] = *(const bf16x8*)(cb + O_AP + (16 * ct + l15) * P_KT + 16 * g);
                    }
                    asm volatile("s_waitcnt lgkmcnt(8)" ::: "memory");
                    __builtin_amdgcn_sched_barrier(0);
#pragma unroll
                    for (int kt = 0; kt < 4; ++kt) {
                        f32x4 acc = St[kt] * fG[kt];
                        acc = __builtin_amdgcn_mfma_f32_16x16x32_bf16(fBG[kt], ub, acc, 0, 0, 0);
                        acc = __builtin_amdgcn_mfma_f32_16x16x32_bf16(fKDG[kt], vm, acc, 0, 0, 0);
                        St[kt] = acc; diag_flag(p, nonfin4(acc), 256u);
                    }
                    asm volatile("s_waitcnt lgkmcnt(0)" ::: "memory");
                    __builtin_amdgcn_sched_barrier(0);
#pragma unroll
                    for (int tt = 0; tt < 2; ++tt) {
                        f32x4 acc = (f32x4){0.f, 0.f, 0.f, 0.f};
                        acc = __builtin_amdgcn_mfma_f32_16x16x32_bf16(fRH[tt][0], sb[0], acc, 0, 0, 0);
                        acc = __builtin_amdgcn_mfma_f32_16x16x32_bf16(fRH[tt][1], sb[1], acc, 0, 0, 0);
                        acc = __builtin_amdgcn_mfma_f32_16x16x32_bf16(fAP[tt], ub, acc, 0, 0, 0);
                        acc = __builtin_amdgcn_mfma_f32_16x16x32_bf16(fBP[tt], vm, acc, 0, 0, 0);
                        diag_flag(p, nonfin4(acc), 128u);
                        float* yb = (float*)(lds + O_YB) + (q * 32 + 16 * tt + 4 * g) * YB_PITCH + 16 * wv + l15;
#pragma unroll
                        for (int r = 0; r < 4; ++r) yb[r * YB_PITCH] = acc[r];
                    }
                }
                if (LASTREP(REP_SD)) { S4[0] = St[0]; S4[1] = St[1]; S4[2] = St[2]; S4[3] = St[3]; }
            }
            else if (filler) {
                RS_FILL_STORE();
                RS_FILL_LOAD(((int)blockIdx.x * 4 + (wv - 4)) * 64 + sc * 2 + 1);
            }
            __syncthreads();
            const int tido = wv * 64 + lane_fresh();
#pragma unroll
            for (int jj = 0; jj < 4; ++jj) {
                const int idx = tido + jj * NTHR, i = idx >> 5, v2 = idx & 31;
                const int step = sc * 64 + i, t = z ? (S - 1 - step) : step;
                const float2 yv = *(const float2*)((const float*)(lds + O_YB) + i * YB_PITCH + 2 * v2);
                *(unsigned*)(YS + (size_t)z * T * D + ((size_t)b * S + t) * D + h * HD + 2 * v2) = pg8::cvt_pk_bf16(yv.x, yv.y);
            }
        }
        if (filler) RS_FILL_STORE();
        __syncthreads();
    }
}

struct SchedBase { int G, c; };
struct SchedProj : SchedBase {
    const char* XM; const char* Wrkv; const char* L1t;
    __device__ __forceinline__ bool next(int i, pg8::Unit& u) const {
        const int L = i * G + c; if (L >= 960) return false;
        if (L < 768) {
            if (G == 256) { const int x = c & 7, j = c >> 3; u.job = i; u.pm = 8 * x + (j & 7); u.pn = j >> 3; }
            else { u.job = L >> 8; const int r = L & 255; u.pm = r >> 2; u.pn = r & 3; }
            u.B = Wrkv + ((size_t)u.job * 1024 + u.pn * 256) * 1024 * 2; }
        else { const int r = L - 768; u.job = 3 + r / 64; u.pm = r % 64; u.pn = 0; u.B = L1t + (size_t)(u.job - 3) * 256 * 1024 * 2; }
        u.A = XM + ((size_t)u.job * T + (size_t)u.pm * 256) * D * 2;
        return true;
    }
};
struct SchedLora2 : SchedBase {
    const char* L1b; const char* L2t;
    __device__ __forceinline__ bool next(int i, pg8::Unit& u) const {
        const int L = i * G + c; if (L >= 1280) return false;
        if (G == 256) { const int x = c & 7, j = c >> 3; u.job = i; u.pm = 8 * x + (j & 7); u.pn = j >> 3; }
        else { u.job = L >> 8; const int r = L & 255; u.pm = r >> 2; u.pn = r & 3; }
        u.A = L1b + ((size_t)u.pm * 256 * 512 + (u.job == 4 ? 256 : 0)) * 2;
        u.B = L2t + ((size_t)u.job * 1024 + u.pn * 256) * 256 * 2;
        return true;
    }
};
struct SchedPlain : SchedBase {
    const char* A; const char* B; int nN, lda, ldb;
    __device__ __forceinline__ bool next(int i, pg8::Unit& u) const {
        const int L = i * G + c; if (L >= 64 * nN) return false;
        u.job = 0;
        if (G == 256) { const int x = c & 7, j = c >> 3; u.pm = 8 * x + (j & 7); u.pn = 4 * i + (j >> 3); }
        else { u.pm = L / nN; u.pn = L % nN; }
        u.A = A + (size_t)u.pm * 256 * lda * 2; u.B = B + (size_t)u.pn * 256 * ldb * 2;
        return true;
    }
};
struct SchedLruGate : SchedBase {
    const char* UCB; const char* Wg;
    __device__ __forceinline__ bool next(int i, pg8::Unit& u) const {
        const int L = i * G + c; if (L >= 1024) return false;
        u.job = L >> 6; u.pm = L & 63; u.pn = 0;
        u.A = UCB + ((size_t)u.pm * 256 * D + ((u.job >> 1) & 3) * 256) * 2; u.B = Wg + (size_t)u.job * 256 * 256 * 2;
        return true;
    }
};
struct SchedMoe1 : SchedBase {
    const char* XIN; const char* Wgu;
    __device__ __forceinline__ bool next(int i, pg8::Unit& u) const {
        const int L = i * G + c; if (L >= 2048) return false;
        if (G == 256) { const int x = c & 7, j = c >> 3, xq = x & 3; u.job = 2 * i + (x >> 2); u.pm = (xq & 1) * 4 + (j & 3); u.pn = (xq >> 1) * 8 + (j >> 2); }
        else { u.job = L >> 7; const int r = L & 127; u.pm = r & 7; u.pn = r >> 3; }
        u.A = XIN + ((size_t)u.job * 2048 + u.pm * 256) * D * 2; u.B = Wgu + ((size_t)u.job * 4096 + u.pn * 256) * D * 2;
        return true;
    }
};
struct SchedMoe2 : SchedBase {
    const char* HID; const char* Wdn;
    __device__ __forceinline__ bool next(int i, pg8::Unit& u) const {
        const int L = i * G + c; if (L >= 512) return false;
        if (G == 256) { const int x = c & 7, j = c >> 3; u.job = 8 * i + x; u.pm = j & 7; u.pn = j >> 3; }
        else { u.job = L >> 5; const int r = L & 31; u.pm = r & 7; u.pn = r >> 3; }
        u.A = HID + ((size_t)u.job * 2048 + u.pm * 256) * FF * 2; u.B = Wdn + ((size_t)u.job * 1024 + u.pn * 256) * FF * 2;
        return true;
    }
};

#define EPI_ARGS const pg8::f32x4 (&acc)[2][2][4][2], const pg8::Unit& u, int wr, int wc, int fr, int fq
#define EPI_ROWS for (int ai = 0; ai < 2; ++ai) _Pragma("unroll") for (int m = 0; m < 4; ++m)
#define EPI_COLS for (int bj = 0; bj < 2; ++bj) _Pragma("unroll") for (int n = 0; n < 2; ++n)
struct EpiProj {
    static constexpr bool PERM = true;
    bf16_t* RKVb; bf16_t* L1b;
    __device__ __forceinline__ void operator()(EPI_ARGS) const {
        const int row0 = u.pm * 256 + wr * 64 + fr;
        if (u.job < 3) {
            bf16_t* C = RKVb + (size_t)u.job * T * D; const int col0 = u.pn * 256 + wc * 32 + 8 * fq;
#pragma unroll
            EPI_ROWS { bf16_t* rowp = C + (size_t)(row0 + ai * 128 + m * 16) * D + col0;
#pragma unroll
                for (int bj = 0; bj < 2; ++bj) { const pg8::f32x4 v0 = acc[ai][bj][m][0], v1 = acc[ai][bj][m][1]; pg8::u32x4 w;
                    w.x = pg8::cvt_pk_bf16(v0[0], v0[1]); w.y = pg8::cvt_pk_bf16(v0[2], v0[3]); w.z = pg8::cvt_pk_bf16(v1[0], v1[1]); w.w = pg8::cvt_pk_bf16(v1[2], v1[3]);
                    *(pg8::u32x4*)(rowp + bj * 128) = w; } }
        } else {
            const int col0 = (u.job - 3) * 128 + wc * 32 + 8 * fq; const int act = u.job;
#pragma unroll
            EPI_ROWS { bf16_t* rowp = L1b + (size_t)(row0 + ai * 128 + m * 16) * 512 + col0;
                pg8::f32x4 v0 = acc[ai][0][m][0], v1 = acc[ai][0][m][1];
                if (act == 3) {
#pragma unroll
                    for (int j = 0; j < 4; ++j) { v0[j] = tanhf_(v0[j]); v1[j] = tanhf_(v1[j]); } }
                else if (act == 5) {
#pragma unroll
                    for (int j = 0; j < 4; ++j) { v0[j] = sigmoidf_(v0[j]); v1[j] = sigmoidf_(v1[j]); } }
                pg8::u32x4 w; w.x = pg8::cvt_pk_bf16(v0[0], v0[1]); w.y = pg8::cvt_pk_bf16(v0[2], v0[3]); w.z = pg8::cvt_pk_bf16(v1[0], v1[1]); w.w = pg8::cvt_pk_bf16(v1[2], v1[3]);
                *(pg8::u32x4*)rowp = w;
                if (act == 5) { pg8::u32x4 zz; zz.x = 0u; zz.y = 0u; zz.z = 0u; zz.w = 0u; *(pg8::u32x4*)(rowp + 128) = zz; }
            }
        }
    }
};
struct EpiLora2 {
    static constexpr bool PERM = true;
    bf16_t* WDL; bf16_t* AAb; bf16_t* GGb; const float* w0; const float* a0;
    __device__ __forceinline__ void operator()(EPI_ARGS) const {
        const int row0 = u.pm * 256 + wr * 64 + fr, col0 = u.pn * 256 + wc * 32 + 8 * fq, job = u.job;
        bf16_t* C = job < 2 ? WDL + (size_t)job * T * D : (job < 4 ? AAb + (size_t)(job - 2) * T * D : GGb);
        const float* bias = job < 2 ? w0 + job * D : a0 + (job < 4 ? job - 2 : 0) * D;
        const float sc = job < 2 ? -0.6065306597126334f : 1.0f;
#pragma unroll
        for (int bj = 0; bj < 2; ++bj) {
            const pg8::f32x4 b0 = *(const pg8::f32x4*)(bias + col0 + bj * 128), b1 = *(const pg8::f32x4*)(bias + col0 + bj * 128 + 4);
#pragma unroll
            EPI_ROWS { pg8::f32x4 v0 = acc[ai][bj][m][0], v1 = acc[ai][bj][m][1];
                if (job < 4) { v0 = v0 + b0; v1 = v1 + b1;
#pragma unroll
                    for (int j = 0; j < 4; ++j) { v0[j] = sc * sigmoidf_(v0[j]); v1[j] = sc * sigmoidf_(v1[j]); } }
                pg8::u32x4 w; w.x = pg8::cvt_pk_bf16(v0[0], v0[1]); w.y = pg8::cvt_pk_bf16(v0[2], v0[3]); w.z = pg8::cvt_pk_bf16(v1[0], v1[1]); w.w = pg8::cvt_pk_bf16(v1[2], v1[3]);
                *(pg8::u32x4*)(C + (size_t)(row0 + ai * 128 + m * 16) * D + col0 + bj * 128) = w; }
        }
    }
};
struct EpiStoreF32 {
    static constexpr bool PERM = false;
    float* C; int ldc;
    __device__ __forceinline__ void operator()(EPI_ARGS) const {
        const int row0 = u.pm * 256 + wr * 64 + fr, col0 = u.pn * 256 + wc * 32 + 4 * fq;
#pragma unroll
        EPI_ROWS { float* rowp = C + (size_t)(row0 + ai * 128 + m * 16) * ldc + col0;
#pragma unroll
            EPI_COLS *(pg8::f32x4*)(rowp + bj * 128 + n * 16) = acc[ai][bj][m][n]; }
    }
};
struct EpiAddX {
    static constexpr bool PERM = false;
    float* X;
    __device__ __forceinline__ void operator()(EPI_ARGS) const {
        const int row0 = u.pm * 256 + wr * 64 + fr, col0 = u.pn * 256 + wc * 32 + 4 * fq;
#pragma unroll
        EPI_ROWS { float* rowp = X + (size_t)(row0 + ai * 128 + m * 16) * D + col0;
#pragma unroll
            EPI_COLS { pg8::f32x4* q = (pg8::f32x4*)(rowp + bj * 128 + n * 16); *q = *q + acc[ai][bj][m][n]; } }
    }
};
struct EpiLruGate {
    static constexpr bool PERM = true;
    bf16_t* LA; bf16_t* LB; const bf16_t* UCB; const float* ba; const float* bx; const float* lam;
    __device__ __forceinline__ void operator()(EPI_ARGS) const {
        const int z = u.job >> 3, h = (u.job >> 1) & 3, half = u.job & 1;
        const int row0 = u.pm * 256 + wr * 64 + fr, c0 = h * 256 + half * 128 + wc * 32 + 8 * fq;
        bf16_t* la = LA + (size_t)z * T * D; bf16_t* lb = LB + (size_t)z * T * D;
#pragma unroll
        for (int n = 0; n < 2; ++n) {
            const int c4 = c0 + 4 * n;
            const pg8::f32x4 lm = *(const pg8::f32x4*)(lam + z * D + c4), ba4 = *(const pg8::f32x4*)(ba + z * D + c4), bx4 = *(const pg8::f32x4*)(bx + z * D + c4);
            pg8::f32x4 sp4;
#pragma unroll
            for (int j = 0; j < 4; ++j) sp4[j] = -8.0f * softplusf_(-lm[j]);
#pragma unroll
            EPI_ROWS { const size_t o = (size_t)(row0 + ai * 128 + m * 16) * D + c4;
                const uint2 uu = *(const uint2*)(UCB + o); float uv[4]; bf4_to_f(uu, uv);
                float lo[4], bo[4];
#pragma unroll
                for (int j = 0; j < 4; ++j) { const float ra = acc[ai][0][m][n][j] + ba4[j], ix = acc[ai][1][m][n][j] + bx4[j];
                    const float l = sp4[j] * sigmoidf_(ra); lo[j] = l; bo[j] = __builtin_amdgcn_sqrtf(fmaxf(1.0f - __expf(2.0f * l), 0.f)) * sigmoidf_(ix) * uv[j]; }
                pg8::u32x2 w; w.x = pg8::cvt_pk_bf16(lo[0], lo[1]); w.y = pg8::cvt_pk_bf16(lo[2], lo[3]); *(pg8::u32x2*)(la + o) = w;
                w.x = pg8::cvt_pk_bf16(bo[0], bo[1]); w.y = pg8::cvt_pk_bf16(bo[2], bo[3]); *(pg8::u32x2*)(lb + o) = w; }
        }
    }
};
struct EpiSwiglu {
    static constexpr bool PERM = true;
    bf16_t* HID;
    __device__ __forceinline__ void operator()(EPI_ARGS) const {
        bf16_t* base = HID + (size_t)u.job * 2048 * FF; const int row0 = u.pm * 256 + wr * 64 + fr, col0 = u.pn * 128 + wc * 32 + 8 * fq;
#pragma unroll
        EPI_ROWS { float o[8];
#pragma unroll
            for (int n = 0; n < 2; ++n)
#pragma unroll
                for (int j = 0; j < 4; ++j) { const float gt = acc[ai][0][m][n][j], up = acc[ai][1][m][n][j]; o[n * 4 + j] = gt * sigmoidf_(gt) * up; }
            pg8::u32x4 w; w.x = pg8::cvt_pk_bf16(o[0], o[1]); w.y = pg8::cvt_pk_bf16(o[2], o[3]); w.z = pg8::cvt_pk_bf16(o[4], o[5]); w.w = pg8::cvt_pk_bf16(o[6], o[7]);
            *(pg8::u32x4*)(base + (size_t)(row0 + ai * 128 + m * 16) * FF + col0) = w; }
    }
};
struct EpiDown {
    static constexpr bool PERM = true;
    bf16_t* YEXP; const float* GATE;
    __device__ __forceinline__ void operator()(EPI_ARGS) const {
        const int row0 = u.pm * 256 + wr * 64 + fr, col0 = u.pn * 256 + wc * 32 + 8 * fq;
        bf16_t* C = YEXP + (size_t)u.job * 2048 * D; const float* gt = GATE + (size_t)u.job * 2048;
#pragma unroll
        EPI_ROWS { const int row = row0 + ai * 128 + m * 16; const float gs = gt[row];
#pragma unroll
            for (int bj = 0; bj < 2; ++bj) { const pg8::f32x4 v0 = acc[ai][bj][m][0] * gs, v1 = acc[ai][bj][m][1] * gs; pg8::u32x4 w;
                w.x = pg8::cvt_pk_bf16(v0[0], v0[1]); w.y = pg8::cvt_pk_bf16(v0[2], v0[3]); w.z = pg8::cvt_pk_bf16(v1[0], v1[1]); w.w = pg8::cvt_pk_bf16(v1[2], v1[3]);
                *(pg8::u32x4*)(C + (size_t)row * D + col0 + bj * 128) = w; } }
    }
};
struct EpiStoreBf16 {
    static constexpr bool PERM = true;
    bf16_t* O; int ldc;
    __device__ __forceinline__ void operator()(EPI_ARGS) const {
        const int row0 = u.pm * 256 + wr * 64 + fr, col0 = u.pn * 256 + wc * 32 + 8 * fq;
#pragma unroll
        EPI_ROWS { bf16_t* rowp = O + (size_t)(row0 + ai * 128 + m * 16) * ldc + col0;
#pragma unroll
            for (int bj = 0; bj < 2; ++bj) { const pg8::f32x4 v0 = acc[ai][bj][m][0], v1 = acc[ai][bj][m][1]; pg8::u32x4 w;
                w.x = pg8::cvt_pk_bf16(v0[0], v0[1]); w.y = pg8::cvt_pk_bf16(v0[2], v0[3]); w.z = pg8::cvt_pk_bf16(v1[0], v1[1]); w.w = pg8::cvt_pk_bf16(v1[2], v1[3]);
                *(pg8::u32x4*)(rowp + bj * 128) = w; } }
    }
};

struct RmId { __device__ __forceinline__ int operator()(int n) const { return n; } };
struct RmGU { int off; __device__ __forceinline__ int operator()(int n) const { return ((n >> 7) << 8) + off + (n & 127); } };
template <class RM>
__device__ __forceinline__ void tconv(const int wv, const float* W, int ldw, int K, int N, bf16_t* dst, int ldb, int koff, const RM rm, float* lds, int& rot) {
    const int tid = TID, G = gridDim.x, tn = N >> 7, ntiles = (K >> 6) * tn;
    const int lr = tid >> 5, lc = (tid & 31) * 4;
    const int sn = tid >> 3, sk = (tid & 7) * 8;
    int t = (int)(((unsigned)blockIdx.x + (unsigned)G - (unsigned)(rot % G)) % (unsigned)G);
    float4 cur[4], nx[4];
    if (t < ntiles) { const int k0 = (t / tn) << 6, n0 = (t % tn) << 7;
#pragma unroll
        for (int i = 0; i < 4; ++i) { const pg8::f32x4 t4 = __builtin_nontemporal_load((const pg8::f32x4*)(W + (size_t)(k0 + lr + 16 * i) * ldw + n0 + lc)); cur[i] = make_float4(t4[0], t4[1], t4[2], t4[3]); } }
    for (; t < ntiles; t += G) {
        const int k0 = (t / tn) << 6, n0 = (t % tn) << 7; const int t2 = t + G;
        if (t2 < ntiles) { const int k2 = (t2 / tn) << 6, n2 = (t2 % tn) << 7;
#pragma unroll
            for (int i = 0; i < 4; ++i) { const pg8::f32x4 t4 = __builtin_nontemporal_load((const pg8::f32x4*)(W + (size_t)(k2 + lr + 16 * i) * ldw + n2 + lc)); nx[i] = make_float4(t4[0], t4[1], t4[2], t4[3]); } }
        __syncthreads();
#pragma unroll
        for (int i = 0; i < 4; ++i) { float* q = lds + (lr + 16 * i) * 129 + lc; q[0] = cur[i].x; q[1] = cur[i].y; q[2] = cur[i].z; q[3] = cur[i].w; }
        __syncthreads();
#pragma unroll
        for (int i = 0; i < 2; ++i) { const int n = sn + 64 * i; float f[8];
#pragma unroll
            for (int j = 0; j < 8; ++j) f[j] = lds[(sk + j) * 129 + n];
            pg8::u32x4 w; w.x = pg8::cvt_pk_bf16(f[0], f[1]); w.y = pg8::cvt_pk_bf16(f[2], f[3]); w.z = pg8::cvt_pk_bf16(f[4], f[5]); w.w = pg8::cvt_pk_bf16(f[6], f[7]);
            *(pg8::u32x4*)(dst + (size_t)rm(n0 + n) * ldb + koff + k0 + sk) = w; }
#pragma unroll
        for (int i = 0; i < 4; ++i) cur[i] = nx[i];
    }
    rot += ntiles;
}
__device__ __forceinline__ void tconv_small(const int wv, const float* W, int K, int N, bf16_t* dst, int ldb, int noff) {
    for (int i = blockIdx.x * NTHR + TID; i < K * N; i += gridDim.x * NTHR) { const int k = i / N, n = i - k * N; dst[(size_t)(n + noff) * ldb + k] = f2bf(W[i]); }
}
__device__ __forceinline__ void zfill(const int wv, bf16_t* dst, int ldb, int r0, int r1, int c0, int c1) {
    const int w8 = (c1 - c0) >> 3, tot = (r1 - r0) * w8;
    for (int i = blockIdx.x * NTHR + TID; i < tot; i += gridDim.x * NTHR) { const int r = r0 + i / w8, c = c0 + (i % w8) * 8; *(uint4*)(dst + (size_t)r * ldb + c) = make_uint4(0u, 0u, 0u, 0u); }
}
__device__ __forceinline__ void ph_prologue(const int wv, const P& p, float* lds) {
    int rot = 0;
    unsigned char* ws = p.ws;
    for (int L = 0; L < DEPTH; ++L) {
        if (gridDim.x == 256 && (L % 3) == 0) continue;
        for (int e = 0; e < NE; ++e) {
            bf16_t* gu = (bf16_t*)(ws + WB_MOE + (size_t)L * MOE_STRIDE + MOE_GU) + (size_t)e * 4096 * D;
            bf16_t* dn = (bf16_t*)(ws + WB_MOE + (size_t)L * MOE_STRIDE + MOE_DN) + (size_t)e * D * FF;
            RmGU rg; rg.off = 0; RmGU ru; ru.off = 128;
            tconv(wv, p.in[I_WG] + ((size_t)L * NE + e) * D * FF, FF, D, FF, gu, D, 0, rg, lds, rot);
            tconv(wv, p.in[I_WU] + ((size_t)L * NE + e) * D * FF, FF, D, FF, gu, D, 0, ru, lds, rot);
            tconv(wv, p.in[I_WDN] + ((size_t)L * NE + e) * FF * D, D, FF, D, dn, FF, 0, RmId(), lds, rot);
        }
    }
    for (int ia = 0; ia < 2; ++ia) {
        unsigned char* rb = ws + WB_RW + (size_t)ia * RW_STRIDE;
        for (int q = 0; q < 3; ++q) tconv(wv, p.in[I_WIN] + ((size_t)ia * 3 + q) * D * D, D, D, D, (bf16_t*)(rb + RW_RKV) + (size_t)q * D * D, D, 0, RmId(), lds, rot);
        tconv(wv, p.in[I_WOUT] + (size_t)ia * D * D, D, D, D, (bf16_t*)(rb + RW_OUT), D, 0, RmId(), lds, rot);
        bf16_t* l1 = (bf16_t*)(rb + RW_L1);
        for (int z = 0; z < 2; ++z) { tconv_small(wv, p.in[I_W1] + ((size_t)ia * 2 + z) * D * 64, D, 64, l1, D, z * 64); tconv_small(wv, p.in[I_A1] + ((size_t)ia * 2 + z) * D * 64, D, 64, l1 + 256 * D, D, z * 64); }
        tconv(wv, p.in[I_G1] + (size_t)ia * D * 128, 128, D, 128, l1 + 2 * 256 * D, D, 0, RmId(), lds, rot);
        for (int q = 0; q < 3; ++q) zfill(wv, l1 + (size_t)q * 256 * D, D, 128, 256, 0, D);
        bf16_t* l2 = (bf16_t*)(rb + RW_L2);
        for (int z = 0; z < 2; ++z) {
            tconv(wv, p.in[I_W2] + ((size_t)ia * 2 + z) * 64 * D, D, 64, D, l2 + (size_t)z * 1024 * 256, 256, z * 64, RmId(), lds, rot);
            tconv(wv, p.in[I_A2] + ((size_t)ia * 2 + z) * 64 * D, D, 64, D, l2 + (size_t)(2 + z) * 1024 * 256, 256, 128 + z * 64, RmId(), lds, rot);
        }
        tconv(wv, p.in[I_G2] + (size_t)ia * 128 * D, D, 128, D, l2 + (size_t)4 * 1024 * 256, 256, 0, RmId(), lds, rot);
        for (int j = 0; j < 4; ++j) { const int k0 = j * 64; if (k0 > 0) zfill(wv, l2 + (size_t)j * 1024 * 256, 256, 0, 1024, 0, k0); if (k0 + 64 < 256) zfill(wv, l2 + (size_t)j * 1024 * 256, 256, 0, 1024, k0 + 64, 256); }
        zfill(wv, l2 + (size_t)4 * 1024 * 256, 256, 0, 1024, 128, 256);
    }
    tconv(wv, p.in[I_SCIN], 3 * D, D, 3 * D, (bf16_t*)(ws + WB_SC + SC_IN), D, 0, RmId(), lds, rot);
    tconv(wv, p.in[I_SCOUT], D, D, D, (bf16_t*)(ws + WB_SC + SC_OUT), D, 0, RmId(), lds, rot);
    tconv(wv, p.in[I_LIN], 2 * D, D, 2 * D, (bf16_t*)(ws + WB_LRU + LRU_IN), D, 0, RmId(), lds, rot);
    tconv(wv, p.in[I_LOUT], D, D, D, (bf16_t*)(ws + WB_LRU + LRU_OUT), D, 0, RmId(), lds, rot);
    for (int zh = 0; zh < 8; ++zh) {
        bf16_t* gt = (bf16_t*)(ws + WB_LRU + LRU_G) + (size_t)zh * 2 * 256 * 256;
        RmGU ra; ra.off = 0; RmGU rx; rx.off = 128;
        tconv(wv, p.in[I_LWA] + (size_t)zh * 256 * 256, 256, 256, 256, gt, 256, 0, ra, lds, rot);
        tconv(wv, p.in[I_LWX] + (size_t)zh * 256 * 256, 256, 256, 256, gt, 256, 0, rx, lds, rot);
    }
}


#define XB_TMO      128
#define XB_XCNT(j)  (256  + 64 * (j))
#define XB_XSUB(j)  (1280 + 64 * (j))
#define XB_XGEN(j)  (2304 + 64 * (j))
#define XB_TOP      3328
#define XB_TOPGEN   3392
#define XCD_BAR_WORDS 3456
#define XB_SPIN_CAP (1u << 22)
#define LAS __attribute__((address_space(3)))
__device__ __forceinline__ unsigned xb_ld(unsigned* p)              { return __hip_atomic_load(p, __ATOMIC_RELAXED, __HIP_MEMORY_SCOPE_AGENT); }
__device__ __forceinline__ unsigned xb_add(unsigned* p, unsigned v) { return __hip_atomic_fetch_add(p, v, __ATOMIC_RELAXED, __HIP_MEMORY_SCOPE_AGENT); }
__device__ __forceinline__ unsigned xb_xcc_id() { return (unsigned)__builtin_amdgcn_s_getreg((3 << 11) | 20) & 0xFu; }
#define XB_SPIN(cond, bar) do { unsigned _sp = 0; while (cond) { __builtin_amdgcn_s_sleep(1); \
    if ((++_sp & 255u) == 0u) { if (xb_ld(&(bar)[XB_TMO])) break; if (_sp > XB_SPIN_CAP) { atomicAdd(&(bar)[XB_TMO], 1u); break; } } } } while (0)
struct XcdBarrier { unsigned* bar; unsigned x; volatile LAS unsigned* st; };
__device__ __forceinline__ XcdBarrier xcd_barrier_post(const int wv, unsigned* bar, volatile LAS unsigned* st) {
    XcdBarrier b; b.bar = bar; b.x = xb_xcc_id(); b.st = st;
    if (TID == 0) (void)xb_add(&bar[XB_XCNT(b.x)], 1u);
    return b;
}
__device__ __forceinline__ void xcd_barrier_complete(unsigned* bar, unsigned x, unsigned& nloc, unsigned& nx) {
    const unsigned G = gridDim.x * gridDim.y * gridDim.z;
    unsigned sum, cnt, mine, sp = 0u;
    for (;;) {
        sum = 0u; cnt = 0u; mine = 0u;
#pragma unroll
        for (unsigned j = 0; j < 16; ++j) { const unsigned c = xb_ld(&bar[XB_XCNT(j)]); sum += c; cnt += (c > 0u) ? 1u : 0u; mine = (j == x) ? c : mine; }
        if (sum == G) break;
        __builtin_amdgcn_s_sleep(1);
        if ((++sp & 255u) == 0u) { if (xb_ld(&bar[XB_TMO])) break; if (sp > XB_SPIN_CAP) { atomicAdd(&bar[XB_TMO], 1u); break; } }
    }
    nloc = mine > 0u ? mine : 1u; nx = cnt > 0u ? cnt : 1u;
}
__device__ __forceinline__ void xcd_barrier(const int wv, const XcdBarrier& b) {
    asm volatile("s_waitcnt vmcnt(0)" ::: "memory");
    __syncthreads();
    if (TID == 0) {
        unsigned* bar = b.bar;
        __builtin_amdgcn_s_waitcnt(0);
        unsigned nloc = b.st[0], nx = b.st[1];
        if (nloc == 0u) { xcd_barrier_complete(bar, b.x, nloc, nx); b.st[0] = nloc; b.st[1] = nx; }
        const unsigned old = xb_add(&bar[XB_XSUB(b.x)], 1u);
        const unsigned gen = old / nloc;
        if (old + 1u == (gen + 1u) * nloc) {
            __builtin_amdgcn_fence(__ATOMIC_RELEASE, "agent");
            asm volatile("s_waitcnt vmcnt(0)" ::: "memory");
            const unsigned og = xb_add(&bar[XB_TOP], 1u);
            const unsigned tg = og / nx;
            if (og + 1u == (tg + 1u) * nx) xb_add(&bar[XB_TOPGEN], 1u);
            else XB_SPIN(xb_ld(&bar[XB_TOPGEN]) == tg, bar);
            __builtin_amdgcn_fence(__ATOMIC_ACQUIRE, "agent");
            xb_add(&bar[XB_XGEN(b.x)], 1u);
            asm volatile("s_waitcnt vmcnt(0)" ::: "memory");
        } else {
            XB_SPIN(xb_ld(&bar[XB_XGEN(b.x)]) == gen, bar);
            __builtin_amdgcn_fence(__ATOMIC_ACQUIRE, "agent");
            asm volatile("s_waitcnt vmcnt(0)" ::: "memory");
        }
    }
    __syncthreads();
}
struct PhaseCtl { XcdBarrier bar; int lo, hi; bool did; };
__device__ __forceinline__ bool phase_enter(const int wv, PhaseCtl& c, int k) {
    if (k < c.lo || k >= c.hi) return false;
    if (c.did) REPEAT(REP_BAR) xcd_barrier(wv, c.bar);
    c.did = true;
    return true;
}

#define DIAG 0
constexpr int CTL_DIAG = 4096;
__device__ __forceinline__ void diag_compare(const int wv, const P& p, const float* A, const float* Bq, size_t n) {
    float e = 0.f, r = 0.f; int bad = 0;
    for (size_t i = (size_t)blockIdx.x * NTHR + TID; i < n; i += (size_t)gridDim.x * NTHR) { const float a = A[i], b = Bq[i]; const float d = a - b; e += d * d; r += a * a; if (!(d == d) || fabsf(d) > 3.0e38f) bad = 1; }
    e = wave_sum(e); r = wave_sum(r); bad = __any(bad);
    if (lane_fresh() == 0) { float* c = (float*)(p.ws + WS_CTL) + CTL_DIAG; atomicAdd(c, e); atomicAdd(c + 1, r); if (bad) atomicAdd((unsigned*)(c + 2), 1u); }
}
__device__ __forceinline__ void diag_delay(const int wv, const P& p) {
    if (blockIdx.x == 0 && TID == 0) {
        float* c = (float*)(p.ws + WS_CTL) + CTL_DIAG;
        const float e = __hip_atomic_load(c, __ATOMIC_RELAXED, __HIP_MEMORY_SCOPE_AGENT), r = __hip_atomic_load(c + 1, __ATOMIC_RELAXED, __HIP_MEMORY_SCOPE_AGENT);
        const unsigned bad = __hip_atomic_load((unsigned*)(c + 2), __ATOMIC_RELAXED, __HIP_MEMORY_SCOPE_AGENT);
        const unsigned mask = __hip_atomic_load((unsigned*)(c + 3), __ATOMIC_RELAXED, __HIP_MEMORY_SCOPE_AGENT);
        float ms;
        if (bad) ms = 12.f; else if (!(r > 0.f)) ms = 14.f; else { const float rel = sqrtf(e / r); float lg = log10f(fmaxf(rel, 1e-8f)) + 8.f; lg = fminf(fmaxf(lg, 0.f), 10.f); ms = 1.f + lg; }
        if (DIAGF) { ms = 1.f; if (mask) ms = 2.f + (float)__ffs(mask); if (bad) ms += 10.f; }
        const unsigned long long t0 = __builtin_amdgcn_s_memrealtime(); const unsigned long long ticks = (unsigned long long)(ms * 100000.f);
        while (__builtin_amdgcn_s_memrealtime() - t0 < ticks) __builtin_amdgcn_s_sleep(32);
    }
}
constexpr int LDS_BYTES = 128 * 1024 + 1024;
constexpr int PH_PER_LAYER = 16, PH_FINAL = 1 + DEPTH * PH_PER_LAYER, PH_TOTAL = PH_FINAL + 1;

#define IN(k) phase_enter(wv, pc, (k))
template <int L>
__device__ __forceinline__ void run_layer(const int wv, const P& p, float* lds, PhaseCtl& pc) {
    constexpr int m = L % 3, base = 1 + L * PH_PER_LAYER, ia = L / 3;
    PG8_LAS unsigned char* glds = (PG8_LAS unsigned char*)lds;
    unsigned char* ws = p.ws;
    float* X = (float*)(ws + (L == 3 ? WS_X2 : WS_X)); bf16_t* H = (bf16_t*)(ws + WS_H);
    float* RKV = (float*)(ws + WS_RKV);
    float* WDp = (float*)(ws + WS_WD); float* AAp = (float*)(ws + WS_AA); float* GG = (float*)(ws + WS_GG);
    SchedBase sb; sb.G = gridDim.x; sb.c = blockIdx.x;
    if constexpr (m == 0) {
        if (IN(base + 0)) REPEAT(REP_NORM_MIX) ph_norm_xm(wv, p, L == 0 ? p.in[I_X] : (const float*)(ws + WS_X), X, L > 0, p.in[I_NMG] + L * D, p.in[I_MU] + ia * 6 * D, (unsigned char*)lds);
    } else {
    if (IN(base + 0)) REPEAT(REP_NORM_MIX) ph_norm(wv, p, L == 0 ? p.in[I_X] : X, LASTREP(REP_NORM_MIX) ? X : (float*)(ws + WS_YS), L > 0, p.in[I_NMG] + L * D, LASTREP(REP_NORM_MIX) ? H : (bf16_t*)(ws + WS_YS + 64 * MiB), nullptr, nullptr, lds);
    }
    if constexpr (m == 0) {
        const unsigned char* rb = ws + WB_RW + (size_t)ia * RW_STRIDE;
        if (IN(base + 2)) {
            SchedProj S; S.G = sb.G; S.c = sb.c; S.XM = (const char*)(ws + WS_XM); S.Wrkv = (const char*)(rb + RW_RKV); S.L1t = (const char*)(rb + RW_L1);
            EpiProj E; E.RKVb = (bf16_t*)(ws + WS_RKV); E.L1b = (bf16_t*)(ws + WS_L1);
            pg8::Geo g; g.lda = D; g.ldb = D; g.K = D;
            REPEAT(REP_PROJ) pg8::gemm_phase(wv, glds, g, S, E);
        }
        if (IN(base + 3)) {
            SchedLora2 S; S.G = sb.G; S.c = sb.c; S.L1b = (const char*)(ws + WS_L1); S.L2t = (const char*)(rb + RW_L2);
            EpiLora2 E; E.WDL = (bf16_t*)(ws + WS_WD); E.AAb = (bf16_t*)(ws + WS_AA); E.GGb = (bf16_t*)(ws + WS_GG); E.w0 = p.in[I_W0] + (size_t)ia * 2 * D; E.a0 = p.in[I_A0] + (size_t)ia * 2 * D;
            pg8::Geo g; g.lda = 512; g.ldb = 256; g.K = 256;
            REPEAT(REP_LORA2) pg8::gemm_phase(wv, glds, g, S, E);
        }
        if (IN(base + 4)) {
            REPEAT(REP_SCAN) ph_scan2(wv, p, ia, (unsigned char*)lds, (bf16_t*)(ws + WS_YS), LASTREP(REP_SCAN) ? L : -1);
        }
        if (DIAG) { if (IN(base + 11)) diag_compare(wv, p, (const float*)(ws + WS_YS), (const float*)(ws + WS_XM), (size_t)2 * T * D); }
        if (IN(base + 5)) REPEAT(REP_RPOST) ph_rwkv_post(wv, p, ia);
        if (IN(base + 6)) {
            SchedPlain S; S.G = sb.G; S.c = sb.c; S.A = (const char*)(ws + WS_YG); S.B = (const char*)(rb + RW_OUT); S.nN = 4; S.lda = D; S.ldb = D;
            pg8::Geo g; g.lda = D; g.ldb = D; g.K = D;
            REPEAT(REP_OUT) { EpiAddX E; E.X = LASTREP(REP_OUT) ? X : (float*)(ws + WS_YS); pg8::gemm_phase(wv, glds, g, S, E); }
        }
    } else if constexpr (m == 1) {
        if (IN(base + 1)) {
            SchedPlain S; S.G = sb.G; S.c = sb.c; S.A = (const char*)H; S.B = (const char*)(ws + WB_SC + SC_IN); S.nN = 12; S.lda = D; S.ldb = D;
            EpiStoreBf16 E; E.O = (bf16_t*)(ws + WS_RKV); E.ldc = 3 * D; pg8::Geo g; g.lda = D; g.ldb = D; g.K = D;
            REPEAT(REP_SCIN) pg8::gemm_phase(wv, glds, g, S, E);
        }
        if (IN(base + 2)) REPEAT(REP_SCMID) ph_sc_mid(wv, p);
        if (IN(base + 3)) {
            SchedPlain S; S.G = sb.G; S.c = sb.c; S.A = (const char*)(ws + WS_YG); S.B = (const char*)(ws + WB_SC + SC_OUT); S.nN = 4; S.lda = D; S.ldb = D;
            pg8::Geo g; g.lda = D; g.ldb = D; g.K = D;
            REPEAT(REP_OUT) { EpiAddX E; E.X = LASTREP(REP_OUT) ? X : (float*)(ws + WS_YS); pg8::gemm_phase(wv, glds, g, S, E); }
        }
    } else {
        if (IN(base + 1)) {
            SchedPlain S; S.G = sb.G; S.c = sb.c; S.A = (const char*)H; S.B = (const char*)(ws + WB_LRU + LRU_IN); S.nN = 8; S.lda = D; S.ldb = D;
            EpiStoreBf16 E; E.O = (bf16_t*)(ws + WS_RKV); E.ldc = 2 * D; pg8::Geo g; g.lda = D; g.ldb = D; g.K = D;
            REPEAT(REP_LIN) pg8::gemm_phase(wv, glds, g, S, E);
        }
        if (IN(base + 2)) REPEAT(REP_LCONV) ph_lru_conv(wv, p);
        if (IN(base + 3)) {
            SchedLruGate S; S.G = sb.G; S.c = sb.c; S.UCB = (const char*)(ws + WS_UCB); S.Wg = (const char*)(ws + WB_LRU + LRU_G);
            EpiLruGate E; E.LA = (bf16_t*)(ws + WS_WD); E.LB = (bf16_t*)(ws + WS_AA); E.UCB = (const bf16_t*)(ws + WS_UCB); E.ba = p.in[I_LBA]; E.bx = p.in[I_LBX]; E.lam = p.in[I_LLAM];
            pg8::Geo g; g.lda = D; g.ldb = 256; g.K = 256;
            REPEAT(REP_LGATE) pg8::gemm_phase(wv, glds, g, S, E);
        }
        if (IN(base + 4)) REPEAT(REP_LSCAN) ph_lru_scan(wv, p, lds);
        if (IN(base + 5)) REPEAT(REP_LPOST) ph_lru_post(wv, p);
        if (IN(base + 6)) {
            SchedPlain S; S.G = sb.G; S.c = sb.c; S.A = (const char*)(ws + WS_YG); S.B = (const char*)(ws + WB_LRU + LRU_OUT); S.nN = 4; S.lda = D; S.ldb = D;
            pg8::Geo g; g.lda = D; g.ldb = D; g.K = D;
            REPEAT(REP_OUT) { EpiAddX E; E.X = LASTREP(REP_OUT) ? X : (float*)(ws + WS_YS); pg8::gemm_phase(wv, glds, g, S, E); }
        }
    }
    if (IN(base + 7)) REPEAT(REP_NORM_FFN) ph_norm(wv, p, X, nullptr, false, p.in[I_NFG] + L * D, H, p.in[I_RW] + (size_t)L * D * NE, nullptr, lds);
    if (IN(base + 8)) REPEAT(REP_TOPK) ph_topk(wv, p, lds);
    if (IN(base + 9)) {
        SchedMoe1 S; S.G = sb.G; S.c = sb.c; S.XIN = (const char*)(ws + WS_XIN); S.Wgu = (const char*)(ws + WB_MOE + (size_t)L * MOE_STRIDE + MOE_GU);
        EpiSwiglu E; E.HID = (bf16_t*)(ws + WS_HID); pg8::Geo g; g.lda = D; g.ldb = D; g.K = D;
        REPEAT(REP_MOE1) pg8::gemm_phase(wv, glds, g, S, E);
    }
    if (IN(base + 10)) {
        SchedMoe2 S; S.G = sb.G; S.c = sb.c; S.HID = (const char*)(ws + WS_HID); S.Wdn = (const char*)(ws + WB_MOE + (size_t)L * MOE_STRIDE + MOE_DN);
        EpiDown E; E.YEXP = (bf16_t*)(ws + WS_YEXP); E.GATE = (const float*)(ws + WS_GATE); pg8::Geo g; g.lda = FF; g.ldb = FF; g.K = FF;
        REPEAT(REP_MOE2) pg8::gemm_phase(wv, glds, g, S, E);
    }
}

__global__ void __launch_bounds__(NTHR, 2) mega(P p_unused) {
    extern __shared__ __attribute__((aligned(16))) unsigned char lds_raw[];
    const P& p = *(const P*)__builtin_amdgcn_kernarg_segment_ptr();
    float* lds = (float*)lds_raw;
    volatile LAS unsigned* xbw = (volatile LAS unsigned*)(lds_raw + LDS_BYTES - 16);
    const int wv = __builtin_amdgcn_readfirstlane((int)(threadIdx.x >> 6));
    if (threadIdx.x == 0) { xbw[0] = 0u; xbw[1] = 0u; xbw[2] = 0u; xbw[3] = 0u; }
    __syncthreads();
    PhaseCtl pc; pc.lo = p.ph_lo; pc.hi = p.ph_hi; pc.did = false;
    pc.bar = xcd_barrier_post(wv, (unsigned*)(p.ws + WS_CTL), xbw);
    if (IN(0)) REPEAT(REP_PROLOGUE) ph_prologue(wv, p, lds);
    run_layer<0>(wv, p, lds, pc);
    run_layer<1>(wv, p, lds, pc);
    run_layer<2>(wv, p, lds, pc);
    run_layer<3>(wv, p, lds, pc);
    if (IN(PH_FINAL)) ph_norm(wv, p, (const float*)(p.ws + WS_X2), nullptr, true, p.in[I_FNG], nullptr, nullptr, p.out, lds);
    if (DIAG) { xcd_barrier(wv, pc.bar); diag_delay(wv, p); }
}
#undef IN

}

extern "C" void kernel_launch(void* const* d_in, const int* in_sizes, int n_in, void* d_out, int out_size, void* d_ws, size_t ws_size, hipStream_t stream) {
    static int ready = 0, grid = 256;
    if (!ready) {
        if (n_in != 36 || out_size != T * D || ws_size < WS_END) { fprintf(stderr, "kernel_launch: unexpected problem (n_in %d out %d ws %zu need %zu)\n", n_in, out_size, ws_size, (size_t)WS_END); ready = -1; return; }
        if (hipFuncSetAttribute((const void*)mega, hipFuncAttributeMaxDynamicSharedMemorySize, LDS_BYTES) != hipSuccess) { fprintf(stderr, "kernel_launch: hipFuncSetAttribute failed\n"); ready = -1; return; }
        { int dev = 0, cus = 0; if (hipGetDevice(&dev) == hipSuccess && hipDeviceGetAttribute(&cus, hipDeviceAttributeMultiprocessorCount, dev) == hipSuccess && cus > 0) grid = cus < 256 ? cus : 256; }
        ready = 1;
    }
    if (ready < 0) return;
    (void)in_sizes;
    P p{};
    for (int i = 0; i < 36; ++i) p.in[i] = (const float*)d_in[i];
    p.out = (float*)d_out; p.ws = (unsigned char*)d_ws;
    if (hipMemsetAsync((char*)d_ws + WS_CTL, 0, 32768, stream) != hipSuccess) { fprintf(stderr, "kernel_launch: memset failed\n"); return; }
    p.ph_lo = 0; p.ph_hi = PH_TOTAL;
    hipLaunchKernelGGL(mega, dim3(grid), dim3(NTHR), LDS_BYTES, stream, p);
}
```

```cpp
#include <hip/hip_runtime.h>
#include <stdint.h>
#include <stdio.h>

namespace {
constexpr int D = 1024, NB = 8, S = 2048, T = NB * S, DEPTH = 4, NE = 16, FF = 2048, CAP = 256, NH = 16, HD = 64;
constexpr int NTHR = 512;
constexpr float RMS_EPS = 1e-6f, LNX_EPS = 64e-5f;
typedef unsigned short bf16_t;

constexpr size_t MiB = 1u << 20;
constexpr size_t WS_CTL = 0;
constexpr size_t WS_X = 1 * MiB;
constexpr size_t WS_H = WS_X + 64 * MiB;
constexpr size_t WS_XM = WS_H + 32 * MiB;
constexpr size_t WS_RKV = WS_XM + 192 * MiB;
constexpr size_t WS_L1 = WS_RKV + 192 * MiB;
constexpr size_t WS_WD = WS_L1 + 24 * MiB;
constexpr size_t WS_AA = WS_WD + 128 * MiB;
constexpr size_t WS_GG = WS_AA + 128 * MiB;
constexpr size_t WS_YS = WS_GG + 64 * MiB;
constexpr size_t WS_YG = WS_YS + 128 * MiB;
constexpr size_t WS_UCB = WS_YG + 32 * MiB;
constexpr size_t WS_YEXP = WS_UCB + 32 * MiB;
constexpr size_t WS_AFF = WS_YEXP + 128 * MiB;
constexpr size_t WS_SLOT = WS_AFF + 1 * MiB;
constexpr size_t WS_GATE = WS_SLOT + 1 * MiB;
constexpr size_t WS_ACT_END = WS_GATE + 1 * MiB;
constexpr size_t WB_RW = WS_ACT_END;
constexpr size_t RW_RKV = 0, RW_L1 = 6 * MiB, RW_L2 = RW_L1 + 3 * 256 * 1024 * 2, RW_OUT = RW_L2 + 5 * 1024 * 256 * 2, RW_STRIDE = 12 * MiB;
constexpr size_t WB_SC = WB_RW + 2 * RW_STRIDE;
constexpr size_t SC_IN = 0, SC_OUT = 6 * MiB;
constexpr size_t WB_LRU = WB_SC + 8 * MiB;
constexpr size_t LRU_IN = 0, LRU_G = 4 * MiB, LRU_OUT = 6 * MiB;
constexpr size_t WB_MOE = WB_LRU + 8 * MiB;
constexpr size_t MOE_GU = 0, MOE_DN = 128 * MiB, MOE_STRIDE = 192 * MiB;
constexpr size_t WS_X2 = WB_MOE + 4 * MOE_STRIDE;
constexpr size_t WS_END = WS_X2 + 64 * MiB;
constexpr size_t WS_XIN = WS_XM, WS_HID = WS_XM + 64 * MiB;
constexpr size_t WS_BON = WS_L1 + 16 * MiB;

constexpr int REP_PROLOGUE = 1, REP_NORM_MIX = 1, REP_XM = 1, REP_PROJ = 1, REP_LORA2 = 1, REP_SCAN = 1, REP_RPOST = 1, REP_OUT = 1, REP_SCIN = 1, REP_SCMID = 1,
              REP_LIN = 1, REP_LCONV = 1, REP_LGATE = 1, REP_LSCAN = 1, REP_LPOST = 1, REP_NORM_FFN = 1, REP_TOPK = 1, REP_MOE1 = 1, REP_MOE2 = 1, REP_BAR = 1, REP_SA = 1, REP_SB = 1, REP_SC = 1, REP_SD = 1, GVAR = 0, SVAR = 0;
#define REPEAT(n) for (int rep_ = 0; rep_ < (n); ++rep_)
#define LASTREP(n) (rep_ == (n) - 1)
struct P {
    const float* in[36];
    float* out;
    unsigned char* ws;
    int ph_lo, ph_hi;
};

enum { I_X = 0, I_NMG, I_NFG, I_RW, I_WG, I_WU, I_WDN, I_FNG, I_MU, I_WIN, I_W0, I_W1, I_W2, I_A0, I_A1, I_A2, I_G1, I_G2, I_KK, I_KA, I_RK, I_LNG, I_LNB, I_WOUT,
       I_SCIN, I_SCCW, I_SCOUT, I_LIN, I_LCW, I_LCB, I_LWA, I_LBA, I_LWX, I_LBX, I_LLAM, I_LOUT };

__device__ __forceinline__ int lane_fresh() { int l; asm volatile("v_mbcnt_lo_u32_b32 %0, -1, 0\n\tv_mbcnt_hi_u32_b32 %0, -1, %0" : "=v"(l)); return l; }
#define TID (wv * 64 + lane_fresh())
__device__ __forceinline__ float bf2f(bf16_t v) { return __uint_as_float((unsigned)v << 16); }
__device__ __forceinline__ bf16_t f2bf(float f) { unsigned u = __float_as_uint(f); u += 0x7FFFu + ((u >> 16) & 1u); return (bf16_t)(u >> 16); }
__device__ __forceinline__ void bf4_to_f(uint2 u, float* f) { f[0] = __uint_as_float(u.x << 16); f[1] = __uint_as_float(u.x & 0xffff0000u); f[2] = __uint_as_float(u.y << 16); f[3] = __uint_as_float(u.y & 0xffff0000u); }
__device__ __forceinline__ uint2 f4_to_bf(float a, float b, float c, float d) { return make_uint2((unsigned)f2bf(a) | ((unsigned)f2bf(b) << 16), (unsigned)f2bf(c) | ((unsigned)f2bf(d) << 16)); }
template <int CTRL> __device__ __forceinline__ float dpp_f(float x) { return __builtin_bit_cast(float, __builtin_amdgcn_update_dpp(0, __builtin_bit_cast(int, x), CTRL, 0xf, 0xf, false)); }
__device__ __forceinline__ float row_sum16(float x) { x += dpp_f<0x128>(x); x += dpp_f<0x124>(x); x += dpp_f<0x122>(x); x += dpp_f<0x121>(x); return x; }
__device__ __forceinline__ float row_max16(float x) { x = fmaxf(x, dpp_f<0x128>(x)); x = fmaxf(x, dpp_f<0x124>(x)); x = fmaxf(x, dpp_f<0x122>(x)); x = fmaxf(x, dpp_f<0x121>(x)); return x; }
__device__ __forceinline__ float lane_bcast(float x, int l) { return __builtin_bit_cast(float, __builtin_amdgcn_readlane(__builtin_bit_cast(int, x), l)); }
__device__ __forceinline__ float wave_sum(float v) { v = row_sum16(v); return (lane_bcast(v, 0) + lane_bcast(v, 16)) + (lane_bcast(v, 32) + lane_bcast(v, 48)); }
__device__ __forceinline__ void wave_sum8(float (&v)[8]) {
#pragma unroll
    for (int s = 0; s < 8; ++s) v[s] = wave_sum(v[s]);
}
__device__ __forceinline__ float quad_sum(float v) { v += dpp_f<0xB1>(v); v += dpp_f<0x4E>(v); return v; }
__device__ __forceinline__ float sigmoidf_(float x) { return __builtin_amdgcn_rcpf(1.0f + __expf(-x)); }
__device__ __forceinline__ float tanhf_(float x) { const float e = __expf(-2.0f * fabsf(x)); const float t = (1.0f - e) * __builtin_amdgcn_rcpf(1.0f + e); return x < 0.f ? -t : t; }
__device__ __forceinline__ float softplusf_(float y) { return fmaxf(y, 0.f) + log1pf(__expf(-fabsf(y))); }
__device__ __forceinline__ float gelu_tanh(float x) { const float u = 0.7978845608028654f * (x + 0.044715f * x * x * x); return 0.5f * x * (1.0f + tanhf_(u)); }

__device__ __forceinline__ void ph_norm(const int wv, const P& p, const float* xin, float* xout, bool combine, const float* gamma, bf16_t* hout, const float* router_w, float* fout, float* lds) {
    const int tid = TID, lane = tid & 63, wave = tid >> 6;
    if (router_w) {
        for (int i = tid; i < D * NE; i += NTHR) { const int d = i >> 4, e = i & 15; lds[e * D + d] = router_w[i]; }
        __syncthreads();
    }
    const bf16_t* yexp = (const bf16_t*)(p.ws + WS_YEXP); const int* slot = (const int*)(p.ws + WS_SLOT);
    float* aff = (float*)(p.ws + WS_AFF);
    const int tstep = gridDim.x * 8; int tok = blockIdx.x * 8 + wave;
    float4 xn[4]; int sln = -1;
    if (tok < T) {
#pragma unroll
        for (int i = 0; i < 4; ++i) xn[i] = ((const float4*)(xin + (size_t)tok * D))[i * 64 + lane];
        if (combine) sln = slot[tok * NE + (lane & 15)];
    }
    for (; tok < T; tok += tstep) {
        const int b = tok / S, s = tok % S;
        float4 x[4];
#pragma unroll
        for (int i = 0; i < 4; ++i) x[i] = xn[i];
        const int slv = sln;
        if (tok + tstep < T) {
#pragma unroll
            for (int i = 0; i < 4; ++i) xn[i] = ((const float4*)(xin + (size_t)(tok + tstep) * D))[i * 64 + lane];
            if (combine) sln = slot[(tok + tstep) * NE + (lane & 15)];
        }
        if (combine) {
            unsigned msk = (unsigned)(__ballot(slv >= 0) & 0xffffull);
            while (msk) {
                const int e0 = __ffs(msk) - 1; msk &= msk - 1u;
                const int e1 = msk ? (__ffs(msk) - 1) : e0; const bool two = msk != 0u; msk &= msk - 1u;
                const int s0 = __builtin_amdgcn_readlane(slv, e0), s1 = __builtin_amdgcn_readlane(slv, e1);
                const uint2* r0 = (const uint2*)(yexp + ((size_t)(e0 * NB + b) * CAP + s0) * D); const uint2* r1 = (const uint2*)(yexp + ((size_t)(e1 * NB + b) * CAP + s1) * D);
                uint2 q0[4], q1[4];
#pragma unroll
                for (int i = 0; i < 4; ++i) { q0[i] = r0[i * 64 + lane]; q1[i] = r1[i * 64 + lane]; }
#pragma unroll
                for (int i = 0; i < 4; ++i) { float f[4]; bf4_to_f(q0[i], f); x[i].x += f[0]; x[i].y += f[1]; x[i].z += f[2]; x[i].w += f[3];
                    if (two) { bf4_to_f(q1[i], f); x[i].x += f[0]; x[i].y += f[1]; x[i].z += f[2]; x[i].w += f[3]; } }
            }
        }
        if (xout) {
#pragma unroll
            for (int i = 0; i < 4; ++i) ((float4*)(xout + (size_t)tok * D))[i * 64 + lane] = x[i];
        }
        float ss = 0.f;
#pragma unroll
        for (int i = 0; i < 4; ++i) ss += x[i].x * x[i].x + x[i].y * x[i].y + x[i].z * x[i].z + x[i].w * x[i].w;
        ss = wave_sum(ss);
        const float rstd = __builtin_amdgcn_rsqf(ss * (1.0f / D) + RMS_EPS);
        float4 h[4];
#pragma unroll
        for (int i = 0; i < 4; ++i) {
            const float4 g = ((const float4*)gamma)[i * 64 + lane];
            h[i].x = x[i].x * rstd * g.x; h[i].y = x[i].y * rstd * g.y; h[i].z = x[i].z * rstd * g.z; h[i].w = x[i].w * rstd * g.w;
        }
        if (hout) {
#pragma unroll
            for (int i = 0; i < 4; ++i) ((uint2*)(hout + (size_t)tok * D))[i * 64 + lane] = f4_to_bf(h[i].x, h[i].y, h[i].z, h[i].w);
        }
        if (fout) {
#pragma unroll
            for (int i = 0; i < 4; ++i) ((float4*)(fout + (size_t)tok * D))[i * 64 + lane] = h[i];
        }
        if (router_w) {
            float mylg = -3.0e38f;
#pragma unroll 1
            for (int eg = 0; eg < NE; eg += 8) {
                float a8[8];
#pragma unroll
                for (int j = 0; j < 8; ++j) {
                    float a = 0.f;
#pragma unroll
                    for (int i = 0; i < 4; ++i) { const float4 w = ((const float4*)(lds + (eg + j) * D))[i * 64 + lane]; a += h[i].x * w.x + h[i].y * w.y + h[i].z * w.z + h[i].w * w.w; }
                    a8[j] = a;
                }
                wave_sum8(a8);
#pragma unroll
                for (int j = 0; j < 8; ++j) if (lane == eg + j) mylg = a8[j];
            }
            float mx = mylg;
            mx = row_max16(mx);
            const float mine = (lane < NE) ? __expf(mylg - mx) : 0.f;
            float sum = mine;
            sum = row_sum16(sum);
            if (lane < NE) aff[((size_t)b * NE + lane) * S + s] = mine / sum;
        }
    }
}

__device__ __forceinline__ void ph_norm_xm(const int wv, const P& p, const float* xin, float* xout, bool combine, const float* gamma, const float* mu, unsigned char* lds) {
    const int tid = TID, lane = tid & 63, wave = tid >> 6;
    constexpr int HP = 2064;
    const bf16_t* yexp = (const bf16_t*)(p.ws + WS_YEXP); const int* slot = (const int*)(p.ws + WS_SLOT);
    bf16_t* XM = (bf16_t*)(p.ws + WS_XM);
    for (int unit = blockIdx.x; unit < T / 32; unit += gridDim.x) {
        const int t0 = unit * 32;
        float4 xr[5][4]; int slr[5];
#pragma unroll
        for (int j = 0; j < 5; ++j) {
            const int r = wave + 8 * j, tok = t0 - 1 + r, s = (t0 % S) - 1 + r; slr[j] = -1;
            if (r < 34 && s >= 0 && s < S) {
#pragma unroll
                for (int i = 0; i < 4; ++i) xr[j][i] = ((const float4*)(xin + (size_t)tok * D))[i * 64 + lane];
                if (combine) slr[j] = slot[tok * NE + (lane & 15)];
            } else {
#pragma unroll
                for (int i = 0; i < 4; ++i) xr[j][i] = make_float4(0.f, 0.f, 0.f, 0.f);
            }
        }
#pragma unroll
        for (int j = 0; j < 5; ++j) {
            const int r = wave + 8 * j, tok = t0 - 1 + r, s = (t0 % S) - 1 + r;
            if (r >= 34) continue;
            uint2* hrow = (uint2*)(lds + r * HP);
            if (s < 0 || s >= S) {
#pragma unroll
                for (int i = 0; i < 4; ++i) hrow[i * 64 + lane] = make_uint2(0u, 0u);
                continue;
            }
            const int b = tok / S;
            float4 x[4];
#pragma unroll
            for (int i = 0; i < 4; ++i) x[i] = xr[j][i];
            if (combine) {
                const int slv = slr[j];
                unsigned msk = (unsigned)(__ballot(slv >= 0) & 0xffffull);
                while (msk) {
                    const int e0 = __ffs(msk) - 1; msk &= msk - 1u;
                    const int e1 = msk ? (__ffs(msk) - 1) : e0; const bool two = msk != 0u; msk &= msk - 1u;
                    const int s0 = __builtin_amdgcn_readlane(slv, e0), s1 = __builtin_amdgcn_readlane(slv, e1);
                    const uint2* r0 = (const uint2*)(yexp + ((size_t)(e0 * NB + b) * CAP + s0) * D); const uint2* r1 = (const uint2*)(yexp + ((size_t)(e1 * NB + b) * CAP + s1) * D);
                    uint2 q0[4], q1[4];
#pragma unroll
                    for (int i = 0; i < 4; ++i) { q0[i] = r0[i * 64 + lane]; q1[i] = r1[i * 64 + lane]; }
#pragma unroll
                    for (int i = 0; i < 4; ++i) { float f[4]; bf4_to_f(q0[i], f); x[i].x += f[0]; x[i].y += f[1]; x[i].z += f[2]; x[i].w += f[3];
                        if (two) { bf4_to_f(q1[i], f); x[i].x += f[0]; x[i].y += f[1]; x[i].z += f[2]; x[i].w += f[3]; } }
                }
            }
            if (r >= 1 && r <= 32) {
#pragma unroll
                for (int i = 0; i < 4; ++i) ((float4*)(xout + (size_t)tok * D))[i * 64 + lane] = x[i];
            }
            float ss = 0.f;
#pragma unroll
            for (int i = 0; i < 4; ++i) ss += x[i].x * x[i].x + x[i].y * x[i].y + x[i].z * x[i].z + x[i].w * x[i].w;
            ss = wave_sum(ss);
            const float rstd = __builtin_amdgcn_rsqf(ss * (1.0f / D) + RMS_EPS);
#pragma unroll
            for (int i = 0; i < 4; ++i) {
                const float4 gq = ((const float4*)gamma)[i * 64 + lane];
                hrow[i * 64 + lane] = f4_to_bf(x[i].x * rstd * gq.x, x[i].y * rstd * gq.y, x[i].z * rstd * gq.z, x[i].w * rstd * gq.w);
            }
        }
        __syncthreads();
        for (int r = 1 + wave; r <= 32; r += 8) {
            const int tok = t0 - 1 + r;
#pragma unroll
            for (int i = 0; i < 4; ++i) {
                const int c4 = i * 64 + lane;
                float hc[4], hp[4], hn[4];
                bf4_to_f(((const uint2*)(lds + r * HP))[c4], hc); bf4_to_f(((const uint2*)(lds + (r - 1) * HP))[c4], hp); bf4_to_f(((const uint2*)(lds + (r + 1) * HP))[c4], hn);
                float xx[4];
#pragma unroll
                for (int j = 0; j < 4; ++j) xx[j] = 0.5f * (hp[j] + hn[j]) - hc[j];
#pragma unroll
                for (int q = 0; q < 6; ++q) {
                    const float4 m = ((const float4*)(mu + q * D))[c4];
                    ((uint2*)(XM + ((size_t)q * T + tok) * D))[c4] = f4_to_bf(hc[0] + xx[0] * m.x, hc[1] + xx[1] * m.y, hc[2] + xx[2] * m.z, hc[3] + xx[3] * m.w);
                }
            }
        }
        __syncthreads();
    }
}

__device__ __forceinline__ void ph_xm(const int wv, const P& p, const float* mu) {
    const int tid = TID, lane = tid & 63, wave = tid >> 6;
    const bf16_t* H = (const bf16_t*)(p.ws + WS_H); bf16_t* XM = (bf16_t*)(p.ws + WS_XM);
    for (int tok = blockIdx.x * 8 + wave; tok < T; tok += gridDim.x * 8) {
        const int s = tok % S;
#pragma unroll
        for (int i = 0; i < 4; ++i) {
            const int c4 = i * 64 + lane;
            float hc[4], hp[4] = {0.f, 0.f, 0.f, 0.f}, hn[4] = {0.f, 0.f, 0.f, 0.f};
            bf4_to_f(((const uint2*)(H + (size_t)tok * D))[c4], hc);
            if (s > 0) bf4_to_f(((const uint2*)(H + (size_t)(tok - 1) * D))[c4], hp);
            if (s < S - 1) bf4_to_f(((const uint2*)(H + (size_t)(tok + 1) * D))[c4], hn);
            float xx[4];
#pragma unroll
            for (int j = 0; j < 4; ++j) xx[j] = 0.5f * (hp[j] + hn[j]) - hc[j];
#pragma unroll
            for (int q = 0; q < 6; ++q) {
                const float4 m = ((const float4*)(mu + q * D))[c4];
                ((uint2*)(XM + ((size_t)q * T + tok) * D))[c4] = f4_to_bf(hc[0] + xx[0] * m.x, hc[1] + xx[1] * m.y, hc[2] + xx[2] * m.z, hc[3] + xx[3] * m.w);
            }
        }
    }
}

__device__ __forceinline__ void bf16x16_load(const bf16_t* p16, float* f) {
    const uint4 a = ((const uint4*)p16)[0], b = ((const uint4*)p16)[1];
    const unsigned w[8] = {a.x, a.y, a.z, a.w, b.x, b.y, b.z, b.w};
#pragma unroll
    for (int j = 0; j < 8; ++j) { f[2 * j] = __uint_as_float(w[j] << 16); f[2 * j + 1] = __uint_as_float(w[j] & 0xffff0000u); }
}
__device__ __forceinline__ void ph_rwkv_post(const int wv, const P& p, int ia) {
    const int tid = TID, lane = tid & 63, wave = tid >> 6;
    const bf16_t* RKV = (const bf16_t*)(p.ws + WS_RKV); const bf16_t* GG = (const bf16_t*)(p.ws + WS_GG); const float* BON = (const float*)(p.ws + WS_BON);
    const bf16_t* YS = (const bf16_t*)(p.ws + WS_YS); bf16_t* YG = (bf16_t*)(p.ws + WS_YG);
    const float* lg = p.in[I_LNG] + ia * D; const float* lb = p.in[I_LNB] + ia * D;
    for (int tok = blockIdx.x * 8 + wave; tok < T; tok += gridDim.x * 8) {
        const size_t o = (size_t)tok * D + lane * 16;
        float y[16], v[16], gg[16];
        { float y1[16]; bf16x16_load(YS + o, y); bf16x16_load(YS + (size_t)T * D + o, y1);
#pragma unroll
          for (int j = 0; j < 16; ++j) y[j] += y1[j]; }
        bf16x16_load(RKV + 2 * (size_t)T * D + o, v); bf16x16_load(GG + o, gg);
        const float bon = BON[(size_t)tok * NH + (lane >> 2)] + BON[((size_t)T + tok) * NH + (lane >> 2)];
        float sm = 0.f;
#pragma unroll
        for (int j = 0; j < 16; ++j) sm += y[j];
        const float mean = quad_sum(sm) * (1.0f / 64.0f);
        float sv = 0.f;
#pragma unroll
        for (int j = 0; j < 16; ++j) { const float d = y[j] - mean; sv += d * d; }
        const float rstd = __builtin_amdgcn_rsqf(quad_sum(sv) * (1.0f / 64.0f) + LNX_EPS);
        float outv[16];
#pragma unroll
        for (int j = 0; j < 16; ++j) { const int c = lane * 16 + j; outv[j] = ((y[j] - mean) * rstd * lg[c] + lb[c] + bon * v[j]) * gg[j]; }
#pragma unroll
        for (int j = 0; j < 4; ++j) ((uint2*)(YG + o))[j] = f4_to_bf(outv[4 * j], outv[4 * j + 1], outv[4 * j + 2], outv[4 * j + 3]);
    }
}

__device__ __forceinline__ void ph_sc_mid(const int wv, const P& p) {
    const int tid = TID, lane = tid & 63, wave = tid >> 6;
    const bf16_t* BCU = (const bf16_t*)(p.ws + WS_RKV); bf16_t* BZ = (bf16_t*)(p.ws + WS_YG); const float* cw = p.in[I_SCCW];
    for (int tok = blockIdx.x * 8 + wave; tok < T; tok += gridDim.x * 8) {
        const int s = tok % S;
#pragma unroll
        for (int i = 0; i < 4; ++i) {
            const int c4 = i * 64 + lane;
            float z[4] = {0.f, 0.f, 0.f, 0.f};
#pragma unroll
            for (int j = 0; j < 3; ++j) {
                const int ss = s + j - 1;
                if (ss >= 0 && ss < S) {
                    const size_t ro = (size_t)(tok + j - 1) * (3 * D);
                    float c[4], u[4]; bf4_to_f(((const uint2*)(BCU + ro + D))[c4], c); bf4_to_f(((const uint2*)(BCU + ro + 2 * D))[c4], u);
                    const float4 w = ((const float4*)(cw + j * D))[c4];
                    z[0] += w.x * c[0] * u[0]; z[1] += w.y * c[1] * u[1]; z[2] += w.z * c[2] * u[2]; z[3] += w.w * c[3] * u[3];
                }
            }
            float bg[4]; bf4_to_f(((const uint2*)(BCU + (size_t)tok * (3 * D)))[c4], bg);
            ((uint2*)(BZ + (size_t)tok * D))[c4] = f4_to_bf(bg[0] * z[0], bg[1] * z[1], bg[2] * z[2], bg[3] * z[3]);
        }
    }
}

__device__ __forceinline__ void ph_lru_conv(const int wv, const P& p) {
    const int tid = TID, lane = tid & 63, wave = tid >> 6;
    const bf16_t* GU = (const bf16_t*)(p.ws + WS_RKV); bf16_t* UCB = (bf16_t*)(p.ws + WS_UCB);
    const float* cw = p.in[I_LCW]; const float* cb = p.in[I_LCB];
    for (int tok = blockIdx.x * 8 + wave; tok < T; tok += gridDim.x * 8) {
        const int s = tok % S;
#pragma unroll
        for (int i = 0; i < 4; ++i) {
            const int c4 = i * 64 + lane;
            float4 acc = ((const float4*)cb)[c4];
#pragma unroll
            for (int j = 0; j < 4; ++j) {
                const int ss = s + j - 2;
                if (ss >= 0 && ss < S) {
                    float u[4]; bf4_to_f(((const uint2*)(GU + (size_t)(tok + j - 2) * (2 * D) + D))[c4], u); const float4 w = ((const float4*)(cw + j * D))[c4];
                    acc.x += w.x * u[0]; acc.y += w.y * u[1]; acc.z += w.z * u[2]; acc.w += w.w * u[3];
                }
            }
            ((uint2*)(UCB + (size_t)tok * D))[c4] = f4_to_bf(acc.x, acc.y, acc.z, acc.w);
        }
    }
}

__device__ __forceinline__ void ph_lru_scan(const int wv, const P& p, float* lds) {
    const int tid = TID;
    const bf16_t* LA = (const bf16_t*)(p.ws + WS_WD); const bf16_t* LB = (const bf16_t*)(p.ws + WS_AA);
    bf16_t* HS = (bf16_t*)(p.ws + WS_YS);
    float2* segP = (float2*)lds; float2* segH = (float2*)lds + 512;
    const int cp = tid & 31, seg = tid >> 5;
    for (int unit = blockIdx.x; unit < NB * 2 * 16; unit += gridDim.x) {
        const int cg = unit & 15, z = (unit >> 4) & 1, b = unit >> 5;
        const int c = cg * 64 + cp * 2;
        const bf16_t* la = LA + (size_t)z * T * D; const bf16_t* lb = LB + (size_t)z * T * D;
        float P0 = 0.f, P1 = 0.f, h0 = 0.f, h1 = 0.f;
#pragma unroll 8
        for (int i = seg * 128; i < seg * 128 + 128; ++i) {
            const int t = z ? (S - 1 - i) : i; const size_t o = ((size_t)b * S + t) * D + c;
            const unsigned a2 = *(const unsigned*)(la + o), b2 = *(const unsigned*)(lb + o);
            const float l0 = __uint_as_float(a2 << 16), l1 = __uint_as_float(a2 & 0xffff0000u);
            h0 = __expf(l0) * h0 + __uint_as_float(b2 << 16); h1 = __expf(l1) * h1 + __uint_as_float(b2 & 0xffff0000u);
            P0 += l0; P1 += l1;
        }
        segP[seg * 32 + cp] = make_float2(__expf(P0), __expf(P1)); segH[seg * 32 + cp] = make_float2(h0, h1);
        __syncthreads();
        float c0 = 0.f, c1 = 0.f;
        for (int s2 = 0; s2 < seg; ++s2) { const float2 pp = segP[s2 * 32 + cp], hh = segH[s2 * 32 + cp]; c0 = pp.x * c0 + hh.x; c1 = pp.y * c1 + hh.y; }
        h0 = c0; h1 = c1;
#pragma unroll 8
        for (int i = seg * 128; i < seg * 128 + 128; ++i) {
            const int t = z ? (S - 1 - i) : i; const size_t o = ((size_t)b * S + t) * D + c;
            const unsigned a2 = *(const unsigned*)(la + o), b2 = *(const unsigned*)(lb + o);
            h0 = __expf(__uint_as_float(a2 << 16)) * h0 + __uint_as_float(b2 << 16); h1 = __expf(__uint_as_float(a2 & 0xffff0000u)) * h1 + __uint_as_float(b2 & 0xffff0000u);
            *(unsigned*)(HS + (size_t)z * T * D + o) = (unsigned)f2bf(h0) | ((unsigned)f2bf(h1) << 16);
        }
        __syncthreads();
    }
}

__device__ __forceinline__ void ph_lru_post(const int wv, const P& p) {
    const int tid = TID, lane = tid & 63, wave = tid >> 6;
    const bf16_t* GU = (const bf16_t*)(p.ws + WS_RKV); const bf16_t* HS = (const bf16_t*)(p.ws + WS_YS); bf16_t* YL = (bf16_t*)(p.ws + WS_YG);
    for (int tok = blockIdx.x * 8 + wave; tok < T; tok += gridDim.x * 8) {
#pragma unroll
        for (int i = 0; i < 4; ++i) {
            const int c4 = i * 64 + lane;
            float gq[4]; bf4_to_f(((const uint2*)(GU + (size_t)tok * (2 * D)))[c4], gq); const float4 g = make_float4(gq[0], gq[1], gq[2], gq[3]);
            float hq0[4], hq1[4]; bf4_to_f(((const uint2*)(HS + (size_t)tok * D))[c4], hq0); bf4_to_f(((const uint2*)(HS + (size_t)T * D + (size_t)tok * D))[c4], hq1);
            const float4 h0 = make_float4(hq0[0], hq0[1], hq0[2], hq0[3]), h1 = make_float4(hq1[0], hq1[1], hq1[2], hq1[3]);
            ((uint2*)(YL + (size_t)tok * D))[c4] = f4_to_bf((h0.x + h1.x) * gelu_tanh(g.x), (h0.y + h1.y) * gelu_tanh(g.y), (h0.z + h1.z) * gelu_tanh(g.z), (h0.w + h1.w) * gelu_tanh(g.w));
        }
    }
}

__device__ __forceinline__ int block_sum_i(const int wv, int v, int* wsum  ) {
    const int lane = lane_fresh(), wave = wv;
    v = __popcll(__ballot(v & 1)) + 2 * __popcll(__ballot(v & 2)) + 4 * __popcll(__ballot(v & 4));
    if (lane == 0) wsum[wave] = v;
    __syncthreads();
    int tot = 0;
#pragma unroll
    for (int w = 0; w < 8; ++w) tot += wsum[w];
    return tot;
}
__device__ __forceinline__ int block_excl_scan_i(const int wv, int v, int* wsum  , int& total) {
    const int lane = lane_fresh(), wave = wv;
    int inc = v;
    for (int o = 1; o < 64; o <<= 1) { const int t = __shfl_up(inc, o); if (lane >= o) inc += t; }
    if (lane == 63) wsum[wave] = inc;
    __syncthreads();
    int base = 0, tot = 0;
#pragma unroll
    for (int w = 0; w < 8; ++w) { const int x = wsum[w]; if (w < wave) base += x; tot += x; }
    total = tot;
    return base + inc - v;
}
__device__ __forceinline__ void ph_topk(const int wv, const P& p, float* ldsf) {
    const int tid = TID, lane = tid & 63, wave = tid >> 6;
    int* ldsi = (int*)ldsf;
    int* wsum = ldsi;
    int* idx_l = ldsi + 64;
    const float* aff = (const float*)(p.ws + WS_AFF); int* slot = (int*)(p.ws + WS_SLOT); float* gate = (float*)(p.ws + WS_GATE);
    const bf16_t* HF = (const bf16_t*)(p.ws + WS_H); bf16_t* XIN = (bf16_t*)(p.ws + WS_XIN);
    for (int unit2 = blockIdx.x; unit2 < 2 * NB * NE; unit2 += gridDim.x) {
        const int unit = unit2 >> 1, half = unit2 & 1;
        const int e = unit % NE, b = unit / NE;
        const float4 v4 = ((const float4*)(aff + ((size_t)b * NE + e) * S))[tid];
        const unsigned v[4] = {__float_as_uint(v4.x), __float_as_uint(v4.y), __float_as_uint(v4.z), __float_as_uint(v4.w)};
        unsigned thr = 0u;
        for (int bit = 29; bit >= 0; --bit) {
            const unsigned cand = thr | (1u << bit);
            const int cnt = (int)(v[0] >= cand) + (int)(v[1] >= cand) + (int)(v[2] >= cand) + (int)(v[3] >= cand);
            const int tot = block_sum_i(wv, cnt, wsum + (bit & 1) * 8);
            if (tot >= CAP) thr = cand;
        }
        int g4 = 0, e4 = 0;
#pragma unroll
        for (int j = 0; j < 4; ++j) { g4 += (int)(v[j] > thr); e4 += (int)(v[j] == thr); }
        const int ngt = block_sum_i(wv, g4, wsum + 16);
        const int need_eq = CAP - ngt;
        int toteq; const int eqbase = block_excl_scan_i(wv, e4, wsum + 24, toteq);
        int sel[4], nsel = 0, er = eqbase;
#pragma unroll
        for (int j = 0; j < 4; ++j) { const bool gt = v[j] > thr, eq = v[j] == thr; sel[j] = (gt || (eq && er < need_eq)) ? 1 : 0; er += eq ? 1 : 0; nsel += sel[j]; }
        __syncthreads();
        int totsel; int cpos = block_excl_scan_i(wv, nsel, wsum, totsel);
#pragma unroll
        for (int j = 0; j < 4; ++j) {
            const int t = tid * 4 + j;
            if (sel[j]) {
                if (cpos < CAP) { idx_l[cpos] = t; if (half == 0) { gate[((size_t)e * NB + b) * CAP + cpos] = __uint_as_float(v[j]); slot[((size_t)b * S + t) * NE + e] = cpos; } }
                else if (half == 0) slot[((size_t)b * S + t) * NE + e] = -1;
                ++cpos;
            } else if (half == 0) slot[((size_t)b * S + t) * NE + e] = -1;
        }
        __syncthreads();
#pragma unroll 1
        for (int cb = 0; cb < 16; cb += 4) {
            const int c = half * 128 + wave * 16 + cb;
            const uint4* s0 = (const uint4*)(HF + ((size_t)b * S + idx_l[c]) * D); const uint4* s1 = (const uint4*)(HF + ((size_t)b * S + idx_l[c + 1]) * D);
            const uint4* s2 = (const uint4*)(HF + ((size_t)b * S + idx_l[c + 2]) * D); const uint4* s3 = (const uint4*)(HF + ((size_t)b * S + idx_l[c + 3]) * D);
            const uint4 a0 = s0[lane], b0 = s0[lane + 64], a1 = s1[lane], b1 = s1[lane + 64], a2 = s2[lane], b2 = s2[lane + 64], a3 = s3[lane], b3 = s3[lane + 64];
            uint4* d0 = (uint4*)(XIN + (((size_t)e * NB + b) * CAP + c) * D);
            d0[lane] = a0; d0[lane + 64] = b0; d0[128 + lane] = a1; d0[128 + lane + 64] = b1; d0[256 + lane] = a2; d0[256 + lane + 64] = b2; d0[384 + lane] = a3; d0[384 + lane + 64] = b3;
        }
        __syncthreads();
    }
}


namespace pg8 {
#define PG8_LAS __attribute__((address_space(3)))
typedef short bf16x8 __attribute__((ext_vector_type(8)));
typedef float f32x4 __attribute__((ext_vector_type(4)));
typedef unsigned u32x4 __attribute__((ext_vector_type(4)));
typedef unsigned u32x2 __attribute__((ext_vector_type(2)));
constexpr int BM = 256, BK = 64, HALF = 128, HTB = HALF * BK * 2, STAGE_BYTES = 8 * HTB;
__device__ __forceinline__ int lds_byte(int r, int c) { const int st = (r >> 4) * 2 + (c >> 5), rr = r & 15, cc = c & 31, ob = rr * 64 + cc * 2; return st * 1024 + (ob ^ (((ob >> 9) & 1) << 5)); }
__device__ __forceinline__ void stage_rc(int b, int& R, int& C) { const int st = b / 1024, sb = b % 1024, swz = sb ^ (((sb >> 9) & 1) << 5); R = (st >> 1) * 16 + swz / 64; C = (st & 1) * 32 + (swz % 64) / 2; }
__device__ __forceinline__ int perm32(int rho) { const int n = rho >> 4, i = rho & 15; return 8 * (i >> 2) + 4 * n + (i & 3); }
struct Unit { const char* A; const char* B; int pm, pn, job; };
struct Geo { int lda, ldb, K; };
typedef float f32x2_t __attribute__((ext_vector_type(2)));
typedef __bf16 bf16x2_t __attribute__((ext_vector_type(2)));
__device__ __forceinline__ unsigned cvt_pk_bf16(float lo, float hi) { const f32x2_t v = {lo, hi}; const bf16x2_t b = __builtin_convertvector(v, bf16x2_t); return __builtin_bit_cast(unsigned, b); }

template <class Epi, class Sched>
__device__ __forceinline__ void gemm_phase(const int wv, PG8_LAS unsigned char* lds, const Geo g, const Sched& S, const Epi& E, const bool skip_epi = false) {
    const int tid = TID, wid = wv, lane = tid & 63, wr = wid >> 2, wc = wid & 3, fr = lane & 15, fq = lane >> 4;
    const int nt = g.K / BK;
    unsigned voffA[2], voffB[2];
#pragma unroll
    for (int i = 0; i < 2; ++i) { int R, C; stage_rc(tid * 16 + i * 8192, R, C); const int Rb = Epi::PERM ? ((R & ~31) + perm32(R & 31)) : R;
        voffA[i] = (unsigned)(R * g.lda + C) * 2u; voffB[i] = (unsigned)(Rb * g.ldb + C) * 2u; }
    const size_t kstep = (size_t)(BK * 2);
    const size_t hstepA = (size_t)HALF * g.lda * 2, hstepB = (size_t)HALF * g.ldb * 2;
    const unsigned ldsw = (unsigned)wid * 1024u;
    const int aoff = lds_byte(wr * 64 + fr, fq * 8), boff = lds_byte(wc * 32 + fr, fq * 8);
#define PG8_SA(b, h) (((b) * 2 + (h)) * HTB)
#define PG8_SB(b, h) ((4 + (b) * 2 + (h)) * HTB)
#define PG8_STAGE(bufoff, gbase, voff) do { _Pragma("unroll") for (int _i = 0; _i < 2; ++_i) \
        __builtin_amdgcn_global_load_lds((const unsigned*)((const char*)(gbase) + (voff)[_i]), (PG8_LAS unsigned*)(lds + (bufoff) + ldsw + _i * 8192), 16, 0, 0); } while (0)
#define PG8_LDA(dst, b, h) do { _Pragma("unroll") for (int m = 0; m < 4; ++m) _Pragma("unroll") for (int k = 0; k < 2; ++k) dst[m][k] = *(const PG8_LAS bf16x8*)(lds + PG8_SA(b, h) + aoff + m * 2048 + k * 1024); } while (0)
#define PG8_LDB(dst, b, h) do { _Pragma("unroll") for (int n = 0; n < 2; ++n) _Pragma("unroll") for (int k = 0; k < 2; ++k) dst[n][k] = *(const PG8_LAS bf16x8*)(lds + PG8_SB(b, h) + boff + n * 2048 + k * 1024); } while (0)
#define PG8_MMA(ai, bj, At, Bt) do { __builtin_amdgcn_s_setprio(1); _Pragma("unroll") for (int m = 0; m < 4; ++m) _Pragma("unroll") for (int n = 0; n < 2; ++n) _Pragma("unroll") for (int k = 0; k < 2; ++k) \
        acc[ai][bj][m][n] = __builtin_amdgcn_mfma_f32_16x16x32_bf16(Bt[n][k], At[m][k], acc[ai][bj][m][n], 0, 0, 0); __builtin_amdgcn_s_setprio(0); } while (0)
#define PG8_WAIT_V(n) asm volatile("s_waitcnt vmcnt(" #n ")" ::: "memory")
#define PG8_WAIT_L(n) asm volatile("s_waitcnt lgkmcnt(" #n ")" ::: "memory")
#define PG8_BAR __builtin_amdgcn_s_barrier()
#define PG8_SCHED __builtin_amdgcn_sched_barrier(0)
    Unit cur, nxt; int ui = 0;
    if (!S.next(0, cur)) return;
    f32x4 acc[2][2][4][2];
#pragma unroll
    for (int a = 0; a < 2; ++a)
#pragma unroll
        for (int b = 0; b < 2; ++b)
#pragma unroll
            for (int m = 0; m < 4; ++m)
#pragma unroll
                for (int n = 0; n < 2; ++n) acc[a][b][m][n] = (f32x4){0.f, 0.f, 0.f, 0.f};
    bf16x8 At[4][2], B0[2][2], B1[2][2];
    const char* cA = cur.A; const char* cB = cur.B;
    PG8_STAGE(PG8_SB(0, 0), cB, voffB); PG8_STAGE(PG8_SB(0, 1), cB + hstepB, voffB); PG8_STAGE(PG8_SA(0, 0), cA, voffA); PG8_STAGE(PG8_SA(0, 1), cA + hstepA, voffA);
    if (wr == 1) PG8_BAR;
    PG8_WAIT_V(2); PG8_BAR;
    PG8_STAGE(PG8_SB(1, 0), cB + kstep, voffB); PG8_STAGE(PG8_SA(1, 0), cA + kstep, voffA); PG8_STAGE(PG8_SB(1, 1), cB + hstepB + kstep, voffB);
    PG8_WAIT_V(6); PG8_BAR;
    for (;;) {
        const bool has_next = S.next(ui + 1, nxt);
        const char* nA = has_next ? nxt.A : cA; const char* nB = has_next ? nxt.B : cB;
#pragma unroll 1
        for (int t = 0; t < nt; t += 2) {
            const bool last = (t == nt - 2);
            const char* a1 = cA + (size_t)(t + 1) * kstep;
            const char* a2 = last ? nA : cA + (size_t)(t + 2) * kstep; const char* b2 = last ? nB : cB + (size_t)(t + 2) * kstep;
            const char* a3 = a2 + kstep; const char* b3 = b2 + kstep;
            PG8_LDB(B0, 0, 0); PG8_LDB(B1, 0, 1); PG8_SCHED; PG8_LDA(At, 0, 0); PG8_STAGE(PG8_SA(1, 1), a1 + hstepA, voffA);
            PG8_WAIT_V(8); PG8_WAIT_L(0); PG8_BAR; PG8_MMA(0, 0, At, B0); PG8_MMA(0, 1, At, B1); PG8_BAR; PG8_SCHED;
            PG8_LDA(At, 0, 1); PG8_STAGE(PG8_SB(0, 0), b2, voffB); PG8_STAGE(PG8_SB(0, 1), b2 + hstepB, voffB); PG8_STAGE(PG8_SA(0, 0), a2, voffA);
            PG8_WAIT_V(8); PG8_WAIT_L(0); PG8_BAR; PG8_MMA(1, 0, At, B0); PG8_MMA(1, 1, At, B1); PG8_BAR; PG8_SCHED;
            PG8_LDB(B0, 1, 0); PG8_LDB(B1, 1, 1); PG8_SCHED; PG8_LDA(At, 1, 0); PG8_STAGE(PG8_SA(0, 1), a2 + hstepA, voffA);
            PG8_WAIT_V(8); PG8_WAIT_L(0); PG8_BAR; PG8_MMA(0, 0, At, B0); PG8_MMA(0, 1, At, B1); PG8_BAR; PG8_SCHED;
            PG8_LDA(At, 1, 1); PG8_STAGE(PG8_SB(1, 0), b3, voffB); PG8_STAGE(PG8_SB(1, 1), b3 + hstepB, voffB); PG8_STAGE(PG8_SA(1, 0), a3, voffA);
            PG8_WAIT_V(8); PG8_WAIT_L(0); PG8_BAR; PG8_MMA(1, 0, At, B0); PG8_MMA(1, 1, At, B1); PG8_BAR; PG8_SCHED;
        }
        if (wr == 0) PG8_BAR;
        if (!skip_epi) { const int le = lane_fresh(); E(acc, cur, wr, wc, le & 15, le >> 4); }
        if (!has_next) break;
#pragma unroll
        for (int a = 0; a < 2; ++a)
#pragma unroll
            for (int b = 0; b < 2; ++b)
#pragma unroll
                for (int m = 0; m < 4; ++m)
#pragma unroll
                    for (int n = 0; n < 2; ++n) acc[a][b][m][n] = (f32x4){0.f, 0.f, 0.f, 0.f};
        cur = nxt; cA = nA; cB = nB; ++ui;
        if (wr == 1) PG8_BAR;
    }
    PG8_WAIT_V(0);
    PG8_BAR;
#undef PG8_SA
#undef PG8_SB
#undef PG8_STAGE
#undef PG8_LDA
#undef PG8_LDB
#undef PG8_MMA
#undef PG8_WAIT_V
#undef PG8_WAIT_L
#undef PG8_BAR
#undef PG8_SCHED
}
}


#define DIAGF 0
constexpr int CTL_DIAGW = 4096;
__device__ __forceinline__ void diag_flag(const P& p, bool badv, unsigned bit) {
    if (DIAGF && __any(badv)) { if (lane_fresh() == 0) atomicOr((unsigned*)(p.ws + WS_CTL) + CTL_DIAGW + 3, bit); }
}
__device__ __forceinline__ bool nonfin(float x) { return !(x == x) || fabsf(x) > 3.0e38f; }
__device__ __forceinline__ bool nonfin4(const pg8::f32x4& v) { return nonfin(v[0]) || nonfin(v[1]) || nonfin(v[2]) || nonfin(v[3]); }
namespace rs {
constexpr int P_TK = 144, P_KT = 80;
constexpr int O_KH = 0, O_RH = 4608, O_BT = 9216, O_KDT = 13824;
constexpr int O_BG = 18432, O_KDG = 23552, O_VM = 28672;
constexpr int O_B2 = 33792, O_AP = 36352, O_BP = 38912, O_NT = 41472;
constexpr int O_L = 44032;
constexpr int O_GAM = 48640;
constexpr int O_X = 48896;
constexpr int CHUNK_BYTES = 53760;
constexpr int O_SEGP = 2 * CHUNK_BYTES;
constexpr int O_YB = O_SEGP + 2048;
constexpr int YB_PITCH = 68;
static_assert(O_YB + 64 * YB_PITCH * 4 <= 128 * 1024, "scan LDS");
typedef pg8::bf16x8 bf16x8; typedef pg8::f32x4 f32x4; typedef pg8::u32x4 u32x4; typedef pg8::u32x2 u32x2;
__device__ __forceinline__ bf16x8 mk8(u32x2 lo, u32x2 hi) { u32x4 w; w.x = lo.x; w.y = lo.y; w.z = hi.x; w.w = hi.y; return __builtin_bit_cast(bf16x8, w); }
__device__ __forceinline__ bf16x8 cvt8(const f32x4& a, const f32x4& b) { u32x4 w; w.x = pg8::cvt_pk_bf16(a[0], a[1]); w.y = pg8::cvt_pk_bf16(a[2], a[3]); w.z = pg8::cvt_pk_bf16(b[0], b[1]); w.w = pg8::cvt_pk_bf16(b[2], b[3]); return __builtin_bit_cast(bf16x8, w); }
}
__device__ __forceinline__ void ph_scan2(const int wv, const P& p, int ia, unsigned char* lds, bf16_t* YS, const int moeL, const int var_ = 0) {
    const int var = var_ >= 100 ? var_ - 100 : 0; const bool dummy = var_ >= 100;
    using namespace rs;
#define RS_SYNC() do { if (var != 2) __syncthreads(); } while (0)
    const int lane = lane_fresh(), tid = wv * 64 + lane, l15 = lane & 15, g = lane >> 4;
    const bf16_t* RKV = (const bf16_t*)(p.ws + WS_RKV); const bf16_t* WDp = (const bf16_t*)(p.ws + WS_WD); const bf16_t* AAp = (const bf16_t*)(p.ws + WS_AA);
    for (int unit = blockIdx.x; unit < NB * NH * 2; unit += gridDim.x) {
        const int z = unit & 1, h = (unit >> 1) % NH, b = unit / (2 * NH);
        const float k_k = p.in[I_KK][ia * D + h * HD + lane], k_a = p.in[I_KA][ia * D + h * HD + lane];
        const float r_kq = p.in[I_RK][ia * D + h * HD + lane];
        f32x4 S4[4];
#pragma unroll
        for (int i = 0; i < 4; ++i) S4[i] = (f32x4){0.f, 0.f, 0.f, 0.f};
        float rr[8], kx[8], vv[8], ww[8], aa[8];
#define RS_LOAD(scx) do { _Pragma("unroll") for (int s = 0; s < 8; ++s) { \
            const int step = (scx) * 64 + (wv >> 2) * 32 + (wv & 3) * 8 + s, t = z ? (S - 1 - step) : step; \
            const size_t o = ((size_t)b * S + t) * D + h * HD + lane; \
            rr[s] = bf2f(RKV[o]); kx[s] = bf2f(RKV[(size_t)T * D + o]); vv[s] = bf2f(RKV[2 * (size_t)T * D + o]); \
            ww[s] = bf2f(WDp[(size_t)z * T * D + o]); aa[s] = bf2f(AAp[(size_t)z * T * D + o]); } } while (0)
        RS_LOAD(0);
        float fz[32]; bf16_t* fdst = nullptr; bool fon = false;
#pragma unroll
        for (int r = 0; r < 32; ++r) fz[r] = 0.f;
        const bool filler = (wv >= 4 && moeL >= 0 && unit == (int)blockIdx.x && gridDim.x == 256) && (!dummy || var >= 4);
#define RS_FILL_LOAD(J_) do { const int J = (J_); fon = J < NE * 3 * 1024; \
            if (fon) { const int mat = J >> 10, e = mat / 3, m = mat - 3 * e, jl = J & 1023; const float* fsrc; int fldw; \
                unsigned char* mb = dummy ? p.ws + WS_XM : p.ws + WB_MOE + (size_t)moeL * MOE_STRIDE; \
                if (m < 2) { const int nb = jl >> 5, kb = jl & 31, n = nb * 64 + lane; \
                    fsrc = p.in[m ? I_WU : I_WG] + (((size_t)moeL * NE + e) * D + kb * 32) * FF + n; fldw = FF; \
                    fdst = (bf16_t*)(mb + MOE_GU) + ((size_t)e * 4096 + ((n >> 7) << 8) + m * 128 + (n & 127)) * D + kb * 32; } \
                else { const int nb = jl >> 6, kb = jl & 63, n = nb * 64 + lane; \
                    fsrc = p.in[I_WDN] + (((size_t)moeL * NE + e) * FF + kb * 32) * D + n; fldw = D; \
                    fdst = (bf16_t*)(mb + MOE_DN) + ((size_t)e * D + n) * FF + kb * 32; } \
                if (var != 6) { _Pragma("unroll") for (int r = 0; r < 32; ++r) fz[r] = __builtin_nontemporal_load(fsrc + (size_t)r * fldw); } } \
            else { _Pragma("unroll") for (int r = 0; r < 32; ++r) fz[r] = 0.f; fdst = nullptr; } } while (0)
#define RS_FILL_STORE() do { if (fon && var != 5) { _Pragma("unroll") for (int c = 0; c < 4; ++c) { u32x4 w; \
            w.x = pg8::cvt_pk_bf16(fz[8 * c], fz[8 * c + 1]); w.y = pg8::cvt_pk_bf16(fz[8 * c + 2], fz[8 * c + 3]); w.z = pg8::cvt_pk_bf16(fz[8 * c + 4], fz[8 * c + 5]); w.w = pg8::cvt_pk_bf16(fz[8 * c + 6], fz[8 * c + 7]); \
            *(u32x4*)(fdst + 8 * c) = w; } } } while (0)
        for (int sc = 0; sc < S / 64; ++sc) {
            {
                const int q = wv >> 2, seg = wv & 3; unsigned char* cb = lds + q * CHUNK_BYTES;
                const int lna = lane_fresh(); const int kpos = (lna & 32) | (((lna >> 2) & 3) << 3) | (((lna >> 4) & 1) << 2) | (lna & 3);
                REPEAT(REP_SA) {
                float pl[8];
                pl[0] = ww[0];
#pragma unroll
                for (int s = 1; s < 8; ++s) pl[s] = pl[s - 1] + ww[s];
                ((float*)(lds + O_SEGP))[(q * 4 + seg) * 64 + lane] = pl[7];
                float kkn[8], ssq[8];
#pragma unroll
                for (int s = 0; s < 8; ++s) { kkn[s] = kx[s] * k_k; ssq[s] = kkn[s] * kkn[s]; }
                wave_sum8(ssq);
#pragma unroll
                for (int s = 0; s < 8; ++s) kkn[s] *= __builtin_amdgcn_rsqf(fmaxf(ssq[s], 1e-24f));
                RS_SYNC();
                float prefix = 0.f, PCl = 0.f;
#pragma unroll
                for (int s2 = 0; s2 < 4; ++s2) { const float sp = ((const float*)(lds + O_SEGP))[(q * 4 + s2) * 64 + lane]; if (s2 < seg) prefix += sp; PCl += sp; }
                const float PC = __expf(PCl);
                float bgs[8], kdgs[8], bnv[8];
#pragma unroll
                for (int s = 0; s < 8; ++s) {
                    const int tt = seg * 8 + s;
                    const float cl = prefix + pl[s]; const float Pt = __expf(cl), Pm = __expf(cl - ww[s]), inv = __expf(-cl);
                    const float bb = kkn[s] * aa[s], kd = kx[s] * (1.0f + (aa[s] - 1.0f) * k_a);
                    const float bt = bb * inv, kdt = kd * inv;
                    bnv[s] = rr[s] * kd * r_kq;
                    const unsigned w01 = pg8::cvt_pk_bf16(kkn[s] * Pm, rr[s] * Pt), w23 = pg8::cvt_pk_bf16(bt, kdt);
                    *(bf16_t*)(cb + O_KH + tt * P_TK + kpos * 2) = (bf16_t)w01;
                    *(bf16_t*)(cb + O_RH + tt * P_TK + kpos * 2) = (bf16_t)(w01 >> 16);
                    *(bf16_t*)(cb + O_BT + tt * P_TK + kpos * 2) = (bf16_t)w23;
                    *(bf16_t*)(cb + O_KDT + tt * P_TK + kpos * 2) = (bf16_t)(w23 >> 16);
                    bgs[s] = bt * PC; kdgs[s] = kdt * PC;
                    diag_flag(p, nonfin(bt) || nonfin(kdt) || nonfin(kkn[s] * Pm) || nonfin(rr[s] * Pt) || nonfin(bgs[s]) || nonfin(kdgs[s]) || nonfin(vv[s]), 1u);
                    diag_flag(p, !(Pt > 1e-12f) || nonfin(inv), 2u);
                }
                wave_sum8(bnv);
                { float bsel = bnv[0];
#pragma unroll
                  for (int s = 1; s < 8; ++s) bsel = (lna == s) ? bnv[s] : bsel;
                  if (lna < 8) { const int step = sc * 64 + q * 32 + seg * 8 + lna, t = z ? (S - 1 - step) : step;
                      ((float*)(p.ws + WS_BON))[((size_t)z * T + (size_t)b * S + t) * NH + h] = bsel; } }
                u32x4 w;
                w.x = pg8::cvt_pk_bf16(bgs[0], bgs[1]); w.y = pg8::cvt_pk_bf16(bgs[2], bgs[3]); w.z = pg8::cvt_pk_bf16(bgs[4], bgs[5]); w.w = pg8::cvt_pk_bf16(bgs[6], bgs[7]);
                { u32x2 wl; wl.x = w.x; wl.y = w.y; u32x2 wh; wh.x = w.z; wh.y = w.w; const int pb = 16 * (seg & 1) + 4 * (seg >> 1);
                  *(u32x2*)(cb + O_BG + lane * P_KT + pb * 2) = wl; *(u32x2*)(cb + O_BG + lane * P_KT + (pb + 8) * 2) = wh; }
                w.x = pg8::cvt_pk_bf16(kdgs[0], kdgs[1]); w.y = pg8::cvt_pk_bf16(kdgs[2], kdgs[3]); w.z = pg8::cvt_pk_bf16(kdgs[4], kdgs[5]); w.w = pg8::cvt_pk_bf16(kdgs[6], kdgs[7]);
                *(u32x4*)(cb + O_KDG + lane * P_KT + seg * 16) = w;
                w.x = pg8::cvt_pk_bf16(vv[0], vv[1]); w.y = pg8::cvt_pk_bf16(vv[2], vv[3]); w.z = pg8::cvt_pk_bf16(vv[4], vv[5]); w.w = pg8::cvt_pk_bf16(vv[6], vv[7]);
                *(u32x4*)(cb + O_VM + lane * P_KT + seg * 16) = w;
                if (seg == 0) *(float*)(cb + O_GAM + lane * 4) = PC;
                }
                if (sc + 1 < S / 64 && var != 1) RS_LOAD(sc + 1);
            }
            RS_SYNC();
            {
                const int q = wv >> 2, o = wv & 3; unsigned char* cb = lds + q * CHUNK_BYTES;
                const int lnb = lane_fresh(), l15 = lnb & 15, g = lnb >> 4;
                REPEAT(REP_SB) {
                const unsigned char* Xm = cb + ((o & 1) ? O_KDT : O_BT); const unsigned char* Ym = cb + ((o >> 1) ? O_RH : O_KH);
#pragma unroll
                for (int ti = 0; ti < 2; ++ti)
#pragma unroll
                    for (int tt = 0; tt < 2; ++tt) {
                        f32x4 acc = (f32x4){0.f, 0.f, 0.f, 0.f};
                        if (tt >= ti) {
#pragma unroll
                            for (int ks = 0; ks < 2; ++ks) {
                                const bf16x8 a = *(const bf16x8*)(Xm + (16 * ti + l15) * P_TK + (32 * ks + 8 * g) * 2);
                                const bf16x8 bq = *(const bf16x8*)(Ym + (16 * tt + l15) * P_TK + (32 * ks + 8 * g) * 2);
                                acc = __builtin_amdgcn_mfma_f32_16x16x32_bf16(a, bq, acc, 0, 0, 0);
                            }
                        }
                        const int t = 16 * tt + l15, i0 = 16 * ti + 4 * g;
#pragma unroll
                        for (int r = 0; r < 4; ++r) { const int i = i0 + r; const bool keep = (o < 2) ? (i < t) : (i <= t); if (!keep) acc[r] = 0.f; }
                        diag_flag(p, nonfin4(acc), 4u);
                        if (o == 0) *(f32x4*)(cb + O_L + t * 144 + i0 * 4) = acc;
                        else { u32x2 w; w.x = pg8::cvt_pk_bf16(acc[0], acc[1]); w.y = pg8::cvt_pk_bf16(acc[2], acc[3]);
                               if (o == 2) *(u32x2*)(cb + O_AP + t * P_KT + (8 * g + 4 * ti) * 2) = w;
                               else *(u32x2*)(cb + (o == 1 ? O_B2 : O_BP) + t * P_KT + i0 * 2) = w; }
                    }
                }
            }
            RS_SYNC();
            REPEAT(REP_SC) {
            const int tid = wv * 64 + lane_fresh();
            if (tid < 64) {
                const int q = tid >> 5, d = (tid >> 4) & 1, j = tid & 15; unsigned char* cb = lds + q * CHUNK_BYTES;
                float x[16];
#pragma unroll
                for (int i = 0; i < 16; ++i) x[i] = (i == j) ? 1.f : 0.f;
                const unsigned char* Lb = cb + O_L + (16 * d) * 144 + (16 * d) * 4;
                f32x4 Lr[16][4];
#define RS_LROWS(lo, hi) do { _Pragma("unroll") for (int tl = (lo); tl < (hi); ++tl) { _Pragma("unroll") for (int c4 = 0; c4 < (tl + 3) / 4; ++c4) Lr[tl][c4] = *(const f32x4*)(Lb + tl * 144 + c4 * 16); } \
            asm volatile("s_waitcnt lgkmcnt(0)" ::: "memory"); __builtin_amdgcn_sched_barrier(0); } while (0)
#define RS_LSOLVE(lo, hi) do { _Pragma("unroll") for (int tl = (lo); tl < (hi); ++tl) { float s4[4] = {0.f, 0.f, 0.f, 0.f}; \
            _Pragma("unroll") for (int il = 0; il < tl; ++il) s4[il & 3] += Lr[tl][il >> 2][il & 3] * x[il]; \
            const float s = (s4[0] + s4[1]) + (s4[2] + s4[3]); x[tl] = (tl > j) ? -s : x[tl]; } } while (0)
                RS_LROWS(1, 10); RS_LSOLVE(1, 10);
                RS_LROWS(10, 16); RS_LSOLVE(10, 16);
#undef RS_LROWS
#undef RS_LSOLVE
#pragma unroll
                for (int tl = 0; tl < 16; ++tl) { *(float*)(cb + O_X + (16 * d + tl) * 144 + (16 * d + j) * 4) = x[tl]; diag_flag(p, nonfin(x[tl]) || fabsf(x[tl]) > 1e6f, 8u); }
            }
            if (filler) { RS_FILL_STORE(); RS_FILL_LOAD(((int)blockIdx.x * 4 + (wv - 4)) * 64 + sc * 2); }
            RS_SYNC();
            {
                const int q = tid >> 8, tl = (tid >> 4) & 15, jl = tid & 15; unsigned char* cb = lds + q * CHUNK_BYTES;
                const float* Lr = (const float*)(cb + O_L + (16 + tl) * 144);
                float s = 0.f;
#pragma unroll
                for (int i = 0; i < 16; ++i) s += Lr[i] * *(const float*)(cb + O_X + i * 144 + jl * 4);
                *(float*)(cb + O_X + tl * 144 + (16 + jl) * 4) = s;
            }
            RS_SYNC();
            {
                const int q = tid >> 8, tl = (tid >> 4) & 15, jl = tid & 15; unsigned char* cb = lds + q * CHUNK_BYTES;
                float s = 0.f;
#pragma unroll
                for (int i = 0; i < 16; ++i) s += *(const float*)(cb + O_X + (16 + tl) * 144 + (16 + i) * 4) * *(const float*)(cb + O_X + i * 144 + (16 + jl) * 4);
                diag_flag(p, nonfin(s), 16u);
                const int p0 = 8 * (jl >> 2) + (jl & 3), p1 = p0 + 4;
                *(bf16_t*)(cb + O_NT + (16 + tl) * P_KT + p0 * 2) = f2bf(s);
                *(bf16_t*)(cb + O_NT + tl * P_KT + p0 * 2) = f2bf(-*(const float*)(cb + O_X + tl * 144 + jl * 4));
                *(bf16_t*)(cb + O_NT + (16 + tl) * P_KT + p1 * 2) = f2bf(-*(const float*)(cb + O_X + (16 + tl) * 144 + (16 + jl) * 4));
                *(bf16_t*)(cb + O_NT + tl * P_KT + p1 * 2) = (bf16_t)0;
            }
            RS_SYNC();
            }
            if (wv < 4) REPEAT(REP_SD) {
                const int lnd = lane_fresh(), l15 = lnd & 15, g = lnd >> 4;
                f32x4 St[4] = {S4[0], S4[1], S4[2], S4[3]};
#pragma unroll 1
                for (int q = 0; q < 2; ++q) {
                    const unsigned char* cb = lds + q * CHUNK_BYTES;
                    bf16x8 fKH[2][2], fRH[2][2], fB2[2], fNT[2], fAP[2], fBP[2], fBG[4], fKDG[4]; f32x4 fG[4];
                    const bf16x8 vm = *(const bf16x8*)(cb + O_VM + (16 * wv + l15) * P_KT + 16 * g);
#pragma unroll
                    for (int ct = 0; ct < 2; ++ct) {
#pragma unroll
                        for (int s = 0; s < 2; ++s) fKH[ct][s] = *(const bf16x8*)(cb + O_KH + (16 * ct + l15) * P_TK + (32 * s + 8 * g) * 2);
                        fB2[ct] = *(const bf16x8*)(cb + O_B2 + (16 * ct + l15) * P_KT + 16 * g);
                        fNT[ct] = *(const bf16x8*)(cb + O_NT + (16 * ct + l15) * P_KT + 16 * g);
                    }
                    asm volatile("s_waitcnt lgkmcnt(0)" ::: "memory");
                    __builtin_amdgcn_sched_barrier(0);
                    bf16x8 sb[2]; sb[0] = cvt8(St[0], St[1]); sb[1] = cvt8(St[2], St[3]);
                    f32x4 w2[2];
#pragma unroll
                    for (int ct = 0; ct < 2; ++ct) {
                        f32x4 acc = (f32x4){0.f, 0.f, 0.f, 0.f};
                        acc = __builtin_amdgcn_mfma_f32_16x16x32_bf16(fKH[ct][0], sb[0], acc, 0, 0, 0);
                        acc = __builtin_amdgcn_mfma_f32_16x16x32_bf16(fKH[ct][1], sb[1], acc, 0, 0, 0);
                        acc = __builtin_amdgcn_mfma_f32_16x16x32_bf16(fB2[ct], vm, acc, 0, 0, 0);
                        w2[ct] = acc;
                    }
                    __builtin_amdgcn_sched_barrier(0);
#pragma unroll
                    for (int kt = 0; kt < 4; ++kt) {
                        fG[kt] = *(const f32x4*)(cb + O_GAM + (16 * kt + 4 * g) * 4);
                        fBG[kt] = *(const bf16x8*)(cb + O_BG + (16 * kt + l15) * P_KT + 16 * g);
                        fKDG[kt] = *(const bf16x8*)(cb + O_KDG + (16 * kt + l15) * P_KT + 16 * g);
                    }
                    __builtin_amdgcn_sched_barrier(0);
                    diag_flag(p, nonfin4(w2[0]) || nonfin4(w2[1]), 32u);
                    const bf16x8 wb = cvt8(w2[0], w2[1]);
                    f32x4 u2[2];
#pragma unroll
                    for (int ct = 0; ct < 2; ++ct) u2[ct] = __builtin_amdgcn_mfma_f32_16x16x32_bf16(fNT[ct], wb, (f32x4){0.f, 0.f, 0.f, 0.f}, 0, 0, 0);
                    diag_flag(p, nonfin4(u2[0]) || nonfin4(u2[1]), 64u);
                    const bf16x8 ub = cvt8(u2[0], u2[1]);
                    __builtin_amdgcn_sched_barrier(0);
#pragma unroll
                    for (int ct = 0; ct < 2; ++ct) {
#pragma unroll
                        for (int s = 0; s < 2; ++s) fRH[ct][s] = *(const bf16x8*)(cb + O_RH + (16 * ct + l15) * P_TK + (32 * s + 8 * g) * 2);
                        fBP[ct] = *(const bf16x8*)(cb + O_BP + (16 * ct + l15) * P_KT + 16 * g);
                        fAP[ct] = *(const bf16x8*)(cb + O_AP + (16 * ct + l15) * P_KT + 16 * g);
                    }
                    asm volatile("s_waitcnt lgkmcnt(8)" ::: "memory");
                    __builtin_amdgcn_sched_barrier(0);
#pragma unroll
                    for (int kt = 0; kt < 4; ++kt) {
                        f32x4 acc = St[kt] * fG[kt];
                        acc = __builtin_amdgcn_mfma_f32_16x16x32_bf16(fBG[kt], ub, acc, 0, 0, 0);
                        acc = __builtin_amdgcn_mfma_f32_16x16x32_bf16(fKDG[kt], vm, acc, 0, 0, 0);
                        St[kt] = acc; diag_flag(p, nonfin4(acc), 256u);
                    }
                    asm volatile("s_waitcnt lgkmcnt(0)" ::: "memory");
                    __builtin_amdgcn_sched_barrier(0);
#pragma unroll
                    for (int tt = 0; tt < 2; ++tt) {
                        f32x4 acc = (f32x4){0.f, 0.f, 0.f, 0.f};
                        acc = __builtin_amdgcn_mfma_f32_16x16x32_bf16(fRH[tt][0], sb[0], acc, 0, 0, 0);
                        acc = __builtin_amdgcn_mfma_f32_16x16x32_bf16(fRH[tt][1], sb[1], acc, 0, 0, 0);
                        acc = __builtin_amdgcn_mfma_f32_16x16x32_bf16(fAP[tt], ub, acc, 0, 0, 0);
                        acc = __builtin_amdgcn_mfma_f32_16x16x32_bf16(fBP[tt], vm, acc, 0, 0, 0);
                        diag_flag(p, nonfin4(acc), 128u);
                        float* yb = (float*)(lds + O_YB) + (q * 32 + 16 * tt + 4 * g) * YB_PITCH + 16 * wv + l15;
#pragma unroll
                        for (int r = 0; r < 4; ++r) yb[r * YB_PITCH] = acc[r];
                    }
                }
                if (LASTREP(REP_SD)) { S4[0] = St[0]; S4[1] = St[1]; S4[2] = St[2]; S4[3] = St[3]; }
            }
            else if (filler) {
                RS_FILL_STORE();
                RS_FILL_LOAD(((int)blockIdx.x * 4 + (wv - 4)) * 64 + sc * 2 + 1);
            }
            RS_SYNC();
            const int tido = wv * 64 + lane_fresh();
#pragma unroll
            for (int jj = 0; jj < 4; ++jj) {
                const int idx = tido + jj * NTHR, i = idx >> 5, v2 = idx & 31;
                const int step = sc * 64 + i, t = z ? (S - 1 - step) : step;
                const float2 yv = *(const float2*)((const float*)(lds + O_YB) + i * YB_PITCH + 2 * v2);
                if (var != 3) *(unsigned*)(YS + (size_t)z * T * D + ((size_t)b * S + t) * D + h * HD + 2 * v2) = pg8::cvt_pk_bf16(yv.x, yv.y);
            }
        }
        if (filler) RS_FILL_STORE();
        RS_SYNC();
    }
    __syncthreads();
}
#undef RS_SYNC
struct SchedBase { int G, c; };
struct SchedProj : SchedBase {
    const char* XM; const char* Wrkv; const char* L1t;
    __device__ __forceinline__ bool next(int i, pg8::Unit& u) const {
        const int L = i * G + c; if (L >= 960) return false;
        if (L < 768) {
            if (G == 256) { const int x = c & 7, j = c >> 3; u.job = i; u.pm = 8 * x + (j & 7); u.pn = j >> 3; }
            else { u.job = L >> 8; const int r = L & 255; u.pm = r >> 2; u.pn = r & 3; }
            u.B = Wrkv + ((size_t)u.job * 1024 + u.pn * 256) * 1024 * 2; }
        else { const int r = L - 768; u.job = 3 + r / 64; u.pm = r % 64; u.pn = 0; u.B = L1t + (size_t)(u.job - 3) * 256 * 1024 * 2; }
        u.A = XM + ((size_t)u.job * T + (size_t)u.pm * 256) * D * 2;
        return true;
    }
};
struct SchedLora2 : SchedBase {
    const char* L1b; const char* L2t;
    __device__ __forceinline__ bool next(int i, pg8::Unit& u) const {
        const int L = i * G + c; if (L >= 1280) return false;
        if (G == 256) { const int x = c & 7, j = c >> 3; u.job = i; u.pm = 8 * x + (j & 7); u.pn = j >> 3; }
        else { u.job = L >> 8; const int r = L & 255; u.pm = r >> 2; u.pn = r & 3; }
        u.A = L1b + ((size_t)u.pm * 256 * 512 + (u.job == 4 ? 256 : 0)) * 2;
        u.B = L2t + ((size_t)u.job * 1024 + u.pn * 256) * 256 * 2;
        return true;
    }
};
struct SchedPlain : SchedBase {
    const char* A; const char* B; int nN, lda, ldb;
    __device__ __forceinline__ bool next(int i, pg8::Unit& u) const {
        const int L = i * G + c; if (L >= 64 * nN) return false;
        u.job = 0;
        if (G == 256) { const int x = c & 7, j = c >> 3; u.pm = 8 * x + (j & 7); u.pn = 4 * i + (j >> 3); }
        else { u.pm = L / nN; u.pn = L % nN; }
        u.A = A + (size_t)u.pm * 256 * lda * 2; u.B = B + (size_t)u.pn * 256 * ldb * 2;
        return true;
    }
};
struct SchedLruGate : SchedBase {
    const char* UCB; const char* Wg;
    __device__ __forceinline__ bool next(int i, pg8::Unit& u) const {
        const int L = i * G + c; if (L >= 1024) return false;
        u.job = L >> 6; u.pm = L & 63; u.pn = 0;
        u.A = UCB + ((size_t)u.pm * 256 * D + ((u.job >> 1) & 3) * 256) * 2; u.B = Wg + (size_t)u.job * 256 * 256 * 2;
        return true;
    }
};
struct SchedMoe1 : SchedBase {
    const char* XIN; const char* Wgu;
    __device__ __forceinline__ bool next(int i, pg8::Unit& u) const {
        const int L = i * G + c; if (L >= 2048) return false;
        if (G == 256) { const int x = c & 7, j = c >> 3, xq = x & 3; u.job = 2 * i + (x >> 2); u.pm = (xq & 1) * 4 + (j & 3); u.pn = (xq >> 1) * 8 + (j >> 2); }
        else { u.job = L >> 7; const int r = L & 127; u.pm = r & 7; u.pn = r >> 3; }
        u.A = XIN + ((size_t)u.job * 2048 + u.pm * 256) * D * 2; u.B = Wgu + ((size_t)u.job * 4096 + u.pn * 256) * D * 2;
        return true;
    }
};
struct SchedMoe2 : SchedBase {
    const char* HID; const char* Wdn;
    __device__ __forceinline__ bool next(int i, pg8::Unit& u) const {
        const int L = i * G + c; if (L >= 512) return false;
        if (G == 256) { const int x = c & 7, j = c >> 3; u.job = 8 * i + x; u.pm = j & 7; u.pn = j >> 3; }
        else { u.job = L >> 5; const int r = L & 31; u.pm = r & 7; u.pn = r >> 3; }
        u.A = HID + ((size_t)u.job * 2048 + u.pm * 256) * FF * 2; u.B = Wdn + ((size_t)u.job * 1024 + u.pn * 256) * FF * 2;
        return true;
    }
};

#define EPI_ARGS const pg8::f32x4 (&acc)[2][2][4][2], const pg8::Unit& u, int wr, int wc, int fr, int fq
#define EPI_ROWS for (int ai = 0; ai < 2; ++ai) _Pragma("unroll") for (int m = 0; m < 4; ++m)
#define EPI_COLS for (int bj = 0; bj < 2; ++bj) _Pragma("unroll") for (int n = 0; n < 2; ++n)
struct EpiProj {
    static constexpr bool PERM = true;
    bf16_t* RKVb; bf16_t* L1b;
    __device__ __forceinline__ void operator()(EPI_ARGS) const {
        const int row0 = u.pm * 256 + wr * 64 + fr;
        if (u.job < 3) {
            bf16_t* C = RKVb + (size_t)u.job * T * D; const int col0 = u.pn * 256 + wc * 32 + 8 * fq;
#pragma unroll
            EPI_ROWS { bf16_t* rowp = C + (size_t)(row0 + ai * 128 + m * 16) * D + col0;
#pragma unroll
                for (int bj = 0; bj < 2; ++bj) { const pg8::f32x4 v0 = acc[ai][bj][m][0], v1 = acc[ai][bj][m][1]; pg8::u32x4 w;
                    w.x = pg8::cvt_pk_bf16(v0[0], v0[1]); w.y = pg8::cvt_pk_bf16(v0[2], v0[3]); w.z = pg8::cvt_pk_bf16(v1[0], v1[1]); w.w = pg8::cvt_pk_bf16(v1[2], v1[3]);
                    *(pg8::u32x4*)(rowp + bj * 128) = w; } }
        } else {
            const int col0 = (u.job - 3) * 128 + wc * 32 + 8 * fq; const int act = u.job;
#pragma unroll
            EPI_ROWS { bf16_t* rowp = L1b + (size_t)(row0 + ai * 128 + m * 16) * 512 + col0;
                pg8::f32x4 v0 = acc[ai][0][m][0], v1 = acc[ai][0][m][1];
                if (act == 3) {
#pragma unroll
                    for (int j = 0; j < 4; ++j) { v0[j] = tanhf_(v0[j]); v1[j] = tanhf_(v1[j]); } }
                else if (act == 5) {
#pragma unroll
                    for (int j = 0; j < 4; ++j) { v0[j] = sigmoidf_(v0[j]); v1[j] = sigmoidf_(v1[j]); } }
                pg8::u32x4 w; w.x = pg8::cvt_pk_bf16(v0[0], v0[1]); w.y = pg8::cvt_pk_bf16(v0[2], v0[3]); w.z = pg8::cvt_pk_bf16(v1[0], v1[1]); w.w = pg8::cvt_pk_bf16(v1[2], v1[3]);
                *(pg8::u32x4*)rowp = w;
                if (act == 5) { pg8::u32x4 zz; zz.x = 0u; zz.y = 0u; zz.z = 0u; zz.w = 0u; *(pg8::u32x4*)(rowp + 128) = zz; }
            }
        }
    }
};
struct EpiLora2 {
    static constexpr bool PERM = true;
    bf16_t* WDL; bf16_t* AAb; bf16_t* GGb; const float* w0; const float* a0;
    __device__ __forceinline__ void operator()(EPI_ARGS) const {
        const int row0 = u.pm * 256 + wr * 64 + fr, col0 = u.pn * 256 + wc * 32 + 8 * fq, job = u.job;
        bf16_t* C = job < 2 ? WDL + (size_t)job * T * D : (job < 4 ? AAb + (size_t)(job - 2) * T * D : GGb);
        const float* bias = job < 2 ? w0 + job * D : a0 + (job < 4 ? job - 2 : 0) * D;
        const float sc = job < 2 ? -0.6065306597126334f : 1.0f;
#pragma unroll
        for (int bj = 0; bj < 2; ++bj) {
            const pg8::f32x4 b0 = *(const pg8::f32x4*)(bias + col0 + bj * 128), b1 = *(const pg8::f32x4*)(bias + col0 + bj * 128 + 4);
#pragma unroll
            EPI_ROWS { pg8::f32x4 v0 = acc[ai][bj][m][0], v1 = acc[ai][bj][m][1];
                if (job < 4) { v0 = v0 + b0; v1 = v1 + b1;
#pragma unroll
                    for (int j = 0; j < 4; ++j) { v0[j] = sc * sigmoidf_(v0[j]); v1[j] = sc * sigmoidf_(v1[j]); } }
                pg8::u32x4 w; w.x = pg8::cvt_pk_bf16(v0[0], v0[1]); w.y = pg8::cvt_pk_bf16(v0[2], v0[3]); w.z = pg8::cvt_pk_bf16(v1[0], v1[1]); w.w = pg8::cvt_pk_bf16(v1[2], v1[3]);
                *(pg8::u32x4*)(C + (size_t)(row0 + ai * 128 + m * 16) * D + col0 + bj * 128) = w; }
        }
    }
};
struct EpiStoreF32 {
    static constexpr bool PERM = false;
    float* C; int ldc;
    __device__ __forceinline__ void operator()(EPI_ARGS) const {
        const int row0 = u.pm * 256 + wr * 64 + fr, col0 = u.pn * 256 + wc * 32 + 4 * fq;
#pragma unroll
        EPI_ROWS { float* rowp = C + (size_t)(row0 + ai * 128 + m * 16) * ldc + col0;
#pragma unroll
            EPI_COLS *(pg8::f32x4*)(rowp + bj * 128 + n * 16) = acc[ai][bj][m][n]; }
    }
};
struct EpiAddX {
    static constexpr bool PERM = false;
    float* X;
    __device__ __forceinline__ void operator()(EPI_ARGS) const {
        const int row0 = u.pm * 256 + wr * 64 + fr, col0 = u.pn * 256 + wc * 32 + 4 * fq;
#pragma unroll
        EPI_ROWS { float* rowp = X + (size_t)(row0 + ai * 128 + m * 16) * D + col0;
#pragma unroll
            EPI_COLS { pg8::f32x4* q = (pg8::f32x4*)(rowp + bj * 128 + n * 16); *q = *q + acc[ai][bj][m][n]; } }
    }
};
struct EpiLruGate {
    static constexpr bool PERM = true;
    bf16_t* LA; bf16_t* LB; const bf16_t* UCB; const float* ba; const float* bx; const float* lam;
    __device__ __forceinline__ void operator()(EPI_ARGS) const {
        const int z = u.job >> 3, h = (u.job >> 1) & 3, half = u.job & 1;
        const int row0 = u.pm * 256 + wr * 64 + fr, c0 = h * 256 + half * 128 + wc * 32 + 8 * fq;
        bf16_t* la = LA + (size_t)z * T * D; bf16_t* lb = LB + (size_t)z * T * D;
#pragma unroll
        for (int n = 0; n < 2; ++n) {
            const int c4 = c0 + 4 * n;
            const pg8::f32x4 lm = *(const pg8::f32x4*)(lam + z * D + c4), ba4 = *(const pg8::f32x4*)(ba + z * D + c4), bx4 = *(const pg8::f32x4*)(bx + z * D + c4);
            pg8::f32x4 sp4;
#pragma unroll
            for (int j = 0; j < 4; ++j) sp4[j] = -8.0f * softplusf_(-lm[j]);
#pragma unroll
            EPI_ROWS { const size_t o = (size_t)(row0 + ai * 128 + m * 16) * D + c4;
                const uint2 uu = *(const uint2*)(UCB + o); float uv[4]; bf4_to_f(uu, uv);
                float lo[4], bo[4];
#pragma unroll
                for (int j = 0; j < 4; ++j) { const float ra = acc[ai][0][m][n][j] + ba4[j], ix = acc[ai][1][m][n][j] + bx4[j];
                    const float l = sp4[j] * sigmoidf_(ra); lo[j] = l; const float x2 = 2.0f * l;   const float om = -x2 * (1.0f + x2 * (0.5f + x2 * (0.16666667f + x2 * (0.041666668f + x2 * 0.008333334f)))); bo[j] = __builtin_amdgcn_sqrtf(fmaxf(om, 0.f)) * sigmoidf_(ix) * uv[j]; }
                pg8::u32x2 w; w.x = pg8::cvt_pk_bf16(lo[0], lo[1]); w.y = pg8::cvt_pk_bf16(lo[2], lo[3]); *(pg8::u32x2*)(la + o) = w;
                w.x = pg8::cvt_pk_bf16(bo[0], bo[1]); w.y = pg8::cvt_pk_bf16(bo[2], bo[3]); *(pg8::u32x2*)(lb + o) = w; }
        }
    }
};
struct EpiSwiglu {
    static constexpr bool PERM = true;
    bf16_t* HID;
    __device__ __forceinline__ void operator()(EPI_ARGS) const {
        bf16_t* base = HID + (size_t)u.job * 2048 * FF; const int row0 = u.pm * 256 + wr * 64 + fr, col0 = u.pn * 128 + wc * 32 + 8 * fq;
#pragma unroll
        EPI_ROWS { float o[8];
#pragma unroll
            for (int n = 0; n < 2; ++n)
#pragma unroll
                for (int j = 0; j < 4; ++j) { const float gt = acc[ai][0][m][n][j], up = acc[ai][1][m][n][j]; o[n * 4 + j] = gt * sigmoidf_(gt) * up; }
            pg8::u32x4 w; w.x = pg8::cvt_pk_bf16(o[0], o[1]); w.y = pg8::cvt_pk_bf16(o[2], o[3]); w.z = pg8::cvt_pk_bf16(o[4], o[5]); w.w = pg8::cvt_pk_bf16(o[6], o[7]);
            *(pg8::u32x4*)(base + (size_t)(row0 + ai * 128 + m * 16) * FF + col0) = w; }
    }
};
struct EpiDown {
    static constexpr bool PERM = true;
    bf16_t* YEXP; const float* GATE;
    __device__ __forceinline__ void operator()(EPI_ARGS) const {
        const int row0 = u.pm * 256 + wr * 64 + fr, col0 = u.pn * 256 + wc * 32 + 8 * fq;
        bf16_t* C = YEXP + (size_t)u.job * 2048 * D; const float* gt = GATE + (size_t)u.job * 2048;
#pragma unroll
        EPI_ROWS { const int row = row0 + ai * 128 + m * 16; const float gs = gt[row];
#pragma unroll
            for (int bj = 0; bj < 2; ++bj) { const pg8::f32x4 v0 = acc[ai][bj][m][0] * gs, v1 = acc[ai][bj][m][1] * gs; pg8::u32x4 w;
                w.x = pg8::cvt_pk_bf16(v0[0], v0[1]); w.y = pg8::cvt_pk_bf16(v0[2], v0[3]); w.z = pg8::cvt_pk_bf16(v1[0], v1[1]); w.w = pg8::cvt_pk_bf16(v1[2], v1[3]);
                *(pg8::u32x4*)(C + (size_t)row * D + col0 + bj * 128) = w; } }
    }
};
struct EpiStoreBf16 {
    static constexpr bool PERM = true;
    bf16_t* O; int ldc;
    __device__ __forceinline__ void operator()(EPI_ARGS) const {
        const int row0 = u.pm * 256 + wr * 64 + fr, col0 = u.pn * 256 + wc * 32 + 8 * fq;
#pragma unroll
        EPI_ROWS { bf16_t* rowp = O + (size_t)(row0 + ai * 128 + m * 16) * ldc + col0;
#pragma unroll
            for (int bj = 0; bj < 2; ++bj) { const pg8::f32x4 v0 = acc[ai][bj][m][0], v1 = acc[ai][bj][m][1]; pg8::u32x4 w;
                w.x = pg8::cvt_pk_bf16(v0[0], v0[1]); w.y = pg8::cvt_pk_bf16(v0[2], v0[3]); w.z = pg8::cvt_pk_bf16(v1[0], v1[1]); w.w = pg8::cvt_pk_bf16(v1[2], v1[3]);
                *(pg8::u32x4*)(rowp + bj * 128) = w; } }
    }
};

struct RmId { __device__ __forceinline__ int operator()(int n) const { return n; } };
struct RmGU { int off; __device__ __forceinline__ int operator()(int n) const { return ((n >> 7) << 8) + off + (n & 127); } };
template <class RM>
__device__ __forceinline__ void tconv(const int wv, const float* W, int ldw, int K, int N, bf16_t* dst, int ldb, int koff, const RM rm, float* lds, int& rot) {
    const int tid = TID, G = gridDim.x, tn = N >> 7, ntiles = (K >> 6) * tn;
    const int lr = tid >> 5, lc = (tid & 31) * 4;
    const int sn = tid >> 3, sk = (tid & 7) * 8;
    int t = (int)(((unsigned)blockIdx.x + (unsigned)G - (unsigned)(rot % G)) % (unsigned)G);
    float4 cur[4], nx[4];
    if (t < ntiles) { const int k0 = (t / tn) << 6, n0 = (t % tn) << 7;
#pragma unroll
        for (int i = 0; i < 4; ++i) { const pg8::f32x4 t4 = __builtin_nontemporal_load((const pg8::f32x4*)(W + (size_t)(k0 + lr + 16 * i) * ldw + n0 + lc)); cur[i] = make_float4(t4[0], t4[1], t4[2], t4[3]); } }
    for (; t < ntiles; t += G) {
        const int k0 = (t / tn) << 6, n0 = (t % tn) << 7; const int t2 = t + G;
        if (t2 < ntiles) { const int k2 = (t2 / tn) << 6, n2 = (t2 % tn) << 7;
#pragma unroll
            for (int i = 0; i < 4; ++i) { const pg8::f32x4 t4 = __builtin_nontemporal_load((const pg8::f32x4*)(W + (size_t)(k2 + lr + 16 * i) * ldw + n2 + lc)); nx[i] = make_float4(t4[0], t4[1], t4[2], t4[3]); } }
        __syncthreads();
#pragma unroll
        for (int i = 0; i < 4; ++i) { float* q = lds + (lr + 16 * i) * 129 + lc; q[0] = cur[i].x; q[1] = cur[i].y; q[2] = cur[i].z; q[3] = cur[i].w; }
        __syncthreads();
#pragma unroll
        for (int i = 0; i < 2; ++i) { const int n = sn + 64 * i; float f[8];
#pragma unroll
            for (int j = 0; j < 8; ++j) f[j] = lds[(sk + j) * 129 + n];
            pg8::u32x4 w; w.x = pg8::cvt_pk_bf16(f[0], f[1]); w.y = pg8::cvt_pk_bf16(f[2], f[3]); w.z = pg8::cvt_pk_bf16(f[4], f[5]); w.w = pg8::cvt_pk_bf16(f[6], f[7]);
            *(pg8::u32x4*)(dst + (size_t)rm(n0 + n) * ldb + koff + k0 + sk) = w; }
#pragma unroll
        for (int i = 0; i < 4; ++i) cur[i] = nx[i];
    }
    rot += ntiles;
}
__device__ __forceinline__ void tconv_small(const int wv, const float* W, int K, int N, bf16_t* dst, int ldb, int noff) {
    for (int i = blockIdx.x * NTHR + TID; i < K * N; i += gridDim.x * NTHR) { const int k = i / N, n = i - k * N; dst[(size_t)(n + noff) * ldb + k] = f2bf(W[i]); }
}
__device__ __forceinline__ void zfill(const int wv, bf16_t* dst, int ldb, int r0, int r1, int c0, int c1) {
    const int w8 = (c1 - c0) >> 3, tot = (r1 - r0) * w8;
    for (int i = blockIdx.x * NTHR + TID; i < tot; i += gridDim.x * NTHR) { const int r = r0 + i / w8, c = c0 + (i % w8) * 8; *(uint4*)(dst + (size_t)r * ldb + c) = make_uint4(0u, 0u, 0u, 0u); }
}
__device__ __forceinline__ void ph_prologue(const int wv, const P& p, float* lds) {
    int rot = 0;
    unsigned char* ws = p.ws;
    for (int L = 0; L < DEPTH; ++L) {
        if (gridDim.x == 256 && (L % 3) == 0) continue;
        for (int e = 0; e < NE; ++e) {
            bf16_t* gu = (bf16_t*)(ws + WB_MOE + (size_t)L * MOE_STRIDE + MOE_GU) + (size_t)e * 4096 * D;
            bf16_t* dn = (bf16_t*)(ws + WB_MOE + (size_t)L * MOE_STRIDE + MOE_DN) + (size_t)e * D * FF;
            RmGU rg; rg.off = 0; RmGU ru; ru.off = 128;
            tconv(wv, p.in[I_WG] + ((size_t)L * NE + e) * D * FF, FF, D, FF, gu, D, 0, rg, lds, rot);
            tconv(wv, p.in[I_WU] + ((size_t)L * NE + e) * D * FF, FF, D, FF, gu, D, 0, ru, lds, rot);
            tconv(wv, p.in[I_WDN] + ((size_t)L * NE + e) * FF * D, D, FF, D, dn, FF, 0, RmId(), lds, rot);
        }
    }
    for (int ia = 0; ia < 2; ++ia) {
        unsigned char* rb = ws + WB_RW + (size_t)ia * RW_STRIDE;
        for (int q = 0; q < 3; ++q) tconv(wv, p.in[I_WIN] + ((size_t)ia * 3 + q) * D * D, D, D, D, (bf16_t*)(rb + RW_RKV) + (size_t)q * D * D, D, 0, RmId(), lds, rot);
        tconv(wv, p.in[I_WOUT] + (size_t)ia * D * D, D, D, D, (bf16_t*)(rb + RW_OUT), D, 0, RmId(), lds, rot);
        bf16_t* l1 = (bf16_t*)(rb + RW_L1);
        for (int z = 0; z < 2; ++z) { tconv_small(wv, p.in[I_W1] + ((size_t)ia * 2 + z) * D * 64, D, 64, l1, D, z * 64); tconv_small(wv, p.in[I_A1] + ((size_t)ia * 2 + z) * D * 64, D, 64, l1 + 256 * D, D, z * 64); }
        tconv(wv, p.in[I_G1] + (size_t)ia * D * 128, 128, D, 128, l1 + 2 * 256 * D, D, 0, RmId(), lds, rot);
        for (int q = 0; q < 3; ++q) zfill(wv, l1 + (size_t)q * 256 * D, D, 128, 256, 0, D);
        bf16_t* l2 = (bf16_t*)(rb + RW_L2);
        for (int z = 0; z < 2; ++z) {
            tconv(wv, p.in[I_W2] + ((size_t)ia * 2 + z) * 64 * D, D, 64, D, l2 + (size_t)z * 1024 * 256, 256, z * 64, RmId(), lds, rot);
            tconv(wv, p.in[I_A2] + ((size_t)ia * 2 + z) * 64 * D, D, 64, D, l2 + (size_t)(2 + z) * 1024 * 256, 256, 128 + z * 64, RmId(), lds, rot);
        }
        tconv(wv, p.in[I_G2] + (size_t)ia * 128 * D, D, 128, D, l2 + (size_t)4 * 1024 * 256, 256, 0, RmId(), lds, rot);
        for (int j = 0; j < 4; ++j) { const int k0 = j * 64; if (k0 > 0) zfill(wv, l2 + (size_t)j * 1024 * 256, 256, 0, 1024, 0, k0); if (k0 + 64 < 256) zfill(wv, l2 + (size_t)j * 1024 * 256, 256, 0, 1024, k0 + 64, 256); }
        zfill(wv, l2 + (size_t)4 * 1024 * 256, 256, 0, 1024, 128, 256);
    }
    tconv(wv, p.in[I_SCIN], 3 * D, D, 3 * D, (bf16_t*)(ws + WB_SC + SC_IN), D, 0, RmId(), lds, rot);
    tconv(wv, p.in[I_SCOUT], D, D, D, (bf16_t*)(ws + WB_SC + SC_OUT), D, 0, RmId(), lds, rot);
    tconv(wv, p.in[I_LIN], 2 * D, D, 2 * D, (bf16_t*)(ws + WB_LRU + LRU_IN), D, 0, RmId(), lds, rot);
    tconv(wv, p.in[I_LOUT], D, D, D, (bf16_t*)(ws + WB_LRU + LRU_OUT), D, 0, RmId(), lds, rot);
    for (int zh = 0; zh < 8; ++zh) {
        bf16_t* gt = (bf16_t*)(ws + WB_LRU + LRU_G) + (size_t)zh * 2 * 256 * 256;
        RmGU ra; ra.off = 0; RmGU rx; rx.off = 128;
        tconv(wv, p.in[I_LWA] + (size_t)zh * 256 * 256, 256, 256, 256, gt, 256, 0, ra, lds, rot);
        tconv(wv, p.in[I_LWX] + (size_t)zh * 256 * 256, 256, 256, 256, gt, 256, 0, rx, lds, rot);
    }
}


#define XB_TMO      128
#define XB_XCNT(j)  (256  + 64 * (j))
#define XB_XSUB(j)  (1280 + 64 * (j))
#define XB_XGEN(j)  (2304 + 64 * (j))
#define XB_TOP      3328
#define XB_TOPGEN   3392
#define XCD_BAR_WORDS 3456
#define XB_SPIN_CAP (1u << 22)
#define LAS __attribute__((address_space(3)))
__device__ __forceinline__ unsigned xb_ld(unsigned* p)              { return __hip_atomic_load(p, __ATOMIC_RELAXED, __HIP_MEMORY_SCOPE_AGENT); }
__device__ __forceinline__ unsigned xb_add(unsigned* p, unsigned v) { return __hip_atomic_fetch_add(p, v, __ATOMIC_RELAXED, __HIP_MEMORY_SCOPE_AGENT); }
__device__ __forceinline__ unsigned xb_xcc_id() { return (unsigned)__builtin_amdgcn_s_getreg((3 << 11) | 20) & 0xFu; }
#define XB_SPIN(cond, bar) do { unsigned _sp = 0; while (cond) { __builtin_amdgcn_s_sleep(1); \
    if ((++_sp & 255u) == 0u) { if (xb_ld(&(bar)[XB_TMO])) break; if (_sp > XB_SPIN_CAP) { atomicAdd(&(bar)[XB_TMO], 1u); break; } } } } while (0)
struct XcdBarrier { unsigned* bar; unsigned x; volatile LAS unsigned* st; };
__device__ __forceinline__ XcdBarrier xcd_barrier_post(const int wv, unsigned* bar, volatile LAS unsigned* st) {
    XcdBarrier b; b.bar = bar; b.x = xb_xcc_id(); b.st = st;
    if (TID == 0) (void)xb_add(&bar[XB_XCNT(b.x)], 1u);
    return b;
}
__device__ __forceinline__ void xcd_barrier_complete(unsigned* bar, unsigned x, unsigned& nloc, unsigned& nx) {
    const unsigned G = gridDim.x * gridDim.y * gridDim.z;
    unsigned sum, cnt, mine, sp = 0u;
    for (;;) {
        sum = 0u; cnt = 0u; mine = 0u;
#pragma unroll
        for (unsigned j = 0; j < 16; ++j) { const unsigned c = xb_ld(&bar[XB_XCNT(j)]); sum += c; cnt += (c > 0u) ? 1u : 0u; mine = (j == x) ? c : mine; }
        if (sum == G) break;
        __builtin_amdgcn_s_sleep(1);
        if ((++sp & 255u) == 0u) { if (xb_ld(&bar[XB_TMO])) break; if (sp > XB_SPIN_CAP) { atomicAdd(&bar[XB_TMO], 1u); break; } }
    }
    nloc = mine > 0u ? mine : 1u; nx = cnt > 0u ? cnt : 1u;
}
__device__ __forceinline__ void xcd_barrier(const int wv, const XcdBarrier& b) {
    asm volatile("s_waitcnt vmcnt(0)" ::: "memory");
    __syncthreads();
    if (TID == 0) {
        unsigned* bar = b.bar;
        __builtin_amdgcn_s_waitcnt(0);
        unsigned nloc = b.st[0], nx = b.st[1];
        if (nloc == 0u) { xcd_barrier_complete(bar, b.x, nloc, nx); b.st[0] = nloc; b.st[1] = nx; }
        const unsigned old = xb_add(&bar[XB_XSUB(b.x)], 1u);
        const unsigned gen = old / nloc;
        if (old + 1u == (gen + 1u) * nloc) {
            __builtin_amdgcn_fence(__ATOMIC_RELEASE, "agent");
            asm volatile("s_waitcnt vmcnt(0)" ::: "memory");
            const unsigned og = xb_add(&bar[XB_TOP], 1u);
            const unsigned tg = og / nx;
            if (og + 1u == (tg + 1u) * nx) xb_add(&bar[XB_TOPGEN], 1u);
            else XB_SPIN(xb_ld(&bar[XB_TOPGEN]) == tg, bar);
            __builtin_amdgcn_fence(__ATOMIC_ACQUIRE, "agent");
            xb_add(&bar[XB_XGEN(b.x)], 1u);
            asm volatile("s_waitcnt vmcnt(0)" ::: "memory");
        } else {
            XB_SPIN(xb_ld(&bar[XB_XGEN(b.x)]) == gen, bar);
            __builtin_amdgcn_fence(__ATOMIC_ACQUIRE, "agent");
            asm volatile("s_waitcnt vmcnt(0)" ::: "memory");
        }
    }
    __syncthreads();
}
struct PhaseCtl { XcdBarrier bar; int lo, hi; bool did; };
__device__ __forceinline__ bool phase_enter(const int wv, PhaseCtl& c, int k) {
    if (k < c.lo || k >= c.hi) return false;
    if (c.did) REPEAT(REP_BAR) xcd_barrier(wv, c.bar);
    c.did = true;
    return true;
}

#define DIAG 0
constexpr int CTL_DIAG = 4096;
__device__ __forceinline__ void diag_compare(const int wv, const P& p, const float* A, const float* Bq, size_t n) {
    float e = 0.f, r = 0.f; int bad = 0;
    for (size_t i = (size_t)blockIdx.x * NTHR + TID; i < n; i += (size_t)gridDim.x * NTHR) { const float a = A[i], b = Bq[i]; const float d = a - b; e += d * d; r += a * a; if (!(d == d) || fabsf(d) > 3.0e38f) bad = 1; }
    e = wave_sum(e); r = wave_sum(r); bad = __any(bad);
    if (lane_fresh() == 0) { float* c = (float*)(p.ws + WS_CTL) + CTL_DIAG; atomicAdd(c, e); atomicAdd(c + 1, r); if (bad) atomicAdd((unsigned*)(c + 2), 1u); }
}
__device__ __forceinline__ void diag_delay(const int wv, const P& p) {
    if (blockIdx.x == 0 && TID == 0) {
        float* c = (float*)(p.ws + WS_CTL) + CTL_DIAG;
        const float e = __hip_atomic_load(c, __ATOMIC_RELAXED, __HIP_MEMORY_SCOPE_AGENT), r = __hip_atomic_load(c + 1, __ATOMIC_RELAXED, __HIP_MEMORY_SCOPE_AGENT);
        const unsigned bad = __hip_atomic_load((unsigned*)(c + 2), __ATOMIC_RELAXED, __HIP_MEMORY_SCOPE_AGENT);
        const unsigned mask = __hip_atomic_load((unsigned*)(c + 3), __ATOMIC_RELAXED, __HIP_MEMORY_SCOPE_AGENT);
        float ms;
        if (bad) ms = 12.f; else if (!(r > 0.f)) ms = 14.f; else { const float rel = sqrtf(e / r); float lg = log10f(fmaxf(rel, 1e-8f)) + 8.f; lg = fminf(fmaxf(lg, 0.f), 10.f); ms = 1.f + lg; }
        if (DIAGF) { ms = 1.f; if (mask) ms = 2.f + (float)__ffs(mask); if (bad) ms += 10.f; }
        const unsigned long long t0 = __builtin_amdgcn_s_memrealtime(); const unsigned long long ticks = (unsigned long long)(ms * 100000.f);
        while (__builtin_amdgcn_s_memrealtime() - t0 < ticks) __builtin_amdgcn_s_sleep(32);
    }
}
constexpr int LDS_BYTES = 128 * 1024 + 1024;
constexpr int PH_PER_LAYER = 16, PH_FINAL = 1 + DEPTH * PH_PER_LAYER, PH_TOTAL = PH_FINAL + 1;

#define IN(k) phase_enter(wv, pc, (k))
template <int L>
__device__ __forceinline__ void run_layer(const int wv, const P& p, float* lds, PhaseCtl& pc) {
    constexpr int m = L % 3, base = 1 + L * PH_PER_LAYER, ia = L / 3;
    PG8_LAS unsigned char* glds = (PG8_LAS unsigned char*)lds;
    unsigned char* ws = p.ws;
    float* X = (float*)(ws + (L == 3 ? WS_X2 : WS_X)); bf16_t* H = (bf16_t*)(ws + WS_H);
    float* RKV = (float*)(ws + WS_RKV);
    float* WDp = (float*)(ws + WS_WD); float* AAp = (float*)(ws + WS_AA); float* GG = (float*)(ws + WS_GG);
    SchedBase sb; sb.G = gridDim.x; sb.c = blockIdx.x;
    if constexpr (m == 0) {
        if (IN(base + 0)) REPEAT(REP_NORM_MIX) ph_norm_xm(wv, p, L == 0 ? p.in[I_X] : (const float*)(ws + WS_X), X, L > 0, p.in[I_NMG] + L * D, p.in[I_MU] + ia * 6 * D, (unsigned char*)lds);
    } else {
    if (IN(base + 0)) REPEAT(REP_NORM_MIX) ph_norm(wv, p, L == 0 ? p.in[I_X] : X, LASTREP(REP_NORM_MIX) ? X : (float*)(ws + WS_YS), L > 0, p.in[I_NMG] + L * D, LASTREP(REP_NORM_MIX) ? H : (bf16_t*)(ws + WS_YS + 64 * MiB), nullptr, nullptr, lds);
    }
    if constexpr (m == 0) {
        const unsigned char* rb = ws + WB_RW + (size_t)ia * RW_STRIDE;
        if (IN(base + 2)) {
            SchedProj S; S.G = sb.G; S.c = sb.c; S.XM = (const char*)(ws + WS_XM); S.Wrkv = (const char*)(rb + RW_RKV); S.L1t = (const char*)(rb + RW_L1);
            EpiProj E; E.RKVb = (bf16_t*)(ws + WS_RKV); E.L1b = (bf16_t*)(ws + WS_L1);
            pg8::Geo g; g.lda = D; g.ldb = D; g.K = D;
            REPEAT(REP_PROJ) pg8::gemm_phase(wv, glds, g, S, E);
        }
        if (IN(base + 3)) {
            SchedLora2 S; S.G = sb.G; S.c = sb.c; S.L1b = (const char*)(ws + WS_L1); S.L2t = (const char*)(rb + RW_L2);
            EpiLora2 E; E.WDL = (bf16_t*)(ws + WS_WD); E.AAb = (bf16_t*)(ws + WS_AA); E.GGb = (bf16_t*)(ws + WS_GG); E.w0 = p.in[I_W0] + (size_t)ia * 2 * D; E.a0 = p.in[I_A0] + (size_t)ia * 2 * D;
            pg8::Geo g; g.lda = 512; g.ldb = 256; g.K = 256;
            REPEAT(REP_LORA2) pg8::gemm_phase(wv, glds, g, S, E);
        }
        if (IN(base + 4)) {
            REPEAT(REP_SCAN) ph_scan2(wv, p, ia, (unsigned char*)lds, (bf16_t*)(ws + WS_YS), L, LASTREP(REP_SCAN) ? 0 : 100 + SVAR);
        }
        if (DIAG) { if (IN(base + 11)) diag_compare(wv, p, (const float*)(ws + WS_YS), (const float*)(ws + WS_XM), (size_t)2 * T * D); }
        if (IN(base + 5)) REPEAT(REP_RPOST) ph_rwkv_post(wv, p, ia);
        if (IN(base + 6)) {
            SchedPlain S; S.G = sb.G; S.c = sb.c; S.A = (const char*)(ws + WS_YG); S.B = (const char*)(rb + RW_OUT); S.nN = 4; S.lda = D; S.ldb = D;
            pg8::Geo g; g.lda = D; g.ldb = D; g.K = D;
            REPEAT(REP_OUT) { EpiAddX E; E.X = LASTREP(REP_OUT) ? X : (float*)(ws + WS_YS); pg8::gemm_phase(wv, glds, g, S, E); }
        }
    } else if constexpr (m == 1) {
        if (IN(base + 1)) {
            SchedPlain S; S.G = sb.G; S.c = sb.c; S.A = (const char*)H; S.B = (const char*)(ws + WB_SC + SC_IN); S.nN = 12; S.lda = D; S.ldb = D;
            EpiStoreBf16 E; E.O = (bf16_t*)(ws + WS_RKV); E.ldc = 3 * D; pg8::Geo g; g.lda = D; g.ldb = D; g.K = D;
            REPEAT(REP_SCIN) pg8::gemm_phase(wv, glds, g, S, E);
        }
        if (IN(base + 2)) REPEAT(REP_SCMID) ph_sc_mid(wv, p);
        if (IN(base + 3)) {
            SchedPlain S; S.G = sb.G; S.c = sb.c; S.A = (const char*)(ws + WS_YG); S.B = (const char*)(ws + WB_SC + SC_OUT); S.nN = 4; S.lda = D; S.ldb = D;
            pg8::Geo g; g.lda = D; g.ldb = D; g.K = D;
            REPEAT(REP_OUT) { EpiAddX E; E.X = LASTREP(REP_OUT) ? X : (float*)(ws + WS_YS); pg8::gemm_phase(wv, glds, g, S, E); }
        }
    } else {
        if (IN(base + 1)) {
            SchedPlain S; S.G = sb.G; S.c = sb.c; S.A = (const char*)H; S.B = (const char*)(ws + WB_LRU + LRU_IN); S.nN = 8; S.lda = D; S.ldb = D;
            EpiStoreBf16 E; E.O = (bf16_t*)(ws + WS_RKV); E.ldc = 2 * D; pg8::Geo g; g.lda = D; g.ldb = D; g.K = D;
            REPEAT(REP_LIN) pg8::gemm_phase(wv, glds, g, S, E);
        }
        if (IN(base + 2)) REPEAT(REP_LCONV) ph_lru_conv(wv, p);
        if (IN(base + 3)) {
            SchedLruGate S; S.G = sb.G; S.c = sb.c; S.UCB = (const char*)(ws + WS_UCB); S.Wg = (const char*)(ws + WB_LRU + LRU_G);
            EpiLruGate E; E.LA = (bf16_t*)(ws + WS_WD); E.LB = (bf16_t*)(ws + WS_AA); E.UCB = (const bf16_t*)(ws + WS_UCB); E.ba = p.in[I_LBA]; E.bx = p.in[I_LBX]; E.lam = p.in[I_LLAM];
            pg8::Geo g; g.lda = D; g.ldb = 256; g.K = 256;
            REPEAT(REP_LGATE) pg8::gemm_phase(wv, glds, g, S, E);
        }
        if (IN(base + 4)) REPEAT(REP_LSCAN) ph_lru_scan(wv, p, lds);
        if (IN(base + 5)) REPEAT(REP_LPOST) ph_lru_post(wv, p);
        if (IN(base + 6)) {
            SchedPlain S; S.G = sb.G; S.c = sb.c; S.A = (const char*)(ws + WS_YG); S.B = (const char*)(ws + WB_LRU + LRU_OUT); S.nN = 4; S.lda = D; S.ldb = D;
            pg8::Geo g; g.lda = D; g.ldb = D; g.K = D;
            REPEAT(REP_OUT) { EpiAddX E; E.X = LASTREP(REP_OUT) ? X : (float*)(ws + WS_YS); pg8::gemm_phase(wv, glds, g, S, E); }
        }
    }
    if (IN(base + 7)) REPEAT(REP_NORM_FFN) ph_norm(wv, p, X, nullptr, false, p.in[I_NFG] + L * D, H, p.in[I_RW] + (size_t)L * D * NE, nullptr, lds);
    if (IN(base + 8)) REPEAT(REP_TOPK) ph_topk(wv, p, lds);
    if (IN(base + 9)) {
        SchedMoe1 S; S.G = sb.G; S.c = sb.c; S.XIN = (const char*)(ws + WS_XIN); S.Wgu = (const char*)(ws + WB_MOE + (size_t)L * MOE_STRIDE + MOE_GU);
        EpiSwiglu E; E.HID = (bf16_t*)(ws + WS_HID); pg8::Geo g; g.lda = D; g.ldb = D; g.K = D;
        REPEAT(REP_MOE1) pg8::gemm_phase(wv, glds, g, S, E, !LASTREP(REP_MOE1) && GVAR == 1);
    }
    if (IN(base + 10)) {
        SchedMoe2 S; S.G = sb.G; S.c = sb.c; S.HID = (const char*)(ws + WS_HID); S.Wdn = (const char*)(ws + WB_MOE + (size_t)L * MOE_STRIDE + MOE_DN);
        EpiDown E; E.YEXP = (bf16_t*)(ws + WS_YEXP); E.GATE = (const float*)(ws + WS_GATE); pg8::Geo g; g.lda = FF; g.ldb = FF; g.K = FF;
        REPEAT(REP_MOE2) pg8::gemm_phase(wv, glds, g, S, E, !LASTREP(REP_MOE2) && GVAR == 1);
    }
}

__global__ void __launch_bounds__(NTHR, 2) mega(P p_unused) {
    extern __shared__ __attribute__((aligned(16))) unsigned char lds_raw[];
    const P& p = *(const P*)__builtin_amdgcn_kernarg_segment_ptr();
    float* lds = (float*)lds_raw;
    volatile LAS unsigned* xbw = (volatile LAS unsigned*)(lds_raw + LDS_BYTES - 16);
    const int wv = __builtin_amdgcn_readfirstlane((int)(threadIdx.x >> 6));
    if (threadIdx.x == 0) { xbw[0] = 0u; xbw[1] = 0u; xbw[2] = 0u; xbw[3] = 0u; }
    __syncthreads();
    PhaseCtl pc; pc.lo = p.ph_lo; pc.hi = p.ph_hi; pc.did = false;
    pc.bar = xcd_barrier_post(wv, (unsigned*)(p.ws + WS_CTL), xbw);
    if (IN(0)) REPEAT(REP_PROLOGUE) ph_prologue(wv, p, lds);
    run_layer<0>(wv, p, lds, pc);
    run_layer<1>(wv, p, lds, pc);
    run_layer<2>(wv, p, lds, pc);
    run_layer<3>(wv, p, lds, pc);
    if (IN(PH_FINAL)) ph_norm(wv, p, (const float*)(p.ws + WS_X2), nullptr, true, p.in[I_FNG], nullptr, nullptr, p.out, lds);
    if (DIAG) { xcd_barrier(wv, pc.bar); diag_delay(wv, p); }
}
#undef IN

}

extern "C" void kernel_launch(void* const* d_in, const int* in_sizes, int n_in, void* d_out, int out_size, void* d_ws, size_t ws_size, hipStream_t stream) {
    static int ready = 0, grid = 256;
    if (!ready) {
        if (n_in != 36 || out_size != T * D || ws_size < WS_END) { fprintf(stderr, "kernel_launch: unexpected problem (n_in %d out %d ws %zu need %zu)\n", n_in, out_size, ws_size, (size_t)WS_END); ready = -1; return; }
        if (hipFuncSetAttribute((const void*)mega, hipFuncAttributeMaxDynamicSharedMemorySize, LDS_BYTES) != hipSuccess) { fprintf(stderr, "kernel_launch: hipFuncSetAttribute failed\n"); ready = -1; return; }
        { int dev = 0, cus = 0; if (hipGetDevice(&dev) == hipSuccess && hipDeviceGetAttribute(&cus, hipDeviceAttributeMultiprocessorCount, dev) == hipSuccess && cus > 0) grid = cus < 256 ? cus : 256; }
        ready = 1;
    }
    if (ready < 0) return;
    (void)in_sizes;
    P p{};
    for (int i = 0; i < 36; ++i) p.in[i] = (const float*)d_in[i];
    p.out = (float*)d_out; p.ws = (unsigned char*)d_ws;
    if (hipMemsetAsync((char*)d_ws + WS_CTL, 0, 32768, stream) != hipSuccess) { fprintf(stderr, "kernel_launch: memset failed\n"); return; }
    p.ph_lo = 0; p.ph_hi = PH_TOTAL;
    hipLaunchKernelGGL(mega, dim3(grid), dim3(NTHR), LDS_BYTES, stream, p);
}
```

```cpp
#include <hip/hip_runtime.h>
#include <stdint.h>
#include <stdio.h>

namespace {
constexpr int D = 1024, NB = 8, S = 2048, T = NB * S, DEPTH = 4, NE = 16, FF = 2048, CAP = 256, NH = 16, HD = 64;
constexpr int NTHR = 512;
constexpr float RMS_EPS = 1e-6f, LNX_EPS = 64e-5f;
typedef unsigned short bf16_t;

constexpr size_t MiB = 1u << 20;
constexpr size_t WS_CTL = 0;
constexpr size_t WS_X = 1 * MiB;
constexpr size_t WS_H = WS_X + 64 * MiB;
constexpr size_t WS_XM = WS_H + 32 * MiB;
constexpr size_t WS_RKV = WS_XM + 192 * MiB;
constexpr size_t WS_L1 = WS_RKV + 192 * MiB;
constexpr size_t WS_WD = WS_L1 + 24 * MiB;
constexpr size_t WS_AA = WS_WD + 128 * MiB;
constexpr size_t WS_GG = WS_AA + 128 * MiB;
constexpr size_t WS_YS = WS_GG + 64 * MiB;
constexpr size_t WS_YG = WS_YS + 128 * MiB;
constexpr size_t WS_UCB = WS_YG + 32 * MiB;
constexpr size_t WS_YEXP = WS_UCB + 32 * MiB;
constexpr size_t WS_AFF = WS_YEXP + 128 * MiB;
constexpr size_t WS_SLOT = WS_AFF + 1 * MiB;
constexpr size_t WS_GATE = WS_SLOT + 1 * MiB;
constexpr size_t WS_ACT_END = WS_GATE + 1 * MiB;
constexpr size_t WB_RW = WS_ACT_END;
constexpr size_t RW_RKV = 0, RW_L1 = 6 * MiB, RW_L2 = RW_L1 + 3 * 256 * 1024 * 2, RW_OUT = RW_L2 + 5 * 1024 * 256 * 2, RW_STRIDE = 12 * MiB;
constexpr size_t WB_SC = WB_RW + 2 * RW_STRIDE;
constexpr size_t SC_IN = 0, SC_OUT = 6 * MiB;
constexpr size_t WB_LRU = WB_SC + 8 * MiB;
constexpr size_t LRU_IN = 0, LRU_G = 4 * MiB, LRU_OUT = 6 * MiB;
constexpr size_t WB_MOE = WB_LRU + 8 * MiB;
constexpr size_t MOE_GU = 0, MOE_DN = 128 * MiB, MOE_STRIDE = 192 * MiB;
constexpr size_t WS_X2 = WB_MOE + 4 * MOE_STRIDE;
constexpr size_t WS_END = WS_X2 + 64 * MiB;
constexpr size_t WS_XIN = WS_XM, WS_HID = WS_XM + 64 * MiB;
constexpr size_t WS_BON = WS_L1 + 16 * MiB;

constexpr int REP_PROLOGUE = 1, REP_NORM_MIX = 1, REP_XM = 1, REP_PROJ = 1, REP_LORA2 = 1, REP_SCAN = 1, REP_RPOST = 1, REP_OUT = 1, REP_SCIN = 1, REP_SCMID = 1,
              REP_LIN = 1, REP_LCONV = 1, REP_LGATE = 1, REP_LSCAN = 1, REP_LPOST = 1, REP_NORM_FFN = 1, REP_TOPK = 1, REP_MOE1 = 1, REP_MOE2 = 1, REP_BAR = 1, REP_SA = 1, REP_SB = 1, REP_SC = 1, REP_SD = 1, GVAR = 0, SVAR = 0;
#define REPEAT(n) for (int rep_ = 0; rep_ < (n); ++rep_)
#define LASTREP(n) (rep_ == (n) - 1)
struct P {
    const float* in[36];
    float* out;
    unsigned char* ws;
    int ph_lo, ph_hi;
};

enum { I_X = 0, I_NMG, I_NFG, I_RW, I_WG, I_WU, I_WDN, I_FNG, I_MU, I_WIN, I_W0, I_W1, I_W2, I_A0, I_A1, I_A2, I_G1, I_G2, I_KK, I_KA, I_RK, I_LNG, I_LNB, I_WOUT,
       I_SCIN, I_SCCW, I_SCOUT, I_LIN, I_LCW, I_LCB, I_LWA, I_LBA, I_LWX, I_LBX, I_LLAM, I_LOUT };

__device__ __forceinline__ int lane_fresh() { int l; asm volatile("v_mbcnt_lo_u32_b32 %0, -1, 0\n\tv_mbcnt_hi_u32_b32 %0, -1, %0" : "=v"(l)); return l; }
#define TID (wv * 64 + lane_fresh())
__device__ __forceinline__ float bf2f(bf16_t v) { return __uint_as_float((unsigned)v << 16); }
__device__ __forceinline__ bf16_t f2bf(float f) { unsigned u = __float_as_uint(f); u += 0x7FFFu + ((u >> 16) & 1u); return (bf16_t)(u >> 16); }
__device__ __forceinline__ void bf4_to_f(uint2 u, float* f) { f[0] = __uint_as_float(u.x << 16); f[1] = __uint_as_float(u.x & 0xffff0000u); f[2] = __uint_as_float(u.y << 16); f[3] = __uint_as_float(u.y & 0xffff0000u); }
__device__ __forceinline__ uint2 f4_to_bf(float a, float b, float c, float d) { return make_uint2((unsigned)f2bf(a) | ((unsigned)f2bf(b) << 16), (unsigned)f2bf(c) | ((unsigned)f2bf(d) << 16)); }
template <int CTRL> __device__ __forceinline__ float dpp_f(float x) { return __builtin_bit_cast(float, __builtin_amdgcn_update_dpp(0, __builtin_bit_cast(int, x), CTRL, 0xf, 0xf, false)); }
__device__ __forceinline__ float row_sum16(float x) { x += dpp_f<0x128>(x); x += dpp_f<0x124>(x); x += dpp_f<0x122>(x); x += dpp_f<0x121>(x); return x; }
__device__ __forceinline__ float row_max16(float x) { x = fmaxf(x, dpp_f<0x128>(x)); x = fmaxf(x, dpp_f<0x124>(x)); x = fmaxf(x, dpp_f<0x122>(x)); x = fmaxf(x, dpp_f<0x121>(x)); return x; }
__device__ __forceinline__ float lane_bcast(float x, int l) { return __builtin_bit_cast(float, __builtin_amdgcn_readlane(__builtin_bit_cast(int, x), l)); }
__device__ __forceinline__ float wave_sum(float v) { v = row_sum16(v); return (lane_bcast(v, 0) + lane_bcast(v, 16)) + (lane_bcast(v, 32) + lane_bcast(v, 48)); }
__device__ __forceinline__ void wave_sum8(float (&v)[8]) {
#pragma unroll
    for (int s = 0; s < 8; ++s) v[s] = wave_sum(v[s]);
}
__device__ __forceinline__ float quad_sum(float v) { v += dpp_f<0xB1>(v); v += dpp_f<0x4E>(v); return v; }
__device__ __forceinline__ float sigmoidf_(float x) { return __builtin_amdgcn_rcpf(1.0f + __expf(-x)); }
__device__ __forceinline__ float tanhf_(float x) { const float e = __expf(-2.0f * fabsf(x)); const float t = (1.0f - e) * __builtin_amdgcn_rcpf(1.0f + e); return x < 0.f ? -t : t; }
__device__ __forceinline__ float softplusf_(float y) { return fmaxf(y, 0.f) + log1pf(__expf(-fabsf(y))); }
__device__ __forceinline__ float gelu_tanh(float x) { const float u = 0.7978845608028654f * (x + 0.044715f * x * x * x); return 0.5f * x * (1.0f + tanhf_(u)); }

__device__ __forceinline__ void ph_norm(const int wv, const P& p, const float* xin, const bf16_t* yadd, float* xout, bool combine, const float* gamma, bf16_t* hout, const float* router_w, float* fout, float* lds) {
    const int tid = TID, lane = tid & 63, wave = tid >> 6;
    if (router_w) {
        for (int i = tid; i < D * NE; i += NTHR) { const int d = i >> 4, e = i & 15; lds[e * D + d] = router_w[i]; }
        __syncthreads();
    }
    const bf16_t* yexp = (const bf16_t*)(p.ws + WS_YEXP); const int* slot = (const int*)(p.ws + WS_SLOT);
    float* aff = (float*)(p.ws + WS_AFF);
    const int tstep = gridDim.x * 8; int tok = blockIdx.x * 8 + wave;
    float4 xn[4]; uint2 yn[4]; int sln = -1;
#pragma unroll
    for (int i = 0; i < 4; ++i) yn[i] = make_uint2(0u, 0u);
    if (tok < T) {
#pragma unroll
        for (int i = 0; i < 4; ++i) xn[i] = ((const float4*)(xin + (size_t)tok * D))[i * 64 + lane];
        if (yadd) {
#pragma unroll
            for (int i = 0; i < 4; ++i) yn[i] = ((const uint2*)(yadd + (size_t)tok * D))[i * 64 + lane]; }
        if (combine) sln = slot[tok * NE + (lane & 15)];
    }
    for (; tok < T; tok += tstep) {
        const int b = tok / S, s = tok % S;
        float4 x[4];
#pragma unroll
        for (int i = 0; i < 4; ++i) { x[i] = xn[i]; if (yadd) { float f[4]; bf4_to_f(yn[i], f); x[i].x += f[0]; x[i].y += f[1]; x[i].z += f[2]; x[i].w += f[3]; } }
        const int slv = sln;
        if (tok + tstep < T) {
#pragma unroll
            for (int i = 0; i < 4; ++i) xn[i] = ((const float4*)(xin + (size_t)(tok + tstep) * D))[i * 64 + lane];
            if (yadd) {
#pragma unroll
                for (int i = 0; i < 4; ++i) yn[i] = ((const uint2*)(yadd + (size_t)(tok + tstep) * D))[i * 64 + lane]; }
            if (combine) sln = slot[(tok + tstep) * NE + (lane & 15)];
        }
        if (combine) {
            unsigned msk = (unsigned)(__ballot(slv >= 0) & 0xffffull);
            while (msk) {
                const int e0 = __ffs(msk) - 1; msk &= msk - 1u;
                const int e1 = msk ? (__ffs(msk) - 1) : e0; const bool two = msk != 0u; msk &= msk - 1u;
                const int s0 = __builtin_amdgcn_readlane(slv, e0), s1 = __builtin_amdgcn_readlane(slv, e1);
                const uint2* r0 = (const uint2*)(yexp + ((size_t)(e0 * NB + b) * CAP + s0) * D); const uint2* r1 = (const uint2*)(yexp + ((size_t)(e1 * NB + b) * CAP + s1) * D);
                uint2 q0[4], q1[4];
#pragma unroll
                for (int i = 0; i < 4; ++i) { q0[i] = r0[i * 64 + lane]; q1[i] = r1[i * 64 + lane]; }
#pragma unroll
                for (int i = 0; i < 4; ++i) { float f[4]; bf4_to_f(q0[i], f); x[i].x += f[0]; x[i].y += f[1]; x[i].z += f[2]; x[i].w += f[3];
                    if (two) { bf4_to_f(q1[i], f); x[i].x += f[0]; x[i].y += f[1]; x[i].z += f[2]; x[i].w += f[3]; } }
            }
        }
        if (xout) {
#pragma unroll
            for (int i = 0; i < 4; ++i) ((float4*)(xout + (size_t)tok * D))[i * 64 + lane] = x[i];
        }
        float ss = 0.f;
#pragma unroll
        for (int i = 0; i < 4; ++i) ss += x[i].x * x[i].x + x[i].y * x[i].y + x[i].z * x[i].z + x[i].w * x[i].w;
        ss = wave_sum(ss);
        const float rstd = __builtin_amdgcn_rsqf(ss * (1.0f / D) + RMS_EPS);
        float4 h[4];
#pragma unroll
        for (int i = 0; i < 4; ++i) {
            const float4 g = ((const float4*)gamma)[i * 64 + lane];
            h[i].x = x[i].x * rstd * g.x; h[i].y = x[i].y * rstd * g.y; h[i].z = x[i].z * rstd * g.z; h[i].w = x[i].w * rstd * g.w;
        }
        if (hout) {
#pragma unroll
            for (int i = 0; i < 4; ++i) ((uint2*)(hout + (size_t)tok * D))[i * 64 + lane] = f4_to_bf(h[i].x, h[i].y, h[i].z, h[i].w);
        }
        if (fout) {
#pragma unroll
            for (int i = 0; i < 4; ++i) ((float4*)(fout + (size_t)tok * D))[i * 64 + lane] = h[i];
        }
        if (router_w) {
            float mylg = -3.0e38f;
#pragma unroll 1
            for (int eg = 0; eg < NE; eg += 8) {
                float a8[8];
#pragma unroll
                for (int j = 0; j < 8; ++j) {
                    float a = 0.f;
#pragma unroll
                    for (int i = 0; i < 4; ++i) { const float4 w = ((const float4*)(lds + (eg + j) * D))[i * 64 + lane]; a += h[i].x * w.x + h[i].y * w.y + h[i].z * w.z + h[i].w * w.w; }
                    a8[j] = a;
                }
                wave_sum8(a8);
#pragma unroll
                for (int j = 0; j < 8; ++j) if (lane == eg + j) mylg = a8[j];
            }
            float mx = mylg;
            mx = row_max16(mx);
            const float mine = (lane < NE) ? __expf(mylg - mx) : 0.f;
            float sum = mine;
            sum = row_sum16(sum);
            if (lane < NE) aff[((size_t)b * NE + lane) * S + s] = mine / sum;
        }
    }
}

__device__ __forceinline__ void ph_norm_xm(const int wv, const P& p, const float* xin, const bf16_t* yadd, float* xout, bool combine, const float* gamma, const float* mu, unsigned char* lds) {
    const int tid = TID, lane = tid & 63, wave = tid >> 6;
    constexpr int HP = 2064;
    const bf16_t* yexp = (const bf16_t*)(p.ws + WS_YEXP); const int* slot = (const int*)(p.ws + WS_SLOT);
    bf16_t* XM = (bf16_t*)(p.ws + WS_XM);
    for (int unit = blockIdx.x; unit < T / 32; unit += gridDim.x) {
        const int t0 = unit * 32;
        float4 xr[5][4]; uint2 yr[5][4]; int slr[5];
#pragma unroll
        for (int j = 0; j < 5; ++j) {
            const int r = wave + 8 * j, tok = t0 - 1 + r, s = (t0 % S) - 1 + r; slr[j] = -1;
#pragma unroll
            for (int i = 0; i < 4; ++i) yr[j][i] = make_uint2(0u, 0u);
            if (r < 34 && s >= 0 && s < S) {
#pragma unroll
                for (int i = 0; i < 4; ++i) xr[j][i] = ((const float4*)(xin + (size_t)tok * D))[i * 64 + lane];
                if (yadd) {
#pragma unroll
                    for (int i = 0; i < 4; ++i) yr[j][i] = ((const uint2*)(yadd + (size_t)tok * D))[i * 64 + lane]; }
                if (combine) slr[j] = slot[tok * NE + (lane & 15)];
            } else {
#pragma unroll
                for (int i = 0; i < 4; ++i) xr[j][i] = make_float4(0.f, 0.f, 0.f, 0.f);
            }
        }
#pragma unroll
        for (int j = 0; j < 5; ++j) {
            const int r = wave + 8 * j, tok = t0 - 1 + r, s = (t0 % S) - 1 + r;
            if (r >= 34) continue;
            uint2* hrow = (uint2*)(lds + r * HP);
            if (s < 0 || s >= S) {
#pragma unroll
                for (int i = 0; i < 4; ++i) hrow[i * 64 + lane] = make_uint2(0u, 0u);
                continue;
            }
            const int b = tok / S;
            float4 x[4];
#pragma unroll
            for (int i = 0; i < 4; ++i) { x[i] = xr[j][i]; if (yadd) { float f[4]; bf4_to_f(yr[j][i], f); x[i].x += f[0]; x[i].y += f[1]; x[i].z += f[2]; x[i].w += f[3]; } }
            if (combine) {
                const int slv = slr[j];
                unsigned msk = (unsigned)(__ballot(slv >= 0) & 0xffffull);
                while (msk) {
                    const int e0 = __ffs(msk) - 1; msk &= msk - 1u;
                    const int e1 = msk ? (__ffs(msk) - 1) : e0; const bool two = msk != 0u; msk &= msk - 1u;
                    const int s0 = __builtin_amdgcn_readlane(slv, e0), s1 = __builtin_amdgcn_readlane(slv, e1);
                    const uint2* r0 = (const uint2*)(yexp + ((size_t)(e0 * NB + b) * CAP + s0) * D); const uint2* r1 = (const uint2*)(yexp + ((size_t)(e1 * NB + b) * CAP + s1) * D);
                    uint2 q0[4], q1[4];
#pragma unroll
                    for (int i = 0; i < 4; ++i) { q0[i] = r0[i * 64 + lane]; q1[i] = r1[i * 64 + lane]; }
#pragma unroll
                    for (int i = 0; i < 4; ++i) { float f[4]; bf4_to_f(q0[i], f); x[i].x += f[0]; x[i].y += f[1]; x[i].z += f[2]; x[i].w += f[3];
                        if (two) { bf4_to_f(q1[i], f); x[i].x += f[0]; x[i].y += f[1]; x[i].z += f[2]; x[i].w += f[3]; } }
                }
            }
            if (r >= 1 && r <= 32) {
#pragma unroll
                for (int i = 0; i < 4; ++i) ((float4*)(xout + (size_t)tok * D))[i * 64 + lane] = x[i];
            }
            float ss = 0.f;
#pragma unroll
            for (int i = 0; i < 4; ++i) ss += x[i].x * x[i].x + x[i].y * x[i].y + x[i].z * x[i].z + x[i].w * x[i].w;
            ss = wave_sum(ss);
            const float rstd = __builtin_amdgcn_rsqf(ss * (1.0f / D) + RMS_EPS);
#pragma unroll
            for (int i = 0; i < 4; ++i) {
                const float4 gq = ((const float4*)gamma)[i * 64 + lane];
                hrow[i * 64 + lane] = f4_to_bf(x[i].x * rstd * gq.x, x[i].y * rstd * gq.y, x[i].z * rstd * gq.z, x[i].w * rstd * gq.w);
            }
        }
        __syncthreads();
        for (int r = 1 + wave; r <= 32; r += 8) {
            const int tok = t0 - 1 + r;
#pragma unroll
            for (int i = 0; i < 4; ++i) {
                const int c4 = i * 64 + lane;
                float hc[4], hp[4], hn[4];
                bf4_to_f(((const uint2*)(lds + r * HP))[c4], hc); bf4_to_f(((const uint2*)(lds + (r - 1) * HP))[c4], hp); bf4_to_f(((const uint2*)(lds + (r + 1) * HP))[c4], hn);
                float xx[4];
#pragma unroll
                for (int j = 0; j < 4; ++j) xx[j] = 0.5f * (hp[j] + hn[j]) - hc[j];
#pragma unroll
                for (int q = 0; q < 6; ++q) {
                    const float4 m = ((const float4*)(mu + q * D))[c4];
                    ((uint2*)(XM + ((size_t)q * T + tok) * D))[c4] = f4_to_bf(hc[0] + xx[0] * m.x, hc[1] + xx[1] * m.y, hc[2] + xx[2] * m.z, hc[3] + xx[3] * m.w);
                }
            }
        }
        __syncthreads();
    }
}

__device__ __forceinline__ void ph_xm(const int wv, const P& p, const float* mu) {
    const int tid = TID, lane = tid & 63, wave = tid >> 6;
    const bf16_t* H = (const bf16_t*)(p.ws + WS_H); bf16_t* XM = (bf16_t*)(p.ws + WS_XM);
    for (int tok = blockIdx.x * 8 + wave; tok < T; tok += gridDim.x * 8) {
        const int s = tok % S;
#pragma unroll
        for (int i = 0; i < 4; ++i) {
            const int c4 = i * 64 + lane;
            float hc[4], hp[4] = {0.f, 0.f, 0.f, 0.f}, hn[4] = {0.f, 0.f, 0.f, 0.f};
            bf4_to_f(((const uint2*)(H + (size_t)tok * D))[c4], hc);
            if (s > 0) bf4_to_f(((const uint2*)(H + (size_t)(tok - 1) * D))[c4], hp);
            if (s < S - 1) bf4_to_f(((const uint2*)(H + (size_t)(tok + 1) * D))[c4], hn);
            float xx[4];
#pragma unroll
            for (int j = 0; j < 4; ++j) xx[j] = 0.5f * (hp[j] + hn[j]) - hc[j];
#pragma unroll
            for (int q = 0; q < 6; ++q) {
                const float4 m = ((const float4*)(mu + q * D))[c4];
                ((uint2*)(XM + ((size_t)q * T + tok) * D))[c4] = f4_to_bf(hc[0] + xx[0] * m.x, hc[1] + xx[1] * m.y, hc[2] + xx[2] * m.z, hc[3] + xx[3] * m.w);
            }
        }
    }
}

__device__ __forceinline__ void bf16x16_load(const bf16_t* p16, float* f) {
    const uint4 a = ((const uint4*)p16)[0], b = ((const uint4*)p16)[1];
    const unsigned w[8] = {a.x, a.y, a.z, a.w, b.x, b.y, b.z, b.w};
#pragma unroll
    for (int j = 0; j < 8; ++j) { f[2 * j] = __uint_as_float(w[j] << 16); f[2 * j + 1] = __uint_as_float(w[j] & 0xffff0000u); }
}
__device__ __forceinline__ void ph_rwkv_post(const int wv, const P& p, int ia) {
    const int tid = TID, lane = tid & 63, wave = tid >> 6;
    const bf16_t* __restrict__ RKV = (const bf16_t*)(p.ws + WS_RKV); const bf16_t* __restrict__ GG = (const bf16_t*)(p.ws + WS_GG); const float* __restrict__ BON = (const float*)(p.ws + WS_BON);
    const bf16_t* __restrict__ YS = (const bf16_t*)(p.ws + WS_YS); bf16_t* __restrict__ YG = (bf16_t*)(p.ws + WS_YG);
    const float* lg = p.in[I_LNG] + ia * D; const float* lb = p.in[I_LNB] + ia * D;
#pragma unroll 2
    for (int tok = blockIdx.x * 8 + wave; tok < T; tok += gridDim.x * 8) {
        const size_t o = (size_t)tok * D + lane * 16;
        float y[16], v[16], gg[16];
        { float y1[16]; bf16x16_load(YS + o, y); bf16x16_load(YS + (size_t)T * D + o, y1);
#pragma unroll
          for (int j = 0; j < 16; ++j) y[j] += y1[j]; }
        bf16x16_load(RKV + 2 * (size_t)T * D + o, v); bf16x16_load(GG + o, gg);
        const float bon = BON[(size_t)tok * NH + (lane >> 2)] + BON[((size_t)T + tok) * NH + (lane >> 2)];
        float sm = 0.f;
#pragma unroll
        for (int j = 0; j < 16; ++j) sm += y[j];
        const float mean = quad_sum(sm) * (1.0f / 64.0f);
        float sv = 0.f;
#pragma unroll
        for (int j = 0; j < 16; ++j) { const float d = y[j] - mean; sv += d * d; }
        const float rstd = __builtin_amdgcn_rsqf(quad_sum(sv) * (1.0f / 64.0f) + LNX_EPS);
        float outv[16];
#pragma unroll
        for (int j = 0; j < 16; ++j) { const int c = lane * 16 + j; outv[j] = ((y[j] - mean) * rstd * lg[c] + lb[c] + bon * v[j]) * gg[j]; }
#pragma unroll
        for (int j = 0; j < 4; ++j) ((uint2*)(YG + o))[j] = f4_to_bf(outv[4 * j], outv[4 * j + 1], outv[4 * j + 2], outv[4 * j + 3]);
    }
}

__device__ __forceinline__ void ph_sc_mid(const int wv, const P& p) {
    const int tid = TID, lane = tid & 63, wave = tid >> 6;
    const bf16_t* __restrict__ BCU = (const bf16_t*)(p.ws + WS_RKV); bf16_t* __restrict__ BZ = (bf16_t*)(p.ws + WS_YG); const float* cw = p.in[I_SCCW];
#pragma unroll 2
    for (int tok = blockIdx.x * 8 + wave; tok < T; tok += gridDim.x * 8) {
        const int s = tok % S;
#pragma unroll
        for (int i = 0; i < 4; ++i) {
            const int c4 = i * 64 + lane;
            float z[4] = {0.f, 0.f, 0.f, 0.f};
#pragma unroll
            for (int j = 0; j < 3; ++j) {
                const int ss = s + j - 1;
                if (ss >= 0 && ss < S) {
                    const size_t ro = (size_t)(tok + j - 1) * (3 * D);
                    float c[4], u[4]; bf4_to_f(((const uint2*)(BCU + ro + D))[c4], c); bf4_to_f(((const uint2*)(BCU + ro + 2 * D))[c4], u);
                    const float4 w = ((const float4*)(cw + j * D))[c4];
                    z[0] += w.x * c[0] * u[0]; z[1] += w.y * c[1] * u[1]; z[2] += w.z * c[2] * u[2]; z[3] += w.w * c[3] * u[3];
                }
            }
            float bg[4]; bf4_to_f(((const uint2*)(BCU + (size_t)tok * (3 * D)))[c4], bg);
            ((uint2*)(BZ + (size_t)tok * D))[c4] = f4_to_bf(bg[0] * z[0], bg[1] * z[1], bg[2] * z[2], bg[3] * z[3]);
        }
    }
}

__device__ __forceinline__ void ph_lru_conv(const int wv, const P& p) {
    const int tid = TID, lane = tid & 63, wave = tid >> 6;
    const bf16_t* __restrict__ GU = (const bf16_t*)(p.ws + WS_RKV); bf16_t* __restrict__ UCB = (bf16_t*)(p.ws + WS_UCB);
    const float* cw = p.in[I_LCW]; const float* cb = p.in[I_LCB];
#pragma unroll 2
    for (int tok = blockIdx.x * 8 + wave; tok < T; tok += gridDim.x * 8) {
        const int s = tok % S;
#pragma unroll
        for (int i = 0; i < 4; ++i) {
            const int c4 = i * 64 + lane;
            float4 acc = ((const float4*)cb)[c4];
#pragma unroll
            for (int j = 0; j < 4; ++j) {
                const int ss = s + j - 2;
                if (ss >= 0 && ss < S) {
                    float u[4]; bf4_to_f(((const uint2*)(GU + (size_t)(tok + j - 2) * (2 * D) + D))[c4], u); const float4 w = ((const float4*)(cw + j * D))[c4];
                    acc.x += w.x * u[0]; acc.y += w.y * u[1]; acc.z += w.z * u[2]; acc.w += w.w * u[3];
                }
            }
            ((uint2*)(UCB + (size_t)tok * D))[c4] = f4_to_bf(acc.x, acc.y, acc.z, acc.w);
        }
    }
}

__device__ __forceinline__ void ph_lru_scan(const int wv, const P& p, float* lds) {
    const int tid = TID;
    const bf16_t* LA = (const bf16_t*)(p.ws + WS_WD); const bf16_t* LB = (const bf16_t*)(p.ws + WS_AA);
    bf16_t* HS = (bf16_t*)(p.ws + WS_YS);
    float2* segP = (float2*)lds; float2* segH = (float2*)lds + 512;
    const int cp = tid & 31, seg = tid >> 5;
    for (int unit = blockIdx.x; unit < NB * 2 * 16; unit += gridDim.x) {
        const int cg = unit & 15, z = (unit >> 4) & 1, b = unit >> 5;
        const int c = cg * 64 + cp * 2;
        const bf16_t* la = LA + (size_t)z * T * D; const bf16_t* lb = LB + (size_t)z * T * D;
        float P0 = 0.f, P1 = 0.f, h0 = 0.f, h1 = 0.f;
#pragma unroll 8
        for (int i = seg * 128; i < seg * 128 + 128; ++i) {
            const int t = z ? (S - 1 - i) : i; const size_t o = ((size_t)b * S + t) * D + c;
            const unsigned a2 = *(const unsigned*)(la + o), b2 = *(const unsigned*)(lb + o);
            const float l0 = __uint_as_float(a2 << 16), l1 = __uint_as_float(a2 & 0xffff0000u);
            h0 = __expf(l0) * h0 + __uint_as_float(b2 << 16); h1 = __expf(l1) * h1 + __uint_as_float(b2 & 0xffff0000u);
            P0 += l0; P1 += l1;
        }
        segP[seg * 32 + cp] = make_float2(__expf(P0), __expf(P1)); segH[seg * 32 + cp] = make_float2(h0, h1);
        __syncthreads();
        float c0 = 0.f, c1 = 0.f;
        for (int s2 = 0; s2 < seg; ++s2) { const float2 pp = segP[s2 * 32 + cp], hh = segH[s2 * 32 + cp]; c0 = pp.x * c0 + hh.x; c1 = pp.y * c1 + hh.y; }
        h0 = c0; h1 = c1;
#pragma unroll 8
        for (int i = seg * 128; i < seg * 128 + 128; ++i) {
            const int t = z ? (S - 1 - i) : i; const size_t o = ((size_t)b * S + t) * D + c;
            const unsigned a2 = *(const unsigned*)(la + o), b2 = *(const unsigned*)(lb + o);
            h0 = __expf(__uint_as_float(a2 << 16)) * h0 + __uint_as_float(b2 << 16); h1 = __expf(__uint_as_float(a2 & 0xffff0000u)) * h1 + __uint_as_float(b2 & 0xffff0000u);
            *(unsigned*)(HS + (size_t)z * T * D + o) = (unsigned)f2bf(h0) | ((unsigned)f2bf(h1) << 16);
        }
        __syncthreads();
    }
}

__device__ __forceinline__ void ph_lru_post(const int wv, const P& p) {
    const int tid = TID, lane = tid & 63, wave = tid >> 6;
    const bf16_t* __restrict__ GU = (const bf16_t*)(p.ws + WS_RKV); const bf16_t* __restrict__ HS = (const bf16_t*)(p.ws + WS_YS); bf16_t* __restrict__ YL = (bf16_t*)(p.ws + WS_YG);
#pragma unroll 2
    for (int tok = blockIdx.x * 8 + wave; tok < T; tok += gridDim.x * 8) {
#pragma unroll
        for (int i = 0; i < 4; ++i) {
            const int c4 = i * 64 + lane;
            float gq[4]; bf4_to_f(((const uint2*)(GU + (size_t)tok * (2 * D)))[c4], gq); const float4 g = make_float4(gq[0], gq[1], gq[2], gq[3]);
            float hq0[4], hq1[4]; bf4_to_f(((const uint2*)(HS + (size_t)tok * D))[c4], hq0); bf4_to_f(((const uint2*)(HS + (size_t)T * D + (size_t)tok * D))[c4], hq1);
            const float4 h0 = make_float4(hq0[0], hq0[1], hq0[2], hq0[3]), h1 = make_float4(hq1[0], hq1[1], hq1[2], hq1[3]);
            ((uint2*)(YL + (size_t)tok * D))[c4] = f4_to_bf((h0.x + h1.x) * gelu_tanh(g.x), (h0.y + h1.y) * gelu_tanh(g.y), (h0.z + h1.z) * gelu_tanh(g.z), (h0.w + h1.w) * gelu_tanh(g.w));
        }
    }
}

__device__ __forceinline__ int block_sum_i(const int wv, int v, int* wsum  ) {
    const int lane = lane_fresh(), wave = wv;
    v = __popcll(__ballot(v & 1)) + 2 * __popcll(__ballot(v & 2)) + 4 * __popcll(__ballot(v & 4));
    if (lane == 0) wsum[wave] = v;
    __syncthreads();
    int tot = 0;
#pragma unroll
    for (int w = 0; w < 8; ++w) tot += wsum[w];
    return tot;
}
__device__ __forceinline__ int block_excl_scan_i(const int wv, int v, int* wsum  , int& total) {
    const int lane = lane_fresh(), wave = wv;
    int inc = v;
    for (int o = 1; o < 64; o <<= 1) { const int t = __shfl_up(inc, o); if (lane >= o) inc += t; }
    if (lane == 63) wsum[wave] = inc;
    __syncthreads();
    int base = 0, tot = 0;
#pragma unroll
    for (int w = 0; w < 8; ++w) { const int x = wsum[w]; if (w < wave) base += x; tot += x; }
    total = tot;
    return base + inc - v;
}
__device__ __forceinline__ void ph_topk(const int wv, const P& p, float* ldsf) {
    const int tid = TID, lane = tid & 63, wave = tid >> 6;
    int* ldsi = (int*)ldsf;
    int* wsum = ldsi;
    int* idx_l = ldsi + 64;
    const float* aff = (const float*)(p.ws + WS_AFF); int* slot = (int*)(p.ws + WS_SLOT); float* gate = (float*)(p.ws + WS_GATE);
    const bf16_t* HF = (const bf16_t*)(p.ws + WS_H); bf16_t* XIN = (bf16_t*)(p.ws + WS_XIN);
    for (int unit2 = blockIdx.x; unit2 < 2 * NB * NE; unit2 += gridDim.x) {
        const int unit = unit2 >> 1, half = unit2 & 1;
        const int e = unit % NE, b = unit / NE;
        const float4 v4 = ((const float4*)(aff + ((size_t)b * NE + e) * S))[tid];
        const unsigned v[4] = {__float_as_uint(v4.x), __float_as_uint(v4.y), __float_as_uint(v4.z), __float_as_uint(v4.w)};
        unsigned thr = 0u;
        for (int bit = 29; bit >= 0; --bit) {
            const unsigned cand = thr | (1u << bit);
            const int cnt = (int)(v[0] >= cand) + (int)(v[1] >= cand) + (int)(v[2] >= cand) + (int)(v[3] >= cand);
            const int tot = block_sum_i(wv, cnt, wsum + (bit & 1) * 8);
            if (tot >= CAP) thr = cand;
        }
        int g4 = 0, e4 = 0;
#pragma unroll
        for (int j = 0; j < 4; ++j) { g4 += (int)(v[j] > thr); e4 += (int)(v[j] == thr); }
        const int ngt = block_sum_i(wv, g4, wsum + 16);
        const int need_eq = CAP - ngt;
        int toteq; const int eqbase = block_excl_scan_i(wv, e4, wsum + 24, toteq);
        int sel[4], nsel = 0, er = eqbase;
#pragma unroll
        for (int j = 0; j < 4; ++j) { const bool gt = v[j] > thr, eq = v[j] == thr; sel[j] = (gt || (eq && er < need_eq)) ? 1 : 0; er += eq ? 1 : 0; nsel += sel[j]; }
        __syncthreads();
        int totsel; int cpos = block_excl_scan_i(wv, nsel, wsum, totsel);
#pragma unroll
        for (int j = 0; j < 4; ++j) {
            const int t = tid * 4 + j;
            if (sel[j]) {
                if (cpos < CAP) { idx_l[cpos] = t; if (half == 0) { gate[((size_t)e * NB + b) * CAP + cpos] = __uint_as_float(v[j]); slot[((size_t)b * S + t) * NE + e] = cpos; } }
                else if (half == 0) slot[((size_t)b * S + t) * NE + e] = -1;
                ++cpos;
            } else if (half == 0) slot[((size_t)b * S + t) * NE + e] = -1;
        }
        __syncthreads();
#pragma unroll 1
        for (int cb = 0; cb < 16; cb += 4) {
            const int c = half * 128 + wave * 16 + cb;
            const uint4* s0 = (const uint4*)(HF + ((size_t)b * S + idx_l[c]) * D); const uint4* s1 = (const uint4*)(HF + ((size_t)b * S + idx_l[c + 1]) * D);
            const uint4* s2 = (const uint4*)(HF + ((size_t)b * S + idx_l[c + 2]) * D); const uint4* s3 = (const uint4*)(HF + ((size_t)b * S + idx_l[c + 3]) * D);
            const uint4 a0 = s0[lane], b0 = s0[lane + 64], a1 = s1[lane], b1 = s1[lane + 64], a2 = s2[lane], b2 = s2[lane + 64], a3 = s3[lane], b3 = s3[lane + 64];
            uint4* d0 = (uint4*)(XIN + (((size_t)e * NB + b) * CAP + c) * D);
            d0[lane] = a0; d0[lane + 64] = b0; d0[128 + lane] = a1; d0[128 + lane + 64] = b1; d0[256 + lane] = a2; d0[256 + lane + 64] = b2; d0[384 + lane] = a3; d0[384 + lane + 64] = b3;
        }
        __syncthreads();
    }
}


namespace pg8 {
#define PG8_LAS __attribute__((address_space(3)))
typedef short bf16x8 __attribute__((ext_vector_type(8)));
typedef float f32x4 __attribute__((ext_vector_type(4)));
typedef unsigned u32x4 __attribute__((ext_vector_type(4)));
typedef unsigned u32x2 __attribute__((ext_vector_type(2)));
constexpr int BM = 256, BK = 64, HALF = 128, HTB = HALF * BK * 2, STAGE_BYTES = 8 * HTB;
__device__ __forceinline__ int lds_byte(int r, int c) { const int st = (r >> 4) * 2 + (c >> 5), rr = r & 15, cc = c & 31, ob = rr * 64 + cc * 2; return st * 1024 + (ob ^ (((ob >> 9) & 1) << 5)); }
__device__ __forceinline__ void stage_rc(int b, int& R, int& C) { const int st = b / 1024, sb = b % 1024, swz = sb ^ (((sb >> 9) & 1) << 5); R = (st >> 1) * 16 + swz / 64; C = (st & 1) * 32 + (swz % 64) / 2; }
__device__ __forceinline__ int perm32(int rho) { const int n = rho >> 4, i = rho & 15; return 8 * (i >> 2) + 4 * n + (i & 3); }
struct Unit { const char* A; const char* B; int pm, pn, job; };
struct Geo { int lda, ldb, K; };
typedef float f32x2_t __attribute__((ext_vector_type(2)));
typedef __bf16 bf16x2_t __attribute__((ext_vector_type(2)));
__device__ __forceinline__ unsigned cvt_pk_bf16(float lo, float hi) { const f32x2_t v = {lo, hi}; const bf16x2_t b = __builtin_convertvector(v, bf16x2_t); return __builtin_bit_cast(unsigned, b); }

template <class Epi, class Sched>
__device__ __forceinline__ void gemm_phase(const int wv, PG8_LAS unsigned char* lds, const Geo g, const Sched& S, const Epi& E, const bool skip_epi = false) {
    const int tid = TID, wid = wv, lane = tid & 63, wr = wid >> 2, wc = wid & 3, fr = lane & 15, fq = lane >> 4;
    const int nt = g.K / BK;
    unsigned voffA[2], voffB[2];
#pragma unroll
    for (int i = 0; i < 2; ++i) { int R, C; stage_rc(tid * 16 + i * 8192, R, C); const int Rb = Epi::PERM ? ((R & ~31) + perm32(R & 31)) : R;
        voffA[i] = (unsigned)(R * g.lda + C) * 2u; voffB[i] = (unsigned)(Rb * g.ldb + C) * 2u; }
    const size_t kstep = (size_t)(BK * 2);
    const size_t hstepA = (size_t)HALF * g.lda * 2, hstepB = (size_t)HALF * g.ldb * 2;
    const unsigned ldsw = (unsigned)wid * 1024u;
    const int aoff = lds_byte(wr * 64 + fr, fq * 8), boff = lds_byte(wc * 32 + fr, fq * 8);
#define PG8_SA(b, h) (((b) * 2 + (h)) * HTB)
#define PG8_SB(b, h) ((4 + (b) * 2 + (h)) * HTB)
#define PG8_STAGE(bufoff, gbase, voff) do { _Pragma("unroll") for (int _i = 0; _i < 2; ++_i) \
        __builtin_amdgcn_global_load_lds((const unsigned*)((const char*)(gbase) + (voff)[_i]), (PG8_LAS unsigned*)(lds + (bufoff) + ldsw + _i * 8192), 16, 0, 0); } while (0)
#define PG8_LDA(dst, b, h) do { _Pragma("unroll") for (int m = 0; m < 4; ++m) _Pragma("unroll") for (int k = 0; k < 2; ++k) dst[m][k] = *(const PG8_LAS bf16x8*)(lds + PG8_SA(b, h) + aoff + m * 2048 + k * 1024); } while (0)
#define PG8_LDB(dst, b, h) do { _Pragma("unroll") for (int n = 0; n < 2; ++n) _Pragma("unroll") for (int k = 0; k < 2; ++k) dst[n][k] = *(const PG8_LAS bf16x8*)(lds + PG8_SB(b, h) + boff + n * 2048 + k * 1024); } while (0)
#define PG8_MMA(ai, bj, At, Bt) do { __builtin_amdgcn_s_setprio(1); _Pragma("unroll") for (int m = 0; m < 4; ++m) _Pragma("unroll") for (int n = 0; n < 2; ++n) _Pragma("unroll") for (int k = 0; k < 2; ++k) \
        acc[ai][bj][m][n] = __builtin_amdgcn_mfma_f32_16x16x32_bf16(Bt[n][k], At[m][k], acc[ai][bj][m][n], 0, 0, 0); __builtin_amdgcn_s_setprio(0); } while (0)
#define PG8_WAIT_V(n) asm volatile("s_waitcnt vmcnt(" #n ")" ::: "memory")
#define PG8_WAIT_L(n) asm volatile("s_waitcnt lgkmcnt(" #n ")" ::: "memory")
#define PG8_BAR __builtin_amdgcn_s_barrier()
#define PG8_SCHED __builtin_amdgcn_sched_barrier(0)
    Unit cur, nxt; int ui = 0;
    if (!S.next(0, cur)) return;
    f32x4 acc[2][2][4][2];
#pragma unroll
    for (int a = 0; a < 2; ++a)
#pragma unroll
        for (int b = 0; b < 2; ++b)
#pragma unroll
            for (int m = 0; m < 4; ++m)
#pragma unroll
                for (int n = 0; n < 2; ++n) acc[a][b][m][n] = (f32x4){0.f, 0.f, 0.f, 0.f};
    bf16x8 At[4][2], B0[2][2], B1[2][2];
    const char* cA = cur.A; const char* cB = cur.B;
    PG8_STAGE(PG8_SB(0, 0), cB, voffB); PG8_STAGE(PG8_SB(0, 1), cB + hstepB, voffB); PG8_STAGE(PG8_SA(0, 0), cA, voffA); PG8_STAGE(PG8_SA(0, 1), cA + hstepA, voffA);
    if (wr == 1) PG8_BAR;
    PG8_WAIT_V(2); PG8_BAR;
    PG8_STAGE(PG8_SB(1, 0), cB + kstep, voffB); PG8_STAGE(PG8_SA(1, 0), cA + kstep, voffA); PG8_STAGE(PG8_SB(1, 1), cB + hstepB + kstep, voffB);
    PG8_WAIT_V(6); PG8_BAR;
    for (;;) {
        const bool has_next = S.next(ui + 1, nxt);
        const char* nA = has_next ? nxt.A : cA; const char* nB = has_next ? nxt.B : cB;
#pragma unroll 1
        for (int t = 0; t < nt; t += 2) {
            const bool last = (t == nt - 2);
            const char* a1 = cA + (size_t)(t + 1) * kstep;
            const char* a2 = last ? nA : cA + (size_t)(t + 2) * kstep; const char* b2 = last ? nB : cB + (size_t)(t + 2) * kstep;
            const char* a3 = a2 + kstep; const char* b3 = b2 + kstep;
            PG8_LDB(B0, 0, 0); PG8_LDB(B1, 0, 1); PG8_SCHED; PG8_LDA(At, 0, 0); PG8_STAGE(PG8_SA(1, 1), a1 + hstepA, voffA);
            PG8_WAIT_V(8); PG8_WAIT_L(0); PG8_BAR; PG8_MMA(0, 0, At, B0); PG8_MMA(0, 1, At, B1); PG8_BAR; PG8_SCHED;
            PG8_LDA(At, 0, 1); PG8_STAGE(PG8_SB(0, 0), b2, voffB); PG8_STAGE(PG8_SB(0, 1), b2 + hstepB, voffB); PG8_STAGE(PG8_SA(0, 0), a2, voffA);
            PG8_WAIT_V(8); PG8_WAIT_L(0); PG8_BAR; PG8_MMA(1, 0, At, B0); PG8_MMA(1, 1, At, B1); PG8_BAR; PG8_SCHED;
            PG8_LDB(B0, 1, 0); PG8_LDB(B1, 1, 1); PG8_SCHED; PG8_LDA(At, 1, 0); PG8_STAGE(PG8_SA(0, 1), a2 + hstepA, voffA);
            PG8_WAIT_V(8); PG8_WAIT_L(0); PG8_BAR; PG8_MMA(0, 0, At, B0); PG8_MMA(0, 1, At, B1); PG8_BAR; PG8_SCHED;
            PG8_LDA(At, 1, 1); PG8_STAGE(PG8_SB(1, 0), b3, voffB); PG8_STAGE(PG8_SB(1, 1), b3 + hstepB, voffB); PG8_STAGE(PG8_SA(1, 0), a3, voffA);
            PG8_WAIT_V(8); PG8_WAIT_L(0); PG8_BAR; PG8_MMA(1, 0, At, B0); PG8_MMA(1, 1, At, B1); PG8_BAR; PG8_SCHED;
        }
        if (wr == 0) PG8_BAR;
        if (!skip_epi) { const int le = lane_fresh(); E(acc, cur, wr, wc, le & 15, le >> 4); }
        if (!has_next) break;
#pragma unroll
        for (int a = 0; a < 2; ++a)
#pragma unroll
            for (int b = 0; b < 2; ++b)
#pragma unroll
                for (int m = 0; m < 4; ++m)
#pragma unroll
                    for (int n = 0; n < 2; ++n) acc[a][b][m][n] = (f32x4){0.f, 0.f, 0.f, 0.f};
        cur = nxt; cA = nA; cB = nB; ++ui;
        if (wr == 1) PG8_BAR;
    }
    PG8_WAIT_V(0);
    PG8_BAR;
#undef PG8_SA
#undef PG8_SB
#undef PG8_STAGE
#undef PG8_LDA
#undef PG8_LDB
#undef PG8_MMA
#undef PG8_WAIT_V
#undef PG8_WAIT_L
#undef PG8_BAR
#undef PG8_SCHED
}
}


#define DIAGF 0
constexpr int CTL_DIAGW = 4096;
__device__ __forceinline__ void diag_flag(const P& p, bool badv, unsigned bit) {
    if (DIAGF && __any(badv)) { if (lane_fresh() == 0) atomicOr((unsigned*)(p.ws + WS_CTL) + CTL_DIAGW + 3, bit); }
}
__device__ __forceinline__ bool nonfin(float x) { return !(x == x) || fabsf(x) > 3.0e38f; }
__device__ __forceinline__ bool nonfin4(const pg8::f32x4& v) { return nonfin(v[0]) || nonfin(v[1]) || nonfin(v[2]) || nonfin(v[3]); }
namespace rs {
constexpr int P_TK = 144, P_KT = 80;
constexpr int O_KH = 0, O_RH = 4608, O_BT = 9216, O_KDT = 13824;
constexpr int O_BG = 18432, O_KDG = 23552, O_VM = 28672;
constexpr int O_B2 = 33792, O_AP = 36352, O_BP = 38912, O_NT = 41472;
constexpr int O_L = 44032;
constexpr int O_GAM = 48640;
constexpr int O_X = 48896;
constexpr int CHUNK_BYTES = 53760;
constexpr int O_SEGP = 2 * CHUNK_BYTES;
constexpr int O_YB = O_SEGP + 2048;
constexpr int YB_PITCH = 68;
static_assert(O_YB + 64 * YB_PITCH * 4 <= 128 * 1024, "scan LDS");
typedef pg8::bf16x8 bf16x8; typedef pg8::f32x4 f32x4; typedef pg8::u32x4 u32x4; typedef pg8::u32x2 u32x2;
__device__ __forceinline__ bf16x8 mk8(u32x2 lo, u32x2 hi) { u32x4 w; w.x = lo.x; w.y = lo.y; w.z = hi.x; w.w = hi.y; return __builtin_bit_cast(bf16x8, w); }
__device__ __forceinline__ bf16x8 cvt8(const f32x4& a, const f32x4& b) { u32x4 w; w.x = pg8::cvt_pk_bf16(a[0], a[1]); w.y = pg8::cvt_pk_bf16(a[2], a[3]); w.z = pg8::cvt_pk_bf16(b[0], b[1]); w.w = pg8::cvt_pk_bf16(b[2], b[3]); return __builtin_bit_cast(bf16x8, w); }
}
__device__ __forceinline__ void ph_scan2(const int wv, const P& p, int ia, unsigned char* lds, bf16_t* YS, const int moeL, const int var_ = 0) {
    const int var = var_ >= 100 ? var_ - 100 : 0; const bool dummy = var_ >= 100;
    using namespace rs;
#define RS_SYNC() do { if (var != 2) __syncthreads(); } while (0)
    const int lane = lane_fresh(), tid = wv * 64 + lane, l15 = lane & 15, g = lane >> 4;
    const bf16_t* RKV = (const bf16_t*)(p.ws + WS_RKV); const bf16_t* WDp = (const bf16_t*)(p.ws + WS_WD); const bf16_t* AAp = (const bf16_t*)(p.ws + WS_AA);
    for (int unit = blockIdx.x; unit < NB * NH * 2; unit += gridDim.x) {
        const int z = unit & 1, h = (unit >> 1) % NH, b = unit / (2 * NH);
        const float k_k = p.in[I_KK][ia * D + h * HD + lane], k_a = p.in[I_KA][ia * D + h * HD + lane];
        const float r_kq = p.in[I_RK][ia * D + h * HD + lane];
        f32x4 S4[4];
#pragma unroll
        for (int i = 0; i < 4; ++i) S4[i] = (f32x4){0.f, 0.f, 0.f, 0.f};
        float rr[8], kx[8], vv[8], ww[8], aa[8];
#define RS_LOAD(scx) do { _Pragma("unroll") for (int s = 0; s < 8; ++s) { \
            const int step = (scx) * 64 + (wv >> 2) * 32 + (wv & 3) * 8 + s, t = z ? (S - 1 - step) : step; \
            const size_t o = ((size_t)b * S + t) * D + h * HD + lane; \
            rr[s] = bf2f(RKV[o]); kx[s] = bf2f(RKV[(size_t)T * D + o]); vv[s] = bf2f(RKV[2 * (size_t)T * D + o]); \
            ww[s] = bf2f(WDp[(size_t)z * T * D + o]); aa[s] = bf2f(AAp[(size_t)z * T * D + o]); } } while (0)
        RS_LOAD(0);
        float fz[32]; bf16_t* fdst = nullptr; bool fon = false;
#pragma unroll
        for (int r = 0; r < 32; ++r) fz[r] = 0.f;
        const bool filler = (wv >= 4 && moeL >= 0 && unit == (int)blockIdx.x && gridDim.x == 256) && (!dummy || var >= 4);
#define RS_FILL_LOAD(J_) do { const int J = (J_); fon = J < NE * 3 * 1024; \
            if (fon) { const int mat = J >> 10, e = mat / 3, m = mat - 3 * e, jl = J & 1023; const float* fsrc; int fldw; \
                unsigned char* mb = dummy ? p.ws + WS_XM : p.ws + WB_MOE + (size_t)moeL * MOE_STRIDE; \
                if (m < 2) { const int nb = jl >> 5, kb = jl & 31, n = nb * 64 + lane; \
                    fsrc = p.in[m ? I_WU : I_WG] + (((size_t)moeL * NE + e) * D + kb * 32) * FF + n; fldw = FF; \
                    fdst = (bf16_t*)(mb + MOE_GU) + ((size_t)e * 4096 + ((n >> 7) << 8) + m * 128 + (n & 127)) * D + kb * 32; } \
                else { const int nb = jl >> 6, kb = jl & 63, n = nb * 64 + lane; \
                    fsrc = p.in[I_WDN] + (((size_t)moeL * NE + e) * FF + kb * 32) * D + n; fldw = D; \
                    fdst = (bf16_t*)(mb + MOE_DN) + ((size_t)e * D + n) * FF + kb * 32; } \
                if (var != 6) { _Pragma("unroll") for (int r = 0; r < 32; ++r) fz[r] = __builtin_nontemporal_load(fsrc + (size_t)r * fldw); } } \
            else { _Pragma("unroll") for (int r = 0; r < 32; ++r) fz[r] = 0.f; fdst = nullptr; } } while (0)
#define RS_FILL_STORE() do { if (fon && var != 5) { _Pragma("unroll") for (int c = 0; c < 4; ++c) { u32x4 w; \
            w.x = pg8::cvt_pk_bf16(fz[8 * c], fz[8 * c + 1]); w.y = pg8::cvt_pk_bf16(fz[8 * c + 2], fz[8 * c + 3]); w.z = pg8::cvt_pk_bf16(fz[8 * c + 4], fz[8 * c + 5]); w.w = pg8::cvt_pk_bf16(fz[8 * c + 6], fz[8 * c + 7]); \
            *(u32x4*)(fdst + 8 * c) = w; } } } while (0)
        for (int sc = 0; sc < S / 64; ++sc) {
            {
                const int q = wv >> 2, seg = wv & 3; unsigned char* cb = lds + q * CHUNK_BYTES;
                const int lna = lane_fresh(); const int kpos = (lna & 32) | (((lna >> 2) & 3) << 3) | (((lna >> 4) & 1) << 2) | (lna & 3);
                REPEAT(REP_SA) {
                float pl[8];
                pl[0] = ww[0];
#pragma unroll
                for (int s = 1; s < 8; ++s) pl[s] = pl[s - 1] + ww[s];
                ((float*)(lds + O_SEGP))[(q * 4 + seg) * 64 + lane] = pl[7];
                float kkn[8], ssq[8];
#pragma unroll
                for (int s = 0; s < 8; ++s) { kkn[s] = kx[s] * k_k; ssq[s] = kkn[s] * kkn[s]; }
                wave_sum8(ssq);
#pragma unroll
                for (int s = 0; s < 8; ++s) kkn[s] *= __builtin_amdgcn_rsqf(fmaxf(ssq[s], 1e-24f));
                RS_SYNC();
                float prefix = 0.f, PCl = 0.f;
#pragma unroll
                for (int s2 = 0; s2 < 4; ++s2) { const float sp = ((const float*)(lds + O_SEGP))[(q * 4 + s2) * 64 + lane]; if (s2 < seg) prefix += sp; PCl += sp; }
                const float PC = __expf(PCl);
                float bgs[8], kdgs[8], bnv[8];
#pragma unroll
                for (int s = 0; s < 8; ++s) {
                    const int tt = seg * 8 + s;
                    const float cl = prefix + pl[s]; const float Pt = __expf(cl), Pm = __expf(cl - ww[s]), inv = __expf(-cl);
                    const float bb = kkn[s] * aa[s], kd = kx[s] * (1.0f + (aa[s] - 1.0f) * k_a);
                    const float bt = bb * inv, kdt = kd * inv;
                    bnv[s] = rr[s] * kd * r_kq;
                    const unsigned w01 = pg8::cvt_pk_bf16(kkn[s] * Pm, rr[s] * Pt), w23 = pg8::cvt_pk_bf16(bt, kdt);
                    *(bf16_t*)(cb + O_KH + tt * P_TK + kpos * 2) = (bf16_t)w01;
                    *(bf16_t*)(cb + O_RH + tt * P_TK + kpos * 2) = (bf16_t)(w01 >> 16);
                    *(bf16_t*)(cb + O_BT + tt * P_TK + kpos * 2) = (bf16_t)w23;
                    *(bf16_t*)(cb + O_KDT + tt * P_TK + kpos * 2) = (bf16_t)(w23 >> 16);
                    bgs[s] = bt * PC; kdgs[s] = kdt * PC;
                    diag_flag(p, nonfin(bt) || nonfin(kdt) || nonfin(kkn[s] * Pm) || nonfin(rr[s] * Pt) || nonfin(bgs[s]) || nonfin(kdgs[s]) || nonfin(vv[s]), 1u);
                    diag_flag(p, !(Pt > 1e-12f) || nonfin(inv), 2u);
                }
                wave_sum8(bnv);
                { float bsel = bnv[0];
#pragma unroll
                  for (int s = 1; s < 8; ++s) bsel = (lna == s) ? bnv[s] : bsel;
                  if (lna < 8) { const int step = sc * 64 + q * 32 + seg * 8 + lna, t = z ? (S - 1 - step) : step;
                      ((float*)(p.ws + WS_BON))[((size_t)z * T + (size_t)b * S + t) * NH + h] = bsel; } }
                u32x4 w;
                w.x = pg8::cvt_pk_bf16(bgs[0], bgs[1]); w.y = pg8::cvt_pk_bf16(bgs[2], bgs[3]); w.z = pg8::cvt_pk_bf16(bgs[4], bgs[5]); w.w = pg8::cvt_pk_bf16(bgs[6], bgs[7]);
                { u32x2 wl; wl.x = w.x; wl.y = w.y; u32x2 wh; wh.x = w.z; wh.y = w.w; const int pb = 16 * (seg & 1) + 4 * (seg >> 1);
                  *(u32x2*)(cb + O_BG + lane * P_KT + pb * 2) = wl; *(u32x2*)(cb + O_BG + lane * P_KT + (pb + 8) * 2) = wh; }
                w.x = pg8::cvt_pk_bf16(kdgs[0], kdgs[1]); w.y = pg8::cvt_pk_bf16(kdgs[2], kdgs[3]); w.z = pg8::cvt_pk_bf16(kdgs[4], kdgs[5]); w.w = pg8::cvt_pk_bf16(kdgs[6], kdgs[7]);
                *(u32x4*)(cb + O_KDG + lane * P_KT + seg * 16) = w;
                w.x = pg8::cvt_pk_bf16(vv[0], vv[1]); w.y = pg8::cvt_pk_bf16(vv[2], vv[3]); w.z = pg8::cvt_pk_bf16(vv[4], vv[5]); w.w = pg8::cvt_pk_bf16(vv[6], vv[7]);
                *(u32x4*)(cb + O_VM + lane * P_KT + seg * 16) = w;
                if (seg == 0) *(float*)(cb + O_GAM + lane * 4) = PC;
                }
                if (sc + 1 < S / 64 && var != 1) RS_LOAD(sc + 1);
            }
            RS_SYNC();
            {
                const int q = wv >> 2, o = wv & 3; unsigned char* cb = lds + q * CHUNK_BYTES;
                const int lnb = lane_fresh(), l15 = lnb & 15, g = lnb >> 4;
                REPEAT(REP_SB) {
                const unsigned char* Xm = cb + ((o & 1) ? O_KDT : O_BT); const unsigned char* Ym = cb + ((o >> 1) ? O_RH : O_KH);
#pragma unroll
                for (int ti = 0; ti < 2; ++ti)
#pragma unroll
                    for (int tt = 0; tt < 2; ++tt) {
                        f32x4 acc = (f32x4){0.f, 0.f, 0.f, 0.f};
                        if (tt >= ti) {
#pragma unroll
                            for (int ks = 0; ks < 2; ++ks) {
                                const bf16x8 a = *(const bf16x8*)(Xm + (16 * ti + l15) * P_TK + (32 * ks + 8 * g) * 2);
                                const bf16x8 bq = *(const bf16x8*)(Ym + (16 * tt + l15) * P_TK + (32 * ks + 8 * g) * 2);
                                acc = __builtin_amdgcn_mfma_f32_16x16x32_bf16(a, bq, acc, 0, 0, 0);
                            }
                        }
                        const int t = 16 * tt + l15, i0 = 16 * ti + 4 * g;
#pragma unroll
                        for (int r = 0; r < 4; ++r) { const int i = i0 + r; const bool keep = (o < 2) ? (i < t) : (i <= t); if (!keep) acc[r] = 0.f; }
                        diag_flag(p, nonfin4(acc), 4u);
                        if (o == 0) *(f32x4*)(cb + O_L + t * 144 + i0 * 4) = acc;
                        else { u32x2 w; w.x = pg8::cvt_pk_bf16(acc[0], acc[1]); w.y = pg8::cvt_pk_bf16(acc[2], acc[3]);
                               if (o == 2) *(u32x2*)(cb + O_AP + t * P_KT + (8 * g + 4 * ti) * 2) = w;
                               else *(u32x2*)(cb + (o == 1 ? O_B2 : O_BP) + t * P_KT + i0 * 2) = w; }
                    }
                }
            }
            RS_SYNC();
            REPEAT(REP_SC) {
            const int tid = wv * 64 + lane_fresh();
            if (tid < 64) {
                const int q = tid >> 5, d = (tid >> 4) & 1, j = tid & 15; unsigned char* cb = lds + q * CHUNK_BYTES;
                float x[16];
#pragma unroll
                for (int i = 0; i < 16; ++i) x[i] = (i == j) ? 1.f : 0.f;
                const unsigned char* Lb = cb + O_L + (16 * d) * 144 + (16 * d) * 4;
                f32x4 Lr[16][4];
#define RS_LROWS(lo, hi) do { _Pragma("unroll") for (int tl = (lo); tl < (hi); ++tl) { _Pragma("unroll") for (int c4 = 0; c4 < (tl + 3) / 4; ++c4) Lr[tl][c4] = *(const f32x4*)(Lb + tl * 144 + c4 * 16); } \
            asm volatile("s_waitcnt lgkmcnt(0)" ::: "memory"); __builtin_amdgcn_sched_barrier(0); } while (0)
#define RS_LSOLVE(lo, hi) do { _Pragma("unroll") for (int tl = (lo); tl < (hi); ++tl) { float s4[4] = {0.f, 0.f, 0.f, 0.f}; \
            _Pragma("unroll") for (int il = 0; il < tl; ++il) s4[il & 3] += Lr[tl][il >> 2][il & 3] * x[il]; \
            const float s = (s4[0] + s4[1]) + (s4[2] + s4[3]); x[tl] = (tl > j) ? -s : x[tl]; } } while (0)
                RS_LROWS(1, 10); RS_LSOLVE(1, 10);
                RS_LROWS(10, 16); RS_LSOLVE(10, 16);
#undef RS_LROWS
#undef RS_LSOLVE
#pragma unroll
                for (int tl = 0; tl < 16; ++tl) { *(float*)(cb + O_X + (16 * d + tl) * 144 + (16 * d + j) * 4) = x[tl]; diag_flag(p, nonfin(x[tl]) || fabsf(x[tl]) > 1e6f, 8u); }
            }
            if (filler) { RS_FILL_STORE(); RS_FILL_LOAD(((int)blockIdx.x * 4 + (wv - 4)) * 64 + sc * 2); }
            RS_SYNC();
            {
                const int q = tid >> 8, tl = (tid >> 4) & 15, jl = tid & 15; unsigned char* cb = lds + q * CHUNK_BYTES;
                const float* Lr = (const float*)(cb + O_L + (16 + tl) * 144);
                float s = 0.f;
#pragma unroll
                for (int i = 0; i < 16; ++i) s += Lr[i] * *(const float*)(cb + O_X + i * 144 + jl * 4);
                *(float*)(cb + O_X + tl * 144 + (16 + jl) * 4) = s;
            }
            RS_SYNC();
            {
                const int q = tid >> 8, tl = (tid >> 4) & 15, jl = tid & 15; unsigned char* cb = lds + q * CHUNK_BYTES;
                float s = 0.f;
#pragma unroll
                for (int i = 0; i < 16; ++i) s += *(const float*)(cb + O_X + (16 + tl) * 144 + (16 + i) * 4) * *(const float*)(cb + O_X + i * 144 + (16 + jl) * 4);
                diag_flag(p, nonfin(s), 16u);
                const int p0 = 8 * (jl >> 2) + (jl & 3), p1 = p0 + 4;
                *(bf16_t*)(cb + O_NT + (16 + tl) * P_KT + p0 * 2) = f2bf(s);
                *(bf16_t*)(cb + O_NT + tl * P_KT + p0 * 2) = f2bf(-*(const float*)(cb + O_X + tl * 144 + jl * 4));
                *(bf16_t*)(cb + O_NT + (16 + tl) * P_KT + p1 * 2) = f2bf(-*(const float*)(cb + O_X + (16 + tl) * 144 + (16 + jl) * 4));
                *(bf16_t*)(cb + O_NT + tl * P_KT + p1 * 2) = (bf16_t)0;
            }
            RS_SYNC();
            }
            if (wv < 4) REPEAT(REP_SD) {
                const int lnd = lane_fresh(), l15 = lnd & 15, g = lnd >> 4;
                f32x4 St[4] = {S4[0], S4[1], S4[2], S4[3]};
#pragma unroll 1
                for (int q = 0; q < 2; ++q) {
                    const unsigned char* cb = lds + q * CHUNK_BYTES;
                    bf16x8 fKH[2][2], fRH[2][2], fB2[2], fNT[2], fAP[2], fBP[2], fBG[4], fKDG[4]; f32x4 fG[4];
                    const bf16x8 vm = *(const bf16x8*)(cb + O_VM + (16 * wv + l15) * P_KT + 16 * g);
#pragma unroll
                    for (int ct = 0; ct < 2; ++ct) {
#pragma unroll
                        for (int s = 0; s < 2; ++s) fKH[ct][s] = *(const bf16x8*)(cb + O_KH + (16 * ct + l15) * P_TK + (32 * s + 8 * g) * 2);
                        fB2[ct] = *(const bf16x8*)(cb + O_B2 + (16 * ct + l15) * P_KT + 16 * g);
                        fNT[ct] = *(const bf16x8*)(cb + O_NT + (16 * ct + l15) * P_KT + 16 * g);
                    }
                    asm volatile("s_waitcnt lgkmcnt(0)" ::: "memory");
                    __builtin_amdgcn_sched_barrier(0);
                    bf16x8 sb[2]; sb[0] = cvt8(St[0], St[1]); sb[1] = cvt8(St[2], St[3]);
                    f32x4 w2[2];
#pragma unroll
                    for (int ct = 0; ct < 2; ++ct) {
                        f32x4 acc = (f32x4){0.f, 0.f, 0.f, 0.f};
                        acc = __builtin_amdgcn_mfma_f32_16x16x32_bf16(fKH[ct][0], sb[0], acc, 0, 0, 0);
                        acc = __builtin_amdgcn_mfma_f32_16x16x32_bf16(fKH[ct][1], sb[1], acc, 0, 0, 0);
                        acc = __builtin_amdgcn_mfma_f32_16x16x32_bf16(fB2[ct], vm, acc, 0, 0, 0);
                        w2[ct] = acc;
                    }
                    __builtin_amdgcn_sched_barrier(0);
#pragma unroll
                    for (int kt = 0; kt < 4; ++kt) {
                        fG[kt] = *(const f32x4*)(cb + O_GAM + (16 * kt + 4 * g) * 4);
                        fBG[kt] = *(const bf16x8*)(cb + O_BG + (16 * kt + l15) * P_KT + 16 * g);
                        fKDG[kt] = *(const bf16x8*)(cb + O_KDG + (16 * kt + l15) * P_KT + 16 * g);
                    }
                    __builtin_amdgcn_sched_barrier(0);
                    diag_flag(p, nonfin4(w2[0]) || nonfin4(w2[1]), 32u);
                    const bf16x8 wb = cvt8(w2[0], w2[1]);
                    f32x4 u2[2];
#pragma unroll
                    for (int ct = 0; ct < 2; ++ct) u2[ct] = __builtin_amdgcn_mfma_f32_16x16x32_bf16(fNT[ct], wb, (f32x4){0.f, 0.f, 0.f, 0.f}, 0, 0, 0);
                    diag_flag(p, nonfin4(u2[0]) || nonfin4(u2[1]), 64u);
                    const bf16x8 ub = cvt8(u2[0], u2[1]);
                    __builtin_amdgcn_sched_barrier(0);
#pragma unroll
                    for (int ct = 0; ct < 2; ++ct) {
#pragma unroll
                        for (int s = 0; s < 2; ++s) fRH[ct][s] = *(const bf16x8*)(cb + O_RH + (16 * ct + l15) * P_TK + (32 * s + 8 * g) * 2);
                        fBP[ct] = *(const bf16x8*)(cb + O_BP + (16 * ct + l15) * P_KT + 16 * g);
                        fAP[ct] = *(const bf16x8*)(cb + O_AP + (16 * ct + l15) * P_KT + 16 * g);
                    }
                    asm volatile("s_waitcnt lgkmcnt(8)" ::: "memory");
                    __builtin_amdgcn_sched_barrier(0);
#pragma unroll
                    for (int kt = 0; kt < 4; ++kt) {
                        f32x4 acc = St[kt] * fG[kt];
                        acc = __builtin_amdgcn_mfma_f32_16x16x32_bf16(fBG[kt], ub, acc, 0, 0, 0);
                        acc = __builtin_amdgcn_mfma_f32_16x16x32_bf16(fKDG[kt], vm, acc, 0, 0, 0);
                        St[kt] = acc; diag_flag(p, nonfin4(acc), 256u);
                    }
                    asm volatile("s_waitcnt lgkmcnt(0)" ::: "memory");
                    __builtin_amdgcn_sched_barrier(0);
#pragma unroll
                    for (int tt = 0; tt < 2; ++tt) {
                        f32x4 acc = (f32x4){0.f, 0.f, 0.f, 0.f};
                        acc = __builtin_amdgcn_mfma_f32_16x16x32_bf16(fRH[tt][0], sb[0], acc, 0, 0, 0);
                        acc = __builtin_amdgcn_mfma_f32_16x16x32_bf16(fRH[tt][1], sb[1], acc, 0, 0, 0);
                        acc = __builtin_amdgcn_mfma_f32_16x16x32_bf16(fAP[tt], ub, acc, 0, 0, 0);
                        acc = __builtin_amdgcn_mfma_f32_16x16x32_bf16(fBP[tt], vm, acc, 0, 0, 0);
                        diag_flag(p, nonfin4(acc), 128u);
                        float* yb = (float*)(lds + O_YB) + (q * 32 + 16 * tt + 4 * g) * YB_PITCH + 16 * wv + l15;
#pragma unroll
                        for (int r = 0; r < 4; ++r) yb[r * YB_PITCH] = acc[r];
                    }
                }
                if (LASTREP(REP_SD)) { S4[0] = St[0]; S4[1] = St[1]; S4[2] = St[2]; S4[3] = St[3]; }
            }
            else if (filler) {
                RS_FILL_STORE();
                RS_FILL_LOAD(((int)blockIdx.x * 4 + (wv - 4)) * 64 + sc * 2 + 1);
            }
            RS_SYNC();
            const int tido = wv * 64 + lane_fresh();
#pragma unroll
            for (int jj = 0; jj < 4; ++jj) {
                const int idx = tido + jj * NTHR, i = idx >> 5, v2 = idx & 31;
                const int step = sc * 64 + i, t = z ? (S - 1 - step) : step;
                const float2 yv = *(const float2*)((const float*)(lds + O_YB) + i * YB_PITCH + 2 * v2);
                if (var != 3) *(unsigned*)(YS + (size_t)z * T * D + ((size_t)b * S + t) * D + h * HD + 2 * v2) = pg8::cvt_pk_bf16(yv.x, yv.y);
            }
        }
        if (filler) RS_FILL_STORE();
        RS_SYNC();
    }
    __syncthreads();
}
#undef RS_SYNC
struct SchedBase { int G, c; };
struct SchedProj : SchedBase {
    const char* XM; const char* Wrkv; const char* L1t;
    __device__ __forceinline__ bool next(int i, pg8::Unit& u) const {
        const int L = i * G + c; if (L >= 960) return false;
        if (L < 768) {
            if (G == 256) { const int x = c & 7, j = c >> 3; u.job = i; u.pm = 8 * x + (j & 7); u.pn = j >> 3; }
            else { u.job = L >> 8; const int r = L & 255; u.pm = r >> 2; u.pn = r & 3; }
            u.B = Wrkv + ((size_t)u.job * 1024 + u.pn * 256) * 1024 * 2; }
        else { const int r = L - 768; u.job = 3 + r / 64; u.pm = r % 64; u.pn = 0; u.B = L1t + (size_t)(u.job - 3) * 256 * 1024 * 2; }
        u.A = XM + ((size_t)u.job * T + (size_t)u.pm * 256) * D * 2;
        return true;
    }
};
struct SchedLora2 : SchedBase {
    const char* L1b; const char* L2t;
    __device__ __forceinline__ bool next(int i, pg8::Unit& u) const {
        const int L = i * G + c; if (L >= 1280) return false;
        if (G == 256) { const int x = c & 7, j = c >> 3; u.job = i; u.pm = 8 * x + (j & 7); u.pn = j >> 3; }
        else { u.job = L >> 8; const int r = L & 255; u.pm = r >> 2; u.pn = r & 3; }
        u.A = L1b + ((size_t)u.pm * 256 * 512 + (u.job == 4 ? 256 : 0)) * 2;
        u.B = L2t + ((size_t)u.job * 1024 + u.pn * 256) * 256 * 2;
        return true;
    }
};
struct SchedPlain : SchedBase {
    const char* A; const char* B; int nN, lda, ldb;
    __device__ __forceinline__ bool next(int i, pg8::Unit& u) const {
        const int L = i * G + c; if (L >= 64 * nN) return false;
        u.job = 0;
        if (G == 256) { const int x = c & 7, j = c >> 3; u.pm = 8 * x + (j & 7); u.pn = 4 * i + (j >> 3); }
        else { u.pm = L / nN; u.pn = L % nN; }
        u.A = A + (size_t)u.pm * 256 * lda * 2; u.B = B + (size_t)u.pn * 256 * ldb * 2;
        return true;
    }
};
struct SchedLruGate : SchedBase {
    const char* UCB; const char* Wg;
    __device__ __forceinline__ bool next(int i, pg8::Unit& u) const {
        const int L = i * G + c; if (L >= 1024) return false;
        u.job = L >> 6; u.pm = L & 63; u.pn = 0;
        u.A = UCB + ((size_t)u.pm * 256 * D + ((u.job >> 1) & 3) * 256) * 2; u.B = Wg + (size_t)u.job * 256 * 256 * 2;
        return true;
    }
};
struct SchedMoe1 : SchedBase {
    const char* XIN; const char* Wgu;
    __device__ __forceinline__ bool next(int i, pg8::Unit& u) const {
        const int L = i * G + c; if (L >= 2048) return false;
        if (G == 256) { const int x = c & 7, j = c >> 3, xq = x & 3; u.job = 2 * i + (x >> 2); u.pm = (xq & 1) * 4 + (j & 3); u.pn = (xq >> 1) * 8 + (j >> 2); }
        else { u.job = L >> 7; const int r = L & 127; u.pm = r & 7; u.pn = r >> 3; }
        u.A = XIN + ((size_t)u.job * 2048 + u.pm * 256) * D * 2; u.B = Wgu + ((size_t)u.job * 4096 + u.pn * 256) * D * 2;
        return true;
    }
};
struct SchedMoe2 : SchedBase {
    const char* HID; const char* Wdn;
    __device__ __forceinline__ bool next(int i, pg8::Unit& u) const {
        const int L = i * G + c; if (L >= 512) return false;
        if (G == 256) { const int x = c & 7, j = c >> 3; u.job = 8 * i + x; u.pm = j & 7; u.pn = j >> 3; }
        else { u.job = L >> 5; const int r = L & 31; u.pm = r & 7; u.pn = r >> 3; }
        u.A = HID + ((size_t)u.job * 2048 + u.pm * 256) * FF * 2; u.B = Wdn + ((size_t)u.job * 1024 + u.pn * 256) * FF * 2;
        return true;
    }
};

#define EPI_ARGS const pg8::f32x4 (&acc)[2][2][4][2], const pg8::Unit& u, int wr, int wc, int fr, int fq
#define EPI_ROWS for (int ai = 0; ai < 2; ++ai) _Pragma("unroll") for (int m = 0; m < 4; ++m)
#define EPI_COLS for (int bj = 0; bj < 2; ++bj) _Pragma("unroll") for (int n = 0; n < 2; ++n)
struct EpiProj {
    static constexpr bool PERM = true;
    bf16_t* RKVb; bf16_t* L1b;
    __device__ __forceinline__ void operator()(EPI_ARGS) const {
        const int row0 = u.pm * 256 + wr * 64 + fr;
        if (u.job < 3) {
            bf16_t* C = RKVb + (size_t)u.job * T * D; const int col0 = u.pn * 256 + wc * 32 + 8 * fq;
#pragma unroll
            EPI_ROWS { bf16_t* rowp = C + (size_t)(row0 + ai * 128 + m * 16) * D + col0;
#pragma unroll
                for (int bj = 0; bj < 2; ++bj) { const pg8::f32x4 v0 = acc[ai][bj][m][0], v1 = acc[ai][bj][m][1]; pg8::u32x4 w;
                    w.x = pg8::cvt_pk_bf16(v0[0], v0[1]); w.y = pg8::cvt_pk_bf16(v0[2], v0[3]); w.z = pg8::cvt_pk_bf16(v1[0], v1[1]); w.w = pg8::cvt_pk_bf16(v1[2], v1[3]);
                    *(pg8::u32x4*)(rowp + bj * 128) = w; } }
        } else {
            const int col0 = (u.job - 3) * 128 + wc * 32 + 8 * fq; const int act = u.job;
#pragma unroll
            EPI_ROWS { bf16_t* rowp = L1b + (size_t)(row0 + ai * 128 + m * 16) * 512 + col0;
                pg8::f32x4 v0 = acc[ai][0][m][0], v1 = acc[ai][0][m][1];
                if (act == 3) {
#pragma unroll
                    for (int j = 0; j < 4; ++j) { v0[j] = tanhf_(v0[j]); v1[j] = tanhf_(v1[j]); } }
                else if (act == 5) {
#pragma unroll
                    for (int j = 0; j < 4; ++j) { v0[j] = sigmoidf_(v0[j]); v1[j] = sigmoidf_(v1[j]); } }
                pg8::u32x4 w; w.x = pg8::cvt_pk_bf16(v0[0], v0[1]); w.y = pg8::cvt_pk_bf16(v0[2], v0[3]); w.z = pg8::cvt_pk_bf16(v1[0], v1[1]); w.w = pg8::cvt_pk_bf16(v1[2], v1[3]);
                *(pg8::u32x4*)rowp = w;
                if (act == 5) { pg8::u32x4 zz; zz.x = 0u; zz.y = 0u; zz.z = 0u; zz.w = 0u; *(pg8::u32x4*)(rowp + 128) = zz; }
            }
        }
    }
};
struct EpiLora2 {
    static constexpr bool PERM = true;
    bf16_t* WDL; bf16_t* AAb; bf16_t* GGb; const float* w0; const float* a0;
    __device__ __forceinline__ void operator()(EPI_ARGS) const {
        const int row0 = u.pm * 256 + wr * 64 + fr, col0 = u.pn * 256 + wc * 32 + 8 * fq, job = u.job;
        bf16_t* C = job < 2 ? WDL + (size_t)job * T * D : (job < 4 ? AAb + (size_t)(job - 2) * T * D : GGb);
        const float* bias = job < 2 ? w0 + job * D : a0 + (job < 4 ? job - 2 : 0) * D;
        const float sc = job < 2 ? -0.6065306597126334f : 1.0f;
#pragma unroll
        for (int bj = 0; bj < 2; ++bj) {
            const pg8::f32x4 b0 = *(const pg8::f32x4*)(bias + col0 + bj * 128), b1 = *(const pg8::f32x4*)(bias + col0 + bj * 128 + 4);
#pragma unroll
            EPI_ROWS { pg8::f32x4 v0 = acc[ai][bj][m][0], v1 = acc[ai][bj][m][1];
                if (job < 4) { v0 = v0 + b0; v1 = v1 + b1;
#pragma unroll
                    for (int j = 0; j < 4; ++j) { v0[j] = sc * sigmoidf_(v0[j]); v1[j] = sc * sigmoidf_(v1[j]); } }
                pg8::u32x4 w; w.x = pg8::cvt_pk_bf16(v0[0], v0[1]); w.y = pg8::cvt_pk_bf16(v0[2], v0[3]); w.z = pg8::cvt_pk_bf16(v1[0], v1[1]); w.w = pg8::cvt_pk_bf16(v1[2], v1[3]);
                *(pg8::u32x4*)(C + (size_t)(row0 + ai * 128 + m * 16) * D + col0 + bj * 128) = w; }
        }
    }
};
struct EpiStoreF32 {
    static constexpr bool PERM = false;
    float* C; int ldc;
    __device__ __forceinline__ void operator()(EPI_ARGS) const {
        const int row0 = u.pm * 256 + wr * 64 + fr, col0 = u.pn * 256 + wc * 32 + 4 * fq;
#pragma unroll
        EPI_ROWS { float* rowp = C + (size_t)(row0 + ai * 128 + m * 16) * ldc + col0;
#pragma unroll
            EPI_COLS *(pg8::f32x4*)(rowp + bj * 128 + n * 16) = acc[ai][bj][m][n]; }
    }
};
struct EpiAddX {
    static constexpr bool PERM = false;
    float* X;
    __device__ __forceinline__ void operator()(EPI_ARGS) const {
        const int row0 = u.pm * 256 + wr * 64 + fr, col0 = u.pn * 256 + wc * 32 + 4 * fq;
#pragma unroll
        EPI_ROWS { float* rowp = X + (size_t)(row0 + ai * 128 + m * 16) * D + col0;
#pragma unroll
            EPI_COLS { pg8::f32x4* q = (pg8::f32x4*)(rowp + bj * 128 + n * 16); *q = *q + acc[ai][bj][m][n]; } }
    }
};
struct EpiLruGate {
    static constexpr bool PERM = true;
    bf16_t* LA; bf16_t* LB; const bf16_t* UCB; const float* ba; const float* bx; const float* lam;
    __device__ __forceinline__ void operator()(EPI_ARGS) const {
        const int z = u.job >> 3, h = (u.job >> 1) & 3, half = u.job & 1;
        const int row0 = u.pm * 256 + wr * 64 + fr, c0 = h * 256 + half * 128 + wc * 32 + 8 * fq;
        bf16_t* la = LA + (size_t)z * T * D; bf16_t* lb = LB + (size_t)z * T * D;
#pragma unroll
        for (int n = 0; n < 2; ++n) {
            const int c4 = c0 + 4 * n;
            const pg8::f32x4 lm = *(const pg8::f32x4*)(lam + z * D + c4), ba4 = *(const pg8::f32x4*)(ba + z * D + c4), bx4 = *(const pg8::f32x4*)(bx + z * D + c4);
            pg8::f32x4 sp4;
#pragma unroll
            for (int j = 0; j < 4; ++j) sp4[j] = -8.0f * softplusf_(-lm[j]);
#pragma unroll
            EPI_ROWS { const size_t o = (size_t)(row0 + ai * 128 + m * 16) * D + c4;
                const uint2 uu = *(const uint2*)(UCB + o); float uv[4]; bf4_to_f(uu, uv);
                float lo[4], bo[4];
#pragma unroll
                for (int j = 0; j < 4; ++j) { const float ra = acc[ai][0][m][n][j] + ba4[j], ix = acc[ai][1][m][n][j] + bx4[j];
                    const float l = sp4[j] * sigmoidf_(ra); lo[j] = l; const float x2 = 2.0f * l;   const float om = -x2 * (1.0f + x2 * (0.5f + x2 * (0.16666667f + x2 * (0.041666668f + x2 * 0.008333334f)))); bo[j] = __builtin_amdgcn_sqrtf(fmaxf(om, 0.f)) * sigmoidf_(ix) * uv[j]; }
                pg8::u32x2 w; w.x = pg8::cvt_pk_bf16(lo[0], lo[1]); w.y = pg8::cvt_pk_bf16(lo[2], lo[3]); *(pg8::u32x2*)(la + o) = w;
                w.x = pg8::cvt_pk_bf16(bo[0], bo[1]); w.y = pg8::cvt_pk_bf16(bo[2], bo[3]); *(pg8::u32x2*)(lb + o) = w; }
        }
    }
};
struct EpiSwiglu {
    static constexpr bool PERM = true;
    bf16_t* HID;
    __device__ __forceinline__ void operator()(EPI_ARGS) const {
        bf16_t* base = HID + (size_t)u.job * 2048 * FF; const int row0 = u.pm * 256 + wr * 64 + fr, col0 = u.pn * 128 + wc * 32 + 8 * fq;
#pragma unroll
        EPI_ROWS { float o[8];
#pragma unroll
            for (int n = 0; n < 2; ++n)
#pragma unroll
                for (int j = 0; j < 4; ++j) { const float gt = acc[ai][0][m][n][j], up = acc[ai][1][m][n][j]; o[n * 4 + j] = gt * sigmoidf_(gt) * up; }
            pg8::u32x4 w; w.x = pg8::cvt_pk_bf16(o[0], o[1]); w.y = pg8::cvt_pk_bf16(o[2], o[3]); w.z = pg8::cvt_pk_bf16(o[4], o[5]); w.w = pg8::cvt_pk_bf16(o[6], o[7]);
            *(pg8::u32x4*)(base + (size_t)(row0 + ai * 128 + m * 16) * FF + col0) = w; }
    }
};
struct EpiDown {
    static constexpr bool PERM = true;
    bf16_t* YEXP; const float* GATE;
    __device__ __forceinline__ void operator()(EPI_ARGS) const {
        const int row0 = u.pm * 256 + wr * 64 + fr, col0 = u.pn * 256 + wc * 32 + 8 * fq;
        bf16_t* C = YEXP + (size_t)u.job * 2048 * D; const float* gt = GATE + (size_t)u.job * 2048;
#pragma unroll
        EPI_ROWS { const int row = row0 + ai * 128 + m * 16; const float gs = gt[row];
#pragma unroll
            for (int bj = 0; bj < 2; ++bj) { const pg8::f32x4 v0 = acc[ai][bj][m][0] * gs, v1 = acc[ai][bj][m][1] * gs; pg8::u32x4 w;
                w.x = pg8::cvt_pk_bf16(v0[0], v0[1]); w.y = pg8::cvt_pk_bf16(v0[2], v0[3]); w.z = pg8::cvt_pk_bf16(v1[0], v1[1]); w.w = pg8::cvt_pk_bf16(v1[2], v1[3]);
                *(pg8::u32x4*)(C + (size_t)row * D + col0 + bj * 128) = w; } }
    }
};
struct EpiStoreBf16 {
    static constexpr bool PERM = true;
    bf16_t* O; int ldc;
    __device__ __forceinline__ void operator()(EPI_ARGS) const {
        const int row0 = u.pm * 256 + wr * 64 + fr, col0 = u.pn * 256 + wc * 32 + 8 * fq;
#pragma unroll
        EPI_ROWS { bf16_t* rowp = O + (size_t)(row0 + ai * 128 + m * 16) * ldc + col0;
#pragma unroll
            for (int bj = 0; bj < 2; ++bj) { const pg8::f32x4 v0 = acc[ai][bj][m][0], v1 = acc[ai][bj][m][1]; pg8::u32x4 w;
                w.x = pg8::cvt_pk_bf16(v0[0], v0[1]); w.y = pg8::cvt_pk_bf16(v0[2], v0[3]); w.z = pg8::cvt_pk_bf16(v1[0], v1[1]); w.w = pg8::cvt_pk_bf16(v1[2], v1[3]);
                *(pg8::u32x4*)(rowp + bj * 128) = w; } }
    }
};

struct RmId { __device__ __forceinline__ int operator()(int n) const { return n; } };
struct RmGU { int off; __device__ __forceinline__ int operator()(int n) const { return ((n >> 7) << 8) + off + (n & 127); } };
template <class RM>
__device__ __forceinline__ void tconv(const int wv, const float* W, int ldw, int K, int N, bf16_t* dst, int ldb, int koff, const RM rm, float* lds, int& rot) {
    const int tid = TID, G = gridDim.x, tn = N >> 7, ntiles = (K >> 6) * tn;
    const int lr = tid >> 5, lc = (tid & 31) * 4;
    const int sn = tid >> 3, sk = (tid & 7) * 8;
    int t = (int)(((unsigned)blockIdx.x + (unsigned)G - (unsigned)(rot % G)) % (unsigned)G);
    float4 cur[4], nx[4];
    if (t < ntiles) { const int k0 = (t / tn) << 6, n0 = (t % tn) << 7;
#pragma unroll
        for (int i = 0; i < 4; ++i) { const pg8::f32x4 t4 = __builtin_nontemporal_load((const pg8::f32x4*)(W + (size_t)(k0 + lr + 16 * i) * ldw + n0 + lc)); cur[i] = make_float4(t4[0], t4[1], t4[2], t4[3]); } }
    for (; t < ntiles; t += G) {
        const int k0 = (t / tn) << 6, n0 = (t % tn) << 7; const int t2 = t + G;
        if (t2 < ntiles) { const int k2 = (t2 / tn) << 6, n2 = (t2 % tn) << 7;
#pragma unroll
            for (int i = 0; i < 4; ++i) { const pg8::f32x4 t4 = __builtin_nontemporal_load((const pg8::f32x4*)(W + (size_t)(k2 + lr + 16 * i) * ldw + n2 + lc)); nx[i] = make_float4(t4[0], t4[1], t4[2], t4[3]); } }
        __syncthreads();
#pragma unroll
        for (int i = 0; i < 4; ++i) { float* q = lds + (lr + 16 * i) * 129 + lc; q[0] = cur[i].x; q[1] = cur[i].y; q[2] = cur[i].z; q[3] = cur[i].w; }
        __syncthreads();
#pragma unroll
        for (int i = 0; i < 2; ++i) { const int n = sn + 64 * i; float f[8];
#pragma unroll
            for (int j = 0; j < 8; ++j) f[j] = lds[(sk + j) * 129 + n];
            pg8::u32x4 w; w.x = pg8::cvt_pk_bf16(f[0], f[1]); w.y = pg8::cvt_pk_bf16(f[2], f[3]); w.z = pg8::cvt_pk_bf16(f[4], f[5]); w.w = pg8::cvt_pk_bf16(f[6], f[7]);
            *(pg8::u32x4*)(dst + (size_t)rm(n0 + n) * ldb + koff + k0 + sk) = w; }
#pragma unroll
        for (int i = 0; i < 4; ++i) cur[i] = nx[i];
    }
    rot += ntiles;
}
__device__ __forceinline__ void tconv_small(const int wv, const float* W, int K, int N, bf16_t* dst, int ldb, int noff) {
    for (int i = blockIdx.x * NTHR + TID; i < K * N; i += gridDim.x * NTHR) { const int k = i / N, n = i - k * N; dst[(size_t)(n + noff) * ldb + k] = f2bf(W[i]); }
}
__device__ __forceinline__ void zfill(const int wv, bf16_t* dst, int ldb, int r0, int r1, int c0, int c1) {
    const int w8 = (c1 - c0) >> 3, tot = (r1 - r0) * w8;
    for (int i = blockIdx.x * NTHR + TID; i < tot; i += gridDim.x * NTHR) { const int r = r0 + i / w8, c = c0 + (i % w8) * 8; *(uint4*)(dst + (size_t)r * ldb + c) = make_uint4(0u, 0u, 0u, 0u); }
}
__device__ __forceinline__ void ph_prologue(const int wv, const P& p, float* lds) {
    int rot = 0;
    unsigned char* ws = p.ws;
    for (int L = 0; L < DEPTH; ++L) {
        if (gridDim.x == 256 && (L % 3) == 0) continue;
        for (int e = 0; e < NE; ++e) {
            bf16_t* gu = (bf16_t*)(ws + WB_MOE + (size_t)L * MOE_STRIDE + MOE_GU) + (size_t)e * 4096 * D;
            bf16_t* dn = (bf16_t*)(ws + WB_MOE + (size_t)L * MOE_STRIDE + MOE_DN) + (size_t)e * D * FF;
            RmGU rg; rg.off = 0; RmGU ru; ru.off = 128;
            tconv(wv, p.in[I_WG] + ((size_t)L * NE + e) * D * FF, FF, D, FF, gu, D, 0, rg, lds, rot);
            tconv(wv, p.in[I_WU] + ((size_t)L * NE + e) * D * FF, FF, D, FF, gu, D, 0, ru, lds, rot);
            tconv(wv, p.in[I_WDN] + ((size_t)L * NE + e) * FF * D, D, FF, D, dn, FF, 0, RmId(), lds, rot);
        }
    }
    for (int ia = 0; ia < 2; ++ia) {
        unsigned char* rb = ws + WB_RW + (size_t)ia * RW_STRIDE;
        for (int q = 0; q < 3; ++q) tconv(wv, p.in[I_WIN] + ((size_t)ia * 3 + q) * D * D, D, D, D, (bf16_t*)(rb + RW_RKV) + (size_t)q * D * D, D, 0, RmId(), lds, rot);
        tconv(wv, p.in[I_WOUT] + (size_t)ia * D * D, D, D, D, (bf16_t*)(rb + RW_OUT), D, 0, RmId(), lds, rot);
        bf16_t* l1 = (bf16_t*)(rb + RW_L1);
        for (int z = 0; z < 2; ++z) { tconv_small(wv, p.in[I_W1] + ((size_t)ia * 2 + z) * D * 64, D, 64, l1, D, z * 64); tconv_small(wv, p.in[I_A1] + ((size_t)ia * 2 + z) * D * 64, D, 64, l1 + 256 * D, D, z * 64); }
        tconv(wv, p.in[I_G1] + (size_t)ia * D * 128, 128, D, 128, l1 + 2 * 256 * D, D, 0, RmId(), lds, rot);
        for (int q = 0; q < 3; ++q) zfill(wv, l1 + (size_t)q * 256 * D, D, 128, 256, 0, D);
        bf16_t* l2 = (bf16_t*)(rb + RW_L2);
        for (int z = 0; z < 2; ++z) {
            tconv(wv, p.in[I_W2] + ((size_t)ia * 2 + z) * 64 * D, D, 64, D, l2 + (size_t)z * 1024 * 256, 256, z * 64, RmId(), lds, rot);
            tconv(wv, p.in[I_A2] + ((size_t)ia * 2 + z) * 64 * D, D, 64, D, l2 + (size_t)(2 + z) * 1024 * 256, 256, 128 + z * 64, RmId(), lds, rot);
        }
        tconv(wv, p.in[I_G2] + (size_t)ia * 128 * D, D, 128, D, l2 + (size_t)4 * 1024 * 256, 256, 0, RmId(), lds, rot);
        for (int j = 0; j < 4; ++j) { const int k0 = j * 64; if (k0 > 0) zfill(wv, l2 + (size_t)j * 1024 * 256, 256, 0, 1024, 0, k0); if (k0 + 64 < 256) zfill(wv, l2 + (size_t)j * 1024 * 256, 256, 0, 1024, k0 + 64, 256); }
        zfill(wv, l2 + (size_t)4 * 1024 * 256, 256, 0, 1024, 128, 256);
    }
    tconv(wv, p.in[I_SCIN], 3 * D, D, 3 * D, (bf16_t*)(ws + WB_SC + SC_IN), D, 0, RmId(), lds, rot);
    tconv(wv, p.in[I_SCOUT], D, D, D, (bf16_t*)(ws + WB_SC + SC_OUT), D, 0, RmId(), lds, rot);
    tconv(wv, p.in[I_LIN], 2 * D, D, 2 * D, (bf16_t*)(ws + WB_LRU + LRU_IN), D, 0, RmId(), lds, rot);
    tconv(wv, p.in[I_LOUT], D, D, D, (bf16_t*)(ws + WB_LRU + LRU_OUT), D, 0, RmId(), lds, rot);
    for (int zh = 0; zh < 8; ++zh) {
        bf16_t* gt = (bf16_t*)(ws + WB_LRU + LRU_G) + (size_t)zh * 2 * 256 * 256;
        RmGU ra; ra.off = 0; RmGU rx; rx.off = 128;
        tconv(wv, p.in[I_LWA] + (size_t)zh * 256 * 256, 256, 256, 256, gt, 256, 0, ra, lds, rot);
        tconv(wv, p.in[I_LWX] + (size_t)zh * 256 * 256, 256, 256, 256, gt, 256, 0, rx, lds, rot);
    }
}


#define XB_TMO      128
#define XB_XCNT(j)  (256  + 64 * (j))
#define XB_XSUB(j)  (1280 + 64 * (j))
#define XB_XGEN(j)  (2304 + 64 * (j))
#define XB_TOP      3328
#define XB_TOPGEN   3392
#define XCD_BAR_WORDS 3456
#define XB_SPIN_CAP (1u << 22)
#define LAS __attribute__((address_space(3)))
__device__ __forceinline__ unsigned xb_ld(unsigned* p)              { return __hip_atomic_load(p, __ATOMIC_RELAXED, __HIP_MEMORY_SCOPE_AGENT); }
__device__ __forceinline__ unsigned xb_add(unsigned* p, unsigned v) { return __hip_atomic_fetch_add(p, v, __ATOMIC_RELAXED, __HIP_MEMORY_SCOPE_AGENT); }
__device__ __forceinline__ unsigned xb_xcc_id() { return (unsigned)__builtin_amdgcn_s_getreg((3 << 11) | 20) & 0xFu; }
#define XB_SPIN(cond, bar) do { unsigned _sp = 0; while (cond) { __builtin_amdgcn_s_sleep(1); \
    if ((++_sp & 255u) == 0u) { if (xb_ld(&(bar)[XB_TMO])) break; if (_sp > XB_SPIN_CAP) { atomicAdd(&(bar)[XB_TMO], 1u); break; } } } } while (0)
struct XcdBarrier { unsigned* bar; unsigned x; volatile LAS unsigned* st; };
__device__ __forceinline__ XcdBarrier xcd_barrier_post(const int wv, unsigned* bar, volatile LAS unsigned* st) {
    XcdBarrier b; b.bar = bar; b.x = xb_xcc_id(); b.st = st;
    if (TID == 0) (void)xb_add(&bar[XB_XCNT(b.x)], 1u);
    return b;
}
__device__ __forceinline__ void xcd_barrier_complete(unsigned* bar, unsigned x, unsigned& nloc, unsigned& nx) {
    const unsigned G = gridDim.x * gridDim.y * gridDim.z;
    unsigned sum, cnt, mine, sp = 0u;
    for (;;) {
        sum = 0u; cnt = 0u; mine = 0u;
#pragma unroll
        for (unsigned j = 0; j < 16; ++j) { const unsigned c = xb_ld(&bar[XB_XCNT(j)]); sum += c; cnt += (c > 0u) ? 1u : 0u; mine = (j == x) ? c : mine; }
        if (sum == G) break;
        __builtin_amdgcn_s_sleep(1);
        if ((++sp & 255u) == 0u) { if (xb_ld(&bar[XB_TMO])) break; if (sp > XB_SPIN_CAP) { atomicAdd(&bar[XB_TMO], 1u); break; } }
    }
    nloc = mine > 0u ? mine : 1u; nx = cnt > 0u ? cnt : 1u;
}
__device__ __forceinline__ void xcd_barrier(const int wv, const XcdBarrier& b) {
    asm volatile("s_waitcnt vmcnt(0)" ::: "memory");
    __syncthreads();
    if (TID == 0) {
        unsigned* bar = b.bar;
        __builtin_amdgcn_s_waitcnt(0);
        unsigned nloc = b.st[0], nx = b.st[1];
        if (nloc == 0u) { xcd_barrier_complete(bar, b.x, nloc, nx); b.st[0] = nloc; b.st[1] = nx; }
        const unsigned old = xb_add(&bar[XB_XSUB(b.x)], 1u);
        const unsigned gen = old / nloc;
        if (old + 1u == (gen + 1u) * nloc) {
            __builtin_amdgcn_fence(__ATOMIC_RELEASE, "agent");
            asm volatile("s_waitcnt vmcnt(0)" ::: "memory");
            const unsigned og = xb_add(&bar[XB_TOP], 1u);
            const unsigned tg = og / nx;
            if (og + 1u == (tg + 1u) * nx) xb_add(&bar[XB_TOPGEN], 1u);
            else XB_SPIN(xb_ld(&bar[XB_TOPGEN]) == tg, bar);
            __builtin_amdgcn_fence(__ATOMIC_ACQUIRE, "agent");
            xb_add(&bar[XB_XGEN(b.x)], 1u);
            asm volatile("s_waitcnt vmcnt(0)" ::: "memory");
        } else {
            XB_SPIN(xb_ld(&bar[XB_XGEN(b.x)]) == gen, bar);
            __builtin_amdgcn_fence(__ATOMIC_ACQUIRE, "agent");
            asm volatile("s_waitcnt vmcnt(0)" ::: "memory");
        }
    }
    __syncthreads();
}
struct PhaseCtl { XcdBarrier bar; int lo, hi; bool did; };
__device__ __forceinline__ bool phase_enter(const int wv, PhaseCtl& c, int k) {
    if (k < c.lo || k >= c.hi) return false;
    if (c.did) REPEAT(REP_BAR) xcd_barrier(wv, c.bar);
    c.did = true;
    return true;
}

#define DIAG 0
constexpr int CTL_DIAG = 4096;
__device__ __forceinline__ void diag_compare(const int wv, const P& p, const float* A, const float* Bq, size_t n) {
    float e = 0.f, r = 0.f; int bad = 0;
    for (size_t i = (size_t)blockIdx.x * NTHR + TID; i < n; i += (size_t)gridDim.x * NTHR) { const float a = A[i], b = Bq[i]; const float d = a - b; e += d * d; r += a * a; if (!(d == d) || fabsf(d) > 3.0e38f) bad = 1; }
    e = wave_sum(e); r = wave_sum(r); bad = __any(bad);
    if (lane_fresh() == 0) { float* c = (float*)(p.ws + WS_CTL) + CTL_DIAG; atomicAdd(c, e); atomicAdd(c + 1, r); if (bad) atomicAdd((unsigned*)(c + 2), 1u); }
}
__device__ __forceinline__ void diag_delay(const int wv, const P& p) {
    if (blockIdx.x == 0 && TID == 0) {
        float* c = (float*)(p.ws + WS_CTL) + CTL_DIAG;
        const float e = __hip_atomic_load(c, __ATOMIC_RELAXED, __HIP_MEMORY_SCOPE_AGENT), r = __hip_atomic_load(c + 1, __ATOMIC_RELAXED, __HIP_MEMORY_SCOPE_AGENT);
        const unsigned bad = __hip_atomic_load((unsigned*)(c + 2), __ATOMIC_RELAXED, __HIP_MEMORY_SCOPE_AGENT);
        const unsigned mask = __hip_atomic_load((unsigned*)(c + 3), __ATOMIC_RELAXED, __HIP_MEMORY_SCOPE_AGENT);
        float ms;
        if (bad) ms = 12.f; else if (!(r > 0.f)) ms = 14.f; else { const float rel = sqrtf(e / r); float lg = log10f(fmaxf(rel, 1e-8f)) + 8.f; lg = fminf(fmaxf(lg, 0.f), 10.f); ms = 1.f + lg; }
        if (DIAGF) { ms = 1.f; if (mask) ms = 2.f + (float)__ffs(mask); if (bad) ms += 10.f; }
        const unsigned long long t0 = __builtin_amdgcn_s_memrealtime(); const unsigned long long ticks = (unsigned long long)(ms * 100000.f);
        while (__builtin_amdgcn_s_memrealtime() - t0 < ticks) __builtin_amdgcn_s_sleep(32);
    }
}
constexpr int LDS_BYTES = 128 * 1024 + 1024;
constexpr int PH_PER_LAYER = 16, PH_FINAL = 1 + DEPTH * PH_PER_LAYER, PH_TOTAL = PH_FINAL + 1;

#define IN(k) phase_enter(wv, pc, (k))
template <int L>
__device__ __forceinline__ void run_layer(const int wv, const P& p, float* lds, PhaseCtl& pc) {
    constexpr int m = L % 3, base = 1 + L * PH_PER_LAYER, ia = L / 3;
    PG8_LAS unsigned char* glds = (PG8_LAS unsigned char*)lds;
    unsigned char* ws = p.ws;
    float* X = (float*)(ws + (L == 3 ? WS_X2 : WS_X)); bf16_t* H = (bf16_t*)(ws + WS_H);
    float* RKV = (float*)(ws + WS_RKV);
    float* WDp = (float*)(ws + WS_WD); float* AAp = (float*)(ws + WS_AA); float* GG = (float*)(ws + WS_GG);
    SchedBase sb; sb.G = gridDim.x; sb.c = blockIdx.x;
    if constexpr (m == 0) {
        if (IN(base + 0)) REPEAT(REP_NORM_MIX) ph_norm_xm(wv, p, L == 0 ? p.in[I_X] : (const float*)(ws + WS_X), L == 0 ? nullptr : (const bf16_t*)(ws + WS_UCB), X, L > 0, p.in[I_NMG] + L * D, p.in[I_MU] + ia * 6 * D, (unsigned char*)lds);
    } else {
    if (IN(base + 0)) REPEAT(REP_NORM_MIX) ph_norm(wv, p, L == 0 ? p.in[I_X] : X, L == 0 ? nullptr : (const bf16_t*)(ws + WS_UCB), LASTREP(REP_NORM_MIX) ? X : (float*)(ws + WS_YS), L > 0, p.in[I_NMG] + L * D, LASTREP(REP_NORM_MIX) ? H : (bf16_t*)(ws + WS_YS + 64 * MiB), nullptr, nullptr, lds);
    }
    if constexpr (m == 0) {
        const unsigned char* rb = ws + WB_RW + (size_t)ia * RW_STRIDE;
        if (IN(base + 2)) {
            SchedProj S; S.G = sb.G; S.c = sb.c; S.XM = (const char*)(ws + WS_XM); S.Wrkv = (const char*)(rb + RW_RKV); S.L1t = (const char*)(rb + RW_L1);
            EpiProj E; E.RKVb = (bf16_t*)(ws + WS_RKV); E.L1b = (bf16_t*)(ws + WS_L1);
            pg8::Geo g; g.lda = D; g.ldb = D; g.K = D;
            REPEAT(REP_PROJ) pg8::gemm_phase(wv, glds, g, S, E);
        }
        if (IN(base + 3)) {
            SchedLora2 S; S.G = sb.G; S.c = sb.c; S.L1b = (const char*)(ws + WS_L1); S.L2t = (const char*)(rb + RW_L2);
            EpiLora2 E; E.WDL = (bf16_t*)(ws + WS_WD); E.AAb = (bf16_t*)(ws + WS_AA); E.GGb = (bf16_t*)(ws + WS_GG); E.w0 = p.in[I_W0] + (size_t)ia * 2 * D; E.a0 = p.in[I_A0] + (size_t)ia * 2 * D;
            pg8::Geo g; g.lda = 512; g.ldb = 256; g.K = 256;
            REPEAT(REP_LORA2) pg8::gemm_phase(wv, glds, g, S, E);
        }
        if (IN(base + 4)) {
            REPEAT(REP_SCAN) ph_scan2(wv, p, ia, (unsigned char*)lds, (bf16_t*)(ws + WS_YS), L, LASTREP(REP_SCAN) ? 0 : 100 + SVAR);
        }
        if (DIAG) { if (IN(base + 11)) diag_compare(wv, p, (const float*)(ws + WS_YS), (const float*)(ws + WS_XM), (size_t)2 * T * D); }
        if (IN(base + 5)) REPEAT(REP_RPOST) ph_rwkv_post(wv, p, ia);
        if (IN(base + 6)) {
            SchedPlain S; S.G = sb.G; S.c = sb.c; S.A = (const char*)(ws + WS_YG); S.B = (const char*)(rb + RW_OUT); S.nN = 4; S.lda = D; S.ldb = D;
            pg8::Geo g; g.lda = D; g.ldb = D; g.K = D;
            REPEAT(REP_OUT) { EpiStoreBf16 E; E.O = (bf16_t*)(ws + WS_UCB); E.ldc = D; pg8::gemm_phase(wv, glds, g, S, E); }
        }
    } else if constexpr (m == 1) {
        if (IN(base + 1)) {
            SchedPlain S; S.G = sb.G; S.c = sb.c; S.A = (const char*)H; S.B = (const char*)(ws + WB_SC + SC_IN); S.nN = 12; S.lda = D; S.ldb = D;
            EpiStoreBf16 E; E.O = (bf16_t*)(ws + WS_RKV); E.ldc = 3 * D; pg8::Geo g; g.lda = D; g.ldb = D; g.K = D;
            REPEAT(REP_SCIN) pg8::gemm_phase(wv, glds, g, S, E);
        }
        if (IN(base + 2)) REPEAT(REP_SCMID) ph_sc_mid(wv, p);
        if (IN(base + 3)) {
            SchedPlain S; S.G = sb.G; S.c = sb.c; S.A = (const char*)(ws + WS_YG); S.B = (const char*)(ws + WB_SC + SC_OUT); S.nN = 4; S.lda = D; S.ldb = D;
            pg8::Geo g; g.lda = D; g.ldb = D; g.K = D;
            REPEAT(REP_OUT) { EpiStoreBf16 E; E.O = (bf16_t*)(ws + WS_UCB); E.ldc = D; pg8::gemm_phase(wv, glds, g, S, E); }
        }
    } else {
        if (IN(base + 1)) {
            SchedPlain S; S.G = sb.G; S.c = sb.c; S.A = (const char*)H; S.B = (const char*)(ws + WB_LRU + LRU_IN); S.nN = 8; S.lda = D; S.ldb = D;
            EpiStoreBf16 E; E.O = (bf16_t*)(ws + WS_RKV); E.ldc = 2 * D; pg8::Geo g; g.lda = D; g.ldb = D; g.K = D;
            REPEAT(REP_LIN) pg8::gemm_phase(wv, glds, g, S, E);
        }
        if (IN(base + 2)) REPEAT(REP_LCONV) ph_lru_conv(wv, p);
        if (IN(base + 3)) {
            SchedLruGate S; S.G = sb.G; S.c = sb.c; S.UCB = (const char*)(ws + WS_UCB); S.Wg = (const char*)(ws + WB_LRU + LRU_G);
            EpiLruGate E; E.LA = (bf16_t*)(ws + WS_WD); E.LB = (bf16_t*)(ws + WS_AA); E.UCB = (const bf16_t*)(ws + WS_UCB); E.ba = p.in[I_LBA]; E.bx = p.in[I_LBX]; E.lam = p.in[I_LLAM];
            pg8::Geo g; g.lda = D; g.ldb = 256; g.K = 256;
            REPEAT(REP_LGATE) pg8::gemm_phase(wv, glds, g, S, E);
        }
        if (IN(base + 4)) REPEAT(REP_LSCAN) ph_lru_scan(wv, p, lds);
        if (IN(base + 5)) REPEAT(REP_LPOST) ph_lru_post(wv, p);
        if (IN(base + 6)) {
            SchedPlain S; S.G = sb.G; S.c = sb.c; S.A = (const char*)(ws + WS_YG); S.B = (const char*)(ws + WB_LRU + LRU_OUT); S.nN = 4; S.lda = D; S.ldb = D;
            pg8::Geo g; g.lda = D; g.ldb = D; g.K = D;
            REPEAT(REP_OUT) { EpiStoreBf16 E; E.O = (bf16_t*)(ws + WS_UCB); E.ldc = D; pg8::gemm_phase(wv, glds, g, S, E); }
        }
    }
    if (IN(base + 7)) REPEAT(REP_NORM_FFN) ph_norm(wv, p, X, (const bf16_t*)(ws + WS_UCB), nullptr, false, p.in[I_NFG] + L * D, H, p.in[I_RW] + (size_t)L * D * NE, nullptr, lds);
    if (IN(base + 8)) REPEAT(REP_TOPK) ph_topk(wv, p, lds);
    if (IN(base + 9)) {
        SchedMoe1 S; S.G = sb.G; S.c = sb.c; S.XIN = (const char*)(ws + WS_XIN); S.Wgu = (const char*)(ws + WB_MOE + (size_t)L * MOE_STRIDE + MOE_GU);
        EpiSwiglu E; E.HID = (bf16_t*)(ws + WS_HID); pg8::Geo g; g.lda = D; g.ldb = D; g.K = D;
        REPEAT(REP_MOE1) pg8::gemm_phase(wv, glds, g, S, E, !LASTREP(REP_MOE1) && GVAR == 1);
    }
    if (IN(base + 10)) {
        SchedMoe2 S; S.G = sb.G; S.c = sb.c; S.HID = (const char*)(ws + WS_HID); S.Wdn = (const char*)(ws + WB_MOE + (size_t)L * MOE_STRIDE + MOE_DN);
        EpiDown E; E.YEXP = (bf16_t*)(ws + WS_YEXP); E.GATE = (const float*)(ws + WS_GATE); pg8::Geo g; g.lda = FF; g.ldb = FF; g.K = FF;
        REPEAT(REP_MOE2) pg8::gemm_phase(wv, glds, g, S, E, !LASTREP(REP_MOE2) && GVAR == 1);
    }
}

__global__ void __launch_bounds__(NTHR, 2) mega(P p_unused) {
    extern __shared__ __attribute__((aligned(16))) unsigned char lds_raw[];
    const P& p = *(const P*)__builtin_amdgcn_kernarg_segment_ptr();
    float* lds = (float*)lds_raw;
    volatile LAS unsigned* xbw = (volatile LAS unsigned*)(lds_raw + LDS_BYTES - 16);
    const int wv = __builtin_amdgcn_readfirstlane((int)(threadIdx.x >> 6));
    if (threadIdx.x == 0) { xbw[0] = 0u; xbw[1] = 0u; xbw[2] = 0u; xbw[3] = 0u; }
    __syncthreads();
    PhaseCtl pc; pc.lo = p.ph_lo; pc.hi = p.ph_hi; pc.did = false;
    pc.bar = xcd_barrier_post(wv, (unsigned*)(p.ws + WS_CTL), xbw);
    if (IN(0)) REPEAT(REP_PROLOGUE) ph_prologue(wv, p, lds);
    run_layer<0>(wv, p, lds, pc);
    run_layer<1>(wv, p, lds, pc);
    run_layer<2>(wv, p, lds, pc);
    run_layer<3>(wv, p, lds, pc);
    if (IN(PH_FINAL)) ph_norm(wv, p, (const float*)(p.ws + WS_X2), (const bf16_t*)(p.ws + WS_UCB), nullptr, true, p.in[I_FNG], nullptr, nullptr, p.out, lds);
    if (DIAG) { xcd_barrier(wv, pc.bar); diag_delay(wv, p); }
}
#undef IN

}

extern "C" void kernel_launch(void* const* d_in, const int* in_sizes, int n_in, void* d_out, int out_size, void* d_ws, size_t ws_size, hipStream_t stream) {
    static int ready = 0, grid = 256;
    if (!ready) {
        if (n_in != 36 || out_size != T * D || ws_size < WS_END) { fprintf(stderr, "kernel_launch: unexpected problem (n_in %d out %d ws %zu need %zu)\n", n_in, out_size, ws_size, (size_t)WS_END); ready = -1; return; }
        if (hipFuncSetAttribute((const void*)mega, hipFuncAttributeMaxDynamicSharedMemorySize, LDS_BYTES) != hipSuccess) { fprintf(stderr, "kernel_launch: hipFuncSetAttribute failed\n"); ready = -1; return; }
        { int dev = 0, cus = 0; if (hipGetDevice(&dev) == hipSuccess && hipDeviceGetAttribute(&cus, hipDeviceAttributeMultiprocessorCount, dev) == hipSuccess && cus > 0) grid = cus < 256 ? cus : 256; }
        ready = 1;
    }
    if (ready < 0) return;
    (void)in_sizes;
    P p{};
    for (int i = 0; i < 36; ++i) p.in[i] = (const float*)d_in[i];
    p.out = (float*)d_out; p.ws = (unsigned char*)d_ws;
    if (hipMemsetAsync((char*)d_ws + WS_CTL, 0, 32768, stream) != hipSuccess) { fprintf(stderr, "kernel_launch: memset failed\n"); return; }
    p.ph_lo = 0; p.ph_hi = PH_TOTAL;
    hipLaunchKernelGGL(mega, dim3(grid), dim3(NTHR), LDS_BYTES, stream, p);
}
```

```cpp
#include <hip/hip_runtime.h>
#include <stdint.h>
#include <stdio.h>

namespace {
constexpr int D = 1024, NB = 8, S = 2048, T = NB * S, DEPTH = 4, NE = 16, FF = 2048, CAP = 256, NH = 16, HD = 64;
constexpr int NTHR = 512;
constexpr float RMS_EPS = 1e-6f, LNX_EPS = 64e-5f;
typedef unsigned short bf16_t;

constexpr size_t MiB = 1u << 20;
constexpr size_t WS_CTL = 0;
constexpr size_t WS_X = 1 * MiB;
constexpr size_t WS_H = WS_X + 64 * MiB;
constexpr size_t WS_XM = WS_H + 32 * MiB;
constexpr size_t WS_RKV = WS_XM + 192 * MiB;
constexpr size_t WS_L1 = WS_RKV + 192 * MiB;
constexpr size_t WS_WD = WS_L1 + 24 * MiB;
constexpr size_t WS_AA = WS_WD + 128 * MiB;
constexpr size_t WS_GG = WS_AA + 128 * MiB;
constexpr size_t WS_YS = WS_GG + 64 * MiB;
constexpr size_t WS_YG = WS_YS + 128 * MiB;
constexpr size_t WS_UCB = WS_YG + 32 * MiB;
constexpr size_t WS_YEXP = WS_UCB + 32 * MiB;
constexpr size_t WS_AFF = WS_YEXP + 128 * MiB;
constexpr size_t WS_SLOT = WS_AFF + 1 * MiB;
constexpr size_t WS_GATE = WS_SLOT + 1 * MiB;
constexpr size_t WS_ACT_END = WS_GATE + 1 * MiB;
constexpr size_t WB_RW = WS_ACT_END;
constexpr size_t RW_RKV = 0, RW_L1 = 6 * MiB, RW_L2 = RW_L1 + 3 * 256 * 1024 * 2, RW_OUT = RW_L2 + 5 * 1024 * 256 * 2, RW_STRIDE = 12 * MiB;
constexpr size_t WB_SC = WB_RW + 2 * RW_STRIDE;
constexpr size_t SC_IN = 0, SC_OUT = 6 * MiB;
constexpr size_t WB_LRU = WB_SC + 8 * MiB;
constexpr size_t LRU_IN = 0, LRU_G = 4 * MiB, LRU_OUT = 6 * MiB;
constexpr size_t WB_MOE = WB_LRU + 8 * MiB;
constexpr size_t MOE_GU = 0, MOE_DN = 128 * MiB, MOE_STRIDE = 192 * MiB;
constexpr size_t WS_X2 = WB_MOE + 4 * MOE_STRIDE;
constexpr size_t WS_END = WS_X2 + 64 * MiB;
constexpr size_t WS_XIN = WS_XM, WS_HID = WS_XM + 64 * MiB;
constexpr size_t WS_BON = WS_L1 + 16 * MiB;

constexpr int REP_PROLOGUE = 1, REP_NORM_MIX = 1, REP_XM = 1, REP_PROJ = 1, REP_LORA2 = 1, REP_SCAN = 1, REP_RPOST = 1, REP_OUT = 1, REP_SCIN = 1, REP_SCMID = 1,
              REP_LIN = 1, REP_LCONV = 1, REP_LGATE = 1, REP_LSCAN = 1, REP_LPOST = 1, REP_NORM_FFN = 1, REP_TOPK = 1, REP_MOE1 = 1, REP_MOE2 = 1, REP_BAR = 1, REP_SA = 1, REP_SB = 1, REP_SC = 1, REP_SD = 1, GVAR = 0, SVAR = 0;
#define REPEAT(n) for (int rep_ = 0; rep_ < (n); ++rep_)
#define LASTREP(n) (rep_ == (n) - 1)
struct P {
    const float* in[36];
    float* out;
    unsigned char* ws;
    int ph_lo, ph_hi;
};

enum { I_X = 0, I_NMG, I_NFG, I_RW, I_WG, I_WU, I_WDN, I_FNG, I_MU, I_WIN, I_W0, I_W1, I_W2, I_A0, I_A1, I_A2, I_G1, I_G2, I_KK, I_KA, I_RK, I_LNG, I_LNB, I_WOUT,
       I_SCIN, I_SCCW, I_SCOUT, I_LIN, I_LCW, I_LCB, I_LWA, I_LBA, I_LWX, I_LBX, I_LLAM, I_LOUT };

__device__ __forceinline__ int lane_fresh() { int l; asm volatile("v_mbcnt_lo_u32_b32 %0, -1, 0\n\tv_mbcnt_hi_u32_b32 %0, -1, %0" : "=v"(l)); return l; }
#define TID (wv * 64 + lane_fresh())
__device__ __forceinline__ float bf2f(bf16_t v) { return __uint_as_float((unsigned)v << 16); }
__device__ __forceinline__ bf16_t f2bf(float f) { unsigned u = __float_as_uint(f); u += 0x7FFFu + ((u >> 16) & 1u); return (bf16_t)(u >> 16); }
__device__ __forceinline__ void bf4_to_f(uint2 u, float* f) { f[0] = __uint_as_float(u.x << 16); f[1] = __uint_as_float(u.x & 0xffff0000u); f[2] = __uint_as_float(u.y << 16); f[3] = __uint_as_float(u.y & 0xffff0000u); }
__device__ __forceinline__ uint2 f4_to_bf(float a, float b, float c, float d) { return make_uint2((unsigned)f2bf(a) | ((unsigned)f2bf(b) << 16), (unsigned)f2bf(c) | ((unsigned)f2bf(d) << 16)); }
template <int CTRL> __device__ __forceinline__ float dpp_f(float x) { return __builtin_bit_cast(float, __builtin_amdgcn_update_dpp(0, __builtin_bit_cast(int, x), CTRL, 0xf, 0xf, false)); }
__device__ __forceinline__ float row_sum16(float x) { x += dpp_f<0x128>(x); x += dpp_f<0x124>(x); x += dpp_f<0x122>(x); x += dpp_f<0x121>(x); return x; }
__device__ __forceinline__ float row_max16(float x) { x = fmaxf(x, dpp_f<0x128>(x)); x = fmaxf(x, dpp_f<0x124>(x)); x = fmaxf(x, dpp_f<0x122>(x)); x = fmaxf(x, dpp_f<0x121>(x)); return x; }
__device__ __forceinline__ float lane_bcast(float x, int l) { return __builtin_bit_cast(float, __builtin_amdgcn_readlane(__builtin_bit_cast(int, x), l)); }
__device__ __forceinline__ float wave_sum(float v) { v = row_sum16(v); return (lane_bcast(v, 0) + lane_bcast(v, 16)) + (lane_bcast(v, 32) + lane_bcast(v, 48)); }
__device__ __forceinline__ void wave_sum8(float (&v)[8]) {
#pragma unroll
    for (int s = 0; s < 8; ++s) v[s] = wave_sum(v[s]);
}
__device__ __forceinline__ float quad_sum(float v) { v += dpp_f<0xB1>(v); v += dpp_f<0x4E>(v); return v; }
__device__ __forceinline__ float sigmoidf_(float x) { return __builtin_amdgcn_rcpf(1.0f + __expf(-x)); }
__device__ __forceinline__ float tanhf_(float x) { const float e = __expf(-2.0f * fabsf(x)); const float t = (1.0f - e) * __builtin_amdgcn_rcpf(1.0f + e); return x < 0.f ? -t : t; }
__device__ __forceinline__ float softplusf_(float y) { return fmaxf(y, 0.f) + log1pf(__expf(-fabsf(y))); }
__device__ __forceinline__ float gelu_tanh(float x) { const float u = 0.7978845608028654f * (x + 0.044715f * x * x * x); return 0.5f * x * (1.0f + tanhf_(u)); }

__device__ __forceinline__ void ph_norm(const int wv, const P& p, const float* xin, const bf16_t* yadd, float* xout, bool combine, const float* gamma, bf16_t* hout, const float* router_w, float* fout, float* lds) {
    const int tid = TID, lane = tid & 63, wave = tid >> 6;
    if (router_w) {
        for (int i = tid; i < D * NE; i += NTHR) { const int d = i >> 4, e = i & 15; lds[e * D + d] = router_w[i]; }
        __syncthreads();
    }
    const bf16_t* yexp = (const bf16_t*)(p.ws + WS_YEXP); const int* slot = (const int*)(p.ws + WS_SLOT);
    float* aff = (float*)(p.ws + WS_AFF);
    const int tstep = gridDim.x * 8; int tok = blockIdx.x * 8 + wave;
    float4 xn[4]; uint2 yn[4]; int sln = -1;
#pragma unroll
    for (int i = 0; i < 4; ++i) yn[i] = make_uint2(0u, 0u);
    if (tok < T) {
#pragma unroll
        for (int i = 0; i < 4; ++i) xn[i] = ((const float4*)(xin + (size_t)tok * D))[i * 64 + lane];
        if (yadd) {
#pragma unroll
            for (int i = 0; i < 4; ++i) yn[i] = ((const uint2*)(yadd + (size_t)tok * D))[i * 64 + lane]; }
        if (combine) sln = slot[tok * NE + (lane & 15)];
    }
    for (; tok < T; tok += tstep) {
        const int b = tok / S, s = tok % S;
        float4 x[4];
#pragma unroll
        for (int i = 0; i < 4; ++i) { x[i] = xn[i]; if (yadd) { float f[4]; bf4_to_f(yn[i], f); x[i].x += f[0]; x[i].y += f[1]; x[i].z += f[2]; x[i].w += f[3]; } }
        const int slv = sln;
        if (tok + tstep < T) {
#pragma unroll
            for (int i = 0; i < 4; ++i) xn[i] = ((const float4*)(xin + (size_t)(tok + tstep) * D))[i * 64 + lane];
            if (yadd) {
#pragma unroll
                for (int i = 0; i < 4; ++i) yn[i] = ((const uint2*)(yadd + (size_t)(tok + tstep) * D))[i * 64 + lane]; }
            if (combine) sln = slot[(tok + tstep) * NE + (lane & 15)];
        }
        if (combine) {
            unsigned msk = (unsigned)(__ballot(slv >= 0) & 0xffffull);
            while (msk) {
                const int e0 = __ffs(msk) - 1; msk &= msk - 1u;
                const int e1 = msk ? (__ffs(msk) - 1) : e0; const bool two = msk != 0u; msk &= msk - 1u;
                const int s0 = __builtin_amdgcn_readlane(slv, e0), s1 = __builtin_amdgcn_readlane(slv, e1);
                const uint2* r0 = (const uint2*)(yexp + ((size_t)(e0 * NB + b) * CAP + s0) * D); const uint2* r1 = (const uint2*)(yexp + ((size_t)(e1 * NB + b) * CAP + s1) * D);
                uint2 q0[4], q1[4];
#pragma unroll
                for (int i = 0; i < 4; ++i) { q0[i] = r0[i * 64 + lane]; q1[i] = r1[i * 64 + lane]; }
#pragma unroll
                for (int i = 0; i < 4; ++i) { float f[4]; bf4_to_f(q0[i], f); x[i].x += f[0]; x[i].y += f[1]; x[i].z += f[2]; x[i].w += f[3];
                    if (two) { bf4_to_f(q1[i], f); x[i].x += f[0]; x[i].y += f[1]; x[i].z += f[2]; x[i].w += f[3]; } }
            }
        }
        if (xout) {
#pragma unroll
            for (int i = 0; i < 4; ++i) ((float4*)(xout + (size_t)tok * D))[i * 64 + lane] = x[i];
        }
        float ss = 0.f;
#pragma unroll
        for (int i = 0; i < 4; ++i) ss += x[i].x * x[i].x + x[i].y * x[i].y + x[i].z * x[i].z + x[i].w * x[i].w;
        ss = wave_sum(ss);
        const float rstd = __builtin_amdgcn_rsqf(ss * (1.0f / D) + RMS_EPS);
        float4 h[4];
#pragma unroll
        for (int i = 0; i < 4; ++i) {
            const float4 g = ((const float4*)gamma)[i * 64 + lane];
            h[i].x = x[i].x * rstd * g.x; h[i].y = x[i].y * rstd * g.y; h[i].z = x[i].z * rstd * g.z; h[i].w = x[i].w * rstd * g.w;
        }
        if (hout) {
#pragma unroll
            for (int i = 0; i < 4; ++i) ((uint2*)(hout + (size_t)tok * D))[i * 64 + lane] = f4_to_bf(h[i].x, h[i].y, h[i].z, h[i].w);
        }
        if (fout) {
#pragma unroll
            for (int i = 0; i < 4; ++i) ((float4*)(fout + (size_t)tok * D))[i * 64 + lane] = h[i];
        }
        if (router_w) {
            float mylg = -3.0e38f;
#pragma unroll 1
            for (int eg = 0; eg < NE; eg += 8) {
                float a8[8];
#pragma unroll
                for (int j = 0; j < 8; ++j) {
                    float a = 0.f;
#pragma unroll
                    for (int i = 0; i < 4; ++i) { const float4 w = ((const float4*)(lds + (eg + j) * D))[i * 64 + lane]; a += h[i].x * w.x + h[i].y * w.y + h[i].z * w.z + h[i].w * w.w; }
                    a8[j] = a;
                }
                wave_sum8(a8);
#pragma unroll
                for (int j = 0; j < 8; ++j) if (lane == eg + j) mylg = a8[j];
            }
            float mx = mylg;
            mx = row_max16(mx);
            const float mine = (lane < NE) ? __expf(mylg - mx) : 0.f;
            float sum = mine;
            sum = row_sum16(sum);
            if (lane < NE) aff[((size_t)b * NE + lane) * S + s] = mine / sum;
        }
    }
}

__device__ __forceinline__ void ph_norm_xm(const int wv, const P& p, const float* xin, const bf16_t* yadd, float* xout, bool combine, const float* gamma, const float* mu, unsigned char* lds) {
    const int tid = TID, lane = tid & 63, wave = tid >> 6;
    constexpr int HP = 2064;
    const bf16_t* yexp = (const bf16_t*)(p.ws + WS_YEXP); const int* slot = (const int*)(p.ws + WS_SLOT);
    bf16_t* XM = (bf16_t*)(p.ws + WS_XM);
    for (int unit = blockIdx.x; unit < T / 32; unit += gridDim.x) {
        const int t0 = unit * 32;
        float4 xr[5][4]; uint2 yr[5][4]; int slr[5];
#pragma unroll
        for (int j = 0; j < 5; ++j) {
            const int r = wave + 8 * j, tok = t0 - 1 + r, s = (t0 % S) - 1 + r; slr[j] = -1;
#pragma unroll
            for (int i = 0; i < 4; ++i) yr[j][i] = make_uint2(0u, 0u);
            if (r < 34 && s >= 0 && s < S) {
#pragma unroll
                for (int i = 0; i < 4; ++i) xr[j][i] = ((const float4*)(xin + (size_t)tok * D))[i * 64 + lane];
                if (yadd) {
#pragma unroll
                    for (int i = 0; i < 4; ++i) yr[j][i] = ((const uint2*)(yadd + (size_t)tok * D))[i * 64 + lane]; }
                if (combine) slr[j] = slot[tok * NE + (lane & 15)];
            } else {
#pragma unroll
                for (int i = 0; i < 4; ++i) xr[j][i] = make_float4(0.f, 0.f, 0.f, 0.f);
            }
        }
#pragma unroll
        for (int j = 0; j < 5; ++j) {
            const int r = wave + 8 * j, tok = t0 - 1 + r, s = (t0 % S) - 1 + r;
            if (r >= 34) continue;
            uint2* hrow = (uint2*)(lds + r * HP);
            if (s < 0 || s >= S) {
#pragma unroll
                for (int i = 0; i < 4; ++i) hrow[i * 64 + lane] = make_uint2(0u, 0u);
                continue;
            }
            const int b = tok / S;
            float4 x[4];
#pragma unroll
            for (int i = 0; i < 4; ++i) { x[i] = xr[j][i]; if (yadd) { float f[4]; bf4_to_f(yr[j][i], f); x[i].x += f[0]; x[i].y += f[1]; x[i].z += f[2]; x[i].w += f[3]; } }
            if (combine) {
                const int slv = slr[j];
                unsigned msk = (unsigned)(__ballot(slv >= 0) & 0xffffull);
                while (msk) {
                    const int e0 = __ffs(msk) - 1; msk &= msk - 1u;
                    const int e1 = msk ? (__ffs(msk) - 1) : e0; const bool two = msk != 0u; msk &= msk - 1u;
                    const int s0 = __builtin_amdgcn_readlane(slv, e0), s1 = __builtin_amdgcn_readlane(slv, e1);
                    const uint2* r0 = (const uint2*)(yexp + ((size_t)(e0 * NB + b) * CAP + s0) * D); const uint2* r1 = (const uint2*)(yexp + ((size_t)(e1 * NB + b) * CAP + s1) * D);
                    uint2 q0[4], q1[4];
#pragma unroll
                    for (int i = 0; i < 4; ++i) { q0[i] = r0[i * 64 + lane]; q1[i] = r1[i * 64 + lane]; }
#pragma unroll
                    for (int i = 0; i < 4; ++i) { float f[4]; bf4_to_f(q0[i], f); x[i].x += f[0]; x[i].y += f[1]; x[i].z += f[2]; x[i].w += f[3];
                        if (two) { bf4_to_f(q1[i], f); x[i].x += f[0]; x[i].y += f[1]; x[i].z += f[2]; x[i].w += f[3]; } }
                }
            }
            if (r >= 1 && r <= 32) {
#pragma unroll
                for (int i = 0; i < 4; ++i) ((float4*)(xout + (size_t)tok * D))[i * 64 + lane] = x[i];
            }
            float ss = 0.f;
#pragma unroll
            for (int i = 0; i < 4; ++i) ss += x[i].x * x[i].x + x[i].y * x[i].y + x[i].z * x[i].z + x[i].w * x[i].w;
            ss = wave_sum(ss);
            const float rstd = __builtin_amdgcn_rsqf(ss * (1.0f / D) + RMS_EPS);
#pragma unroll
            for (int i = 0; i < 4; ++i) {
                const float4 gq = ((const float4*)gamma)[i * 64 + lane];
                hrow[i * 64 + lane] = f4_to_bf(x[i].x * rstd * gq.x, x[i].y * rstd * gq.y, x[i].z * rstd * gq.z, x[i].w * rstd * gq.w);
            }
        }
        __syncthreads();
        for (int r = 1 + wave; r <= 32; r += 8) {
            const int tok = t0 - 1 + r;
#pragma unroll
            for (int i = 0; i < 4; ++i) {
                const int c4 = i * 64 + lane;
                float hc[4], hp[4], hn[4];
                bf4_to_f(((const uint2*)(lds + r * HP))[c4], hc); bf4_to_f(((const uint2*)(lds + (r - 1) * HP))[c4], hp); bf4_to_f(((const uint2*)(lds + (r + 1) * HP))[c4], hn);
                float xx[4];
#pragma unroll
                for (int j = 0; j < 4; ++j) xx[j] = 0.5f * (hp[j] + hn[j]) - hc[j];
#pragma unroll
                for (int q = 0; q < 6; ++q) {
                    const float4 m = ((const float4*)(mu + q * D))[c4];
                    ((uint2*)(XM + ((size_t)q * T + tok) * D))[c4] = f4_to_bf(hc[0] + xx[0] * m.x, hc[1] + xx[1] * m.y, hc[2] + xx[2] * m.z, hc[3] + xx[3] * m.w);
                }
            }
        }
        __syncthreads();
    }
}

__device__ __forceinline__ void ph_xm(const int wv, const P& p, const float* mu) {
    const int tid = TID, lane = tid & 63, wave = tid >> 6;
    const bf16_t* H = (const bf16_t*)(p.ws + WS_H); bf16_t* XM = (bf16_t*)(p.ws + WS_XM);
    for (int tok = blockIdx.x * 8 + wave; tok < T; tok += gridDim.x * 8) {
        const int s = tok % S;
#pragma unroll
        for (int i = 0; i < 4; ++i) {
            const int c4 = i * 64 + lane;
            float hc[4], hp[4] = {0.f, 0.f, 0.f, 0.f}, hn[4] = {0.f, 0.f, 0.f, 0.f};
            bf4_to_f(((const uint2*)(H + (size_t)tok * D))[c4], hc);
            if (s > 0) bf4_to_f(((const uint2*)(H + (size_t)(tok - 1) * D))[c4], hp);
            if (s < S - 1) bf4_to_f(((const uint2*)(H + (size_t)(tok + 1) * D))[c4], hn);
            float xx[4];
#pragma unroll
            for (int j = 0; j < 4; ++j) xx[j] = 0.5f * (hp[j] + hn[j]) - hc[j];
#pragma unroll
            for (int q = 0; q < 6; ++q) {
                const float4 m = ((const float4*)(mu + q * D))[c4];
                ((uint2*)(XM + ((size_t)q * T + tok) * D))[c4] = f4_to_bf(hc[0] + xx[0] * m.x, hc[1] + xx[1] * m.y, hc[2] + xx[2] * m.z, hc[3] + xx[3] * m.w);
            }
        }
    }
}

__device__ __forceinline__ void bf16x16_load(const bf16_t* p16, float* f) {
    const uint4 a = ((const uint4*)p16)[0], b = ((const uint4*)p16)[1];
    const unsigned w[8] = {a.x, a.y, a.z, a.w, b.x, b.y, b.z, b.w};
#pragma unroll
    for (int j = 0; j < 8; ++j) { f[2 * j] = __uint_as_float(w[j] << 16); f[2 * j + 1] = __uint_as_float(w[j] & 0xffff0000u); }
}
__device__ __forceinline__ void ph_rwkv_post(const int wv, const P& p, int ia) {
    const int tid = TID, lane = tid & 63, wave = tid >> 6;
    const bf16_t* __restrict__ RKV = (const bf16_t*)(p.ws + WS_RKV); const bf16_t* __restrict__ GG = (const bf16_t*)(p.ws + WS_GG); const float* __restrict__ BON = (const float*)(p.ws + WS_BON);
    const bf16_t* __restrict__ YS = (const bf16_t*)(p.ws + WS_YS); bf16_t* __restrict__ YG = (bf16_t*)(p.ws + WS_YG);
    const float* lg = p.in[I_LNG] + ia * D; const float* lb = p.in[I_LNB] + ia * D;
#pragma unroll 2
    for (int tok = blockIdx.x * 8 + wave; tok < T; tok += gridDim.x * 8) {
        const size_t o = (size_t)tok * D + lane * 16;
        float y[16], v[16], gg[16];
        { float y1[16]; bf16x16_load(YS + o, y); bf16x16_load(YS + (size_t)T * D + o, y1);
#pragma unroll
          for (int j = 0; j < 16; ++j) y[j] += y1[j]; }
        bf16x16_load(RKV + 2 * (size_t)T * D + o, v); bf16x16_load(GG + o, gg);
        const float bon = BON[(size_t)tok * NH + (lane >> 2)] + BON[((size_t)T + tok) * NH + (lane >> 2)];
        float sm = 0.f;
#pragma unroll
        for (int j = 0; j < 16; ++j) sm += y[j];
        const float mean = quad_sum(sm) * (1.0f / 64.0f);
        float sv = 0.f;
#pragma unroll
        for (int j = 0; j < 16; ++j) { const float d = y[j] - mean; sv += d * d; }
        const float rstd = __builtin_amdgcn_rsqf(quad_sum(sv) * (1.0f / 64.0f) + LNX_EPS);
        float outv[16];
#pragma unroll
        for (int j = 0; j < 16; ++j) { const int c = lane * 16 + j; outv[j] = ((y[j] - mean) * rstd * lg[c] + lb[c] + bon * v[j]) * gg[j]; }
#pragma unroll
        for (int j = 0; j < 4; ++j) ((uint2*)(YG + o))[j] = f4_to_bf(outv[4 * j], outv[4 * j + 1], outv[4 * j + 2], outv[4 * j + 3]);
    }
}

__device__ __forceinline__ void ph_sc_mid(const int wv, const P& p) {
    const int tid = TID, lane = tid & 63, wave = tid >> 6;
    const bf16_t* __restrict__ BCU = (const bf16_t*)(p.ws + WS_RKV); bf16_t* __restrict__ BZ = (bf16_t*)(p.ws + WS_YG); const float* cw = p.in[I_SCCW];
#pragma unroll 2
    for (int tok = blockIdx.x * 8 + wave; tok < T; tok += gridDim.x * 8) {
        const int s = tok % S;
#pragma unroll
        for (int i = 0; i < 4; ++i) {
            const int c4 = i * 64 + lane;
            float z[4] = {0.f, 0.f, 0.f, 0.f};
#pragma unroll
            for (int j = 0; j < 3; ++j) {
                const int ss = s + j - 1;
                if (ss >= 0 && ss < S) {
                    const size_t ro = (size_t)(tok + j - 1) * (3 * D);
                    float c[4], u[4]; bf4_to_f(((const uint2*)(BCU + ro + D))[c4], c); bf4_to_f(((const uint2*)(BCU + ro + 2 * D))[c4], u);
                    const float4 w = ((const float4*)(cw + j * D))[c4];
                    z[0] += w.x * c[0] * u[0]; z[1] += w.y * c[1] * u[1]; z[2] += w.z * c[2] * u[2]; z[3] += w.w * c[3] * u[3];
                }
            }
            float bg[4]; bf4_to_f(((const uint2*)(BCU + (size_t)tok * (3 * D)))[c4], bg);
            ((uint2*)(BZ + (size_t)tok * D))[c4] = f4_to_bf(bg[0] * z[0], bg[1] * z[1], bg[2] * z[2], bg[3] * z[3]);
        }
    }
}

__device__ __forceinline__ void ph_lru_conv(const int wv, const P& p) {
    const int tid = TID, lane = tid & 63, wave = tid >> 6;
    const bf16_t* __restrict__ GU = (const bf16_t*)(p.ws + WS_RKV); bf16_t* __restrict__ UCB = (bf16_t*)(p.ws + WS_UCB);
    const float* cw = p.in[I_LCW]; const float* cb = p.in[I_LCB];
#pragma unroll 2
    for (int tok = blockIdx.x * 8 + wave; tok < T; tok += gridDim.x * 8) {
        const int s = tok % S;
#pragma unroll
        for (int i = 0; i < 4; ++i) {
            const int c4 = i * 64 + lane;
            float4 acc = ((const float4*)cb)[c4];
#pragma unroll
            for (int j = 0; j < 4; ++j) {
                const int ss = s + j - 2;
                if (ss >= 0 && ss < S) {
                    float u[4]; bf4_to_f(((const uint2*)(GU + (size_t)(tok + j - 2) * (2 * D) + D))[c4], u); const float4 w = ((const float4*)(cw + j * D))[c4];
                    acc.x += w.x * u[0]; acc.y += w.y * u[1]; acc.z += w.z * u[2]; acc.w += w.w * u[3];
                }
            }
            ((uint2*)(UCB + (size_t)tok * D))[c4] = f4_to_bf(acc.x, acc.y, acc.z, acc.w);
        }
    }
}

__device__ __forceinline__ void ph_lru_scan(const int wv, const P& p, float* lds) {
    const int tid = TID;
    const bf16_t* LA = (const bf16_t*)(p.ws + WS_WD); const bf16_t* LB = (const bf16_t*)(p.ws + WS_AA);
    bf16_t* HS = (bf16_t*)(p.ws + WS_YS);
    float2* segP = (float2*)lds; float2* segH = (float2*)lds + 512;
    const int cp = tid & 31, seg = tid >> 5;
    for (int unit = blockIdx.x; unit < NB * 2 * 16; unit += gridDim.x) {
        const int cg = unit & 15, z = (unit >> 4) & 1, b = unit >> 5;
        const int c = cg * 64 + cp * 2;
        const bf16_t* la = LA + (size_t)z * T * D; const bf16_t* lb = LB + (size_t)z * T * D;
        float P0 = 0.f, P1 = 0.f, h0 = 0.f, h1 = 0.f;
#pragma unroll 8
        for (int i = seg * 128; i < seg * 128 + 128; ++i) {
            const int t = z ? (S - 1 - i) : i; const size_t o = ((size_t)b * S + t) * D + c;
            const unsigned a2 = *(const unsigned*)(la + o), b2 = *(const unsigned*)(lb + o);
            const float l0 = __uint_as_float(a2 << 16), l1 = __uint_as_float(a2 & 0xffff0000u);
            h0 = __expf(l0) * h0 + __uint_as_float(b2 << 16); h1 = __expf(l1) * h1 + __uint_as_float(b2 & 0xffff0000u);
            P0 += l0; P1 += l1;
        }
        segP[seg * 32 + cp] = make_float2(__expf(P0), __expf(P1)); segH[seg * 32 + cp] = make_float2(h0, h1);
        __syncthreads();
        float c0 = 0.f, c1 = 0.f;
        for (int s2 = 0; s2 < seg; ++s2) { const float2 pp = segP[s2 * 32 + cp], hh = segH[s2 * 32 + cp]; c0 = pp.x * c0 + hh.x; c1 = pp.y * c1 + hh.y; }
        h0 = c0; h1 = c1;
#pragma unroll 8
        for (int i = seg * 128; i < seg * 128 + 128; ++i) {
            const int t = z ? (S - 1 - i) : i; const size_t o = ((size_t)b * S + t) * D + c;
            const unsigned a2 = *(const unsigned*)(la + o), b2 = *(const unsigned*)(lb + o);
            h0 = __expf(__uint_as_float(a2 << 16)) * h0 + __uint_as_float(b2 << 16); h1 = __expf(__uint_as_float(a2 & 0xffff0000u)) * h1 + __uint_as_float(b2 & 0xffff0000u);
            *(unsigned*)(HS + (size_t)z * T * D + o) = (unsigned)f2bf(h0) | ((unsigned)f2bf(h1) << 16);
        }
        __syncthreads();
    }
}

__device__ __forceinline__ void ph_lru_post(const int wv, const P& p) {
    const int tid = TID, lane = tid & 63, wave = tid >> 6;
    const bf16_t* __restrict__ GU = (const bf16_t*)(p.ws + WS_RKV); const bf16_t* __restrict__ HS = (const bf16_t*)(p.ws + WS_YS); bf16_t* __restrict__ YL = (bf16_t*)(p.ws + WS_YG);
#pragma unroll 2
    for (int tok = blockIdx.x * 8 + wave; tok < T; tok += gridDim.x * 8) {
#pragma unroll
        for (int i = 0; i < 4; ++i) {
            const int c4 = i * 64 + lane;
            float gq[4]; bf4_to_f(((const uint2*)(GU + (size_t)tok * (2 * D)))[c4], gq); const float4 g = make_float4(gq[0], gq[1], gq[2], gq[3]);
            float hq0[4], hq1[4]; bf4_to_f(((const uint2*)(HS + (size_t)tok * D))[c4], hq0); bf4_to_f(((const uint2*)(HS + (size_t)T * D + (size_t)tok * D))[c4], hq1);
            const float4 h0 = make_float4(hq0[0], hq0[1], hq0[2], hq0[3]), h1 = make_float4(hq1[0], hq1[1], hq1[2], hq1[3]);
            ((uint2*)(YL + (size_t)tok * D))[c4] = f4_to_bf((h0.x + h1.x) * gelu_tanh(g.x), (h0.y + h1.y) * gelu_tanh(g.y), (h0.z + h1.z) * gelu_tanh(g.z), (h0.w + h1.w) * gelu_tanh(g.w));
        }
    }
}

__device__ __forceinline__ int block_sum_i(const int wv, int v, int* wsum  ) {
    const int lane = lane_fresh(), wave = wv;
    v = __popcll(__ballot(v & 1)) + 2 * __popcll(__ballot(v & 2)) + 4 * __popcll(__ballot(v & 4));
    if (lane == 0) wsum[wave] = v;
    __syncthreads();
    int tot = 0;
#pragma unroll
    for (int w = 0; w < 8; ++w) tot += wsum[w];
    return tot;
}
__device__ __forceinline__ int block_excl_scan_i(const int wv, int v, int* wsum  , int& total) {
    const int lane = lane_fresh(), wave = wv;
    int inc = v;
    for (int o = 1; o < 64; o <<= 1) { const int t = __shfl_up(inc, o); if (lane >= o) inc += t; }
    if (lane == 63) wsum[wave] = inc;
    __syncthreads();
    int base = 0, tot = 0;
#pragma unroll
    for (int w = 0; w < 8; ++w) { const int x = wsum[w]; if (w < wave) base += x; tot += x; }
    total = tot;
    return base + inc - v;
}
__device__ __forceinline__ void ph_topk(const int wv, const P& p, float* ldsf) {
    const int tid = TID, lane = tid & 63, wave = tid >> 6;
    int* ldsi = (int*)ldsf;
    int* wsum = ldsi;
    int* idx_l = ldsi + 64;
    const float* aff = (const float*)(p.ws + WS_AFF); int* slot = (int*)(p.ws + WS_SLOT); float* gate = (float*)(p.ws + WS_GATE);
    const bf16_t* HF = (const bf16_t*)(p.ws + WS_H); bf16_t* XIN = (bf16_t*)(p.ws + WS_XIN);
    for (int unit2 = blockIdx.x; unit2 < 2 * NB * NE; unit2 += gridDim.x) {
        const int unit = unit2 >> 1, half = unit2 & 1;
        const int e = unit % NE, b = unit / NE;
        const float4 v4 = ((const float4*)(aff + ((size_t)b * NE + e) * S))[tid];
        const unsigned v[4] = {__float_as_uint(v4.x), __float_as_uint(v4.y), __float_as_uint(v4.z), __float_as_uint(v4.w)};
        unsigned thr = 0u;
        for (int bit = 29; bit >= 0; --bit) {
            const unsigned cand = thr | (1u << bit);
            const int cnt = (int)(v[0] >= cand) + (int)(v[1] >= cand) + (int)(v[2] >= cand) + (int)(v[3] >= cand);
            const int tot = block_sum_i(wv, cnt, wsum + (bit & 1) * 8);
            if (tot >= CAP) thr = cand;
        }
        int g4 = 0, e4 = 0;
#pragma unroll
        for (int j = 0; j < 4; ++j) { g4 += (int)(v[j] > thr); e4 += (int)(v[j] == thr); }
        const int ngt = block_sum_i(wv, g4, wsum + 16);
        const int need_eq = CAP - ngt;
        int toteq; const int eqbase = block_excl_scan_i(wv, e4, wsum + 24, toteq);
        int sel[4], nsel = 0, er = eqbase;
#pragma unroll
        for (int j = 0; j < 4; ++j) { const bool gt = v[j] > thr, eq = v[j] == thr; sel[j] = (gt || (eq && er < need_eq)) ? 1 : 0; er += eq ? 1 : 0; nsel += sel[j]; }
        __syncthreads();
        int totsel; int cpos = block_excl_scan_i(wv, nsel, wsum, totsel);
#pragma unroll
        for (int j = 0; j < 4; ++j) {
            const int t = tid * 4 + j;
            if (sel[j]) {
                if (cpos < CAP) { idx_l[cpos] = t; if (half == 0) { gate[((size_t)e * NB + b) * CAP + cpos] = __uint_as_float(v[j]); slot[((size_t)b * S + t) * NE + e] = cpos; } }
                else if (half == 0) slot[((size_t)b * S + t) * NE + e] = -1;
                ++cpos;
            } else if (half == 0) slot[((size_t)b * S + t) * NE + e] = -1;
        }
        __syncthreads();
#pragma unroll 1
        for (int cb = 0; cb < 16; cb += 4) {
            const int c = half * 128 + wave * 16 + cb;
            const uint4* s0 = (const uint4*)(HF + ((size_t)b * S + idx_l[c]) * D); const uint4* s1 = (const uint4*)(HF + ((size_t)b * S + idx_l[c + 1]) * D);
            const uint4* s2 = (const uint4*)(HF + ((size_t)b * S + idx_l[c + 2]) * D); const uint4* s3 = (const uint4*)(HF + ((size_t)b * S + idx_l[c + 3]) * D);
            const uint4 a0 = s0[lane], b0 = s0[lane + 64], a1 = s1[lane], b1 = s1[lane + 64], a2 = s2[lane], b2 = s2[lane + 64], a3 = s3[lane], b3 = s3[lane + 64];
            uint4* d0 = (uint4*)(XIN + (((size_t)e * NB + b) * CAP + c) * D);
            d0[lane] = a0; d0[lane + 64] = b0; d0[128 + lane] = a1; d0[128 + lane + 64] = b1; d0[256 + lane] = a2; d0[256 + lane + 64] = b2; d0[384 + lane] = a3; d0[384 + lane + 64] = b3;
        }
        __syncthreads();
    }
}


namespace pg8 {
#define PG8_LAS __attribute__((address_space(3)))
typedef short bf16x8 __attribute__((ext_vector_type(8)));
typedef float f32x4 __attribute__((ext_vector_type(4)));
typedef unsigned u32x4 __attribute__((ext_vector_type(4)));
typedef unsigned u32x2 __attribute__((ext_vector_type(2)));
constexpr int BM = 256, BK = 64, HALF = 128, HTB = HALF * BK * 2, STAGE_BYTES = 8 * HTB;
__device__ __forceinline__ int lds_byte(int r, int c) { const int st = (r >> 4) * 2 + (c >> 5), rr = r & 15, cc = c & 31, ob = rr * 64 + cc * 2; return st * 1024 + (ob ^ (((ob >> 9) & 1) << 5)); }
__device__ __forceinline__ void stage_rc(int b, int& R, int& C) { const int st = b / 1024, sb = b % 1024, swz = sb ^ (((sb >> 9) & 1) << 5); R = (st >> 1) * 16 + swz / 64; C = (st & 1) * 32 + (swz % 64) / 2; }
__device__ __forceinline__ int perm32(int rho) { const int n = rho >> 4, i = rho & 15; return 8 * (i >> 2) + 4 * n + (i & 3); }
struct Unit { const char* A; const char* B; int pm, pn, job; };
struct Geo { int lda, ldb, K; };
typedef float f32x2_t __attribute__((ext_vector_type(2)));
typedef __bf16 bf16x2_t __attribute__((ext_vector_type(2)));
__device__ __forceinline__ unsigned cvt_pk_bf16(float lo, float hi) { const f32x2_t v = {lo, hi}; const bf16x2_t b = __builtin_convertvector(v, bf16x2_t); return __builtin_bit_cast(unsigned, b); }

template <class Epi, class Sched>
__device__ __forceinline__ void gemm_phase(const int wv, PG8_LAS unsigned char* lds, const Geo g, const Sched& S, const Epi& E, const bool skip_epi = false) {
    const int tid = TID, wid = wv, lane = tid & 63, wr = wid >> 2, wc = wid & 3, fr = lane & 15, fq = lane >> 4;
    const int nt = g.K / BK;
    unsigned voffA[2], voffB[2];
#pragma unroll
    for (int i = 0; i < 2; ++i) { int R, C; stage_rc(tid * 16 + i * 8192, R, C); const int Rb = Epi::PERM ? ((R & ~31) + perm32(R & 31)) : R;
        voffA[i] = (unsigned)(R * g.lda + C) * 2u; voffB[i] = (unsigned)(Rb * g.ldb + C) * 2u; }
    const size_t kstep = (size_t)(BK * 2);
    const size_t hstepA = (size_t)HALF * g.lda * 2, hstepB = (size_t)HALF * g.ldb * 2;
    const unsigned ldsw = (unsigned)wid * 1024u;
    const int aoff = lds_byte(wr * 64 + fr, fq * 8), boff = lds_byte(wc * 32 + fr, fq * 8);
#define PG8_SA(b, h) (((b) * 2 + (h)) * HTB)
#define PG8_SB(b, h) ((4 + (b) * 2 + (h)) * HTB)
#define PG8_STAGE(bufoff, gbase, voff) do { _Pragma("unroll") for (int _i = 0; _i < 2; ++_i) \
        __builtin_amdgcn_global_load_lds((const unsigned*)((const char*)(gbase) + (voff)[_i]), (PG8_LAS unsigned*)(lds + (bufoff) + ldsw + _i * 8192), 16, 0, 0); } while (0)
#define PG8_LDA(dst, b, h) do { _Pragma("unroll") for (int m = 0; m < 4; ++m) _Pragma("unroll") for (int k = 0; k < 2; ++k) dst[m][k] = *(const PG8_LAS bf16x8*)(lds + PG8_SA(b, h) + aoff + m * 2048 + k * 1024); } while (0)
#define PG8_LDB(dst, b, h) do { _Pragma("unroll") for (int n = 0; n < 2; ++n) _Pragma("unroll") for (int k = 0; k < 2; ++k) dst[n][k] = *(const PG8_LAS bf16x8*)(lds + PG8_SB(b, h) + boff + n * 2048 + k * 1024); } while (0)
#define PG8_MMA(ai, bj, At, Bt) do { __builtin_amdgcn_s_setprio(1); _Pragma("unroll") for (int m = 0; m < 4; ++m) _Pragma("unroll") for (int n = 0; n < 2; ++n) _Pragma("unroll") for (int k = 0; k < 2; ++k) \
        acc[ai][bj][m][n] = __builtin_amdgcn_mfma_f32_16x16x32_bf16(Bt[n][k], At[m][k], acc[ai][bj][m][n], 0, 0, 0); __builtin_amdgcn_s_setprio(0); } while (0)
#define PG8_WAIT_V(n) asm volatile("s_waitcnt vmcnt(" #n ")" ::: "memory")
#define PG8_WAIT_L(n) asm volatile("s_waitcnt lgkmcnt(" #n ")" ::: "memory")
#define PG8_BAR __builtin_amdgcn_s_barrier()
#define PG8_SCHED __builtin_amdgcn_sched_barrier(0)
    Unit cur, nxt; int ui = 0;
    if (!S.next(0, cur)) return;
    f32x4 acc[2][2][4][2];
#pragma unroll
    for (int a = 0; a < 2; ++a)
#pragma unroll
        for (int b = 0; b < 2; ++b)
#pragma unroll
            for (int m = 0; m < 4; ++m)
#pragma unroll
                for (int n = 0; n < 2; ++n) acc[a][b][m][n] = (f32x4){0.f, 0.f, 0.f, 0.f};
    bf16x8 At[4][2], B0[2][2], B1[2][2];
    const char* cA = cur.A; const char* cB = cur.B;
    PG8_STAGE(PG8_SB(0, 0), cB, voffB); PG8_STAGE(PG8_SB(0, 1), cB + hstepB, voffB); PG8_STAGE(PG8_SA(0, 0), cA, voffA); PG8_STAGE(PG8_SA(0, 1), cA + hstepA, voffA);
    if (wr == 1) PG8_BAR;
    PG8_WAIT_V(2); PG8_BAR;
    PG8_STAGE(PG8_SB(1, 0), cB + kstep, voffB); PG8_STAGE(PG8_SA(1, 0), cA + kstep, voffA); PG8_STAGE(PG8_SB(1, 1), cB + hstepB + kstep, voffB);
    PG8_WAIT_V(6); PG8_BAR;
    for (;;) {
        const bool has_next = S.next(ui + 1, nxt);
        const char* nA = has_next ? nxt.A : cA; const char* nB = has_next ? nxt.B : cB;
#pragma unroll 1
        for (int t = 0; t < nt; t += 2) {
            const bool last = (t == nt - 2);
            const char* a1 = cA + (size_t)(t + 1) * kstep;
            const char* a2 = last ? nA : cA + (size_t)(t + 2) * kstep; const char* b2 = last ? nB : cB + (size_t)(t + 2) * kstep;
            const char* a3 = a2 + kstep; const char* b3 = b2 + kstep;
            PG8_LDB(B0, 0, 0); PG8_LDB(B1, 0, 1); PG8_SCHED; PG8_LDA(At, 0, 0); PG8_STAGE(PG8_SA(1, 1), a1 + hstepA, voffA);
            PG8_WAIT_V(8); PG8_WAIT_L(0); PG8_BAR; PG8_MMA(0, 0, At, B0); PG8_MMA(0, 1, At, B1); PG8_BAR; PG8_SCHED;
            PG8_LDA(At, 0, 1); PG8_STAGE(PG8_SB(0, 0), b2, voffB); PG8_STAGE(PG8_SB(0, 1), b2 + hstepB, voffB); PG8_STAGE(PG8_SA(0, 0), a2, voffA);
            PG8_WAIT_V(8); PG8_WAIT_L(0); PG8_BAR; PG8_MMA(1, 0, At, B0); PG8_MMA(1, 1, At, B1); PG8_BAR; PG8_SCHED;
            PG8_LDB(B0, 1, 0); PG8_LDB(B1, 1, 1); PG8_SCHED; PG8_LDA(At, 1, 0); PG8_STAGE(PG8_SA(0, 1), a2 + hstepA, voffA);
            PG8_WAIT_V(8); PG8_WAIT_L(0); PG8_BAR; PG8_MMA(0, 0, At, B0); PG8_MMA(0, 1, At, B1); PG8_BAR; PG8_SCHED;
            PG8_LDA(At, 1, 1); PG8_STAGE(PG8_SB(1, 0), b3, voffB); PG8_STAGE(PG8_SB(1, 1), b3 + hstepB, voffB); PG8_STAGE(PG8_SA(1, 0), a3, voffA);
            PG8_WAIT_V(8); PG8_WAIT_L(0); PG8_BAR; PG8_MMA(1, 0, At, B0); PG8_MMA(1, 1, At, B1); PG8_BAR; PG8_SCHED;
        }
        if (wr == 0) PG8_BAR;
        if (!skip_epi) { const int le = lane_fresh(); E(acc, cur, wr, wc, le & 15, le >> 4); }
        if (!has_next) break;
#pragma unroll
        for (int a = 0; a < 2; ++a)
#pragma unroll
            for (int b = 0; b < 2; ++b)
#pragma unroll
                for (int m = 0; m < 4; ++m)
#pragma unroll
                    for (int n = 0; n < 2; ++n) acc[a][b][m][n] = (f32x4){0.f, 0.f, 0.f, 0.f};
        cur = nxt; cA = nA; cB = nB; ++ui;
        if (wr == 1) PG8_BAR;
    }
    PG8_WAIT_V(0);
    PG8_BAR;
#undef PG8_SA
#undef PG8_SB
#undef PG8_STAGE
#undef PG8_LDA
#undef PG8_LDB
#undef PG8_MMA
#undef PG8_WAIT_V
#undef PG8_WAIT_L
#undef PG8_BAR
#undef PG8_SCHED
}
}


#define DIAGF 0
constexpr int CTL_DIAGW = 4096;
__device__ __forceinline__ void diag_flag(const P& p, bool badv, unsigned bit) {
    if (DIAGF && __any(badv)) { if (lane_fresh() == 0) atomicOr((unsigned*)(p.ws + WS_CTL) + CTL_DIAGW + 3, bit); }
}
__device__ __forceinline__ bool nonfin(float x) { return !(x == x) || fabsf(x) > 3.0e38f; }
__device__ __forceinline__ bool nonfin4(const pg8::f32x4& v) { return nonfin(v[0]) || nonfin(v[1]) || nonfin(v[2]) || nonfin(v[3]); }
namespace rs {
constexpr int P_TK = 144, P_KT = 80;
constexpr int O_KH = 0, O_RH = 4608, O_BT = 9216, O_KDT = 13824;
constexpr int O_BG = 18432, O_KDG = 23552, O_VM = 28672;
constexpr int O_B2 = 33792, O_AP = 36352, O_BP = 38912, O_NT = 41472;
constexpr int O_L = 44032;
constexpr int O_GAM = 48640;
constexpr int O_X = 48896;
constexpr int CHUNK_BYTES = 53760;
constexpr int O_SEGP = 2 * CHUNK_BYTES;
constexpr int O_YB = O_SEGP + 2048;
constexpr int YB_PITCH = 68;
static_assert(O_YB + 64 * YB_PITCH * 4 <= 128 * 1024, "scan LDS");
typedef pg8::bf16x8 bf16x8; typedef pg8::f32x4 f32x4; typedef pg8::u32x4 u32x4; typedef pg8::u32x2 u32x2;
__device__ __forceinline__ bf16x8 mk8(u32x2 lo, u32x2 hi) { u32x4 w; w.x = lo.x; w.y = lo.y; w.z = hi.x; w.w = hi.y; return __builtin_bit_cast(bf16x8, w); }
__device__ __forceinline__ bf16x8 cvt8(const f32x4& a, const f32x4& b) { u32x4 w; w.x = pg8::cvt_pk_bf16(a[0], a[1]); w.y = pg8::cvt_pk_bf16(a[2], a[3]); w.z = pg8::cvt_pk_bf16(b[0], b[1]); w.w = pg8::cvt_pk_bf16(b[2], b[3]); return __builtin_bit_cast(bf16x8, w); }
}
__device__ __forceinline__ void ph_scan2(const int wv, const P& p, int ia, unsigned char* lds, bf16_t* YS, const int moeL, const int var_ = 0) {
    const int var = var_ >= 100 ? var_ - 100 : 0; const bool dummy = var_ >= 100;
    using namespace rs;
#define RS_SYNC() do { if (var != 2) __syncthreads(); } while (0)
    const int lane = lane_fresh(), tid = wv * 64 + lane, l15 = lane & 15, g = lane >> 4;
    const bf16_t* RKV = (const bf16_t*)(p.ws + WS_RKV); const bf16_t* WDp = (const bf16_t*)(p.ws + WS_WD); const bf16_t* AAp = (const bf16_t*)(p.ws + WS_AA);
    for (int unit = blockIdx.x; unit < NB * NH * 2; unit += gridDim.x) {
        const int z = unit & 1, h = (unit >> 1) % NH, b = unit / (2 * NH);
        const float k_k = p.in[I_KK][ia * D + h * HD + lane], k_a = p.in[I_KA][ia * D + h * HD + lane];
        const float r_kq = p.in[I_RK][ia * D + h * HD + lane];
        f32x4 S4[4];
#pragma unroll
        for (int i = 0; i < 4; ++i) S4[i] = (f32x4){0.f, 0.f, 0.f, 0.f};
        float rr[8], kx[8], vv[8], ww[8], aa[8];
#define RS_LOAD(scx) do { _Pragma("unroll") for (int s = 0; s < 8; ++s) { \
            const int step = (scx) * 64 + (wv >> 2) * 32 + (wv & 3) * 8 + s, t = z ? (S - 1 - step) : step; \
            const size_t o = ((size_t)b * S + t) * D + h * HD + lane; \
            rr[s] = bf2f(RKV[o]); kx[s] = bf2f(RKV[(size_t)T * D + o]); vv[s] = bf2f(RKV[2 * (size_t)T * D + o]); \
            ww[s] = bf2f(WDp[(size_t)z * T * D + o]); aa[s] = bf2f(AAp[(size_t)z * T * D + o]); } } while (0)
        RS_LOAD(0);
        float fz[32]; bf16_t* fdst = nullptr; bool fon = false;
#pragma unroll
        for (int r = 0; r < 32; ++r) fz[r] = 0.f;
        const bool filler = (wv >= 4 && moeL >= 0 && unit == (int)blockIdx.x && gridDim.x == 256) && (!dummy || var >= 4);
#define RS_FILL_LOAD(J_) do { const int J = (J_); fon = J < NE * 3 * 1024; \
            if (fon) { const int mat = J >> 10, e = mat / 3, m = mat - 3 * e, jl = J & 1023; const float* fsrc; int fldw; \
                unsigned char* mb = dummy ? p.ws + WS_XM : p.ws + WB_MOE + (size_t)moeL * MOE_STRIDE; \
                if (m < 2) { const int nb = jl >> 5, kb = jl & 31, n = nb * 64 + lane; \
                    fsrc = p.in[m ? I_WU : I_WG] + (((size_t)moeL * NE + e) * D + kb * 32) * FF + n; fldw = FF; \
                    fdst = (bf16_t*)(mb + MOE_GU) + ((size_t)e * 4096 + ((n >> 7) << 8) + m * 128 + (n & 127)) * D + kb * 32; } \
                else { const int nb = jl >> 6, kb = jl & 63, n = nb * 64 + lane; \
                    fsrc = p.in[I_WDN] + (((size_t)moeL * NE + e) * FF + kb * 32) * D + n; fldw = D; \
                    fdst = (bf16_t*)(mb + MOE_DN) + ((size_t)e * D + n) * FF + kb * 32; } \
                if (var != 6) { _Pragma("unroll") for (int r = 0; r < 32; ++r) fz[r] = __builtin_nontemporal_load(fsrc + (size_t)r * fldw); } } \
            else { _Pragma("unroll") for (int r = 0; r < 32; ++r) fz[r] = 0.f; fdst = nullptr; } } while (0)
#define RS_FILL_STORE() do { if (fon && var != 5) { _Pragma("unroll") for (int c = 0; c < 4; ++c) { u32x4 w; \
            w.x = pg8::cvt_pk_bf16(fz[8 * c], fz[8 * c + 1]); w.y = pg8::cvt_pk_bf16(fz[8 * c + 2], fz[8 * c + 3]); w.z = pg8::cvt_pk_bf16(fz[8 * c + 4], fz[8 * c + 5]); w.w = pg8::cvt_pk_bf16(fz[8 * c + 6], fz[8 * c + 7]); \
            *(u32x4*)(fdst + 8 * c) = w; } } } while (0)
        for (int sc = 0; sc < S / 64; ++sc) {
            {
                const int q = wv >> 2, seg = wv & 3; unsigned char* cb = lds + q * CHUNK_BYTES;
                const int lna = lane_fresh(); const int kpos = (lna & 32) | (((lna >> 2) & 3) << 3) | (((lna >> 4) & 1) << 2) | (lna & 3);
                REPEAT(REP_SA) {
                float pl[8];
                pl[0] = ww[0];
#pragma unroll
                for (int s = 1; s < 8; ++s) pl[s] = pl[s - 1] + ww[s];
                ((float*)(lds + O_SEGP))[(q * 4 + seg) * 64 + lane] = pl[7];
                float kkn[8], ssq[8];
#pragma unroll
                for (int s = 0; s < 8; ++s) { kkn[s] = kx[s] * k_k; ssq[s] = kkn[s] * kkn[s]; }
                wave_sum8(ssq);
#pragma unroll
                for (int s = 0; s < 8; ++s) kkn[s] *= __builtin_amdgcn_rsqf(fmaxf(ssq[s], 1e-24f));
                RS_SYNC();
                float prefix = 0.f, PCl = 0.f;
#pragma unroll
                for (int s2 = 0; s2 < 4; ++s2) { const float sp = ((const float*)(lds + O_SEGP))[(q * 4 + s2) * 64 + lane]; if (s2 < seg) prefix += sp; PCl += sp; }
                const float PC = __expf(PCl);
                float bgs[8], kdgs[8], bnv[8];
#pragma unroll
                for (int s = 0; s < 8; ++s) {
                    const int tt = seg * 8 + s;
                    const float cl = prefix + pl[s]; const float Pt = __expf(cl), Pm = __expf(cl - ww[s]), inv = __expf(-cl);
                    const float bb = kkn[s] * aa[s], kd = kx[s] * (1.0f + (aa[s] - 1.0f) * k_a);
                    const float bt = bb * inv, kdt = kd * inv;
                    bnv[s] = rr[s] * kd * r_kq;
                    const unsigned w01 = pg8::cvt_pk_bf16(kkn[s] * Pm, rr[s] * Pt), w23 = pg8::cvt_pk_bf16(bt, kdt);
                    *(bf16_t*)(cb + O_KH + tt * P_TK + kpos * 2) = (bf16_t)w01;
                    *(bf16_t*)(cb + O_RH + tt * P_TK + kpos * 2) = (bf16_t)(w01 >> 16);
                    *(bf16_t*)(cb + O_BT + tt * P_TK + kpos * 2) = (bf16_t)w23;
                    *(bf16_t*)(cb + O_KDT + tt * P_TK + kpos * 2) = (bf16_t)(w23 >> 16);
                    bgs[s] = bt * PC; kdgs[s] = kdt * PC;
                    diag_flag(p, nonfin(bt) || nonfin(kdt) || nonfin(kkn[s] * Pm) || nonfin(rr[s] * Pt) || nonfin(bgs[s]) || nonfin(kdgs[s]) || nonfin(vv[s]), 1u);
                    diag_flag(p, !(Pt > 1e-12f) || nonfin(inv), 2u);
                }
                wave_sum8(bnv);
                { float bsel = bnv[0];
#pragma unroll
                  for (int s = 1; s < 8; ++s) bsel = (lna == s) ? bnv[s] : bsel;
                  if (lna < 8) { const int step = sc * 64 + q * 32 + seg * 8 + lna, t = z ? (S - 1 - step) : step;
                      ((float*)(p.ws + WS_BON))[((size_t)z * T + (size_t)b * S + t) * NH + h] = bsel; } }
                u32x4 w;
                w.x = pg8::cvt_pk_bf16(bgs[0], bgs[1]); w.y = pg8::cvt_pk_bf16(bgs[2], bgs[3]); w.z = pg8::cvt_pk_bf16(bgs[4], bgs[5]); w.w = pg8::cvt_pk_bf16(bgs[6], bgs[7]);
                { u32x2 wl; wl.x = w.x; wl.y = w.y; u32x2 wh; wh.x = w.z; wh.y = w.w; const int pb = 16 * (seg & 1) + 4 * (seg >> 1);
                  *(u32x2*)(cb + O_BG + lane * P_KT + pb * 2) = wl; *(u32x2*)(cb + O_BG + lane * P_KT + (pb + 8) * 2) = wh; }
                w.x = pg8::cvt_pk_bf16(kdgs[0], kdgs[1]); w.y = pg8::cvt_pk_bf16(kdgs[2], kdgs[3]); w.z = pg8::cvt_pk_bf16(kdgs[4], kdgs[5]); w.w = pg8::cvt_pk_bf16(kdgs[6], kdgs[7]);
                *(u32x4*)(cb + O_KDG + lane * P_KT + seg * 16) = w;
                w.x = pg8::cvt_pk_bf16(vv[0], vv[1]); w.y = pg8::cvt_pk_bf16(vv[2], vv[3]); w.z = pg8::cvt_pk_bf16(vv[4], vv[5]); w.w = pg8::cvt_pk_bf16(vv[6], vv[7]);
                *(u32x4*)(cb + O_VM + lane * P_KT + seg * 16) = w;
                if (seg == 0) *(float*)(cb + O_GAM + lane * 4) = PC;
                }
                if (sc + 1 < S / 64 && var != 1) RS_LOAD(sc + 1);
            }
            RS_SYNC();
            {
                const int q = wv >> 2, o = wv & 3; unsigned char* cb = lds + q * CHUNK_BYTES;
                const int lnb = lane_fresh(), l15 = lnb & 15, g = lnb >> 4;
                REPEAT(REP_SB) {
                const unsigned char* Xm = cb + ((o & 1) ? O_KDT : O_BT); const unsigned char* Ym = cb + ((o >> 1) ? O_RH : O_KH);
#pragma unroll
                for (int ti = 0; ti < 2; ++ti)
#pragma unroll
                    for (int tt = 0; tt < 2; ++tt) {
                        f32x4 acc = (f32x4){0.f, 0.f, 0.f, 0.f};
                        if (tt >= ti) {
#pragma unroll
                            for (int ks = 0; ks < 2; ++ks) {
                                const bf16x8 a = *(const bf16x8*)(Xm + (16 * ti + l15) * P_TK + (32 * ks + 8 * g) * 2);
                                const bf16x8 bq = *(const bf16x8*)(Ym + (16 * tt + l15) * P_TK + (32 * ks + 8 * g) * 2);
                                acc = __builtin_amdgcn_mfma_f32_16x16x32_bf16(a, bq, acc, 0, 0, 0);
                            }
                        }
                        const int t = 16 * tt + l15, i0 = 16 * ti + 4 * g;
#pragma unroll
                        for (int r = 0; r < 4; ++r) { const int i = i0 + r; const bool keep = (o < 2) ? (i < t) : (i <= t); if (!keep) acc[r] = 0.f; }
                        diag_flag(p, nonfin4(acc), 4u);
                        if (o == 0) *(f32x4*)(cb + O_L + t * 144 + i0 * 4) = acc;
                        else { u32x2 w; w.x = pg8::cvt_pk_bf16(acc[0], acc[1]); w.y = pg8::cvt_pk_bf16(acc[2], acc[3]);
                               if (o == 2) *(u32x2*)(cb + O_AP + t * P_KT + (8 * g + 4 * ti) * 2) = w;
                               else *(u32x2*)(cb + (o == 1 ? O_B2 : O_BP) + t * P_KT + i0 * 2) = w; }
                    }
                }
            }
            RS_SYNC();
            REPEAT(REP_SC) {
            const int tid = wv * 64 + lane_fresh();
            if (tid < 64) {
                const int q = tid >> 5, d = (tid >> 4) & 1, j = tid & 15; unsigned char* cb = lds + q * CHUNK_BYTES;
                float x[16];
#pragma unroll
                for (int i = 0; i < 16; ++i) x[i] = (i == j) ? 1.f : 0.f;
                const unsigned char* Lb = cb + O_L + (16 * d) * 144 + (16 * d) * 4;
                f32x4 Lr[16][4];
#define RS_LROWS(lo, hi) do { _Pragma("unroll") for (int tl = (lo); tl < (hi); ++tl) { _Pragma("unroll") for (int c4 = 0; c4 < (tl + 3) / 4; ++c4) Lr[tl][c4] = *(const f32x4*)(Lb + tl * 144 + c4 * 16); } \
            asm volatile("s_waitcnt lgkmcnt(0)" ::: "memory"); __builtin_amdgcn_sched_barrier(0); } while (0)
#define RS_LSOLVE(lo, hi) do { _Pragma("unroll") for (int tl = (lo); tl < (hi); ++tl) { float s4[4] = {0.f, 0.f, 0.f, 0.f}; \
            _Pragma("unroll") for (int il = 0; il < tl; ++il) s4[il & 3] += Lr[tl][il >> 2][il & 3] * x[il]; \
            const float s = (s4[0] + s4[1]) + (s4[2] + s4[3]); x[tl] = (tl > j) ? -s : x[tl]; } } while (0)
                RS_LROWS(1, 10); RS_LSOLVE(1, 10);
                RS_LROWS(10, 16); RS_LSOLVE(10, 16);
#undef RS_LROWS
#undef RS_LSOLVE
#pragma unroll
                for (int tl = 0; tl < 16; ++tl) { *(float*)(cb + O_X + (16 * d + tl) * 144 + (16 * d + j) * 4) = x[tl]; diag_flag(p, nonfin(x[tl]) || fabsf(x[tl]) > 1e6f, 8u); }
            }
            if (filler) { RS_FILL_STORE(); RS_FILL_LOAD(((int)blockIdx.x * 4 + (wv - 4)) * 64 + sc * 2); }
            RS_SYNC();
            {
                const int q = tid >> 8, tl = (tid >> 4) & 15, jl = tid & 15; unsigned char* cb = lds + q * CHUNK_BYTES;
                const float* Lr = (const float*)(cb + O_L + (16 + tl) * 144);
                float s = 0.f;
#pragma unroll
                for (int i = 0; i < 16; ++i) s += Lr[i] * *(const float*)(cb + O_X + i * 144 + jl * 4);
                *(float*)(cb + O_X + tl * 144 + (16 + jl) * 4) = s;
            }
            RS_SYNC();
            {
                const int q = tid >> 8, tl = (tid >> 4) & 15, jl = tid & 15; unsigned char* cb = lds + q * CHUNK_BYTES;
                float s = 0.f;
#pragma unroll
                for (int i = 0; i < 16; ++i) s += *(const float*)(cb + O_X + (16 + tl) * 144 + (16 + i) * 4) * *(const float*)(cb + O_X + i * 144 + (16 + jl) * 4);
                diag_flag(p, nonfin(s), 16u);
                const int p0 = 8 * (jl >> 2) + (jl & 3), p1 = p0 + 4;
                *(bf16_t*)(cb + O_NT + (16 + tl) * P_KT + p0 * 2) = f2bf(s);
                *(bf16_t*)(cb + O_NT + tl * P_KT + p0 * 2) = f2bf(-*(const float*)(cb + O_X + tl * 144 + jl * 4));
                *(bf16_t*)(cb + O_NT + (16 + tl) * P_KT + p1 * 2) = f2bf(-*(const float*)(cb + O_X + (16 + tl) * 144 + (16 + jl) * 4));
                *(bf16_t*)(cb + O_NT + tl * P_KT + p1 * 2) = (bf16_t)0;
            }
            RS_SYNC();
            }
            if (wv < 4) REPEAT(REP_SD) {
                const int lnd = lane_fresh(), l15 = lnd & 15, g = lnd >> 4;
                f32x4 St[4] = {S4[0], S4[1], S4[2], S4[3]};
#pragma unroll 1
                for (int q = 0; q < 2; ++q) {
                    const unsigned char* cb = lds + q * CHUNK_BYTES;
                    bf16x8 fKH[2][2], fRH[2][2], fB2[2], fNT[2], fAP[2], fBP[2], fBG[4], fKDG[4]; f32x4 fG[4];
                    const bf16x8 vm = *(const bf16x8*)(cb + O_VM + (16 * wv + l15) * P_KT + 16 * g);
#pragma unroll
                    for (int ct = 0; ct < 2; ++ct) {
#pragma unroll
                        for (int s = 0; s < 2; ++s) fKH[ct][s] = *(const bf16x8*)(cb + O_KH + (16 * ct + l15) * P_TK + (32 * s + 8 * g) * 2);
                        fB2[ct] = *(const bf16x8*)(cb + O_B2 + (16 * ct + l15) * P_KT + 16 * g);
                        fNT[ct] = *(const bf16x8*)(cb + O_NT + (16 * ct + l15) * P_KT + 16 * g);
                    }
                    asm volatile("s_waitcnt lgkmcnt(0)" ::: "memory");
                    __builtin_amdgcn_sched_barrier(0);
                    bf16x8 sb[2]; sb[0] = cvt8(St[0], St[1]); sb[1] = cvt8(St[2], St[3]);
                    f32x4 w2[2];
#pragma unroll
                    for (int ct = 0; ct < 2; ++ct) {
                        f32x4 acc = (f32x4){0.f, 0.f, 0.f, 0.f};
                        acc = __builtin_amdgcn_mfma_f32_16x16x32_bf16(fKH[ct][0], sb[0], acc, 0, 0, 0);
                        acc = __builtin_amdgcn_mfma_f32_16x16x32_bf16(fKH[ct][1], sb[1], acc, 0, 0, 0);
                        acc = __builtin_amdgcn_mfma_f32_16x16x32_bf16(fB2[ct], vm, acc, 0, 0, 0);
                        w2[ct] = acc;
                    }
                    __builtin_amdgcn_sched_barrier(0);
#pragma unroll
                    for (int kt = 0; kt < 4; ++kt) {
                        fG[kt] = *(const f32x4*)(cb + O_GAM + (16 * kt + 4 * g) * 4);
                        fBG[kt] = *(const bf16x8*)(cb + O_BG + (16 * kt + l15) * P_KT + 16 * g);
                        fKDG[kt] = *(const bf16x8*)(cb + O_KDG + (16 * kt + l15) * P_KT + 16 * g);
                    }
                    __builtin_amdgcn_sched_barrier(0);
                    diag_flag(p, nonfin4(w2[0]) || nonfin4(w2[1]), 32u);
                    const bf16x8 wb = cvt8(w2[0], w2[1]);
                    f32x4 u2[2];
#pragma unroll
                    for (int ct = 0; ct < 2; ++ct) u2[ct] = __builtin_amdgcn_mfma_f32_16x16x32_bf16(fNT[ct], wb, (f32x4){0.f, 0.f, 0.f, 0.f}, 0, 0, 0);
                    diag_flag(p, nonfin4(u2[0]) || nonfin4(u2[1]), 64u);
                    const bf16x8 ub = cvt8(u2[0], u2[1]);
                    __builtin_amdgcn_sched_barrier(0);
#pragma unroll
                    for (int ct = 0; ct < 2; ++ct) {
#pragma unroll
                        for (int s = 0; s < 2; ++s) fRH[ct][s] = *(const bf16x8*)(cb + O_RH + (16 * ct + l15) * P_TK + (32 * s + 8 * g) * 2);
                        fBP[ct] = *(const bf16x8*)(cb + O_BP + (16 * ct + l15) * P_KT + 16 * g);
                        fAP[ct] = *(const bf16x8*)(cb + O_AP + (16 * ct + l15) * P_KT + 16 * g);
                    }
                    asm volatile("s_waitcnt lgkmcnt(8)" ::: "memory");
                    __builtin_amdgcn_sched_barrier(0);
#pragma unroll
                    for (int kt = 0; kt < 4; ++kt) {
                        f32x4 acc = St[kt] * fG[kt];
                        acc = __builtin_amdgcn_mfma_f32_16x16x32_bf16(fBG[kt], ub, acc, 0, 0, 0);
                        acc = __builtin_amdgcn_mfma_f32_16x16x32_bf16(fKDG[kt], vm, acc, 0, 0, 0);
                        St[kt] = acc; diag_flag(p, nonfin4(acc), 256u);
                    }
                    asm volatile("s_waitcnt lgkmcnt(0)" ::: "memory");
                    __builtin_amdgcn_sched_barrier(0);
#pragma unroll
                    for (int tt = 0; tt < 2; ++tt) {
                        f32x4 acc = (f32x4){0.f, 0.f, 0.f, 0.f};
                        acc = __builtin_amdgcn_mfma_f32_16x16x32_bf16(fRH[tt][0], sb[0], acc, 0, 0, 0);
                        acc = __builtin_amdgcn_mfma_f32_16x16x32_bf16(fRH[tt][1], sb[1], acc, 0, 0, 0);
                        acc = __builtin_amdgcn_mfma_f32_16x16x32_bf16(fAP[tt], ub, acc, 0, 0, 0);
                        acc = __builtin_amdgcn_mfma_f32_16x16x32_bf16(fBP[tt], vm, acc, 0, 0, 0);
                        diag_flag(p, nonfin4(acc), 128u);
                        float* yb = (float*)(lds + O_YB) + (q * 32 + 16 * tt + 4 * g) * YB_PITCH + 16 * wv + l15;
#pragma unroll
                        for (int r = 0; r < 4; ++r) yb[r * YB_PITCH] = acc[r];
                    }
                }
                if (LASTREP(REP_SD)) { S4[0] = St[0]; S4[1] = St[1]; S4[2] = St[2]; S4[3] = St[3]; }
            }
            else if (filler) {
                RS_FILL_STORE();
                RS_FILL_LOAD(((int)blockIdx.x * 4 + (wv - 4)) * 64 + sc * 2 + 1);
            }
            RS_SYNC();
            const int tido = wv * 64 + lane_fresh();
#pragma unroll
            for (int jj = 0; jj < 4; ++jj) {
                const int idx = tido + jj * NTHR, i = idx >> 5, v2 = idx & 31;
                const int step = sc * 64 + i, t = z ? (S - 1 - step) : step;
                const float2 yv = *(const float2*)((const float*)(lds + O_YB) + i * YB_PITCH + 2 * v2);
                if (var != 3) *(unsigned*)(YS + (size_t)z * T * D + ((size_t)b * S + t) * D + h * HD + 2 * v2) = pg8::cvt_pk_bf16(yv.x, yv.y);
            }
        }
        if (filler) RS_FILL_STORE();
        RS_SYNC();
    }
    __syncthreads();
}
#undef RS_SYNC
struct SchedBase { int G, c; };
struct SchedProj : SchedBase {
    const char* XM; const char* Wrkv; const char* L1t;
    __device__ __forceinline__ bool next(int i, pg8::Unit& u) const {
        const int L = i * G + c; if (L >= 960) return false;
        if (L < 768) {
            if (G == 256) { const int x = c & 7, j = c >> 3; u.job = i; u.pm = 8 * x + (j & 7); u.pn = j >> 3; }
            else { u.job = L >> 8; const int r = L & 255; u.pm = r >> 2; u.pn = r & 3; }
            u.B = Wrkv + ((size_t)u.job * 1024 + u.pn * 256) * 1024 * 2; }
        else { const int r = L - 768; u.job = 3 + r / 64; u.pm = r % 64; u.pn = 0; u.B = L1t + (size_t)(u.job - 3) * 256 * 1024 * 2; }
        u.A = XM + ((size_t)u.job * T + (size_t)u.pm * 256) * D * 2;
        return true;
    }
};
struct SchedLora2 : SchedBase {
    const char* L1b; const char* L2t;
    __device__ __forceinline__ bool next(int i, pg8::Unit& u) const {
        const int L = i * G + c; if (L >= 1280) return false;
        if (G == 256) { const int x = c & 7, j = c >> 3; u.job = i; u.pm = 8 * x + (j & 7); u.pn = j >> 3; }
        else { u.job = L >> 8; const int r = L & 255; u.pm = r >> 2; u.pn = r & 3; }
        u.A = L1b + ((size_t)u.pm * 256 * 512 + (u.job < 2 ? 0 : (u.job < 4 ? 128 : 256))) * 2;
        u.B = L2t + ((size_t)u.job * 1024 + u.pn * 256) * 128 * 2;
        return true;
    }
};
struct SchedPlain : SchedBase {
    const char* A; const char* B; int nN, lda, ldb;
    __device__ __forceinline__ bool next(int i, pg8::Unit& u) const {
        const int L = i * G + c; if (L >= 64 * nN) return false;
        u.job = 0;
        if (G == 256) { const int x = c & 7, j = c >> 3; u.pm = 8 * x + (j & 7); u.pn = 4 * i + (j >> 3); }
        else { u.pm = L / nN; u.pn = L % nN; }
        u.A = A + (size_t)u.pm * 256 * lda * 2; u.B = B + (size_t)u.pn * 256 * ldb * 2;
        return true;
    }
};
struct SchedLruGate : SchedBase {
    const char* UCB; const char* Wg;
    __device__ __forceinline__ bool next(int i, pg8::Unit& u) const {
        const int L = i * G + c; if (L >= 1024) return false;
        u.job = L >> 6; u.pm = L & 63; u.pn = 0;
        u.A = UCB + ((size_t)u.pm * 256 * D + ((u.job >> 1) & 3) * 256) * 2; u.B = Wg + (size_t)u.job * 256 * 256 * 2;
        return true;
    }
};
struct SchedMoe1 : SchedBase {
    const char* XIN; const char* Wgu;
    __device__ __forceinline__ bool next(int i, pg8::Unit& u) const {
        const int L = i * G + c; if (L >= 2048) return false;
        if (G == 256) { const int x = c & 7, j = c >> 3, xq = x & 3; u.job = 2 * i + (x >> 2); u.pm = (xq & 1) * 4 + (j & 3); u.pn = (xq >> 1) * 8 + (j >> 2); }
        else { u.job = L >> 7; const int r = L & 127; u.pm = r & 7; u.pn = r >> 3; }
        u.A = XIN + ((size_t)u.job * 2048 + u.pm * 256) * D * 2; u.B = Wgu + ((size_t)u.job * 4096 + u.pn * 256) * D * 2;
        return true;
    }
};
struct SchedMoe2 : SchedBase {
    const char* HID; const char* Wdn;
    __device__ __forceinline__ bool next(int i, pg8::Unit& u) const {
        const int L = i * G + c; if (L >= 512) return false;
        if (G == 256) { const int x = c & 7, j = c >> 3; u.job = 8 * i + x; u.pm = j & 7; u.pn = j >> 3; }
        else { u.job = L >> 5; const int r = L & 31; u.pm = r & 7; u.pn = r >> 3; }
        u.A = HID + ((size_t)u.job * 2048 + u.pm * 256) * FF * 2; u.B = Wdn + ((size_t)u.job * 1024 + u.pn * 256) * FF * 2;
        return true;
    }
};

#define EPI_ARGS const pg8::f32x4 (&acc)[2][2][4][2], const pg8::Unit& u, int wr, int wc, int fr, int fq
#define EPI_ROWS for (int ai = 0; ai < 2; ++ai) _Pragma("unroll") for (int m = 0; m < 4; ++m)
#define EPI_COLS for (int bj = 0; bj < 2; ++bj) _Pragma("unroll") for (int n = 0; n < 2; ++n)
struct EpiProj {
    static constexpr bool PERM = true;
    bf16_t* RKVb; bf16_t* L1b;
    __device__ __forceinline__ void operator()(EPI_ARGS) const {
        const int row0 = u.pm * 256 + wr * 64 + fr;
        if (u.job < 3) {
            bf16_t* C = RKVb + (size_t)u.job * T * D; const int col0 = u.pn * 256 + wc * 32 + 8 * fq;
#pragma unroll
            EPI_ROWS { bf16_t* rowp = C + (size_t)(row0 + ai * 128 + m * 16) * D + col0;
#pragma unroll
                for (int bj = 0; bj < 2; ++bj) { const pg8::f32x4 v0 = acc[ai][bj][m][0], v1 = acc[ai][bj][m][1]; pg8::u32x4 w;
                    w.x = pg8::cvt_pk_bf16(v0[0], v0[1]); w.y = pg8::cvt_pk_bf16(v0[2], v0[3]); w.z = pg8::cvt_pk_bf16(v1[0], v1[1]); w.w = pg8::cvt_pk_bf16(v1[2], v1[3]);
                    *(pg8::u32x4*)(rowp + bj * 128) = w; } }
        } else {
            const int col0 = (u.job - 3) * 128 + wc * 32 + 8 * fq; const int act = u.job;
#pragma unroll
            EPI_ROWS { bf16_t* rowp = L1b + (size_t)(row0 + ai * 128 + m * 16) * 512 + col0;
                pg8::f32x4 v0 = acc[ai][0][m][0], v1 = acc[ai][0][m][1];
                if (act == 3) {
#pragma unroll
                    for (int j = 0; j < 4; ++j) { v0[j] = tanhf_(v0[j]); v1[j] = tanhf_(v1[j]); } }
                else if (act == 5) {
#pragma unroll
                    for (int j = 0; j < 4; ++j) { v0[j] = sigmoidf_(v0[j]); v1[j] = sigmoidf_(v1[j]); } }
                pg8::u32x4 w; w.x = pg8::cvt_pk_bf16(v0[0], v0[1]); w.y = pg8::cvt_pk_bf16(v0[2], v0[3]); w.z = pg8::cvt_pk_bf16(v1[0], v1[1]); w.w = pg8::cvt_pk_bf16(v1[2], v1[3]);
                *(pg8::u32x4*)rowp = w;
                if (act == 5) { pg8::u32x4 zz; zz.x = 0u; zz.y = 0u; zz.z = 0u; zz.w = 0u; *(pg8::u32x4*)(rowp + 128) = zz; }
            }
        }
    }
};
struct EpiLora2 {
    static constexpr bool PERM = true;
    bf16_t* WDL; bf16_t* AAb; bf16_t* GGb; const float* w0; const float* a0;
    __device__ __forceinline__ void operator()(EPI_ARGS) const {
        const int row0 = u.pm * 256 + wr * 64 + fr, col0 = u.pn * 256 + wc * 32 + 8 * fq, job = u.job;
        bf16_t* C = job < 2 ? WDL + (size_t)job * T * D : (job < 4 ? AAb + (size_t)(job - 2) * T * D : GGb);
        const float* bias = job < 2 ? w0 + job * D : a0 + (job < 4 ? job - 2 : 0) * D;
        const float sc = job < 2 ? -0.6065306597126334f : 1.0f;
#pragma unroll
        for (int bj = 0; bj < 2; ++bj) {
            const pg8::f32x4 b0 = *(const pg8::f32x4*)(bias + col0 + bj * 128), b1 = *(const pg8::f32x4*)(bias + col0 + bj * 128 + 4);
#pragma unroll
            EPI_ROWS { pg8::f32x4 v0 = acc[ai][bj][m][0], v1 = acc[ai][bj][m][1];
                if (job < 4) { v0 = v0 + b0; v1 = v1 + b1;
#pragma unroll
                    for (int j = 0; j < 4; ++j) { v0[j] = sc * sigmoidf_(v0[j]); v1[j] = sc * sigmoidf_(v1[j]); } }
                pg8::u32x4 w; w.x = pg8::cvt_pk_bf16(v0[0], v0[1]); w.y = pg8::cvt_pk_bf16(v0[2], v0[3]); w.z = pg8::cvt_pk_bf16(v1[0], v1[1]); w.w = pg8::cvt_pk_bf16(v1[2], v1[3]);
                *(pg8::u32x4*)(C + (size_t)(row0 + ai * 128 + m * 16) * D + col0 + bj * 128) = w; }
        }
    }
};
struct EpiStoreF32 {
    static constexpr bool PERM = false;
    float* C; int ldc;
    __device__ __forceinline__ void operator()(EPI_ARGS) const {
        const int row0 = u.pm * 256 + wr * 64 + fr, col0 = u.pn * 256 + wc * 32 + 4 * fq;
#pragma unroll
        EPI_ROWS { float* rowp = C + (size_t)(row0 + ai * 128 + m * 16) * ldc + col0;
#pragma unroll
            EPI_COLS *(pg8::f32x4*)(rowp + bj * 128 + n * 16) = acc[ai][bj][m][n]; }
    }
};
struct EpiAddX {
    static constexpr bool PERM = false;
    float* X;
    __device__ __forceinline__ void operator()(EPI_ARGS) const {
        const int row0 = u.pm * 256 + wr * 64 + fr, col0 = u.pn * 256 + wc * 32 + 4 * fq;
#pragma unroll
        EPI_ROWS { float* rowp = X + (size_t)(row0 + ai * 128 + m * 16) * D + col0;
#pragma unroll
            EPI_COLS { pg8::f32x4* q = (pg8::f32x4*)(rowp + bj * 128 + n * 16); *q = *q + acc[ai][bj][m][n]; } }
    }
};
struct EpiLruGate {
    static constexpr bool PERM = true;
    bf16_t* LA; bf16_t* LB; const bf16_t* UCB; const float* ba; const float* bx; const float* lam;
    __device__ __forceinline__ void operator()(EPI_ARGS) const {
        const int z = u.job >> 3, h = (u.job >> 1) & 3, half = u.job & 1;
        const int row0 = u.pm * 256 + wr * 64 + fr, c0 = h * 256 + half * 128 + wc * 32 + 8 * fq;
        bf16_t* la = LA + (size_t)z * T * D; bf16_t* lb = LB + (size_t)z * T * D;
#pragma unroll
        for (int n = 0; n < 2; ++n) {
            const int c4 = c0 + 4 * n;
            const pg8::f32x4 lm = *(const pg8::f32x4*)(lam + z * D + c4), ba4 = *(const pg8::f32x4*)(ba + z * D + c4), bx4 = *(const pg8::f32x4*)(bx + z * D + c4);
            pg8::f32x4 sp4;
#pragma unroll
            for (int j = 0; j < 4; ++j) sp4[j] = -8.0f * softplusf_(-lm[j]);
#pragma unroll
            EPI_ROWS { const size_t o = (size_t)(row0 + ai * 128 + m * 16) * D + c4;
                const uint2 uu = *(const uint2*)(UCB + o); float uv[4]; bf4_to_f(uu, uv);
                float lo[4], bo[4];
#pragma unroll
                for (int j = 0; j < 4; ++j) { const float ra = acc[ai][0][m][n][j] + ba4[j], ix = acc[ai][1][m][n][j] + bx4[j];
                    const float l = sp4[j] * sigmoidf_(ra); lo[j] = l; const float x2 = 2.0f * l;   const float om = -x2 * (1.0f + x2 * (0.5f + x2 * (0.16666667f + x2 * (0.041666668f + x2 * 0.008333334f)))); bo[j] = __builtin_amdgcn_sqrtf(fmaxf(om, 0.f)) * sigmoidf_(ix) * uv[j]; }
                pg8::u32x2 w; w.x = pg8::cvt_pk_bf16(lo[0], lo[1]); w.y = pg8::cvt_pk_bf16(lo[2], lo[3]); *(pg8::u32x2*)(la + o) = w;
                w.x = pg8::cvt_pk_bf16(bo[0], bo[1]); w.y = pg8::cvt_pk_bf16(bo[2], bo[3]); *(pg8::u32x2*)(lb + o) = w; }
        }
    }
};
struct EpiSwiglu {
    static constexpr bool PERM = true;
    bf16_t* HID;
    __device__ __forceinline__ void operator()(EPI_ARGS) const {
        bf16_t* base = HID + (size_t)u.job * 2048 * FF; const int row0 = u.pm * 256 + wr * 64 + fr, col0 = u.pn * 128 + wc * 32 + 8 * fq;
#pragma unroll
        EPI_ROWS { float o[8];
#pragma unroll
            for (int n = 0; n < 2; ++n)
#pragma unroll
                for (int j = 0; j < 4; ++j) { const float gt = acc[ai][0][m][n][j], up = acc[ai][1][m][n][j]; o[n * 4 + j] = gt * sigmoidf_(gt) * up; }
            pg8::u32x4 w; w.x = pg8::cvt_pk_bf16(o[0], o[1]); w.y = pg8::cvt_pk_bf16(o[2], o[3]); w.z = pg8::cvt_pk_bf16(o[4], o[5]); w.w = pg8::cvt_pk_bf16(o[6], o[7]);
            *(pg8::u32x4*)(base + (size_t)(row0 + ai * 128 + m * 16) * FF + col0) = w; }
    }
};
struct EpiDown {
    static constexpr bool PERM = true;
    bf16_t* YEXP; const float* GATE;
    __device__ __forceinline__ void operator()(EPI_ARGS) const {
        const int row0 = u.pm * 256 + wr * 64 + fr, col0 = u.pn * 256 + wc * 32 + 8 * fq;
        bf16_t* C = YEXP + (size_t)u.job * 2048 * D; const float* gt = GATE + (size_t)u.job * 2048;
#pragma unroll
        EPI_ROWS { const int row = row0 + ai * 128 + m * 16; const float gs = gt[row];
#pragma unroll
            for (int bj = 0; bj < 2; ++bj) { const pg8::f32x4 v0 = acc[ai][bj][m][0] * gs, v1 = acc[ai][bj][m][1] * gs; pg8::u32x4 w;
                w.x = pg8::cvt_pk_bf16(v0[0], v0[1]); w.y = pg8::cvt_pk_bf16(v0[2], v0[3]); w.z = pg8::cvt_pk_bf16(v1[0], v1[1]); w.w = pg8::cvt_pk_bf16(v1[2], v1[3]);
                *(pg8::u32x4*)(C + (size_t)row * D + col0 + bj * 128) = w; } }
    }
};
struct EpiStoreBf16 {
    static constexpr bool PERM = true;
    bf16_t* O; int ldc;
    __device__ __forceinline__ void operator()(EPI_ARGS) const {
        const int row0 = u.pm * 256 + wr * 64 + fr, col0 = u.pn * 256 + wc * 32 + 8 * fq;
#pragma unroll
        EPI_ROWS { bf16_t* rowp = O + (size_t)(row0 + ai * 128 + m * 16) * ldc + col0;
#pragma unroll
            for (int bj = 0; bj < 2; ++bj) { const pg8::f32x4 v0 = acc[ai][bj][m][0], v1 = acc[ai][bj][m][1]; pg8::u32x4 w;
                w.x = pg8::cvt_pk_bf16(v0[0], v0[1]); w.y = pg8::cvt_pk_bf16(v0[2], v0[3]); w.z = pg8::cvt_pk_bf16(v1[0], v1[1]); w.w = pg8::cvt_pk_bf16(v1[2], v1[3]);
                *(pg8::u32x4*)(rowp + bj * 128) = w; } }
    }
};

struct RmId { __device__ __forceinline__ int operator()(int n) const { return n; } };
struct RmGU { int off; __device__ __forceinline__ int operator()(int n) const { return ((n >> 7) << 8) + off + (n & 127); } };
template <class RM>
__device__ __forceinline__ void tconv(const int wv, const float* W, int ldw, int K, int N, bf16_t* dst, int ldb, int koff, const RM rm, float* lds, int& rot) {
    const int tid = TID, G = gridDim.x, tn = N >> 7, ntiles = (K >> 6) * tn;
    const int lr = tid >> 5, lc = (tid & 31) * 4;
    const int sn = tid >> 3, sk = (tid & 7) * 8;
    int t = (int)(((unsigned)blockIdx.x + (unsigned)G - (unsigned)(rot % G)) % (unsigned)G);
    float4 cur[4], nx[4];
    if (t < ntiles) { const int k0 = (t / tn) << 6, n0 = (t % tn) << 7;
#pragma unroll
        for (int i = 0; i < 4; ++i) { const pg8::f32x4 t4 = __builtin_nontemporal_load((const pg8::f32x4*)(W + (size_t)(k0 + lr + 16 * i) * ldw + n0 + lc)); cur[i] = make_float4(t4[0], t4[1], t4[2], t4[3]); } }
    for (; t < ntiles; t += G) {
        const int k0 = (t / tn) << 6, n0 = (t % tn) << 7; const int t2 = t + G;
        if (t2 < ntiles) { const int k2 = (t2 / tn) << 6, n2 = (t2 % tn) << 7;
#pragma unroll
            for (int i = 0; i < 4; ++i) { const pg8::f32x4 t4 = __builtin_nontemporal_load((const pg8::f32x4*)(W + (size_t)(k2 + lr + 16 * i) * ldw + n2 + lc)); nx[i] = make_float4(t4[0], t4[1], t4[2], t4[3]); } }
        __syncthreads();
#pragma unroll
        for (int i = 0; i < 4; ++i) { float* q = lds + (lr + 16 * i) * 129 + lc; q[0] = cur[i].x; q[1] = cur[i].y; q[2] = cur[i].z; q[3] = cur[i].w; }
        __syncthreads();
#pragma unroll
        for (int i = 0; i < 2; ++i) { const int n = sn + 64 * i; float f[8];
#pragma unroll
            for (int j = 0; j < 8; ++j) f[j] = lds[(sk + j) * 129 + n];
            pg8::u32x4 w; w.x = pg8::cvt_pk_bf16(f[0], f[1]); w.y = pg8::cvt_pk_bf16(f[2], f[3]); w.z = pg8::cvt_pk_bf16(f[4], f[5]); w.w = pg8::cvt_pk_bf16(f[6], f[7]);
            *(pg8::u32x4*)(dst + (size_t)rm(n0 + n) * ldb + koff + k0 + sk) = w; }
#pragma unroll
        for (int i = 0; i < 4; ++i) cur[i] = nx[i];
    }
    rot += ntiles;
}
__device__ __forceinline__ void tconv_small(const int wv, const float* W, int K, int N, bf16_t* dst, int ldb, int noff) {
    for (int i = blockIdx.x * NTHR + TID; i < K * N; i += gridDim.x * NTHR) { const int k = i / N, n = i - k * N; dst[(size_t)(n + noff) * ldb + k] = f2bf(W[i]); }
}
__device__ __forceinline__ void zfill(const int wv, bf16_t* dst, int ldb, int r0, int r1, int c0, int c1) {
    const int w8 = (c1 - c0) >> 3, tot = (r1 - r0) * w8;
    for (int i = blockIdx.x * NTHR + TID; i < tot; i += gridDim.x * NTHR) { const int r = r0 + i / w8, c = c0 + (i % w8) * 8; *(uint4*)(dst + (size_t)r * ldb + c) = make_uint4(0u, 0u, 0u, 0u); }
}
__device__ __forceinline__ void ph_prologue(const int wv, const P& p, float* lds) {
    int rot = 0;
    unsigned char* ws = p.ws;
    for (int L = 0; L < DEPTH; ++L) {
        if (gridDim.x == 256 && (L % 3) == 0) continue;
        for (int e = 0; e < NE; ++e) {
            bf16_t* gu = (bf16_t*)(ws + WB_MOE + (size_t)L * MOE_STRIDE + MOE_GU) + (size_t)e * 4096 * D;
            bf16_t* dn = (bf16_t*)(ws + WB_MOE + (size_t)L * MOE_STRIDE + MOE_DN) + (size_t)e * D * FF;
            RmGU rg; rg.off = 0; RmGU ru; ru.off = 128;
            tconv(wv, p.in[I_WG] + ((size_t)L * NE + e) * D * FF, FF, D, FF, gu, D, 0, rg, lds, rot);
            tconv(wv, p.in[I_WU] + ((size_t)L * NE + e) * D * FF, FF, D, FF, gu, D, 0, ru, lds, rot);
            tconv(wv, p.in[I_WDN] + ((size_t)L * NE + e) * FF * D, D, FF, D, dn, FF, 0, RmId(), lds, rot);
        }
    }
    for (int ia = 0; ia < 2; ++ia) {
        unsigned char* rb = ws + WB_RW + (size_t)ia * RW_STRIDE;
        for (int q = 0; q < 3; ++q) tconv(wv, p.in[I_WIN] + ((size_t)ia * 3 + q) * D * D, D, D, D, (bf16_t*)(rb + RW_RKV) + (size_t)q * D * D, D, 0, RmId(), lds, rot);
        tconv(wv, p.in[I_WOUT] + (size_t)ia * D * D, D, D, D, (bf16_t*)(rb + RW_OUT), D, 0, RmId(), lds, rot);
        bf16_t* l1 = (bf16_t*)(rb + RW_L1);
        for (int z = 0; z < 2; ++z) { tconv_small(wv, p.in[I_W1] + ((size_t)ia * 2 + z) * D * 64, D, 64, l1, D, z * 64); tconv_small(wv, p.in[I_A1] + ((size_t)ia * 2 + z) * D * 64, D, 64, l1 + 256 * D, D, z * 64); }
        tconv(wv, p.in[I_G1] + (size_t)ia * D * 128, 128, D, 128, l1 + 2 * 256 * D, D, 0, RmId(), lds, rot);
        for (int q = 0; q < 3; ++q) zfill(wv, l1 + (size_t)q * 256 * D, D, 128, 256, 0, D);
        bf16_t* l2 = (bf16_t*)(rb + RW_L2);
        for (int z = 0; z < 2; ++z) {
            tconv(wv, p.in[I_W2] + ((size_t)ia * 2 + z) * 64 * D, D, 64, D, l2 + (size_t)z * 1024 * 128, 128, z * 64, RmId(), lds, rot);
            tconv(wv, p.in[I_A2] + ((size_t)ia * 2 + z) * 64 * D, D, 64, D, l2 + (size_t)(2 + z) * 1024 * 128, 128, z * 64, RmId(), lds, rot);
            zfill(wv, l2 + (size_t)z * 1024 * 128, 128, 0, 1024, (1 - z) * 64, (1 - z) * 64 + 64);
            zfill(wv, l2 + (size_t)(2 + z) * 1024 * 128, 128, 0, 1024, (1 - z) * 64, (1 - z) * 64 + 64);
        }
        tconv(wv, p.in[I_G2] + (size_t)ia * 128 * D, D, 128, D, l2 + (size_t)4 * 1024 * 128, 128, 0, RmId(), lds, rot);
    }
    tconv(wv, p.in[I_SCIN], 3 * D, D, 3 * D, (bf16_t*)(ws + WB_SC + SC_IN), D, 0, RmId(), lds, rot);
    tconv(wv, p.in[I_SCOUT], D, D, D, (bf16_t*)(ws + WB_SC + SC_OUT), D, 0, RmId(), lds, rot);
    tconv(wv, p.in[I_LIN], 2 * D, D, 2 * D, (bf16_t*)(ws + WB_LRU + LRU_IN), D, 0, RmId(), lds, rot);
    tconv(wv, p.in[I_LOUT], D, D, D, (bf16_t*)(ws + WB_LRU + LRU_OUT), D, 0, RmId(), lds, rot);
    for (int zh = 0; zh < 8; ++zh) {
        bf16_t* gt = (bf16_t*)(ws + WB_LRU + LRU_G) + (size_t)zh * 2 * 256 * 256;
        RmGU ra; ra.off = 0; RmGU rx; rx.off = 128;
        tconv(wv, p.in[I_LWA] + (size_t)zh * 256 * 256, 256, 256, 256, gt, 256, 0, ra, lds, rot);
        tconv(wv, p.in[I_LWX] + (size_t)zh * 256 * 256, 256, 256, 256, gt, 256, 0, rx, lds, rot);
    }
}


#define XB_TMO      128
#define XB_XCNT(j)  (256  + 64 * (j))
#define XB_XSUB(j)  (1280 + 64 * (j))
#define XB_XGEN(j)  (2304 + 64 * (j))
#define XB_TOP      3328
#define XB_TOPGEN   3392
#define XCD_BAR_WORDS 3456
#define XB_SPIN_CAP (1u << 22)
#define LAS __attribute__((address_space(3)))
__device__ __forceinline__ unsigned xb_ld(unsigned* p)              { return __hip_atomic_load(p, __ATOMIC_RELAXED, __HIP_MEMORY_SCOPE_AGENT); }
__device__ __forceinline__ unsigned xb_add(unsigned* p, unsigned v) { return __hip_atomic_fetch_add(p, v, __ATOMIC_RELAXED, __HIP_MEMORY_SCOPE_AGENT); }
__device__ __forceinline__ unsigned xb_xcc_id() { return (unsigned)__builtin_amdgcn_s_getreg((3 << 11) | 20) & 0xFu; }
#define XB_SPIN(cond, bar) do { unsigned _sp = 0; while (cond) { __builtin_amdgcn_s_sleep(1); \
    if ((++_sp & 255u) == 0u) { if (xb_ld(&(bar)[XB_TMO])) break; if (_sp > XB_SPIN_CAP) { atomicAdd(&(bar)[XB_TMO], 1u); break; } } } } while (0)
struct XcdBarrier { unsigned* bar; unsigned x; volatile LAS unsigned* st; };
__device__ __forceinline__ XcdBarrier xcd_barrier_post(const int wv, unsigned* bar, volatile LAS unsigned* st) {
    XcdBarrier b; b.bar = bar; b.x = xb_xcc_id(); b.st = st;
    if (TID == 0) (void)xb_add(&bar[XB_XCNT(b.x)], 1u);
    return b;
}
__device__ __forceinline__ void xcd_barrier_complete(unsigned* bar, unsigned x, unsigned& nloc, unsigned& nx) {
    const unsigned G = gridDim.x * gridDim.y * gridDim.z;
    unsigned sum, cnt, mine, sp = 0u;
    for (;;) {
        sum = 0u; cnt = 0u; mine = 0u;
#pragma unroll
        for (unsigned j = 0; j < 16; ++j) { const unsigned c = xb_ld(&bar[XB_XCNT(j)]); sum += c; cnt += (c > 0u) ? 1u : 0u; mine = (j == x) ? c : mine; }
        if (sum == G) break;
        __builtin_amdgcn_s_sleep(1);
        if ((++sp & 255u) == 0u) { if (xb_ld(&bar[XB_TMO])) break; if (sp > XB_SPIN_CAP) { atomicAdd(&bar[XB_TMO], 1u); break; } }
    }
    nloc = mine > 0u ? mine : 1u; nx = cnt > 0u ? cnt : 1u;
}
__device__ __forceinline__ void xcd_barrier(const int wv, const XcdBarrier& b) {
    asm volatile("s_waitcnt vmcnt(0)" ::: "memory");
    __syncthreads();
    if (TID == 0) {
        unsigned* bar = b.bar;
        __builtin_amdgcn_s_waitcnt(0);
        unsigned nloc = b.st[0], nx = b.st[1];
        if (nloc == 0u) { xcd_barrier_complete(bar, b.x, nloc, nx); b.st[0] = nloc; b.st[1] = nx; }
        const unsigned old = xb_add(&bar[XB_XSUB(b.x)], 1u);
        const unsigned gen = old / nloc;
        if (old + 1u == (gen + 1u) * nloc) {
            __builtin_amdgcn_fence(__ATOMIC_RELEASE, "agent");
            asm volatile("s_waitcnt vmcnt(0)" ::: "memory");
            const unsigned og = xb_add(&bar[XB_TOP], 1u);
            const unsigned tg = og / nx;
            if (og + 1u == (tg + 1u) * nx) xb_add(&bar[XB_TOPGEN], 1u);
            else XB_SPIN(xb_ld(&bar[XB_TOPGEN]) == tg, bar);
            __builtin_amdgcn_fence(__ATOMIC_ACQUIRE, "agent");
            xb_add(&bar[XB_XGEN(b.x)], 1u);
            asm volatile("s_waitcnt vmcnt(0)" ::: "memory");
        } else {
            XB_SPIN(xb_ld(&bar[XB_XGEN(b.x)]) == gen, bar);
            __builtin_amdgcn_fence(__ATOMIC_ACQUIRE, "agent");
            asm volatile("s_waitcnt vmcnt(0)" ::: "memory");
        }
    }
    __syncthreads();
}
struct PhaseCtl { XcdBarrier bar; int lo, hi; bool did; };
__device__ __forceinline__ bool phase_enter(const int wv, PhaseCtl& c, int k) {
    if (k < c.lo || k >= c.hi) return false;
    if (c.did) REPEAT(REP_BAR) xcd_barrier(wv, c.bar);
    c.did = true;
    return true;
}

#define DIAG 0
constexpr int CTL_DIAG = 4096;
__device__ __forceinline__ void diag_compare(const int wv, const P& p, const float* A, const float* Bq, size_t n) {
    float e = 0.f, r = 0.f; int bad = 0;
    for (size_t i = (size_t)blockIdx.x * NTHR + TID; i < n; i += (size_t)gridDim.x * NTHR) { const float a = A[i], b = Bq[i]; const float d = a - b; e += d * d; r += a * a; if (!(d == d) || fabsf(d) > 3.0e38f) bad = 1; }
    e = wave_sum(e); r = wave_sum(r); bad = __any(bad);
    if (lane_fresh() == 0) { float* c = (float*)(p.ws + WS_CTL) + CTL_DIAG; atomicAdd(c, e); atomicAdd(c + 1, r); if (bad) atomicAdd((unsigned*)(c + 2), 1u); }
}
__device__ __forceinline__ void diag_delay(const int wv, const P& p) {
    if (blockIdx.x == 0 && TID == 0) {
        float* c = (float*)(p.ws + WS_CTL) + CTL_DIAG;
        const float e = __hip_atomic_load(c, __ATOMIC_RELAXED, __HIP_MEMORY_SCOPE_AGENT), r = __hip_atomic_load(c + 1, __ATOMIC_RELAXED, __HIP_MEMORY_SCOPE_AGENT);
        const unsigned bad = __hip_atomic_load((unsigned*)(c + 2), __ATOMIC_RELAXED, __HIP_MEMORY_SCOPE_AGENT);
        const unsigned mask = __hip_atomic_load((unsigned*)(c + 3), __ATOMIC_RELAXED, __HIP_MEMORY_SCOPE_AGENT);
        float ms;
        if (bad) ms = 12.f; else if (!(r > 0.f)) ms = 14.f; else { const float rel = sqrtf(e / r); float lg = log10f(fmaxf(rel, 1e-8f)) + 8.f; lg = fminf(fmaxf(lg, 0.f), 10.f); ms = 1.f + lg; }
        if (DIAGF) { ms = 1.f; if (mask) ms = 2.f + (float)__ffs(mask); if (bad) ms += 10.f; }
        const unsigned long long t0 = __builtin_amdgcn_s_memrealtime(); const unsigned long long ticks = (unsigned long long)(ms * 100000.f);
        while (__builtin_amdgcn_s_memrealtime() - t0 < ticks) __builtin_amdgcn_s_sleep(32);
    }
}
constexpr int LDS_BYTES = 128 * 1024 + 1024;
constexpr int PH_PER_LAYER = 16, PH_FINAL = 1 + DEPTH * PH_PER_LAYER, PH_TOTAL = PH_FINAL + 1;

#define IN(k) phase_enter(wv, pc, (k))
template <int L>
__device__ __forceinline__ void run_layer(const int wv, const P& p, float* lds, PhaseCtl& pc) {
    constexpr int m = L % 3, base = 1 + L * PH_PER_LAYER, ia = L / 3;
    PG8_LAS unsigned char* glds = (PG8_LAS unsigned char*)lds;
    unsigned char* ws = p.ws;
    float* X = (float*)(ws + (L == 3 ? WS_X2 : WS_X)); bf16_t* H = (bf16_t*)(ws + WS_H);
    float* RKV = (float*)(ws + WS_RKV);
    float* WDp = (float*)(ws + WS_WD); float* AAp = (float*)(ws + WS_AA); float* GG = (float*)(ws + WS_GG);
    SchedBase sb; sb.G = gridDim.x; sb.c = blockIdx.x;
    if constexpr (m == 0) {
        if (IN(base + 0)) REPEAT(REP_NORM_MIX) ph_norm_xm(wv, p, L == 0 ? p.in[I_X] : (const float*)(ws + WS_X), L == 0 ? nullptr : (const bf16_t*)(ws + WS_UCB), X, L > 0, p.in[I_NMG] + L * D, p.in[I_MU] + ia * 6 * D, (unsigned char*)lds);
    } else {
    if (IN(base + 0)) REPEAT(REP_NORM_MIX) ph_norm(wv, p, L == 0 ? p.in[I_X] : X, L == 0 ? nullptr : (const bf16_t*)(ws + WS_UCB), LASTREP(REP_NORM_MIX) ? X : (float*)(ws + WS_YS), L > 0, p.in[I_NMG] + L * D, LASTREP(REP_NORM_MIX) ? H : (bf16_t*)(ws + WS_YS + 64 * MiB), nullptr, nullptr, lds);
    }
    if constexpr (m == 0) {
        const unsigned char* rb = ws + WB_RW + (size_t)ia * RW_STRIDE;
        if (IN(base + 2)) {
            SchedProj S; S.G = sb.G; S.c = sb.c; S.XM = (const char*)(ws + WS_XM); S.Wrkv = (const char*)(rb + RW_RKV); S.L1t = (const char*)(rb + RW_L1);
            EpiProj E; E.RKVb = (bf16_t*)(ws + WS_RKV); E.L1b = (bf16_t*)(ws + WS_L1);
            pg8::Geo g; g.lda = D; g.ldb = D; g.K = D;
            REPEAT(REP_PROJ) pg8::gemm_phase(wv, glds, g, S, E);
        }
        if (IN(base + 3)) {
            SchedLora2 S; S.G = sb.G; S.c = sb.c; S.L1b = (const char*)(ws + WS_L1); S.L2t = (const char*)(rb + RW_L2);
            EpiLora2 E; E.WDL = (bf16_t*)(ws + WS_WD); E.AAb = (bf16_t*)(ws + WS_AA); E.GGb = (bf16_t*)(ws + WS_GG); E.w0 = p.in[I_W0] + (size_t)ia * 2 * D; E.a0 = p.in[I_A0] + (size_t)ia * 2 * D;
            pg8::Geo g; g.lda = 512; g.ldb = 128; g.K = 128;
            REPEAT(REP_LORA2) pg8::gemm_phase(wv, glds, g, S, E);
        }
        if (IN(base + 4)) {
            REPEAT(REP_SCAN) ph_scan2(wv, p, ia, (unsigned char*)lds, (bf16_t*)(ws + WS_YS), L, LASTREP(REP_SCAN) ? 0 : 100 + SVAR);
        }
        if (DIAG) { if (IN(base + 11)) diag_compare(wv, p, (const float*)(ws + WS_YS), (const float*)(ws + WS_XM), (size_t)2 * T * D); }
        if (IN(base + 5)) REPEAT(REP_RPOST) ph_rwkv_post(wv, p, ia);
        if (IN(base + 6)) {
            SchedPlain S; S.G = sb.G; S.c = sb.c; S.A = (const char*)(ws + WS_YG); S.B = (const char*)(rb + RW_OUT); S.nN = 4; S.lda = D; S.ldb = D;
            pg8::Geo g; g.lda = D; g.ldb = D; g.K = D;
            REPEAT(REP_OUT) { EpiStoreBf16 E; E.O = (bf16_t*)(ws + WS_UCB); E.ldc = D; pg8::gemm_phase(wv, glds, g, S, E); }
        }
    } else if constexpr (m == 1) {
        if (IN(base + 1)) {
            SchedPlain S; S.G = sb.G; S.c = sb.c; S.A = (const char*)H; S.B = (const char*)(ws + WB_SC + SC_IN); S.nN = 12; S.lda = D; S.ldb = D;
            EpiStoreBf16 E; E.O = (bf16_t*)(ws + WS_RKV); E.ldc = 3 * D; pg8::Geo g; g.lda = D; g.ldb = D; g.K = D;
            REPEAT(REP_SCIN) pg8::gemm_phase(wv, glds, g, S, E);
        }
        if (IN(base + 2)) REPEAT(REP_SCMID) ph_sc_mid(wv, p);
        if (IN(base + 3)) {
            SchedPlain S; S.G = sb.G; S.c = sb.c; S.A = (const char*)(ws + WS_YG); S.B = (const char*)(ws + WB_SC + SC_OUT); S.nN = 4; S.lda = D; S.ldb = D;
            pg8::Geo g; g.lda = D; g.ldb = D; g.K = D;
            REPEAT(REP_OUT) { EpiStoreBf16 E; E.O = (bf16_t*)(ws + WS_UCB); E.ldc = D; pg8::gemm_phase(wv, glds, g, S, E); }
        }
    } else {
        if (IN(base + 1)) {
            SchedPlain S; S.G = sb.G; S.c = sb.c; S.A = (const char*)H; S.B = (const char*)(ws + WB_LRU + LRU_IN); S.nN = 8; S.lda = D; S.ldb = D;
            EpiStoreBf16 E; E.O = (bf16_t*)(ws + WS_RKV); E.ldc = 2 * D; pg8::Geo g; g.lda = D; g.ldb = D; g.K = D;
            REPEAT(REP_LIN) pg8::gemm_phase(wv, glds, g, S, E);
        }
        if (IN(base + 2)) REPEAT(REP_LCONV) ph_lru_conv(wv, p);
        if (IN(base + 3)) {
            SchedLruGate S; S.G = sb.G; S.c = sb.c; S.UCB = (const char*)(ws + WS_UCB); S.Wg = (const char*)(ws + WB_LRU + LRU_G);
            EpiLruGate E; E.LA = (bf16_t*)(ws + WS_WD); E.LB = (bf16_t*)(ws + WS_AA); E.UCB = (const bf16_t*)(ws + WS_UCB); E.ba = p.in[I_LBA]; E.bx = p.in[I_LBX]; E.lam = p.in[I_LLAM];
            pg8::Geo g; g.lda = D; g.ldb = 256; g.K = 256;
            REPEAT(REP_LGATE) pg8::gemm_phase(wv, glds, g, S, E);
        }
        if (IN(base + 4)) REPEAT(REP_LSCAN) ph_lru_scan(wv, p, lds);
        if (IN(base + 5)) REPEAT(REP_LPOST) ph_lru_post(wv, p);
        if (IN(base + 6)) {
            SchedPlain S; S.G = sb.G; S.c = sb.c; S.A = (const char*)(ws + WS_YG); S.B = (const char*)(ws + WB_LRU + LRU_OUT); S.nN = 4; S.lda = D; S.ldb = D;
            pg8::Geo g; g.lda = D; g.ldb = D; g.K = D;
            REPEAT(REP_OUT) { EpiStoreBf16 E; E.O = (bf16_t*)(ws + WS_UCB); E.ldc = D; pg8::gemm_phase(wv, glds, g, S, E); }
        }
    }
    if (IN(base + 7)) REPEAT(REP_NORM_FFN) ph_norm(wv, p, X, (const bf16_t*)(ws + WS_UCB), nullptr, false, p.in[I_NFG] + L * D, H, p.in[I_RW] + (size_t)L * D * NE, nullptr, lds);
    if (IN(base + 8)) REPEAT(REP_TOPK) ph_topk(wv, p, lds);
    if (IN(base + 9)) {
        SchedMoe1 S; S.G = sb.G; S.c = sb.c; S.XIN = (const char*)(ws + WS_XIN); S.Wgu = (const char*)(ws + WB_MOE + (size_t)L * MOE_STRIDE + MOE_GU);
        EpiSwiglu E; E.HID = (bf16_t*)(ws + WS_HID); pg8::Geo g; g.lda = D; g.ldb = D; g.K = D;
        REPEAT(REP_MOE1) pg8::gemm_phase(wv, glds, g, S, E, !LASTREP(REP_MOE1) && GVAR == 1);
    }
    if (IN(base + 10)) {
        SchedMoe2 S; S.G = sb.G; S.c = sb.c; S.HID = (const char*)(ws + WS_HID); S.Wdn = (const char*)(ws + WB_MOE + (size_t)L * MOE_STRIDE + MOE_DN);
        EpiDown E; E.YEXP = (bf16_t*)(ws + WS_YEXP); E.GATE = (const float*)(ws + WS_GATE); pg8::Geo g; g.lda = FF; g.ldb = FF; g.K = FF;
        REPEAT(REP_MOE2) pg8::gemm_phase(wv, glds, g, S, E, !LASTREP(REP_MOE2) && GVAR == 1);
    }
}

__global__ void __launch_bounds__(NTHR, 2) mega(P p_unused) {
    extern __shared__ __attribute__((aligned(16))) unsigned char lds_raw[];
    const P& p = *(const P*)__builtin_amdgcn_kernarg_segment_ptr();
    float* lds = (float*)lds_raw;
    volatile LAS unsigned* xbw = (volatile LAS unsigned*)(lds_raw + LDS_BYTES - 16);
    const int wv = __builtin_amdgcn_readfirstlane((int)(threadIdx.x >> 6));
    if (threadIdx.x == 0) { xbw[0] = 0u; xbw[1] = 0u; xbw[2] = 0u; xbw[3] = 0u; }
    __syncthreads();
    PhaseCtl pc; pc.lo = p.ph_lo; pc.hi = p.ph_hi; pc.did = false;
    pc.bar = xcd_barrier_post(wv, (unsigned*)(p.ws + WS_CTL), xbw);
    if (IN(0)) REPEAT(REP_PROLOGUE) ph_prologue(wv, p, lds);
    run_layer<0>(wv, p, lds, pc);
    run_layer<1>(wv, p, lds, pc);
    run_layer<2>(wv, p, lds, pc);
    run_layer<3>(wv, p, lds, pc);
    if (IN(PH_FINAL)) ph_norm(wv, p, (const float*)(p.ws + WS_X2), (const bf16_t*)(p.ws + WS_UCB), nullptr, true, p.in[I_FNG], nullptr, nullptr, p.out, lds);
    if (DIAG) { xcd_barrier(wv, pc.bar); diag_delay(wv, p); }
}
#undef IN

}

extern "C" void kernel_launch(void* const* d_in, const int* in_sizes, int n_in, void* d_out, int out_size, void* d_ws, size_t ws_size, hipStream_t stream) {
    static int ready = 0, grid = 256;
    if (!ready) {
        if (n_in != 36 || out_size != T * D || ws_size < WS_END) { fprintf(stderr, "kernel_launch: unexpected problem (n_in %d out %d ws %zu need %zu)\n", n_in, out_size, ws_size, (size_t)WS_END); ready = -1; return; }
        if (hipFuncSetAttribute((const void*)mega, hipFuncAttributeMaxDynamicSharedMemorySize, LDS_BYTES) != hipSuccess) { fprintf(stderr, "kernel_launch: hipFuncSetAttribute failed\n"); ready = -1; return; }
        { int dev = 0, cus = 0; if (hipGetDevice(&dev) == hipSuccess && hipDeviceGetAttribute(&cus, hipDeviceAttributeMultiprocessorCount, dev) == hipSuccess && cus > 0) grid = cus < 256 ? cus : 256; }
        ready = 1;
    }
    if (ready < 0) return;
    (void)in_sizes;
    P p{};
    for (int i = 0; i < 36; ++i) p.in[i] = (const float*)d_in[i];
    p.out = (float*)d_out; p.ws = (unsigned char*)d_ws;
    if (hipMemsetAsync((char*)d_ws + WS_CTL, 0, 32768, stream) != hipSuccess) { fprintf(stderr, "kernel_launch: memset failed\n"); return; }
    p.ph_lo = 0; p.ph_hi = PH_TOTAL;
    hipLaunchKernelGGL(mega, dim3(grid), dim3(NTHR), LDS_BYTES, stream, p);
}
```

```cpp
#include <hip/hip_runtime.h>
#include <stdint.h>
#include <stdio.h>

namespace {
constexpr int D = 1024, NB = 8, S = 2048, T = NB * S, DEPTH = 4, NE = 16, FF = 2048, CAP = 256, NH = 16, HD = 64;
constexpr int NTHR = 512;
constexpr float RMS_EPS = 1e-6f, LNX_EPS = 64e-5f;
typedef unsigned short bf16_t;

constexpr size_t MiB = 1u << 20;
constexpr size_t WS_CTL = 0;
constexpr size_t WS_X = 1 * MiB;
constexpr size_t WS_H = WS_X + 64 * MiB;
constexpr size_t WS_XM = WS_H + 32 * MiB;
constexpr size_t WS_RKV = WS_XM + 192 * MiB;
constexpr size_t WS_L1 = WS_RKV + 192 * MiB;
constexpr size_t WS_WD = WS_L1 + 24 * MiB;
constexpr size_t WS_AA = WS_WD + 128 * MiB;
constexpr size_t WS_GG = WS_AA + 128 * MiB;
constexpr size_t WS_YS = WS_GG + 64 * MiB;
constexpr size_t WS_YG = WS_YS + 128 * MiB;
constexpr size_t WS_UCB = WS_YG + 32 * MiB;
constexpr size_t WS_YEXP = WS_UCB + 32 * MiB;
constexpr size_t WS_AFF = WS_YEXP + 128 * MiB;
constexpr size_t WS_SLOT = WS_AFF + 1 * MiB;
constexpr size_t WS_GATE = WS_SLOT + 1 * MiB;
constexpr size_t WS_ACT_END = WS_GATE + 1 * MiB;
constexpr size_t WB_RW = WS_ACT_END;
constexpr size_t RW_RKV = 0, RW_L1 = 6 * MiB, RW_L2 = RW_L1 + 3 * 256 * 1024 * 2, RW_OUT = RW_L2 + 5 * 1024 * 256 * 2, RW_STRIDE = 12 * MiB;
constexpr size_t WB_SC = WB_RW + 2 * RW_STRIDE;
constexpr size_t SC_IN = 0, SC_OUT = 6 * MiB;
constexpr size_t WB_LRU = WB_SC + 8 * MiB;
constexpr size_t LRU_IN = 0, LRU_G = 4 * MiB, LRU_OUT = 6 * MiB;
constexpr size_t WB_MOE = WB_LRU + 8 * MiB;
constexpr size_t MOE_GU = 0, MOE_DN = 128 * MiB, MOE_STRIDE = 192 * MiB;
constexpr size_t WS_X2 = WB_MOE + 4 * MOE_STRIDE;
constexpr size_t WS_END = WS_X2 + 64 * MiB;
constexpr size_t WS_XIN = WS_XM, WS_HID = WS_XM + 64 * MiB;
constexpr size_t WS_BON = WS_L1 + 16 * MiB;

constexpr int REP_PROLOGUE = 1, REP_NORM_MIX = 1, REP_XM = 1, REP_PROJ = 1, REP_LORA2 = 1, REP_SCAN = 1, REP_RPOST = 1, REP_OUT = 1, REP_SCIN = 1, REP_SCMID = 1,
              REP_LIN = 1, REP_LCONV = 1, REP_LGATE = 1, REP_LSCAN = 1, REP_LPOST = 1, REP_NORM_FFN = 1, REP_TOPK = 1, REP_MOE1 = 1, REP_MOE2 = 1, REP_BAR = 1, REP_SA = 1, REP_SB = 1, REP_SC = 1, REP_SD = 1, GVAR = 0, SVAR = 0;
#define REPEAT(n) for (int rep_ = 0; rep_ < (n); ++rep_)
#define LASTREP(n) (rep_ == (n) - 1)
struct P {
    const float* in[36];
    float* out;
    unsigned char* ws;
    int ph_lo, ph_hi;
};

enum { I_X = 0, I_NMG, I_NFG, I_RW, I_WG, I_WU, I_WDN, I_FNG, I_MU, I_WIN, I_W0, I_W1, I_W2, I_A0, I_A1, I_A2, I_G1, I_G2, I_KK, I_KA, I_RK, I_LNG, I_LNB, I_WOUT,
       I_SCIN, I_SCCW, I_SCOUT, I_LIN, I_LCW, I_LCB, I_LWA, I_LBA, I_LWX, I_LBX, I_LLAM, I_LOUT };

__device__ __forceinline__ int lane_fresh() { int l; asm volatile("v_mbcnt_lo_u32_b32 %0, -1, 0\n\tv_mbcnt_hi_u32_b32 %0, -1, %0" : "=v"(l)); return l; }
#define TID (wv * 64 + lane_fresh())
__device__ __forceinline__ float bf2f(bf16_t v) { return __uint_as_float((unsigned)v << 16); }
__device__ __forceinline__ bf16_t f2bf(float f) { unsigned u = __float_as_uint(f); u += 0x7FFFu + ((u >> 16) & 1u); return (bf16_t)(u >> 16); }
__device__ __forceinline__ void bf4_to_f(uint2 u, float* f) { f[0] = __uint_as_float(u.x << 16); f[1] = __uint_as_float(u.x & 0xffff0000u); f[2] = __uint_as_float(u.y << 16); f[3] = __uint_as_float(u.y & 0xffff0000u); }
__device__ __forceinline__ uint2 f4_to_bf(float a, float b, float c, float d) { return make_uint2((unsigned)f2bf(a) | ((unsigned)f2bf(b) << 16), (unsigned)f2bf(c) | ((unsigned)f2bf(d) << 16)); }
template <int CTRL> __device__ __forceinline__ float dpp_f(float x) { return __builtin_bit_cast(float, __builtin_amdgcn_update_dpp(0, __builtin_bit_cast(int, x), CTRL, 0xf, 0xf, false)); }
__device__ __forceinline__ float row_sum16(float x) { x += dpp_f<0x128>(x); x += dpp_f<0x124>(x); x += dpp_f<0x122>(x); x += dpp_f<0x121>(x); return x; }
__device__ __forceinline__ float row_max16(float x) { x = fmaxf(x, dpp_f<0x128>(x)); x = fmaxf(x, dpp_f<0x124>(x)); x = fmaxf(x, dpp_f<0x122>(x)); x = fmaxf(x, dpp_f<0x121>(x)); return x; }
__device__ __forceinline__ float lane_bcast(float x, int l) { return __builtin_bit_cast(float, __builtin_amdgcn_readlane(__builtin_bit_cast(int, x), l)); }
__device__ __forceinline__ float wave_sum(float v) { v = row_sum16(v); return (lane_bcast(v, 0) + lane_bcast(v, 16)) + (lane_bcast(v, 32) + lane_bcast(v, 48)); }
__device__ __forceinline__ void wave_sum8(float (&v)[8]) {
#pragma unroll
    for (int s = 0; s < 8; ++s) v[s] = wave_sum(v[s]);
}
__device__ __forceinline__ float quad_sum(float v) { v += dpp_f<0xB1>(v); v += dpp_f<0x4E>(v); return v; }
__device__ __forceinline__ float sigmoidf_(float x) { return __builtin_amdgcn_rcpf(1.0f + __expf(-x)); }
__device__ __forceinline__ float tanhf_(float x) { const float e = __expf(-2.0f * fabsf(x)); const float t = (1.0f - e) * __builtin_amdgcn_rcpf(1.0f + e); return x < 0.f ? -t : t; }
__device__ __forceinline__ float softplusf_(float y) { return fmaxf(y, 0.f) + log1pf(__expf(-fabsf(y))); }
__device__ __forceinline__ float gelu_tanh(float x) { const float u = 0.7978845608028654f * (x + 0.044715f * x * x * x); return 0.5f * x * (1.0f + tanhf_(u)); }

__device__ __forceinline__ void ph_norm(const int wv, const P& p, const float* xin, const bf16_t* yadd, float* xout, bool combine, const float* gamma, bf16_t* hout, const float* router_w, float* fout, float* lds) {
    const int tid = TID, lane = tid & 63, wave = tid >> 6;
    if (router_w) {
        for (int i = tid; i < D * NE; i += NTHR) { const int d = i >> 4, e = i & 15; lds[e * D + d] = router_w[i]; }
        __syncthreads();
    }
    const bf16_t* yexp = (const bf16_t*)(p.ws + WS_YEXP); const int* slot = (const int*)(p.ws + WS_SLOT);
    float* aff = (float*)(p.ws + WS_AFF);
    const int tstep = gridDim.x * 8; int tok = blockIdx.x * 8 + wave;
    float4 xn[4]; uint2 yn[4]; int sln = -1;
#pragma unroll
    for (int i = 0; i < 4; ++i) yn[i] = make_uint2(0u, 0u);
    if (tok < T) {
#pragma unroll
        for (int i = 0; i < 4; ++i) xn[i] = ((const float4*)(xin + (size_t)tok * D))[i * 64 + lane];
        if (yadd) {
#pragma unroll
            for (int i = 0; i < 4; ++i) yn[i] = ((const uint2*)(yadd + (size_t)tok * D))[i * 64 + lane]; }
        if (combine) sln = slot[tok * NE + (lane & 15)];
    }
    for (; tok < T; tok += tstep) {
        const int b = tok / S, s = tok % S;
        float4 x[4];
#pragma unroll
        for (int i = 0; i < 4; ++i) { x[i] = xn[i]; if (yadd) { float f[4]; bf4_to_f(yn[i], f); x[i].x += f[0]; x[i].y += f[1]; x[i].z += f[2]; x[i].w += f[3]; } }
        const int slv = sln;
        if (tok + tstep < T) {
#pragma unroll
            for (int i = 0; i < 4; ++i) xn[i] = ((const float4*)(xin + (size_t)(tok + tstep) * D))[i * 64 + lane];
            if (yadd) {
#pragma unroll
                for (int i = 0; i < 4; ++i) yn[i] = ((const uint2*)(yadd + (size_t)(tok + tstep) * D))[i * 64 + lane]; }
            if (combine) sln = slot[(tok + tstep) * NE + (lane & 15)];
        }
        if (combine) {
            unsigned msk = (unsigned)(__ballot(slv >= 0) & 0xffffull);
            while (msk) {
                const int e0 = __ffs(msk) - 1; msk &= msk - 1u;
                const int e1 = msk ? (__ffs(msk) - 1) : e0; const bool two = msk != 0u; msk &= msk - 1u;
                const int s0 = __builtin_amdgcn_readlane(slv, e0), s1 = __builtin_amdgcn_readlane(slv, e1);
                const uint2* r0 = (const uint2*)(yexp + ((size_t)(e0 * NB + b) * CAP + s0) * D); const uint2* r1 = (const uint2*)(yexp + ((size_t)(e1 * NB + b) * CAP + s1) * D);
                uint2 q0[4], q1[4];
#pragma unroll
                for (int i = 0; i < 4; ++i) { q0[i] = r0[i * 64 + lane]; q1[i] = r1[i * 64 + lane]; }
#pragma unroll
                for (int i = 0; i < 4; ++i) { float f[4]; bf4_to_f(q0[i], f); x[i].x += f[0]; x[i].y += f[1]; x[i].z += f[2]; x[i].w += f[3];
                    if (two) { bf4_to_f(q1[i], f); x[i].x += f[0]; x[i].y += f[1]; x[i].z += f[2]; x[i].w += f[3]; } }
            }
        }
        if (xout) {
#pragma unroll
            for (int i = 0; i < 4; ++i) ((float4*)(xout + (size_t)tok * D))[i * 64 + lane] = x[i];
        }
        float ss = 0.f;
#pragma unroll
        for (int i = 0; i < 4; ++i) ss += x[i].x * x[i].x + x[i].y * x[i].y + x[i].z * x[i].z + x[i].w * x[i].w;
        ss = wave_sum(ss);
        const float rstd = __builtin_amdgcn_rsqf(ss * (1.0f / D) + RMS_EPS);
        float4 h[4];
#pragma unroll
        for (int i = 0; i < 4; ++i) {
            const float4 g = ((const float4*)gamma)[i * 64 + lane];
            h[i].x = x[i].x * rstd * g.x; h[i].y = x[i].y * rstd * g.y; h[i].z = x[i].z * rstd * g.z; h[i].w = x[i].w * rstd * g.w;
        }
        if (hout) {
#pragma unroll
            for (int i = 0; i < 4; ++i) ((uint2*)(hout + (size_t)tok * D))[i * 64 + lane] = f4_to_bf(h[i].x, h[i].y, h[i].z, h[i].w);
        }
        if (fout) {
#pragma unroll
            for (int i = 0; i < 4; ++i) ((float4*)(fout + (size_t)tok * D))[i * 64 + lane] = h[i];
        }
        if (router_w) {
            float mylg = -3.0e38f;
#pragma unroll 1
            for (int eg = 0; eg < NE; eg += 8) {
                float a8[8];
#pragma unroll
                for (int j = 0; j < 8; ++j) {
                    float a = 0.f;
#pragma unroll
                    for (int i = 0; i < 4; ++i) { const float4 w = ((const float4*)(lds + (eg + j) * D))[i * 64 + lane]; a += h[i].x * w.x + h[i].y * w.y + h[i].z * w.z + h[i].w * w.w; }
                    a8[j] = a;
                }
                wave_sum8(a8);
#pragma unroll
                for (int j = 0; j < 8; ++j) if (lane == eg + j) mylg = a8[j];
            }
            float mx = mylg;
            mx = row_max16(mx);
            const float mine = (lane < NE) ? __expf(mylg - mx) : 0.f;
            float sum = mine;
            sum = row_sum16(sum);
            if (lane < NE) aff[((size_t)b * NE + lane) * S + s] = mine / sum;
        }
    }
}

__device__ __forceinline__ void ph_norm_xm(const int wv, const P& p, const float* xin, const bf16_t* yadd, float* xout, bool combine, const float* gamma, const float* mu, unsigned char* lds) {
    const int tid = TID, lane = tid & 63, wave = tid >> 6;
    constexpr int HP = 2064;
    const bf16_t* yexp = (const bf16_t*)(p.ws + WS_YEXP); const int* slot = (const int*)(p.ws + WS_SLOT);
    bf16_t* XM = (bf16_t*)(p.ws + WS_XM);
    for (int unit = blockIdx.x; unit < T / 32; unit += gridDim.x) {
        const int t0 = unit * 32;
        float4 xr[5][4]; uint2 yr[5][4]; int slr[5];
#pragma unroll
        for (int j = 0; j < 5; ++j) {
            const int r = wave + 8 * j, tok = t0 - 1 + r, s = (t0 % S) - 1 + r; slr[j] = -1;
#pragma unroll
            for (int i = 0; i < 4; ++i) yr[j][i] = make_uint2(0u, 0u);
            if (r < 34 && s >= 0 && s < S) {
#pragma unroll
                for (int i = 0; i < 4; ++i) xr[j][i] = ((const float4*)(xin + (size_t)tok * D))[i * 64 + lane];
                if (yadd) {
#pragma unroll
                    for (int i = 0; i < 4; ++i) yr[j][i] = ((const uint2*)(yadd + (size_t)tok * D))[i * 64 + lane]; }
                if (combine) slr[j] = slot[tok * NE + (lane & 15)];
            } else {
#pragma unroll
                for (int i = 0; i < 4; ++i) xr[j][i] = make_float4(0.f, 0.f, 0.f, 0.f);
            }
        }
#pragma unroll
        for (int j = 0; j < 5; ++j) {
            const int r = wave + 8 * j, tok = t0 - 1 + r, s = (t0 % S) - 1 + r;
            if (r >= 34) continue;
            uint2* hrow = (uint2*)(lds + r * HP);
            if (s < 0 || s >= S) {
#pragma unroll
                for (int i = 0; i < 4; ++i) hrow[i * 64 + lane] = make_uint2(0u, 0u);
                continue;
            }
            const int b = tok / S;
            float4 x[4];
#pragma unroll
            for (int i = 0; i < 4; ++i) { x[i] = xr[j][i]; if (yadd) { float f[4]; bf4_to_f(yr[j][i], f); x[i].x += f[0]; x[i].y += f[1]; x[i].z += f[2]; x[i].w += f[3]; } }
            if (combine) {
                const int slv = slr[j];
                unsigned msk = (unsigned)(__ballot(slv >= 0) & 0xffffull);
                while (msk) {
                    const int e0 = __ffs(msk) - 1; msk &= msk - 1u;
                    const int e1 = msk ? (__ffs(msk) - 1) : e0; const bool two = msk != 0u; msk &= msk - 1u;
                    const int s0 = __builtin_amdgcn_readlane(slv, e0), s1 = __builtin_amdgcn_readlane(slv, e1);
                    const uint2* r0 = (const uint2*)(yexp + ((size_t)(e0 * NB + b) * CAP + s0) * D); const uint2* r1 = (const uint2*)(yexp + ((size_t)(e1 * NB + b) * CAP + s1) * D);
                    uint2 q0[4], q1[4];
#pragma unroll
                    for (int i = 0; i < 4; ++i) { q0[i] = r0[i * 64 + lane]; q1[i] = r1[i * 64 + lane]; }
#pragma unroll
                    for (int i = 0; i < 4; ++i) { float f[4]; bf4_to_f(q0[i], f); x[i].x += f[0]; x[i].y += f[1]; x[i].z += f[2]; x[i].w += f[3];
                        if (two) { bf4_to_f(q1[i], f); x[i].x += f[0]; x[i].y += f[1]; x[i].z += f[2]; x[i].w += f[3]; } }
                }
            }
            if (r >= 1 && r <= 32) {
#pragma unroll
                for (int i = 0; i < 4; ++i) ((float4*)(xout + (size_t)tok * D))[i * 64 + lane] = x[i];
            }
            float ss = 0.f;
#pragma unroll
            for (int i = 0; i < 4; ++i) ss += x[i].x * x[i].x + x[i].y * x[i].y + x[i].z * x[i].z + x[i].w * x[i].w;
            ss = wave_sum(ss);
            const float rstd = __builtin_amdgcn_rsqf(ss * (1.0f / D) + RMS_EPS);
#pragma unroll
            for (int i = 0; i < 4; ++i) {
                const float4 gq = ((const float4*)gamma)[i * 64 + lane];
                hrow[i * 64 + lane] = f4_to_bf(x[i].x * rstd * gq.x, x[i].y * rstd * gq.y, x[i].z * rstd * gq.z, x[i].w * rstd * gq.w);
            }
        }
        __syncthreads();
        for (int r = 1 + wave; r <= 32; r += 8) {
            const int tok = t0 - 1 + r;
#pragma unroll
            for (int i = 0; i < 4; ++i) {
                const int c4 = i * 64 + lane;
                float hc[4], hp[4], hn[4];
                bf4_to_f(((const uint2*)(lds + r * HP))[c4], hc); bf4_to_f(((const uint2*)(lds + (r - 1) * HP))[c4], hp); bf4_to_f(((const uint2*)(lds + (r + 1) * HP))[c4], hn);
                float xx[4];
#pragma unroll
                for (int j = 0; j < 4; ++j) xx[j] = 0.5f * (hp[j] + hn[j]) - hc[j];
#pragma unroll
                for (int q = 0; q < 6; ++q) {
                    const float4 m = ((const float4*)(mu + q * D))[c4];
                    ((uint2*)(XM + ((size_t)q * T + tok) * D))[c4] = f4_to_bf(hc[0] + xx[0] * m.x, hc[1] + xx[1] * m.y, hc[2] + xx[2] * m.z, hc[3] + xx[3] * m.w);
                }
            }
        }
        __syncthreads();
    }
}

__device__ __forceinline__ void ph_xm(const int wv, const P& p, const float* mu) {
    const int tid = TID, lane = tid & 63, wave = tid >> 6;
    const bf16_t* H = (const bf16_t*)(p.ws + WS_H); bf16_t* XM = (bf16_t*)(p.ws + WS_XM);
    for (int tok = blockIdx.x * 8 + wave; tok < T; tok += gridDim.x * 8) {
        const int s = tok % S;
#pragma unroll
        for (int i = 0; i < 4; ++i) {
            const int c4 = i * 64 + lane;
            float hc[4], hp[4] = {0.f, 0.f, 0.f, 0.f}, hn[4] = {0.f, 0.f, 0.f, 0.f};
            bf4_to_f(((const uint2*)(H + (size_t)tok * D))[c4], hc);
            if (s > 0) bf4_to_f(((const uint2*)(H + (size_t)(tok - 1) * D))[c4], hp);
            if (s < S - 1) bf4_to_f(((const uint2*)(H + (size_t)(tok + 1) * D))[c4], hn);
            float xx[4];
#pragma unroll
            for (int j = 0; j < 4; ++j) xx[j] = 0.5f * (hp[j] + hn[j]) - hc[j];
#pragma unroll
            for (int q = 0; q < 6; ++q) {
                const float4 m = ((const float4*)(mu + q * D))[c4];
                ((uint2*)(XM + ((size_t)q * T + tok) * D))[c4] = f4_to_bf(hc[0] + xx[0] * m.x, hc[1] + xx[1] * m.y, hc[2] + xx[2] * m.z, hc[3] + xx[3] * m.w);
            }
        }
    }
}

__device__ __forceinline__ void bf16x16_load(const bf16_t* p16, float* f) {
    const uint4 a = ((const uint4*)p16)[0], b = ((const uint4*)p16)[1];
    const unsigned w[8] = {a.x, a.y, a.z, a.w, b.x, b.y, b.z, b.w};
#pragma unroll
    for (int j = 0; j < 8; ++j) { f[2 * j] = __uint_as_float(w[j] << 16); f[2 * j + 1] = __uint_as_float(w[j] & 0xffff0000u); }
}
__device__ __forceinline__ void ph_rwkv_post(const int wv, const P& p, int ia) {
    const int tid = TID, lane = tid & 63, wave = tid >> 6;
    const bf16_t* __restrict__ RKV = (const bf16_t*)(p.ws + WS_RKV); const bf16_t* __restrict__ GG = (const bf16_t*)(p.ws + WS_GG); const float* __restrict__ BON = (const float*)(p.ws + WS_BON);
    const bf16_t* __restrict__ YS = (const bf16_t*)(p.ws + WS_YS); bf16_t* __restrict__ YG = (bf16_t*)(p.ws + WS_YG);
    const float* lg = p.in[I_LNG] + ia * D; const float* lb = p.in[I_LNB] + ia * D;
#pragma unroll 2
    for (int tok = blockIdx.x * 8 + wave; tok < T; tok += gridDim.x * 8) {
        const size_t o = (size_t)tok * D + lane * 16;
        float y[16], v[16], gg[16];
        { float y1[16]; bf16x16_load(YS + o, y); bf16x16_load(YS + (size_t)T * D + o, y1);
#pragma unroll
          for (int j = 0; j < 16; ++j) y[j] += y1[j]; }
        bf16x16_load(RKV + 2 * (size_t)T * D + o, v); bf16x16_load(GG + o, gg);
        const float bon = BON[(size_t)tok * NH + (lane >> 2)] + BON[((size_t)T + tok) * NH + (lane >> 2)];
        float sm = 0.f;
#pragma unroll
        for (int j = 0; j < 16; ++j) sm += y[j];
        const float mean = quad_sum(sm) * (1.0f / 64.0f);
        float sv = 0.f;
#pragma unroll
        for (int j = 0; j < 16; ++j) { const float d = y[j] - mean; sv += d * d; }
        const float rstd = __builtin_amdgcn_rsqf(quad_sum(sv) * (1.0f / 64.0f) + LNX_EPS);
        float outv[16];
#pragma unroll
        for (int j = 0; j < 16; ++j) { const int c = lane * 16 + j; outv[j] = ((y[j] - mean) * rstd * lg[c] + lb[c] + bon * v[j]) * gg[j]; }
#pragma unroll
        for (int j = 0; j < 4; ++j) ((uint2*)(YG + o))[j] = f4_to_bf(outv[4 * j], outv[4 * j + 1], outv[4 * j + 2], outv[4 * j + 3]);
    }
}

__device__ __forceinline__ void ph_sc_mid(const int wv, const P& p) {
    const int tid = TID, lane = tid & 63, wave = tid >> 6;
    const bf16_t* __restrict__ BCU = (const bf16_t*)(p.ws + WS_RKV); bf16_t* __restrict__ BZ = (bf16_t*)(p.ws + WS_YG); const float* cw = p.in[I_SCCW];
#pragma unroll 2
    for (int tok = blockIdx.x * 8 + wave; tok < T; tok += gridDim.x * 8) {
        const int s = tok % S;
#pragma unroll
        for (int i = 0; i < 4; ++i) {
            const int c4 = i * 64 + lane;
            float z[4] = {0.f, 0.f, 0.f, 0.f};
#pragma unroll
            for (int j = 0; j < 3; ++j) {
                const int ss = s + j - 1;
                if (ss >= 0 && ss < S) {
                    const size_t ro = (size_t)(tok + j - 1) * (3 * D);
                    float c[4], u[4]; bf4_to_f(((const uint2*)(BCU + ro + D))[c4], c); bf4_to_f(((const uint2*)(BCU + ro + 2 * D))[c4], u);
                    const float4 w = ((const float4*)(cw + j * D))[c4];
                    z[0] += w.x * c[0] * u[0]; z[1] += w.y * c[1] * u[1]; z[2] += w.z * c[2] * u[2]; z[3] += w.w * c[3] * u[3];
                }
            }
            float bg[4]; bf4_to_f(((const uint2*)(BCU + (size_t)tok * (3 * D)))[c4], bg);
            ((uint2*)(BZ + (size_t)tok * D))[c4] = f4_to_bf(bg[0] * z[0], bg[1] * z[1], bg[2] * z[2], bg[3] * z[3]);
        }
    }
}

__device__ __forceinline__ void ph_lru_conv(const int wv, const P& p) {
    const int tid = TID, lane = tid & 63, wave = tid >> 6;
    const bf16_t* __restrict__ GU = (const bf16_t*)(p.ws + WS_RKV); bf16_t* __restrict__ UCB = (bf16_t*)(p.ws + WS_UCB);
    const float* cw = p.in[I_LCW]; const float* cb = p.in[I_LCB];
#pragma unroll 2
    for (int tok = blockIdx.x * 8 + wave; tok < T; tok += gridDim.x * 8) {
        const int s = tok % S;
#pragma unroll
        for (int i = 0; i < 4; ++i) {
            const int c4 = i * 64 + lane;
            float4 acc = ((const float4*)cb)[c4];
#pragma unroll
            for (int j = 0; j < 4; ++j) {
                const int ss = s + j - 2;
                if (ss >= 0 && ss < S) {
                    float u[4]; bf4_to_f(((const uint2*)(GU + (size_t)(tok + j - 2) * (2 * D) + D))[c4], u); const float4 w = ((const float4*)(cw + j * D))[c4];
                    acc.x += w.x * u[0]; acc.y += w.y * u[1]; acc.z += w.z * u[2]; acc.w += w.w * u[3];
                }
            }
            ((uint2*)(UCB + (size_t)tok * D))[c4] = f4_to_bf(acc.x, acc.y, acc.z, acc.w);
        }
    }
}

__device__ __forceinline__ void ph_lru_scan(const int wv, const P& p, float* lds) {
    const int tid = TID;
    const bf16_t* LA = (const bf16_t*)(p.ws + WS_WD); const bf16_t* LB = (const bf16_t*)(p.ws + WS_AA);
    bf16_t* HS = (bf16_t*)(p.ws + WS_YS);
    float2* segP = (float2*)lds; float2* segH = (float2*)lds + 512;
    const int cp = tid & 31, seg = tid >> 5;
    for (int unit = blockIdx.x; unit < NB * 2 * 16; unit += gridDim.x) {
        const int cg = unit & 15, z = (unit >> 4) & 1, b = unit >> 5;
        const int c = cg * 64 + cp * 2;
        const bf16_t* la = LA + (size_t)z * T * D; const bf16_t* lb = LB + (size_t)z * T * D;
        float P0 = 0.f, P1 = 0.f, h0 = 0.f, h1 = 0.f;
#pragma unroll 8
        for (int i = seg * 128; i < seg * 128 + 128; ++i) {
            const int t = z ? (S - 1 - i) : i; const size_t o = ((size_t)b * S + t) * D + c;
            const unsigned a2 = *(const unsigned*)(la + o), b2 = *(const unsigned*)(lb + o);
            const float l0 = __uint_as_float(a2 << 16), l1 = __uint_as_float(a2 & 0xffff0000u);
            h0 = __expf(l0) * h0 + __uint_as_float(b2 << 16); h1 = __expf(l1) * h1 + __uint_as_float(b2 & 0xffff0000u);
            P0 += l0; P1 += l1;
        }
        segP[seg * 32 + cp] = make_float2(__expf(P0), __expf(P1)); segH[seg * 32 + cp] = make_float2(h0, h1);
        __syncthreads();
        float c0 = 0.f, c1 = 0.f;
        for (int s2 = 0; s2 < seg; ++s2) { const float2 pp = segP[s2 * 32 + cp], hh = segH[s2 * 32 + cp]; c0 = pp.x * c0 + hh.x; c1 = pp.y * c1 + hh.y; }
        h0 = c0; h1 = c1;
#pragma unroll 8
        for (int i = seg * 128; i < seg * 128 + 128; ++i) {
            const int t = z ? (S - 1 - i) : i; const size_t o = ((size_t)b * S + t) * D + c;
            const unsigned a2 = *(const unsigned*)(la + o), b2 = *(const unsigned*)(lb + o);
            h0 = __expf(__uint_as_float(a2 << 16)) * h0 + __uint_as_float(b2 << 16); h1 = __expf(__uint_as_float(a2 & 0xffff0000u)) * h1 + __uint_as_float(b2 & 0xffff0000u);
            *(unsigned*)(HS + (size_t)z * T * D + o) = (unsigned)f2bf(h0) | ((unsigned)f2bf(h1) << 16);
        }
        __syncthreads();
    }
}

__device__ __forceinline__ void ph_lru_post(const int wv, const P& p) {
    const int tid = TID, lane = tid & 63, wave = tid >> 6;
    const bf16_t* __restrict__ GU = (const bf16_t*)(p.ws + WS_RKV); const bf16_t* __restrict__ HS = (const bf16_t*)(p.ws + WS_YS); bf16_t* __restrict__ YL = (bf16_t*)(p.ws + WS_YG);
#pragma unroll 2
    for (int tok = blockIdx.x * 8 + wave; tok < T; tok += gridDim.x * 8) {
#pragma unroll
        for (int i = 0; i < 4; ++i) {
            const int c4 = i * 64 + lane;
            float gq[4]; bf4_to_f(((const uint2*)(GU + (size_t)tok * (2 * D)))[c4], gq); const float4 g = make_float4(gq[0], gq[1], gq[2], gq[3]);
            float hq0[4], hq1[4]; bf4_to_f(((const uint2*)(HS + (size_t)tok * D))[c4], hq0); bf4_to_f(((const uint2*)(HS + (size_t)T * D + (size_t)tok * D))[c4], hq1);
            const float4 h0 = make_float4(hq0[0], hq0[1], hq0[2], hq0[3]), h1 = make_float4(hq1[0], hq1[1], hq1[2], hq1[3]);
            ((uint2*)(YL + (size_t)tok * D))[c4] = f4_to_bf((h0.x + h1.x) * gelu_tanh(g.x), (h0.y + h1.y) * gelu_tanh(g.y), (h0.z + h1.z) * gelu_tanh(g.z), (h0.w + h1.w) * gelu_tanh(g.w));
        }
    }
}

__device__ __forceinline__ int block_sum_i(const int wv, int v, int* wsum  ) {
    const int lane = lane_fresh(), wave = wv;
    v = __popcll(__ballot(v & 1)) + 2 * __popcll(__ballot(v & 2)) + 4 * __popcll(__ballot(v & 4));
    if (lane == 0) wsum[wave] = v;
    __syncthreads();
    int tot = 0;
#pragma unroll
    for (int w = 0; w < 8; ++w) tot += wsum[w];
    return tot;
}
__device__ __forceinline__ int block_excl_scan_i(const int wv, int v, int* wsum  , int& total) {
    const int lane = lane_fresh(), wave = wv;
    int inc = v;
    for (int o = 1; o < 64; o <<= 1) { const int t = __shfl_up(inc, o); if (lane >= o) inc += t; }
    if (lane == 63) wsum[wave] = inc;
    __syncthreads();
    int base = 0, tot = 0;
#pragma unroll
    for (int w = 0; w < 8; ++w) { const int x = wsum[w]; if (w < wave) base += x; tot += x; }
    total = tot;
    return base + inc - v;
}
__device__ __forceinline__ void ph_topk(const int wv, const P& p, float* ldsf) {
    const int tid = TID, lane = tid & 63, wave = tid >> 6;
    int* ldsi = (int*)ldsf;
    int* wsum = ldsi;
    int* idx_l = ldsi + 64;
    const float* aff = (const float*)(p.ws + WS_AFF); int* slot = (int*)(p.ws + WS_SLOT); float* gate = (float*)(p.ws + WS_GATE);
    const bf16_t* HF = (const bf16_t*)(p.ws + WS_H); bf16_t* XIN = (bf16_t*)(p.ws + WS_XIN);
    for (int unit2 = blockIdx.x; unit2 < 2 * NB * NE; unit2 += gridDim.x) {
        const int unit = unit2 >> 1, half = unit2 & 1;
        const int e = unit % NE, b = unit / NE;
        const float4 v4 = ((const float4*)(aff + ((size_t)b * NE + e) * S))[tid];
        const unsigned v[4] = {__float_as_uint(v4.x), __float_as_uint(v4.y), __float_as_uint(v4.z), __float_as_uint(v4.w)};
        unsigned thr = 0u;
        for (int bit = 29; bit >= 0; --bit) {
            const unsigned cand = thr | (1u << bit);
            const int cnt = (int)(v[0] >= cand) + (int)(v[1] >= cand) + (int)(v[2] >= cand) + (int)(v[3] >= cand);
            const int tot = block_sum_i(wv, cnt, wsum + (bit & 1) * 8);
            if (tot >= CAP) thr = cand;
        }
        int g4 = 0, e4 = 0;
#pragma unroll
        for (int j = 0; j < 4; ++j) { g4 += (int)(v[j] > thr); e4 += (int)(v[j] == thr); }
        const int ngt = block_sum_i(wv, g4, wsum + 16);
        const int need_eq = CAP - ngt;
        int toteq; const int eqbase = block_excl_scan_i(wv, e4, wsum + 24, toteq);
        int sel[4], nsel = 0, er = eqbase;
#pragma unroll
        for (int j = 0; j < 4; ++j) { const bool gt = v[j] > thr, eq = v[j] == thr; sel[j] = (gt || (eq && er < need_eq)) ? 1 : 0; er += eq ? 1 : 0; nsel += sel[j]; }
        __syncthreads();
        int totsel; int cpos = block_excl_scan_i(wv, nsel, wsum, totsel);
#pragma unroll
        for (int j = 0; j < 4; ++j) {
            const int t = tid * 4 + j;
            if (sel[j]) {
                if (cpos < CAP) { idx_l[cpos] = t; if (half == 0) { gate[((size_t)e * NB + b) * CAP + cpos] = __uint_as_float(v[j]); slot[((size_t)b * S + t) * NE + e] = cpos; } }
                else if (half == 0) slot[((size_t)b * S + t) * NE + e] = -1;
                ++cpos;
            } else if (half == 0) slot[((size_t)b * S + t) * NE + e] = -1;
        }
        __syncthreads();
#pragma unroll 1
        for (int cb = 0; cb < 16; cb += 4) {
            const int c = half * 128 + wave * 16 + cb;
            const uint4* s0 = (const uint4*)(HF + ((size_t)b * S + idx_l[c]) * D); const uint4* s1 = (const uint4*)(HF + ((size_t)b * S + idx_l[c + 1]) * D);
            const uint4* s2 = (const uint4*)(HF + ((size_t)b * S + idx_l[c + 2]) * D); const uint4* s3 = (const uint4*)(HF + ((size_t)b * S + idx_l[c + 3]) * D);
            const uint4 a0 = s0[lane], b0 = s0[lane + 64], a1 = s1[lane], b1 = s1[lane + 64], a2 = s2[lane], b2 = s2[lane + 64], a3 = s3[lane], b3 = s3[lane + 64];
            uint4* d0 = (uint4*)(XIN + (((size_t)e * NB + b) * CAP + c) * D);
            d0[lane] = a0; d0[lane + 64] = b0; d0[128 + lane] = a1; d0[128 + lane + 64] = b1; d0[256 + lane] = a2; d0[256 + lane + 64] = b2; d0[384 + lane] = a3; d0[384 + lane + 64] = b3;
        }
        __syncthreads();
    }
}


namespace pg8 {
#define PG8_LAS __attribute__((address_space(3)))
typedef short bf16x8 __attribute__((ext_vector_type(8)));
typedef float f32x4 __attribute__((ext_vector_type(4)));
typedef unsigned u32x4 __attribute__((ext_vector_type(4)));
typedef unsigned u32x2 __attribute__((ext_vector_type(2)));
constexpr int BM = 256, BK = 64, HALF = 128, HTB = HALF * BK * 2, STAGE_BYTES = 8 * HTB;
__device__ __forceinline__ int lds_byte(int r, int c) { const int st = (r >> 4) * 2 + (c >> 5), rr = r & 15, cc = c & 31, ob = rr * 64 + cc * 2; return st * 1024 + (ob ^ (((ob >> 9) & 1) << 5)); }
__device__ __forceinline__ void stage_rc(int b, int& R, int& C) { const int st = b / 1024, sb = b % 1024, swz = sb ^ (((sb >> 9) & 1) << 5); R = (st >> 1) * 16 + swz / 64; C = (st & 1) * 32 + (swz % 64) / 2; }
__device__ __forceinline__ int perm32(int rho) { const int n = rho >> 4, i = rho & 15; return 8 * (i >> 2) + 4 * n + (i & 3); }
struct Unit { const char* A; const char* B; int pm, pn, job; };
struct Geo { int lda, ldb, K; };
typedef float f32x2_t __attribute__((ext_vector_type(2)));
typedef __bf16 bf16x2_t __attribute__((ext_vector_type(2)));
__device__ __forceinline__ unsigned cvt_pk_bf16(float lo, float hi) { const f32x2_t v = {lo, hi}; const bf16x2_t b = __builtin_convertvector(v, bf16x2_t); return __builtin_bit_cast(unsigned, b); }

template <class Epi, class Sched>
__device__ __forceinline__ void gemm_phase(const int wv, PG8_LAS unsigned char* lds, const Geo g, const Sched& S, const Epi& E, const bool skip_epi = false) {
    const int tid = TID, wid = wv, lane = tid & 63, wr = wid >> 2, wc = wid & 3, fr = lane & 15, fq = lane >> 4;
    const int nt = g.K / BK;
    unsigned voffA[2], voffB[2];
#pragma unroll
    for (int i = 0; i < 2; ++i) { int R, C; stage_rc(tid * 16 + i * 8192, R, C); const int Rb = Epi::PERM ? ((R & ~31) + perm32(R & 31)) : R;
        voffA[i] = (unsigned)(R * g.lda + C) * 2u; voffB[i] = (unsigned)(Rb * g.ldb + C) * 2u; }
    const size_t kstep = (size_t)(BK * 2);
    const size_t hstepA = (size_t)HALF * g.lda * 2, hstepB = (size_t)HALF * g.ldb * 2;
    const unsigned ldsw = (unsigned)wid * 1024u;
    const int aoff = lds_byte(wr * 64 + fr, fq * 8), boff = lds_byte(wc * 32 + fr, fq * 8);
#define PG8_SA(b, h) (((b) * 2 + (h)) * HTB)
#define PG8_SB(b, h) ((4 + (b) * 2 + (h)) * HTB)
#define PG8_STAGE(bufoff, gbase, voff) do { _Pragma("unroll") for (int _i = 0; _i < 2; ++_i) \
        __builtin_amdgcn_global_load_lds((const unsigned*)((const char*)(gbase) + (voff)[_i]), (PG8_LAS unsigned*)(lds + (bufoff) + ldsw + _i * 8192), 16, 0, 0); } while (0)
#define PG8_LDA(dst, b, h) do { _Pragma("unroll") for (int m = 0; m < 4; ++m) _Pragma("unroll") for (int k = 0; k < 2; ++k) dst[m][k] = *(const PG8_LAS bf16x8*)(lds + PG8_SA(b, h) + aoff + m * 2048 + k * 1024); } while (0)
#define PG8_LDB(dst, b, h) do { _Pragma("unroll") for (int n = 0; n < 2; ++n) _Pragma("unroll") for (int k = 0; k < 2; ++k) dst[n][k] = *(const PG8_LAS bf16x8*)(lds + PG8_SB(b, h) + boff + n * 2048 + k * 1024); } while (0)
#define PG8_MMA(ai, bj, At, Bt) do { __builtin_amdgcn_s_setprio(1); _Pragma("unroll") for (int m = 0; m < 4; ++m) _Pragma("unroll") for (int n = 0; n < 2; ++n) _Pragma("unroll") for (int k = 0; k < 2; ++k) \
        acc[ai][bj][m][n] = __builtin_amdgcn_mfma_f32_16x16x32_bf16(Bt[n][k], At[m][k], acc[ai][bj][m][n], 0, 0, 0); __builtin_amdgcn_s_setprio(0); } while (0)
#define PG8_WAIT_V(n) asm volatile("s_waitcnt vmcnt(" #n ")" ::: "memory")
#define PG8_WAIT_L(n) asm volatile("s_waitcnt lgkmcnt(" #n ")" ::: "memory")
#define PG8_BAR __builtin_amdgcn_s_barrier()
#define PG8_SCHED __builtin_amdgcn_sched_barrier(0)
    Unit cur, nxt; int ui = 0;
    if (!S.next(0, cur)) return;
    f32x4 acc[2][2][4][2];
#pragma unroll
    for (int a = 0; a < 2; ++a)
#pragma unroll
        for (int b = 0; b < 2; ++b)
#pragma unroll
            for (int m = 0; m < 4; ++m)
#pragma unroll
                for (int n = 0; n < 2; ++n) acc[a][b][m][n] = (f32x4){0.f, 0.f, 0.f, 0.f};
    bf16x8 At[4][2], B0[2][2], B1[2][2];
    const char* cA = cur.A; const char* cB = cur.B;
    PG8_STAGE(PG8_SB(0, 0), cB, voffB); PG8_STAGE(PG8_SB(0, 1), cB + hstepB, voffB); PG8_STAGE(PG8_SA(0, 0), cA, voffA); PG8_STAGE(PG8_SA(0, 1), cA + hstepA, voffA);
    if (wr == 1) PG8_BAR;
    PG8_WAIT_V(2); PG8_BAR;
    PG8_STAGE(PG8_SB(1, 0), cB + kstep, voffB); PG8_STAGE(PG8_SA(1, 0), cA + kstep, voffA); PG8_STAGE(PG8_SB(1, 1), cB + hstepB + kstep, voffB);
    PG8_WAIT_V(6); PG8_BAR;
    for (;;) {
        const bool has_next = S.next(ui + 1, nxt);
        const char* nA = has_next ? nxt.A : cA; const char* nB = has_next ? nxt.B : cB;
#pragma unroll 1
        for (int t = 0; t < nt; t += 2) {
            const bool last = (t == nt - 2);
            const char* a1 = cA + (size_t)(t + 1) * kstep;
            const char* a2 = last ? nA : cA + (size_t)(t + 2) * kstep; const char* b2 = last ? nB : cB + (size_t)(t + 2) * kstep;
            const char* a3 = a2 + kstep; const char* b3 = b2 + kstep;
            PG8_LDB(B0, 0, 0); PG8_LDB(B1, 0, 1); PG8_SCHED; PG8_LDA(At, 0, 0); PG8_STAGE(PG8_SA(1, 1), a1 + hstepA, voffA);
            PG8_WAIT_V(8); PG8_WAIT_L(0); PG8_BAR; PG8_MMA(0, 0, At, B0); PG8_MMA(0, 1, At, B1); PG8_BAR; PG8_SCHED;
            PG8_LDA(At, 0, 1); PG8_STAGE(PG8_SB(0, 0), b2, voffB); PG8_STAGE(PG8_SB(0, 1), b2 + hstepB, voffB); PG8_STAGE(PG8_SA(0, 0), a2, voffA);
            PG8_WAIT_V(8); PG8_WAIT_L(0); PG8_BAR; PG8_MMA(1, 0, At, B0); PG8_MMA(1, 1, At, B1); PG8_BAR; PG8_SCHED;
            PG8_LDB(B0, 1, 0); PG8_LDB(B1, 1, 1); PG8_SCHED; PG8_LDA(At, 1, 0); PG8_STAGE(PG8_SA(0, 1), a2 + hstepA, voffA);
            PG8_WAIT_V(8); PG8_WAIT_L(0); PG8_BAR; PG8_MMA(0, 0, At, B0); PG8_MMA(0, 1, At, B1); PG8_BAR; PG8_SCHED;
            PG8_LDA(At, 1, 1); PG8_STAGE(PG8_SB(1, 0), b3, voffB); PG8_STAGE(PG8_SB(1, 1), b3 + hstepB, voffB); PG8_STAGE(PG8_SA(1, 0), a3, voffA);
            PG8_WAIT_V(8); PG8_WAIT_L(0); PG8_BAR; PG8_MMA(1, 0, At, B0); PG8_MMA(1, 1, At, B1); PG8_BAR; PG8_SCHED;
        }
        if (wr == 0) PG8_BAR;
        if (!skip_epi) { const int le = lane_fresh(); E(acc, cur, wr, wc, le & 15, le >> 4); }
        if (!has_next) break;
#pragma unroll
        for (int a = 0; a < 2; ++a)
#pragma unroll
            for (int b = 0; b < 2; ++b)
#pragma unroll
                for (int m = 0; m < 4; ++m)
#pragma unroll
                    for (int n = 0; n < 2; ++n) acc[a][b][m][n] = (f32x4){0.f, 0.f, 0.f, 0.f};
        cur = nxt; cA = nA; cB = nB; ++ui;
        if (wr == 1) PG8_BAR;
    }
    PG8_WAIT_V(0);
    PG8_BAR;
#undef PG8_SA
#undef PG8_SB
#undef PG8_STAGE
#undef PG8_LDA
#undef PG8_LDB
#undef PG8_MMA
#undef PG8_WAIT_V
#undef PG8_WAIT_L
#undef PG8_BAR
#undef PG8_SCHED
}
}


#define DIAGF 0
constexpr int CTL_DIAGW = 4096;
__device__ __forceinline__ void diag_flag(const P& p, bool badv, unsigned bit) {
    if (DIAGF && __any(badv)) { if (lane_fresh() == 0) atomicOr((unsigned*)(p.ws + WS_CTL) + CTL_DIAGW + 3, bit); }
}
__device__ __forceinline__ bool nonfin(float x) { return !(x == x) || fabsf(x) > 3.0e38f; }
__device__ __forceinline__ bool nonfin4(const pg8::f32x4& v) { return nonfin(v[0]) || nonfin(v[1]) || nonfin(v[2]) || nonfin(v[3]); }
namespace rs {
constexpr int P_TK = 144, P_KT = 80;
constexpr int O_KH = 0, O_RH = 4608, O_BT = 9216, O_KDT = 13824;
constexpr int O_BG = 18432, O_KDG = 23552, O_VM = 28672;
constexpr int O_B2 = 33792, O_AP = 36352, O_BP = 38912, O_NT = 41472;
constexpr int O_L = 44032;
constexpr int O_GAM = 48640;
constexpr int O_X = 48896;
constexpr int CHUNK_BYTES = 53760;
constexpr int O_SEGP = 2 * CHUNK_BYTES;
constexpr int O_YB = O_SEGP + 2048;
constexpr int YB_PITCH = 68;
static_assert(O_YB + 64 * YB_PITCH * 4 <= 128 * 1024, "scan LDS");
typedef pg8::bf16x8 bf16x8; typedef pg8::f32x4 f32x4; typedef pg8::u32x4 u32x4; typedef pg8::u32x2 u32x2;
__device__ __forceinline__ bf16x8 mk8(u32x2 lo, u32x2 hi) { u32x4 w; w.x = lo.x; w.y = lo.y; w.z = hi.x; w.w = hi.y; return __builtin_bit_cast(bf16x8, w); }
__device__ __forceinline__ bf16x8 cvt8(const f32x4& a, const f32x4& b) { u32x4 w; w.x = pg8::cvt_pk_bf16(a[0], a[1]); w.y = pg8::cvt_pk_bf16(a[2], a[3]); w.z = pg8::cvt_pk_bf16(b[0], b[1]); w.w = pg8::cvt_pk_bf16(b[2], b[3]); return __builtin_bit_cast(bf16x8, w); }
}
__device__ __forceinline__ void ph_scan2(const int wv, const P& p, int ia, unsigned char* lds, bf16_t* YS, const int moeL, const int var_ = 0) {
    const int var = var_ >= 100 ? var_ - 100 : 0; const bool dummy = var_ >= 100;
    using namespace rs;
#define RS_SYNC() do { if (var != 2) __syncthreads(); } while (0)
    const int lane = lane_fresh(), tid = wv * 64 + lane, l15 = lane & 15, g = lane >> 4;
    const bf16_t* RKV = (const bf16_t*)(p.ws + WS_RKV); const bf16_t* WDp = (const bf16_t*)(p.ws + WS_WD); const bf16_t* AAp = (const bf16_t*)(p.ws + WS_AA);
    for (int unit = blockIdx.x; unit < NB * NH * 2; unit += gridDim.x) {
        const int z = unit & 1, h = (unit >> 1) % NH, b = unit / (2 * NH);
        const float k_k = p.in[I_KK][ia * D + h * HD + lane], k_a = p.in[I_KA][ia * D + h * HD + lane];
        const float r_kq = p.in[I_RK][ia * D + h * HD + lane];
        f32x4 S4[4];
#pragma unroll
        for (int i = 0; i < 4; ++i) S4[i] = (f32x4){0.f, 0.f, 0.f, 0.f};
        float rr[8], kx[8], vv[8], ww[8], aa[8];
#define RS_LOAD(scx) do { _Pragma("unroll") for (int s = 0; s < 8; ++s) { \
            const int step = (scx) * 64 + (wv >> 2) * 32 + (wv & 3) * 8 + s, t = z ? (S - 1 - step) : step; \
            const size_t o = ((size_t)b * S + t) * D + h * HD + lane; \
            rr[s] = bf2f(RKV[o]); kx[s] = bf2f(RKV[(size_t)T * D + o]); vv[s] = bf2f(RKV[2 * (size_t)T * D + o]); \
            ww[s] = bf2f(WDp[(size_t)z * T * D + o]); aa[s] = bf2f(AAp[(size_t)z * T * D + o]); } } while (0)
        RS_LOAD(0);
        float fz[32]; bf16_t* fdst = nullptr; bool fon = false;
#pragma unroll
        for (int r = 0; r < 32; ++r) fz[r] = 0.f;
        const bool filler = (wv >= 4 && moeL >= 0 && unit == (int)blockIdx.x && gridDim.x == 256) && (!dummy || var >= 4);
#define RS_FILL_LOAD(J_) do { const int J = (J_); fon = J < NE * 3 * 1024; \
            if (fon) { const int mat = J >> 10, e = mat / 3, m = mat - 3 * e, jl = J & 1023; const float* fsrc; int fldw; \
                unsigned char* mb = dummy ? p.ws + WS_XM : p.ws + WB_MOE + (size_t)moeL * MOE_STRIDE; \
                if (m < 2) { const int nb = jl >> 5, kb = jl & 31, n = nb * 64 + lane; \
                    fsrc = p.in[m ? I_WU : I_WG] + (((size_t)moeL * NE + e) * D + kb * 32) * FF + n; fldw = FF; \
                    fdst = (bf16_t*)(mb + MOE_GU) + ((size_t)e * 4096 + ((n >> 7) << 8) + m * 128 + (n & 127)) * D + kb * 32; } \
                else { const int nb = jl >> 6, kb = jl & 63, n = nb * 64 + lane; \
                    fsrc = p.in[I_WDN] + (((size_t)moeL * NE + e) * FF + kb * 32) * D + n; fldw = D; \
                    fdst = (bf16_t*)(mb + MOE_DN) + ((size_t)e * D + n) * FF + kb * 32; } \
                if (var != 6) { _Pragma("unroll") for (int r = 0; r < 32; ++r) fz[r] = __builtin_nontemporal_load(fsrc + (size_t)r * fldw); } } \
            else { _Pragma("unroll") for (int r = 0; r < 32; ++r) fz[r] = 0.f; fdst = nullptr; } } while (0)
#define RS_FILL_STORE() do { if (fon && var != 5) { _Pragma("unroll") for (int c = 0; c < 4; ++c) { u32x4 w; \
            w.x = pg8::cvt_pk_bf16(fz[8 * c], fz[8 * c + 1]); w.y = pg8::cvt_pk_bf16(fz[8 * c + 2], fz[8 * c + 3]); w.z = pg8::cvt_pk_bf16(fz[8 * c + 4], fz[8 * c + 5]); w.w = pg8::cvt_pk_bf16(fz[8 * c + 6], fz[8 * c + 7]); \
            *(u32x4*)(fdst + 8 * c) = w; } } } while (0)
        for (int sc = 0; sc < S / 64; ++sc) {
            {
                const int q = wv >> 2, seg = wv & 3; unsigned char* cb = lds + q * CHUNK_BYTES;
                const int lna = lane_fresh(); const int kpos = (lna & 32) | (((lna >> 2) & 3) << 3) | (((lna >> 4) & 1) << 2) | (lna & 3);
                REPEAT(REP_SA) {
                float pl[8];
                pl[0] = ww[0];
#pragma unroll
                for (int s = 1; s < 8; ++s) pl[s] = pl[s - 1] + ww[s];
                ((float*)(lds + O_SEGP))[(q * 4 + seg) * 64 + lane] = pl[7];
                float kkn[8], ssq[8];
#pragma unroll
                for (int s = 0; s < 8; ++s) { kkn[s] = kx[s] * k_k; ssq[s] = kkn[s] * kkn[s]; }
                wave_sum8(ssq);
#pragma unroll
                for (int s = 0; s < 8; ++s) kkn[s] *= __builtin_amdgcn_rsqf(fmaxf(ssq[s], 1e-24f));
                RS_SYNC();
                float prefix = 0.f, PCl = 0.f;
#pragma unroll
                for (int s2 = 0; s2 < 4; ++s2) { const float sp = ((const float*)(lds + O_SEGP))[(q * 4 + s2) * 64 + lane]; if (s2 < seg) prefix += sp; PCl += sp; }
                const float PC = __expf(PCl);
                float bgs[8], kdgs[8], bnv[8]; float Pprev = 1.f;
#pragma unroll
                for (int s = 0; s < 8; ++s) {
                    const int tt = seg * 8 + s;
                    const float cl = prefix + pl[s]; const float Pt = __expf(cl), Pm = (s == 0) ? __expf(prefix) : Pprev, inv = __builtin_amdgcn_rcpf(Pt); Pprev = Pt;
                    const float bb = kkn[s] * aa[s], kd = kx[s] * (1.0f + (aa[s] - 1.0f) * k_a);
                    const float bt = bb * inv, kdt = kd * inv;
                    bnv[s] = rr[s] * kd * r_kq;
                    const unsigned w01 = pg8::cvt_pk_bf16(kkn[s] * Pm, rr[s] * Pt), w23 = pg8::cvt_pk_bf16(bt, kdt);
                    *(bf16_t*)(cb + O_KH + tt * P_TK + kpos * 2) = (bf16_t)w01;
                    *(bf16_t*)(cb + O_RH + tt * P_TK + kpos * 2) = (bf16_t)(w01 >> 16);
                    *(bf16_t*)(cb + O_BT + tt * P_TK + kpos * 2) = (bf16_t)w23;
                    *(bf16_t*)(cb + O_KDT + tt * P_TK + kpos * 2) = (bf16_t)(w23 >> 16);
                    bgs[s] = bt * PC; kdgs[s] = kdt * PC;
                    diag_flag(p, nonfin(bt) || nonfin(kdt) || nonfin(kkn[s] * Pm) || nonfin(rr[s] * Pt) || nonfin(bgs[s]) || nonfin(kdgs[s]) || nonfin(vv[s]), 1u);
                    diag_flag(p, !(Pt > 1e-12f) || nonfin(inv), 2u);
                }
                wave_sum8(bnv);
                { float bsel = bnv[0];
#pragma unroll
                  for (int s = 1; s < 8; ++s) bsel = (lna == s) ? bnv[s] : bsel;
                  if (lna < 8) { const int step = sc * 64 + q * 32 + seg * 8 + lna, t = z ? (S - 1 - step) : step;
                      ((float*)(p.ws + WS_BON))[((size_t)z * T + (size_t)b * S + t) * NH + h] = bsel; } }
                u32x4 w;
                w.x = pg8::cvt_pk_bf16(bgs[0], bgs[1]); w.y = pg8::cvt_pk_bf16(bgs[2], bgs[3]); w.z = pg8::cvt_pk_bf16(bgs[4], bgs[5]); w.w = pg8::cvt_pk_bf16(bgs[6], bgs[7]);
                { u32x2 wl; wl.x = w.x; wl.y = w.y; u32x2 wh; wh.x = w.z; wh.y = w.w; const int pb = 16 * (seg & 1) + 4 * (seg >> 1);
                  *(u32x2*)(cb + O_BG + lane * P_KT + pb * 2) = wl; *(u32x2*)(cb + O_BG + lane * P_KT + (pb + 8) * 2) = wh; }
                w.x = pg8::cvt_pk_bf16(kdgs[0], kdgs[1]); w.y = pg8::cvt_pk_bf16(kdgs[2], kdgs[3]); w.z = pg8::cvt_pk_bf16(kdgs[4], kdgs[5]); w.w = pg8::cvt_pk_bf16(kdgs[6], kdgs[7]);
                *(u32x4*)(cb + O_KDG + lane * P_KT + seg * 16) = w;
                w.x = pg8::cvt_pk_bf16(vv[0], vv[1]); w.y = pg8::cvt_pk_bf16(vv[2], vv[3]); w.z = pg8::cvt_pk_bf16(vv[4], vv[5]); w.w = pg8::cvt_pk_bf16(vv[6], vv[7]);
                *(u32x4*)(cb + O_VM + lane * P_KT + seg * 16) = w;
                if (seg == 0) *(float*)(cb + O_GAM + lane * 4) = PC;
                }
                if (sc + 1 < S / 64 && var != 1) RS_LOAD(sc + 1);
            }
            RS_SYNC();
            {
                const int q = wv >> 2, o = wv & 3; unsigned char* cb = lds + q * CHUNK_BYTES;
                const int lnb = lane_fresh(), l15 = lnb & 15, g = lnb >> 4;
                REPEAT(REP_SB) {
                const unsigned char* Xm = cb + ((o & 1) ? O_KDT : O_BT); const unsigned char* Ym = cb + ((o >> 1) ? O_RH : O_KH);
#pragma unroll
                for (int ti = 0; ti < 2; ++ti)
#pragma unroll
                    for (int tt = 0; tt < 2; ++tt) {
                        f32x4 acc = (f32x4){0.f, 0.f, 0.f, 0.f};
                        if (tt >= ti) {
#pragma unroll
                            for (int ks = 0; ks < 2; ++ks) {
                                const bf16x8 a = *(const bf16x8*)(Xm + (16 * ti + l15) * P_TK + (32 * ks + 8 * g) * 2);
                                const bf16x8 bq = *(const bf16x8*)(Ym + (16 * tt + l15) * P_TK + (32 * ks + 8 * g) * 2);
                                acc = __builtin_amdgcn_mfma_f32_16x16x32_bf16(a, bq, acc, 0, 0, 0);
                            }
                        }
                        const int t = 16 * tt + l15, i0 = 16 * ti + 4 * g;
#pragma unroll
                        for (int r = 0; r < 4; ++r) { const int i = i0 + r; const bool keep = (o < 2) ? (i < t) : (i <= t); if (!keep) acc[r] = 0.f; }
                        diag_flag(p, nonfin4(acc), 4u);
                        if (o == 0) *(f32x4*)(cb + O_L + t * 144 + i0 * 4) = acc;
                        else { u32x2 w; w.x = pg8::cvt_pk_bf16(acc[0], acc[1]); w.y = pg8::cvt_pk_bf16(acc[2], acc[3]);
                               if (o == 2) *(u32x2*)(cb + O_AP + t * P_KT + (8 * g + 4 * ti) * 2) = w;
                               else *(u32x2*)(cb + (o == 1 ? O_B2 : O_BP) + t * P_KT + i0 * 2) = w; }
                    }
                }
            }
            RS_SYNC();
            REPEAT(REP_SC) {
            const int tid = wv * 64 + lane_fresh();
            if (tid < 64) {
                const int q = tid >> 5, d = (tid >> 4) & 1, j = tid & 15; unsigned char* cb = lds + q * CHUNK_BYTES;
                float x[16];
#pragma unroll
                for (int i = 0; i < 16; ++i) x[i] = (i == j) ? 1.f : 0.f;
                const unsigned char* Lb = cb + O_L + (16 * d) * 144 + (16 * d) * 4;
                f32x4 Lr[16][4];
#define RS_LROWS(lo, hi) do { _Pragma("unroll") for (int tl = (lo); tl < (hi); ++tl) { _Pragma("unroll") for (int c4 = 0; c4 < (tl + 3) / 4; ++c4) Lr[tl][c4] = *(const f32x4*)(Lb + tl * 144 + c4 * 16); } \
            asm volatile("s_waitcnt lgkmcnt(0)" ::: "memory"); __builtin_amdgcn_sched_barrier(0); } while (0)
#define RS_LSOLVE(lo, hi) do { _Pragma("unroll") for (int tl = (lo); tl < (hi); ++tl) { float s4[4] = {0.f, 0.f, 0.f, 0.f}; \
            _Pragma("unroll") for (int il = 0; il < tl; ++il) s4[il & 3] += Lr[tl][il >> 2][il & 3] * x[il]; \
            const float s = (s4[0] + s4[1]) + (s4[2] + s4[3]); x[tl] = (tl > j) ? -s : x[tl]; } } while (0)
                RS_LROWS(1, 10); RS_LSOLVE(1, 10);
                RS_LROWS(10, 16); RS_LSOLVE(10, 16);
#undef RS_LROWS
#undef RS_LSOLVE
#pragma unroll
                for (int tl = 0; tl < 16; ++tl) { *(float*)(cb + O_X + (16 * d + tl) * 144 + (16 * d + j) * 4) = x[tl]; diag_flag(p, nonfin(x[tl]) || fabsf(x[tl]) > 1e6f, 8u); }
            }
            if (filler) { RS_FILL_STORE(); RS_FILL_LOAD(((int)blockIdx.x * 4 + (wv - 4)) * 64 + sc * 2); }
            RS_SYNC();
            {
                const int q = tid >> 8, tl = (tid >> 4) & 15, jl = tid & 15; unsigned char* cb = lds + q * CHUNK_BYTES;
                const float* Lr = (const float*)(cb + O_L + (16 + tl) * 144);
                float s = 0.f;
#pragma unroll
                for (int i = 0; i < 16; ++i) s += Lr[i] * *(const float*)(cb + O_X + i * 144 + jl * 4);
                *(float*)(cb + O_X + tl * 144 + (16 + jl) * 4) = s;
            }
            RS_SYNC();
            {
                const int q = tid >> 8, tl = (tid >> 4) & 15, jl = tid & 15; unsigned char* cb = lds + q * CHUNK_BYTES;
                float s = 0.f;
#pragma unroll
                for (int i = 0; i < 16; ++i) s += *(const float*)(cb + O_X + (16 + tl) * 144 + (16 + i) * 4) * *(const float*)(cb + O_X + i * 144 + (16 + jl) * 4);
                diag_flag(p, nonfin(s), 16u);
                const int p0 = 8 * (jl >> 2) + (jl & 3), p1 = p0 + 4;
                *(bf16_t*)(cb + O_NT + (16 + tl) * P_KT + p0 * 2) = f2bf(s);
                *(bf16_t*)(cb + O_NT + tl * P_KT + p0 * 2) = f2bf(-*(const float*)(cb + O_X + tl * 144 + jl * 4));
                *(bf16_t*)(cb + O_NT + (16 + tl) * P_KT + p1 * 2) = f2bf(-*(const float*)(cb + O_X + (16 + tl) * 144 + (16 + jl) * 4));
                *(bf16_t*)(cb + O_NT + tl * P_KT + p1 * 2) = (bf16_t)0;
            }
            RS_SYNC();
            }
            if (wv < 4) REPEAT(REP_SD) {
                const int lnd = lane_fresh(), l15 = lnd & 15, g = lnd >> 4;
                f32x4 St[4] = {S4[0], S4[1], S4[2], S4[3]};
#pragma unroll 1
                for (int q = 0; q < 2; ++q) {
                    const unsigned char* cb = lds + q * CHUNK_BYTES;
                    bf16x8 fKH[2][2], fRH[2][2], fB2[2], fNT[2], fAP[2], fBP[2], fBG[4], fKDG[4]; f32x4 fG[4];
                    const bf16x8 vm = *(const bf16x8*)(cb + O_VM + (16 * wv + l15) * P_KT + 16 * g);
#pragma unroll
                    for (int ct = 0; ct < 2; ++ct) {
#pragma unroll
                        for (int s = 0; s < 2; ++s) fKH[ct][s] = *(const bf16x8*)(cb + O_KH + (16 * ct + l15) * P_TK + (32 * s + 8 * g) * 2);
                        fB2[ct] = *(const bf16x8*)(cb + O_B2 + (16 * ct + l15) * P_KT + 16 * g);
                        fNT[ct] = *(const bf16x8*)(cb + O_NT + (16 * ct + l15) * P_KT + 16 * g);
                    }
                    asm volatile("s_waitcnt lgkmcnt(0)" ::: "memory");
                    __builtin_amdgcn_sched_barrier(0);
                    bf16x8 sb[2]; sb[0] = cvt8(St[0], St[1]); sb[1] = cvt8(St[2], St[3]);
                    f32x4 w2[2];
#pragma unroll
                    for (int ct = 0; ct < 2; ++ct) {
                        f32x4 acc = (f32x4){0.f, 0.f, 0.f, 0.f};
                        acc = __builtin_amdgcn_mfma_f32_16x16x32_bf16(fKH[ct][0], sb[0], acc, 0, 0, 0);
                        acc = __builtin_amdgcn_mfma_f32_16x16x32_bf16(fKH[ct][1], sb[1], acc, 0, 0, 0);
                        acc = __builtin_amdgcn_mfma_f32_16x16x32_bf16(fB2[ct], vm, acc, 0, 0, 0);
                        w2[ct] = acc;
                    }
                    __builtin_amdgcn_sched_barrier(0);
#pragma unroll
                    for (int kt = 0; kt < 4; ++kt) {
                        fG[kt] = *(const f32x4*)(cb + O_GAM + (16 * kt + 4 * g) * 4);
                        fBG[kt] = *(const bf16x8*)(cb + O_BG + (16 * kt + l15) * P_KT + 16 * g);
                        fKDG[kt] = *(const bf16x8*)(cb + O_KDG + (16 * kt + l15) * P_KT + 16 * g);
                    }
                    __builtin_amdgcn_sched_barrier(0);
                    diag_flag(p, nonfin4(w2[0]) || nonfin4(w2[1]), 32u);
                    const bf16x8 wb = cvt8(w2[0], w2[1]);
                    f32x4 u2[2];
#pragma unroll
                    for (int ct = 0; ct < 2; ++ct) u2[ct] = __builtin_amdgcn_mfma_f32_16x16x32_bf16(fNT[ct], wb, (f32x4){0.f, 0.f, 0.f, 0.f}, 0, 0, 0);
                    diag_flag(p, nonfin4(u2[0]) || nonfin4(u2[1]), 64u);
                    const bf16x8 ub = cvt8(u2[0], u2[1]);
                    __builtin_amdgcn_sched_barrier(0);
#pragma unroll
                    for (int ct = 0; ct < 2; ++ct) {
#pragma unroll
                        for (int s = 0; s < 2; ++s) fRH[ct][s] = *(const bf16x8*)(cb + O_RH + (16 * ct + l15) * P_TK + (32 * s + 8 * g) * 2);
                        fBP[ct] = *(const bf16x8*)(cb + O_BP + (16 * ct + l15) * P_KT + 16 * g);
                        fAP[ct] = *(const bf16x8*)(cb + O_AP + (16 * ct + l15) * P_KT + 16 * g);
                    }
                    asm volatile("s_waitcnt lgkmcnt(8)" ::: "memory");
                    __builtin_amdgcn_sched_barrier(0);
#pragma unroll
                    for (int kt = 0; kt < 4; ++kt) {
                        f32x4 acc = St[kt] * fG[kt];
                        acc = __builtin_amdgcn_mfma_f32_16x16x32_bf16(fBG[kt], ub, acc, 0, 0, 0);
                        acc = __builtin_amdgcn_mfma_f32_16x16x32_bf16(fKDG[kt], vm, acc, 0, 0, 0);
                        St[kt] = acc; diag_flag(p, nonfin4(acc), 256u);
                    }
                    asm volatile("s_waitcnt lgkmcnt(0)" ::: "memory");
                    __builtin_amdgcn_sched_barrier(0);
#pragma unroll
                    for (int tt = 0; tt < 2; ++tt) {
                        f32x4 acc = (f32x4){0.f, 0.f, 0.f, 0.f};
                        acc = __builtin_amdgcn_mfma_f32_16x16x32_bf16(fRH[tt][0], sb[0], acc, 0, 0, 0);
                        acc = __builtin_amdgcn_mfma_f32_16x16x32_bf16(fRH[tt][1], sb[1], acc, 0, 0, 0);
                        acc = __builtin_amdgcn_mfma_f32_16x16x32_bf16(fAP[tt], ub, acc, 0, 0, 0);
                        acc = __builtin_amdgcn_mfma_f32_16x16x32_bf16(fBP[tt], vm, acc, 0, 0, 0);
                        diag_flag(p, nonfin4(acc), 128u);
                        float* yb = (float*)(lds + O_YB) + (q * 32 + 16 * tt + 4 * g) * YB_PITCH + 16 * wv + l15;
#pragma unroll
                        for (int r = 0; r < 4; ++r) yb[r * YB_PITCH] = acc[r];
                    }
                }
                if (LASTREP(REP_SD)) { S4[0] = St[0]; S4[1] = St[1]; S4[2] = St[2]; S4[3] = St[3]; }
            }
            else if (filler) {
                RS_FILL_STORE();
                RS_FILL_LOAD(((int)blockIdx.x * 4 + (wv - 4)) * 64 + sc * 2 + 1);
            }
            RS_SYNC();
            const int tido = wv * 64 + lane_fresh();
#pragma unroll
            for (int jj = 0; jj < 4; ++jj) {
                const int idx = tido + jj * NTHR, i = idx >> 5, v2 = idx & 31;
                const int step = sc * 64 + i, t = z ? (S - 1 - step) : step;
                const float2 yv = *(const float2*)((const float*)(lds + O_YB) + i * YB_PITCH + 2 * v2);
                if (var != 3) *(unsigned*)(YS + (size_t)z * T * D + ((size_t)b * S + t) * D + h * HD + 2 * v2) = pg8::cvt_pk_bf16(yv.x, yv.y);
            }
        }
        if (filler) RS_FILL_STORE();
        RS_SYNC();
    }
    __syncthreads();
}
#undef RS_SYNC
struct SchedBase { int G, c; };
struct SchedProj : SchedBase {
    const char* XM; const char* Wrkv; const char* L1t;
    __device__ __forceinline__ bool next(int i, pg8::Unit& u) const {
        const int L = i * G + c; if (L >= 960) return false;
        if (L < 768) {
            if (G == 256) { const int x = c & 7, j = c >> 3; u.job = i; u.pm = 8 * x + (j & 7); u.pn = j >> 3; }
            else { u.job = L >> 8; const int r = L & 255; u.pm = r >> 2; u.pn = r & 3; }
            u.B = Wrkv + ((size_t)u.job * 1024 + u.pn * 256) * 1024 * 2; }
        else { const int r = L - 768; u.job = 3 + r / 64; u.pm = r % 64; u.pn = 0; u.B = L1t + (size_t)(u.job - 3) * 256 * 1024 * 2; }
        u.A = XM + ((size_t)u.job * T + (size_t)u.pm * 256) * D * 2;
        return true;
    }
};
struct SchedLora2 : SchedBase {
    const char* L1b; const char* L2t;
    __device__ __forceinline__ bool next(int i, pg8::Unit& u) const {
        const int L = i * G + c; if (L >= 1280) return false;
        if (G == 256) { const int x = c & 7, j = c >> 3; u.job = i; u.pm = 8 * x + (j & 7); u.pn = j >> 3; }
        else { u.job = L >> 8; const int r = L & 255; u.pm = r >> 2; u.pn = r & 3; }
        u.A = L1b + ((size_t)u.pm * 256 * 512 + (u.job < 2 ? 0 : (u.job < 4 ? 128 : 256))) * 2;
        u.B = L2t + ((size_t)u.job * 1024 + u.pn * 256) * 128 * 2;
        return true;
    }
};
struct SchedPlain : SchedBase {
    const char* A; const char* B; int nN, lda, ldb;
    __device__ __forceinline__ bool next(int i, pg8::Unit& u) const {
        const int L = i * G + c; if (L >= 64 * nN) return false;
        u.job = 0;
        if (G == 256) { const int x = c & 7, j = c >> 3; u.pm = 8 * x + (j & 7); u.pn = 4 * i + (j >> 3); }
        else { u.pm = L / nN; u.pn = L % nN; }
        u.A = A + (size_t)u.pm * 256 * lda * 2; u.B = B + (size_t)u.pn * 256 * ldb * 2;
        return true;
    }
};
struct SchedLruGate : SchedBase {
    const char* UCB; const char* Wg;
    __device__ __forceinline__ bool next(int i, pg8::Unit& u) const {
        const int L = i * G + c; if (L >= 1024) return false;
        u.job = L >> 6; u.pm = L & 63; u.pn = 0;
        u.A = UCB + ((size_t)u.pm * 256 * D + ((u.job >> 1) & 3) * 256) * 2; u.B = Wg + (size_t)u.job * 256 * 256 * 2;
        return true;
    }
};
struct SchedMoe1 : SchedBase {
    const char* XIN; const char* Wgu;
    __device__ __forceinline__ bool next(int i, pg8::Unit& u) const {
        const int L = i * G + c; if (L >= 2048) return false;
        if (G == 256) { const int x = c & 7, j = c >> 3, xq = x & 3; u.job = 2 * i + (x >> 2); u.pm = (xq & 1) * 4 + (j & 3); u.pn = (xq >> 1) * 8 + (j >> 2); }
        else { u.job = L >> 7; const int r = L & 127; u.pm = r & 7; u.pn = r >> 3; }
        u.A = XIN + ((size_t)u.job * 2048 + u.pm * 256) * D * 2; u.B = Wgu + ((size_t)u.job * 4096 + u.pn * 256) * D * 2;
        return true;
    }
};
struct SchedMoe2 : SchedBase {
    const char* HID; const char* Wdn;
    __device__ __forceinline__ bool next(int i, pg8::Unit& u) const {
        const int L = i * G + c; if (L >= 512) return false;
        if (G == 256) { const int x = c & 7, j = c >> 3; u.job = 8 * i + x; u.pm = j & 7; u.pn = j >> 3; }
        else { u.job = L >> 5; const int r = L & 31; u.pm = r & 7; u.pn = r >> 3; }
        u.A = HID + ((size_t)u.job * 2048 + u.pm * 256) * FF * 2; u.B = Wdn + ((size_t)u.job * 1024 + u.pn * 256) * FF * 2;
        return true;
    }
};

#define EPI_ARGS const pg8::f32x4 (&acc)[2][2][4][2], const pg8::Unit& u, int wr, int wc, int fr, int fq
#define EPI_ROWS for (int ai = 0; ai < 2; ++ai) _Pragma("unroll") for (int m = 0; m < 4; ++m)
#define EPI_COLS for (int bj = 0; bj < 2; ++bj) _Pragma("unroll") for (int n = 0; n < 2; ++n)
struct EpiProj {
    static constexpr bool PERM = true;
    bf16_t* RKVb; bf16_t* L1b;
    __device__ __forceinline__ void operator()(EPI_ARGS) const {
        const int row0 = u.pm * 256 + wr * 64 + fr;
        if (u.job < 3) {
            bf16_t* C = RKVb + (size_t)u.job * T * D; const int col0 = u.pn * 256 + wc * 32 + 8 * fq;
#pragma unroll
            EPI_ROWS { bf16_t* rowp = C + (size_t)(row0 + ai * 128 + m * 16) * D + col0;
#pragma unroll
                for (int bj = 0; bj < 2; ++bj) { const pg8::f32x4 v0 = acc[ai][bj][m][0], v1 = acc[ai][bj][m][1]; pg8::u32x4 w;
                    w.x = pg8::cvt_pk_bf16(v0[0], v0[1]); w.y = pg8::cvt_pk_bf16(v0[2], v0[3]); w.z = pg8::cvt_pk_bf16(v1[0], v1[1]); w.w = pg8::cvt_pk_bf16(v1[2], v1[3]);
                    *(pg8::u32x4*)(rowp + bj * 128) = w; } }
        } else {
            const int col0 = (u.job - 3) * 128 + wc * 32 + 8 * fq; const int act = u.job;
#pragma unroll
            EPI_ROWS { bf16_t* rowp = L1b + (size_t)(row0 + ai * 128 + m * 16) * 512 + col0;
                pg8::f32x4 v0 = acc[ai][0][m][0], v1 = acc[ai][0][m][1];
                if (act == 3) {
#pragma unroll
                    for (int j = 0; j < 4; ++j) { v0[j] = tanhf_(v0[j]); v1[j] = tanhf_(v1[j]); } }
                else if (act == 5) {
#pragma unroll
                    for (int j = 0; j < 4; ++j) { v0[j] = sigmoidf_(v0[j]); v1[j] = sigmoidf_(v1[j]); } }
                pg8::u32x4 w; w.x = pg8::cvt_pk_bf16(v0[0], v0[1]); w.y = pg8::cvt_pk_bf16(v0[2], v0[3]); w.z = pg8::cvt_pk_bf16(v1[0], v1[1]); w.w = pg8::cvt_pk_bf16(v1[2], v1[3]);
                *(pg8::u32x4*)rowp = w;
                if (act == 5) { pg8::u32x4 zz; zz.x = 0u; zz.y = 0u; zz.z = 0u; zz.w = 0u; *(pg8::u32x4*)(rowp + 128) = zz; }
            }
        }
    }
};
struct EpiLora2 {
    static constexpr bool PERM = true;
    bf16_t* WDL; bf16_t* AAb; bf16_t* GGb; const float* w0; const float* a0;
    __device__ __forceinline__ void operator()(EPI_ARGS) const {
        const int row0 = u.pm * 256 + wr * 64 + fr, col0 = u.pn * 256 + wc * 32 + 8 * fq, job = u.job;
        bf16_t* C = job < 2 ? WDL + (size_t)job * T * D : (job < 4 ? AAb + (size_t)(job - 2) * T * D : GGb);
        const float* bias = job < 2 ? w0 + job * D : a0 + (job < 4 ? job - 2 : 0) * D;
        const float sc = job < 2 ? -0.6065306597126334f : 1.0f;
#pragma unroll
        for (int bj = 0; bj < 2; ++bj) {
            const pg8::f32x4 b0 = *(const pg8::f32x4*)(bias + col0 + bj * 128), b1 = *(const pg8::f32x4*)(bias + col0 + bj * 128 + 4);
#pragma unroll
            EPI_ROWS { pg8::f32x4 v0 = acc[ai][bj][m][0], v1 = acc[ai][bj][m][1];
                if (job < 4) { v0 = v0 + b0; v1 = v1 + b1;
#pragma unroll
                    for (int j = 0; j < 4; ++j) { v0[j] = sc * sigmoidf_(v0[j]); v1[j] = sc * sigmoidf_(v1[j]); } }
                pg8::u32x4 w; w.x = pg8::cvt_pk_bf16(v0[0], v0[1]); w.y = pg8::cvt_pk_bf16(v0[2], v0[3]); w.z = pg8::cvt_pk_bf16(v1[0], v1[1]); w.w = pg8::cvt_pk_bf16(v1[2], v1[3]);
                *(pg8::u32x4*)(C + (size_t)(row0 + ai * 128 + m * 16) * D + col0 + bj * 128) = w; }
        }
    }
};
struct EpiStoreF32 {
    static constexpr bool PERM = false;
    float* C; int ldc;
    __device__ __forceinline__ void operator()(EPI_ARGS) const {
        const int row0 = u.pm * 256 + wr * 64 + fr, col0 = u.pn * 256 + wc * 32 + 4 * fq;
#pragma unroll
        EPI_ROWS { float* rowp = C + (size_t)(row0 + ai * 128 + m * 16) * ldc + col0;
#pragma unroll
            EPI_COLS *(pg8::f32x4*)(rowp + bj * 128 + n * 16) = acc[ai][bj][m][n]; }
    }
};
struct EpiAddX {
    static constexpr bool PERM = false;
    float* X;
    __device__ __forceinline__ void operator()(EPI_ARGS) const {
        const int row0 = u.pm * 256 + wr * 64 + fr, col0 = u.pn * 256 + wc * 32 + 4 * fq;
#pragma unroll
        EPI_ROWS { float* rowp = X + (size_t)(row0 + ai * 128 + m * 16) * D + col0;
#pragma unroll
            EPI_COLS { pg8::f32x4* q = (pg8::f32x4*)(rowp + bj * 128 + n * 16); *q = *q + acc[ai][bj][m][n]; } }
    }
};
struct EpiLruGate {
    static constexpr bool PERM = true;
    bf16_t* LA; bf16_t* LB; const bf16_t* UCB; const float* ba; const float* bx; const float* lam;
    __device__ __forceinline__ void operator()(EPI_ARGS) const {
        const int z = u.job >> 3, h = (u.job >> 1) & 3, half = u.job & 1;
        const int row0 = u.pm * 256 + wr * 64 + fr, c0 = h * 256 + half * 128 + wc * 32 + 8 * fq;
        bf16_t* la = LA + (size_t)z * T * D; bf16_t* lb = LB + (size_t)z * T * D;
#pragma unroll
        for (int n = 0; n < 2; ++n) {
            const int c4 = c0 + 4 * n;
            const pg8::f32x4 lm = *(const pg8::f32x4*)(lam + z * D + c4), ba4 = *(const pg8::f32x4*)(ba + z * D + c4), bx4 = *(const pg8::f32x4*)(bx + z * D + c4);
            pg8::f32x4 sp4;
#pragma unroll
            for (int j = 0; j < 4; ++j) sp4[j] = -8.0f * softplusf_(-lm[j]);
#pragma unroll
            EPI_ROWS { const size_t o = (size_t)(row0 + ai * 128 + m * 16) * D + c4;
                const uint2 uu = *(const uint2*)(UCB + o); float uv[4]; bf4_to_f(uu, uv);
                float lo[4], bo[4];
#pragma unroll
                for (int j = 0; j < 4; ++j) { const float ra = acc[ai][0][m][n][j] + ba4[j], ix = acc[ai][1][m][n][j] + bx4[j];
                    const float l = sp4[j] * sigmoidf_(ra); lo[j] = l; const float x2 = 2.0f * l;   const float om = -x2 * (1.0f + x2 * (0.5f + x2 * (0.16666667f + x2 * (0.041666668f + x2 * 0.008333334f)))); bo[j] = __builtin_amdgcn_sqrtf(fmaxf(om, 0.f)) * sigmoidf_(ix) * uv[j]; }
                pg8::u32x2 w; w.x = pg8::cvt_pk_bf16(lo[0], lo[1]); w.y = pg8::cvt_pk_bf16(lo[2], lo[3]); *(pg8::u32x2*)(la + o) = w;
                w.x = pg8::cvt_pk_bf16(bo[0], bo[1]); w.y = pg8::cvt_pk_bf16(bo[2], bo[3]); *(pg8::u32x2*)(lb + o) = w; }
        }
    }
};
struct EpiSwiglu {
    static constexpr bool PERM = true;
    bf16_t* HID;
    __device__ __forceinline__ void operator()(EPI_ARGS) const {
        bf16_t* base = HID + (size_t)u.job * 2048 * FF; const int row0 = u.pm * 256 + wr * 64 + fr, col0 = u.pn * 128 + wc * 32 + 8 * fq;
#pragma unroll
        EPI_ROWS { float o[8];
#pragma unroll
            for (int n = 0; n < 2; ++n)
#pragma unroll
                for (int j = 0; j < 4; ++j) { const float gt = acc[ai][0][m][n][j], up = acc[ai][1][m][n][j]; o[n * 4 + j] = gt * sigmoidf_(gt) * up; }
            pg8::u32x4 w; w.x = pg8::cvt_pk_bf16(o[0], o[1]); w.y = pg8::cvt_pk_bf16(o[2], o[3]); w.z = pg8::cvt_pk_bf16(o[4], o[5]); w.w = pg8::cvt_pk_bf16(o[6], o[7]);
            *(pg8::u32x4*)(base + (size_t)(row0 + ai * 128 + m * 16) * FF + col0) = w; }
    }
};
struct EpiDown {
    static constexpr bool PERM = true;
    bf16_t* YEXP; const float* GATE;
    __device__ __forceinline__ void operator()(EPI_ARGS) const {
        const int row0 = u.pm * 256 + wr * 64 + fr, col0 = u.pn * 256 + wc * 32 + 8 * fq;
        bf16_t* C = YEXP + (size_t)u.job * 2048 * D; const float* gt = GATE + (size_t)u.job * 2048;
#pragma unroll
        EPI_ROWS { const int row = row0 + ai * 128 + m * 16; const float gs = gt[row];
#pragma unroll
            for (int bj = 0; bj < 2; ++bj) { const pg8::f32x4 v0 = acc[ai][bj][m][0] * gs, v1 = acc[ai][bj][m][1] * gs; pg8::u32x4 w;
                w.x = pg8::cvt_pk_bf16(v0[0], v0[1]); w.y = pg8::cvt_pk_bf16(v0[2], v0[3]); w.z = pg8::cvt_pk_bf16(v1[0], v1[1]); w.w = pg8::cvt_pk_bf16(v1[2], v1[3]);
                *(pg8::u32x4*)(C + (size_t)row * D + col0 + bj * 128) = w; } }
    }
};
struct EpiStoreBf16 {
    static constexpr bool PERM = true;
    bf16_t* O; int ldc;
    __device__ __forceinline__ void operator()(EPI_ARGS) const {
        const int row0 = u.pm * 256 + wr * 64 + fr, col0 = u.pn * 256 + wc * 32 + 8 * fq;
#pragma unroll
        EPI_ROWS { bf16_t* rowp = O + (size_t)(row0 + ai * 128 + m * 16) * ldc + col0;
#pragma unroll
            for (int bj = 0; bj < 2; ++bj) { const pg8::f32x4 v0 = acc[ai][bj][m][0], v1 = acc[ai][bj][m][1]; pg8::u32x4 w;
                w.x = pg8::cvt_pk_bf16(v0[0], v0[1]); w.y = pg8::cvt_pk_bf16(v0[2], v0[3]); w.z = pg8::cvt_pk_bf16(v1[0], v1[1]); w.w = pg8::cvt_pk_bf16(v1[2], v1[3]);
                *(pg8::u32x4*)(rowp + bj * 128) = w; } }
    }
};

struct RmId { __device__ __forceinline__ int operator()(int n) const { return n; } };
struct RmGU { int off; __device__ __forceinline__ int operator()(int n) const { return ((n >> 7) << 8) + off + (n & 127); } };
template <class RM>
__device__ __forceinline__ void tconv(const int wv, const float* W, int ldw, int K, int N, bf16_t* dst, int ldb, int koff, const RM rm, float* lds, int& rot) {
    const int tid = TID, G = gridDim.x, tn = N >> 7, ntiles = (K >> 6) * tn;
    const int lr = tid >> 5, lc = (tid & 31) * 4;
    const int sn = tid >> 3, sk = (tid & 7) * 8;
    int t = (int)(((unsigned)blockIdx.x + (unsigned)G - (unsigned)(rot % G)) % (unsigned)G);
    float4 cur[4], nx[4];
    if (t < ntiles) { const int k0 = (t / tn) << 6, n0 = (t % tn) << 7;
#pragma unroll
        for (int i = 0; i < 4; ++i) { const pg8::f32x4 t4 = __builtin_nontemporal_load((const pg8::f32x4*)(W + (size_t)(k0 + lr + 16 * i) * ldw + n0 + lc)); cur[i] = make_float4(t4[0], t4[1], t4[2], t4[3]); } }
    for (; t < ntiles; t += G) {
        const int k0 = (t / tn) << 6, n0 = (t % tn) << 7; const int t2 = t + G;
        if (t2 < ntiles) { const int k2 = (t2 / tn) << 6, n2 = (t2 % tn) << 7;
#pragma unroll
            for (int i = 0; i < 4; ++i) { const pg8::f32x4 t4 = __builtin_nontemporal_load((const pg8::f32x4*)(W + (size_t)(k2 + lr + 16 * i) * ldw + n2 + lc)); nx[i] = make_float4(t4[0], t4[1], t4[2], t4[3]); } }
        __syncthreads();
#pragma unroll
        for (int i = 0; i < 4; ++i) { float* q = lds + (lr + 16 * i) * 129 + lc; q[0] = cur[i].x; q[1] = cur[i].y; q[2] = cur[i].z; q[3] = cur[i].w; }
        __syncthreads();
#pragma unroll
        for (int i = 0; i < 2; ++i) { const int n = sn + 64 * i; float f[8];
#pragma unroll
            for (int j = 0; j < 8; ++j) f[j] = lds[(sk + j) * 129 + n];
            pg8::u32x4 w; w.x = pg8::cvt_pk_bf16(f[0], f[1]); w.y = pg8::cvt_pk_bf16(f[2], f[3]); w.z = pg8::cvt_pk_bf16(f[4], f[5]); w.w = pg8::cvt_pk_bf16(f[6], f[7]);
            *(pg8::u32x4*)(dst + (size_t)rm(n0 + n) * ldb + koff + k0 + sk) = w; }
#pragma unroll
        for (int i = 0; i < 4; ++i) cur[i] = nx[i];
    }
    rot += ntiles;
}
__device__ __forceinline__ void tconv_small(const int wv, const float* W, int K, int N, bf16_t* dst, int ldb, int noff) {
    for (int i = blockIdx.x * NTHR + TID; i < K * N; i += gridDim.x * NTHR) { const int k = i / N, n = i - k * N; dst[(size_t)(n + noff) * ldb + k] = f2bf(W[i]); }
}
__device__ __forceinline__ void zfill(const int wv, bf16_t* dst, int ldb, int r0, int r1, int c0, int c1) {
    const int w8 = (c1 - c0) >> 3, tot = (r1 - r0) * w8;
    for (int i = blockIdx.x * NTHR + TID; i < tot; i += gridDim.x * NTHR) { const int r = r0 + i / w8, c = c0 + (i % w8) * 8; *(uint4*)(dst + (size_t)r * ldb + c) = make_uint4(0u, 0u, 0u, 0u); }
}
__device__ __forceinline__ void ph_prologue(const int wv, const P& p, float* lds) {
    int rot = 0;
    unsigned char* ws = p.ws;
    for (int L = 0; L < DEPTH; ++L) {
        if (gridDim.x == 256 && (L % 3) == 0) continue;
        for (int e = 0; e < NE; ++e) {
            bf16_t* gu = (bf16_t*)(ws + WB_MOE + (size_t)L * MOE_STRIDE + MOE_GU) + (size_t)e * 4096 * D;
            bf16_t* dn = (bf16_t*)(ws + WB_MOE + (size_t)L * MOE_STRIDE + MOE_DN) + (size_t)e * D * FF;
            RmGU rg; rg.off = 0; RmGU ru; ru.off = 128;
            tconv(wv, p.in[I_WG] + ((size_t)L * NE + e) * D * FF, FF, D, FF, gu, D, 0, rg, lds, rot);
            tconv(wv, p.in[I_WU] + ((size_t)L * NE + e) * D * FF, FF, D, FF, gu, D, 0, ru, lds, rot);
            tconv(wv, p.in[I_WDN] + ((size_t)L * NE + e) * FF * D, D, FF, D, dn, FF, 0, RmId(), lds, rot);
        }
    }
    for (int ia = 0; ia < 2; ++ia) {
        unsigned char* rb = ws + WB_RW + (size_t)ia * RW_STRIDE;
        for (int q = 0; q < 3; ++q) tconv(wv, p.in[I_WIN] + ((size_t)ia * 3 + q) * D * D, D, D, D, (bf16_t*)(rb + RW_RKV) + (size_t)q * D * D, D, 0, RmId(), lds, rot);
        tconv(wv, p.in[I_WOUT] + (size_t)ia * D * D, D, D, D, (bf16_t*)(rb + RW_OUT), D, 0, RmId(), lds, rot);
        bf16_t* l1 = (bf16_t*)(rb + RW_L1);
        for (int z = 0; z < 2; ++z) { tconv_small(wv, p.in[I_W1] + ((size_t)ia * 2 + z) * D * 64, D, 64, l1, D, z * 64); tconv_small(wv, p.in[I_A1] + ((size_t)ia * 2 + z) * D * 64, D, 64, l1 + 256 * D, D, z * 64); }
        tconv(wv, p.in[I_G1] + (size_t)ia * D * 128, 128, D, 128, l1 + 2 * 256 * D, D, 0, RmId(), lds, rot);
        for (int q = 0; q < 3; ++q) zfill(wv, l1 + (size_t)q * 256 * D, D, 128, 256, 0, D);
        bf16_t* l2 = (bf16_t*)(rb + RW_L2);
        for (int z = 0; z < 2; ++z) {
            tconv(wv, p.in[I_W2] + ((size_t)ia * 2 + z) * 64 * D, D, 64, D, l2 + (size_t)z * 1024 * 128, 128, z * 64, RmId(), lds, rot);
            tconv(wv, p.in[I_A2] + ((size_t)ia * 2 + z) * 64 * D, D, 64, D, l2 + (size_t)(2 + z) * 1024 * 128, 128, z * 64, RmId(), lds, rot);
            zfill(wv, l2 + (size_t)z * 1024 * 128, 128, 0, 1024, (1 - z) * 64, (1 - z) * 64 + 64);
            zfill(wv, l2 + (size_t)(2 + z) * 1024 * 128, 128, 0, 1024, (1 - z) * 64, (1 - z) * 64 + 64);
        }
        tconv(wv, p.in[I_G2] + (size_t)ia * 128 * D, D, 128, D, l2 + (size_t)4 * 1024 * 128, 128, 0, RmId(), lds, rot);
    }
    tconv(wv, p.in[I_SCIN], 3 * D, D, 3 * D, (bf16_t*)(ws + WB_SC + SC_IN), D, 0, RmId(), lds, rot);
    tconv(wv, p.in[I_SCOUT], D, D, D, (bf16_t*)(ws + WB_SC + SC_OUT), D, 0, RmId(), lds, rot);
    tconv(wv, p.in[I_LIN], 2 * D, D, 2 * D, (bf16_t*)(ws + WB_LRU + LRU_IN), D, 0, RmId(), lds, rot);
    tconv(wv, p.in[I_LOUT], D, D, D, (bf16_t*)(ws + WB_LRU + LRU_OUT), D, 0, RmId(), lds, rot);
    for (int zh = 0; zh < 8; ++zh) {
        bf16_t* gt = (bf16_t*)(ws + WB_LRU + LRU_G) + (size_t)zh * 2 * 256 * 256;
        RmGU ra; ra.off = 0; RmGU rx; rx.off = 128;
        tconv(wv, p.in[I_LWA] + (size_t)zh * 256 * 256, 256, 256, 256, gt, 256, 0, ra, lds, rot);
        tconv(wv, p.in[I_LWX] + (size_t)zh * 256 * 256, 256, 256, 256, gt, 256, 0, rx, lds, rot);
    }
}


#define XB_TMO      128
#define XB_XCNT(j)  (256  + 64 * (j))
#define XB_XSUB(j)  (1280 + 64 * (j))
#define XB_XGEN(j)  (2304 + 64 * (j))
#define XB_TOP      3328
#define XB_TOPGEN   3392
#define XCD_BAR_WORDS 3456
#define XB_SPIN_CAP (1u << 22)
#define LAS __attribute__((address_space(3)))
__device__ __forceinline__ unsigned xb_ld(unsigned* p)              { return __hip_atomic_load(p, __ATOMIC_RELAXED, __HIP_MEMORY_SCOPE_AGENT); }
__device__ __forceinline__ unsigned xb_add(unsigned* p, unsigned v) { return __hip_atomic_fetch_add(p, v, __ATOMIC_RELAXED, __HIP_MEMORY_SCOPE_AGENT); }
__device__ __forceinline__ unsigned xb_xcc_id() { return (unsigned)__builtin_amdgcn_s_getreg((3 << 11) | 20) & 0xFu; }
#define XB_SPIN(cond, bar) do { unsigned _sp = 0; while (cond) { __builtin_amdgcn_s_sleep(1); \
    if ((++_sp & 255u) == 0u) { if (xb_ld(&(bar)[XB_TMO])) break; if (_sp > XB_SPIN_CAP) { atomicAdd(&(bar)[XB_TMO], 1u); break; } } } } while (0)
struct XcdBarrier { unsigned* bar; unsigned x; volatile LAS unsigned* st; };
__device__ __forceinline__ XcdBarrier xcd_barrier_post(const int wv, unsigned* bar, volatile LAS unsigned* st) {
    XcdBarrier b; b.bar = bar; b.x = xb_xcc_id(); b.st = st;
    if (TID == 0) (void)xb_add(&bar[XB_XCNT(b.x)], 1u);
    return b;
}
__device__ __forceinline__ void xcd_barrier_complete(unsigned* bar, unsigned x, unsigned& nloc, unsigned& nx) {
    const unsigned G = gridDim.x * gridDim.y * gridDim.z;
    unsigned sum, cnt, mine, sp = 0u;
    for (;;) {
        sum = 0u; cnt = 0u; mine = 0u;
#pragma unroll
        for (unsigned j = 0; j < 16; ++j) { const unsigned c = xb_ld(&bar[XB_XCNT(j)]); sum += c; cnt += (c > 0u) ? 1u : 0u; mine = (j == x) ? c : mine; }
        if (sum == G) break;
        __builtin_amdgcn_s_sleep(1);
        if ((++sp & 255u) == 0u) { if (xb_ld(&bar[XB_TMO])) break; if (sp > XB_SPIN_CAP) { atomicAdd(&bar[XB_TMO], 1u); break; } }
    }
    nloc = mine > 0u ? mine : 1u; nx = cnt > 0u ? cnt : 1u;
}
__device__ __forceinline__ void xcd_barrier(const int wv, const XcdBarrier& b) {
    asm volatile("s_waitcnt vmcnt(0)" ::: "memory");
    __syncthreads();
    if (TID == 0) {
        unsigned* bar = b.bar;
        __builtin_amdgcn_s_waitcnt(0);
        unsigned nloc = b.st[0], nx = b.st[1];
        if (nloc == 0u) { xcd_barrier_complete(bar, b.x, nloc, nx); b.st[0] = nloc; b.st[1] = nx; }
        const unsigned old = xb_add(&bar[XB_XSUB(b.x)], 1u);
        const unsigned gen = old / nloc;
        if (old + 1u == (gen + 1u) * nloc) {
            __builtin_amdgcn_fence(__ATOMIC_RELEASE, "agent");
            asm volatile("s_waitcnt vmcnt(0)" ::: "memory");
            const unsigned og = xb_add(&bar[XB_TOP], 1u);
            const unsigned tg = og / nx;
            if (og + 1u == (tg + 1u) * nx) xb_add(&bar[XB_TOPGEN], 1u);
            else XB_SPIN(xb_ld(&bar[XB_TOPGEN]) == tg, bar);
            __builtin_amdgcn_fence(__ATOMIC_ACQUIRE, "agent");
            xb_add(&bar[XB_XGEN(b.x)], 1u);
            asm volatile("s_waitcnt vmcnt(0)" ::: "memory");
        } else {
            XB_SPIN(xb_ld(&bar[XB_XGEN(b.x)]) == gen, bar);
            __builtin_amdgcn_fence(__ATOMIC_ACQUIRE, "agent");
            asm volatile("s_waitcnt vmcnt(0)" ::: "memory");
        }
    }
    __syncthreads();
}
struct PhaseCtl { XcdBarrier bar; int lo, hi; bool did; };
__device__ __forceinline__ bool phase_enter(const int wv, PhaseCtl& c, int k) {
    if (k < c.lo || k >= c.hi) return false;
    if (c.did) REPEAT(REP_BAR) xcd_barrier(wv, c.bar);
    c.did = true;
    return true;
}

#define DIAG 0
constexpr int CTL_DIAG = 4096;
__device__ __forceinline__ void diag_compare(const int wv, const P& p, const float* A, const float* Bq, size_t n) {
    float e = 0.f, r = 0.f; int bad = 0;
    for (size_t i = (size_t)blockIdx.x * NTHR + TID; i < n; i += (size_t)gridDim.x * NTHR) { const float a = A[i], b = Bq[i]; const float d = a - b; e += d * d; r += a * a; if (!(d == d) || fabsf(d) > 3.0e38f) bad = 1; }
    e = wave_sum(e); r = wave_sum(r); bad = __any(bad);
    if (lane_fresh() == 0) { float* c = (float*)(p.ws + WS_CTL) + CTL_DIAG; atomicAdd(c, e); atomicAdd(c + 1, r); if (bad) atomicAdd((unsigned*)(c + 2), 1u); }
}
__device__ __forceinline__ void diag_delay(const int wv, const P& p) {
    if (blockIdx.x == 0 && TID == 0) {
        float* c = (float*)(p.ws + WS_CTL) + CTL_DIAG;
        const float e = __hip_atomic_load(c, __ATOMIC_RELAXED, __HIP_MEMORY_SCOPE_AGENT), r = __hip_atomic_load(c + 1, __ATOMIC_RELAXED, __HIP_MEMORY_SCOPE_AGENT);
        const unsigned bad = __hip_atomic_load((unsigned*)(c + 2), __ATOMIC_RELAXED, __HIP_MEMORY_SCOPE_AGENT);
        const unsigned mask = __hip_atomic_load((unsigned*)(c + 3), __ATOMIC_RELAXED, __HIP_MEMORY_SCOPE_AGENT);
        float ms;
        if (bad) ms = 12.f; else if (!(r > 0.f)) ms = 14.f; else { const float rel = sqrtf(e / r); float lg = log10f(fmaxf(rel, 1e-8f)) + 8.f; lg = fminf(fmaxf(lg, 0.f), 10.f); ms = 1.f + lg; }
        if (DIAGF) { ms = 1.f; if (mask) ms = 2.f + (float)__ffs(mask); if (bad) ms += 10.f; }
        const unsigned long long t0 = __builtin_amdgcn_s_memrealtime(); const unsigned long long ticks = (unsigned long long)(ms * 100000.f);
        while (__builtin_amdgcn_s_memrealtime() - t0 < ticks) __builtin_amdgcn_s_sleep(32);
    }
}
constexpr int LDS_BYTES = 128 * 1024 + 1024;
constexpr int PH_PER_LAYER = 16, PH_FINAL = 1 + DEPTH * PH_PER_LAYER, PH_TOTAL = PH_FINAL + 1;

#define IN(k) phase_enter(wv, pc, (k))
template <int L>
__device__ __forceinline__ void run_layer(const int wv, const P& p, float* lds, PhaseCtl& pc) {
    constexpr int m = L % 3, base = 1 + L * PH_PER_LAYER, ia = L / 3;
    PG8_LAS unsigned char* glds = (PG8_LAS unsigned char*)lds;
    unsigned char* ws = p.ws;
    float* X = (float*)(ws + (L == 3 ? WS_X2 : WS_X)); bf16_t* H = (bf16_t*)(ws + WS_H);
    float* RKV = (float*)(ws + WS_RKV);
    float* WDp = (float*)(ws + WS_WD); float* AAp = (float*)(ws + WS_AA); float* GG = (float*)(ws + WS_GG);
    SchedBase sb; sb.G = gridDim.x; sb.c = blockIdx.x;
    if constexpr (m == 0) {
        if (IN(base + 0)) REPEAT(REP_NORM_MIX) ph_norm_xm(wv, p, L == 0 ? p.in[I_X] : (const float*)(ws + WS_X), L == 0 ? nullptr : (const bf16_t*)(ws + WS_UCB), X, L > 0, p.in[I_NMG] + L * D, p.in[I_MU] + ia * 6 * D, (unsigned char*)lds);
    } else {
    if (IN(base + 0)) REPEAT(REP_NORM_MIX) ph_norm(wv, p, L == 0 ? p.in[I_X] : X, L == 0 ? nullptr : (const bf16_t*)(ws + WS_UCB), LASTREP(REP_NORM_MIX) ? X : (float*)(ws + WS_YS), L > 0, p.in[I_NMG] + L * D, LASTREP(REP_NORM_MIX) ? H : (bf16_t*)(ws + WS_YS + 64 * MiB), nullptr, nullptr, lds);
    }
    if constexpr (m == 0) {
        const unsigned char* rb = ws + WB_RW + (size_t)ia * RW_STRIDE;
        if (IN(base + 2)) {
            SchedProj S; S.G = sb.G; S.c = sb.c; S.XM = (const char*)(ws + WS_XM); S.Wrkv = (const char*)(rb + RW_RKV); S.L1t = (const char*)(rb + RW_L1);
            EpiProj E; E.RKVb = (bf16_t*)(ws + WS_RKV); E.L1b = (bf16_t*)(ws + WS_L1);
            pg8::Geo g; g.lda = D; g.ldb = D; g.K = D;
            REPEAT(REP_PROJ) pg8::gemm_phase(wv, glds, g, S, E);
        }
        if (IN(base + 3)) {
            SchedLora2 S; S.G = sb.G; S.c = sb.c; S.L1b = (const char*)(ws + WS_L1); S.L2t = (const char*)(rb + RW_L2);
            EpiLora2 E; E.WDL = (bf16_t*)(ws + WS_WD); E.AAb = (bf16_t*)(ws + WS_AA); E.GGb = (bf16_t*)(ws + WS_GG); E.w0 = p.in[I_W0] + (size_t)ia * 2 * D; E.a0 = p.in[I_A0] + (size_t)ia * 2 * D;
            pg8::Geo g; g.lda = 512; g.ldb = 128; g.K = 128;
            REPEAT(REP_LORA2) pg8::gemm_phase(wv, glds, g, S, E);
        }
        if (IN(base + 4)) {
            REPEAT(REP_SCAN) ph_scan2(wv, p, ia, (unsigned char*)lds, (bf16_t*)(ws + WS_YS), L, LASTREP(REP_SCAN) ? 0 : 100 + SVAR);
        }
        if (DIAG) { if (IN(base + 11)) diag_compare(wv, p, (const float*)(ws + WS_YS), (const float*)(ws + WS_XM), (size_t)2 * T * D); }
        if (IN(base + 5)) REPEAT(REP_RPOST) ph_rwkv_post(wv, p, ia);
        if (IN(base + 6)) {
            SchedPlain S; S.G = sb.G; S.c = sb.c; S.A = (const char*)(ws + WS_YG); S.B = (const char*)(rb + RW_OUT); S.nN = 4; S.lda = D; S.ldb = D;
            pg8::Geo g; g.lda = D; g.ldb = D; g.K = D;
            REPEAT(REP_OUT) { EpiStoreBf16 E; E.O = (bf16_t*)(ws + WS_UCB); E.ldc = D; pg8::gemm_phase(wv, glds, g, S, E); }
        }
    } else if constexpr (m == 1) {
        if (IN(base + 1)) {
            SchedPlain S; S.G = sb.G; S.c = sb.c; S.A = (const char*)H; S.B = (const char*)(ws + WB_SC + SC_IN); S.nN = 12; S.lda = D; S.ldb = D;
            EpiStoreBf16 E; E.O = (bf16_t*)(ws + WS_RKV); E.ldc = 3 * D; pg8::Geo g; g.lda = D; g.ldb = D; g.K = D;
            REPEAT(REP_SCIN) pg8::gemm_phase(wv, glds, g, S, E);
        }
        if (IN(base + 2)) REPEAT(REP_SCMID) ph_sc_mid(wv, p);
        if (IN(base + 3)) {
            SchedPlain S; S.G = sb.G; S.c = sb.c; S.A = (const char*)(ws + WS_YG); S.B = (const char*)(ws + WB_SC + SC_OUT); S.nN = 4; S.lda = D; S.ldb = D;
            pg8::Geo g; g.lda = D; g.ldb = D; g.K = D;
            REPEAT(REP_OUT) { EpiStoreBf16 E; E.O = (bf16_t*)(ws + WS_UCB); E.ldc = D; pg8::gemm_phase(wv, glds, g, S, E); }
        }
    } else {
        if (IN(base + 1)) {
            SchedPlain S; S.G = sb.G; S.c = sb.c; S.A = (const char*)H; S.B = (const char*)(ws + WB_LRU + LRU_IN); S.nN = 8; S.lda = D; S.ldb = D;
            EpiStoreBf16 E; E.O = (bf16_t*)(ws + WS_RKV); E.ldc = 2 * D; pg8::Geo g; g.lda = D; g.ldb = D; g.K = D;
            REPEAT(REP_LIN) pg8::gemm_phase(wv, glds, g, S, E);
        }
        if (IN(base + 2)) REPEAT(REP_LCONV) ph_lru_conv(wv, p);
        if (IN(base + 3)) {
            SchedLruGate S; S.G = sb.G; S.c = sb.c; S.UCB = (const char*)(ws + WS_UCB); S.Wg = (const char*)(ws + WB_LRU + LRU_G);
            EpiLruGate E; E.LA = (bf16_t*)(ws + WS_WD); E.LB = (bf16_t*)(ws + WS_AA); E.UCB = (const bf16_t*)(ws + WS_UCB); E.ba = p.in[I_LBA]; E.bx = p.in[I_LBX]; E.lam = p.in[I_LLAM];
            pg8::Geo g; g.lda = D; g.ldb = 256; g.K = 256;
            REPEAT(REP_LGATE) pg8::gemm_phase(wv, glds, g, S, E);
        }
        if (IN(base + 4)) REPEAT(REP_LSCAN) ph_lru_scan(wv, p, lds);
        if (IN(base + 5)) REPEAT(REP_LPOST) ph_lru_post(wv, p);
        if (IN(base + 6)) {
            SchedPlain S; S.G = sb.G; S.c = sb.c; S.A = (const char*)(ws + WS_YG); S.B = (const char*)(ws + WB_LRU + LRU_OUT); S.nN = 4; S.lda = D; S.ldb = D;
            pg8::Geo g; g.lda = D; g.ldb = D; g.K = D;
            REPEAT(REP_OUT) { EpiStoreBf16 E; E.O = (bf16_t*)(ws + WS_UCB); E.ldc = D; pg8::gemm_phase(wv, glds, g, S, E); }
        }
    }
    if (IN(base + 7)) REPEAT(REP_NORM_FFN) ph_norm(wv, p, X, (const bf16_t*)(ws + WS_UCB), nullptr, false, p.in[I_NFG] + L * D, H, p.in[I_RW] + (size_t)L * D * NE, nullptr, lds);
    if (IN(base + 8)) REPEAT(REP_TOPK) ph_topk(wv, p, lds);
    if (IN(base + 9)) {
        SchedMoe1 S; S.G = sb.G; S.c = sb.c; S.XIN = (const char*)(ws + WS_XIN); S.Wgu = (const char*)(ws + WB_MOE + (size_t)L * MOE_STRIDE + MOE_GU);
        EpiSwiglu E; E.HID = (bf16_t*)(ws + WS_HID); pg8::Geo g; g.lda = D; g.ldb = D; g.K = D;
        REPEAT(REP_MOE1) pg8::gemm_phase(wv, glds, g, S, E, !LASTREP(REP_MOE1) && GVAR == 1);
    }
    if (IN(base + 10)) {
        SchedMoe2 S; S.G = sb.G; S.c = sb.c; S.HID = (const char*)(ws + WS_HID); S.Wdn = (const char*)(ws + WB_MOE + (size_t)L * MOE_STRIDE + MOE_DN);
        EpiDown E; E.YEXP = (bf16_t*)(ws + WS_YEXP); E.GATE = (const float*)(ws + WS_GATE); pg8::Geo g; g.lda = FF; g.ldb = FF; g.K = FF;
        REPEAT(REP_MOE2) pg8::gemm_phase(wv, glds, g, S, E, !LASTREP(REP_MOE2) && GVAR == 1);
    }
}

__global__ void __launch_bounds__(NTHR, 2) mega(P p_unused) {
    extern __shared__ __attribute__((aligned(16))) unsigned char lds_raw[];
    const P& p = *(const P*)__builtin_amdgcn_kernarg_segment_ptr();
    float* lds = (float*)lds_raw;
    volatile LAS unsigned* xbw = (volatile LAS unsigned*)(lds_raw + LDS_BYTES - 16);
    const int wv = __builtin_amdgcn_readfirstlane((int)(threadIdx.x >> 6));
    if (threadIdx.x == 0) { xbw[0] = 0u; xbw[1] = 0u; xbw[2] = 0u; xbw[3] = 0u; }
    __syncthreads();
    PhaseCtl pc; pc.lo = p.ph_lo; pc.hi = p.ph_hi; pc.did = false;
    pc.bar = xcd_barrier_post(wv, (unsigned*)(p.ws + WS_CTL), xbw);
    if (IN(0)) REPEAT(REP_PROLOGUE) ph_prologue(wv, p, lds);
    run_layer<0>(wv, p, lds, pc);
    run_layer<1>(wv, p, lds, pc);
    run_layer<2>(wv, p, lds, pc);
    run_layer<3>(wv, p, lds, pc);
    if (IN(PH_FINAL)) ph_norm(wv, p, (const float*)(p.ws + WS_X2), (const bf16_t*)(p.ws + WS_UCB), nullptr, true, p.in[I_FNG], nullptr, nullptr, p.out, lds);
    if (DIAG) { xcd_barrier(wv, pc.bar); diag_delay(wv, p); }
}
#undef IN

}

extern "C" void kernel_launch(void* const* d_in, const int* in_sizes, int n_in, void* d_out, int out_size, void* d_ws, size_t ws_size, hipStream_t stream) {
    static int ready = 0, grid = 256;
    if (!ready) {
        if (n_in != 36 || out_size != T * D || ws_size < WS_END) { fprintf(stderr, "kernel_launch: unexpected problem (n_in %d out %d ws %zu need %zu)\n", n_in, out_size, ws_size, (size_t)WS_END); ready = -1; return; }
        if (hipFuncSetAttribute((const void*)mega, hipFuncAttributeMaxDynamicSharedMemorySize, LDS_BYTES) != hipSuccess) { fprintf(stderr, "kernel_launch: hipFuncSetAttribute failed\n"); ready = -1; return; }
        { int dev = 0, cus = 0; if (hipGetDevice(&dev) == hipSuccess && hipDeviceGetAttribute(&cus, hipDeviceAttributeMultiprocessorCount, dev) == hipSuccess && cus > 0) grid = cus < 256 ? cus : 256; }
        ready = 1;
    }
    if (ready < 0) return;
    (void)in_sizes;
    P p{};
    for (int i = 0; i < 36; ++i) p.in[i] = (const float*)d_in[i];
    p.out = (float*)d_out; p.ws = (unsigned char*)d_ws;
    if (hipMemsetAsync((char*)d_ws + WS_CTL, 0, 32768, stream) != hipSuccess) { fprintf(stderr, "kernel_launch: memset failed\n"); return; }
    p.ph_lo = 0; p.ph_hi = PH_TOTAL;
    hipLaunchKernelGGL(mega, dim3(grid), dim3(NTHR), LDS_BYTES, stream, p);
}
```

```cpp
#include <hip/hip_runtime.h>
#include <stdint.h>
#include <stdio.h>

namespace {
constexpr int D = 1024, NB = 8, S = 2048, T = NB * S, DEPTH = 4, NE = 16, FF = 2048, CAP = 256, NH = 16, HD = 64;
constexpr int NTHR = 512;
constexpr float RMS_EPS = 1e-6f, LNX_EPS = 64e-5f;
typedef unsigned short bf16_t;

constexpr size_t MiB = 1u << 20;
constexpr size_t WS_CTL = 0;
constexpr size_t WS_X = 1 * MiB;
constexpr size_t WS_H = WS_X + 64 * MiB;
constexpr size_t WS_XM = WS_H + 32 * MiB;
constexpr size_t WS_RKV = WS_XM + 192 * MiB;
constexpr size_t WS_L1 = WS_RKV + 192 * MiB;
constexpr size_t WS_WD = WS_L1 + 24 * MiB;
constexpr size_t WS_AA = WS_WD + 128 * MiB;
constexpr size_t WS_GG = WS_AA + 128 * MiB;
constexpr size_t WS_YS = WS_GG + 64 * MiB;
constexpr size_t WS_YG = WS_YS + 128 * MiB;
constexpr size_t WS_UCB = WS_YG + 32 * MiB;
constexpr size_t WS_YEXP = WS_UCB + 32 * MiB;
constexpr size_t WS_AFF = WS_YEXP + 128 * MiB;
constexpr size_t WS_SLOT = WS_AFF + 1 * MiB;
constexpr size_t WS_GATE = WS_SLOT + 1 * MiB;
constexpr size_t WS_ACT_END = WS_GATE + 1 * MiB;
constexpr size_t WB_RW = WS_ACT_END;
constexpr size_t RW_RKV = 0, RW_L1 = 6 * MiB, RW_L2 = RW_L1 + 3 * 256 * 1024 * 2, RW_OUT = RW_L2 + 5 * 1024 * 256 * 2, RW_STRIDE = 12 * MiB;
constexpr size_t WB_SC = WB_RW + 2 * RW_STRIDE;
constexpr size_t SC_IN = 0, SC_OUT = 6 * MiB;
constexpr size_t WB_LRU = WB_SC + 8 * MiB;
constexpr size_t LRU_IN = 0, LRU_G = 4 * MiB, LRU_OUT = 6 * MiB;
constexpr size_t WB_MOE = WB_LRU + 8 * MiB;
constexpr size_t MOE_GU = 0, MOE_DN = 128 * MiB, MOE_STRIDE = 192 * MiB;
constexpr size_t WS_X2 = WB_MOE + 4 * MOE_STRIDE;
constexpr size_t WS_END = WS_X2 + 64 * MiB;
constexpr size_t WS_XIN = WS_XM, WS_HID = WS_XM + 64 * MiB;
constexpr size_t WS_BON = WS_L1 + 16 * MiB;

constexpr int REP_PROLOGUE = 1, REP_NORM_MIX = 1, REP_XM = 1, REP_PROJ = 1, REP_LORA2 = 1, REP_SCAN = 1, REP_RPOST = 1, REP_OUT = 1, REP_SCIN = 1, REP_SCMID = 1,
              REP_LIN = 1, REP_LCONV = 1, REP_LGATE = 1, REP_LSCAN = 1, REP_LPOST = 1, REP_NORM_FFN = 1, REP_TOPK = 1, REP_MOE1 = 1, REP_MOE2 = 1, REP_BAR = 1, REP_SA = 1, REP_SB = 1, REP_SC = 1, REP_SD = 1, GVAR = 0, SVAR = 0;
#define REPEAT(n) for (int rep_ = 0; rep_ < (n); ++rep_)
#define LASTREP(n) (rep_ == (n) - 1)
struct P {
    const float* in[36];
    float* out;
    unsigned char* ws;
    int ph_lo, ph_hi;
};

enum { I_X = 0, I_NMG, I_NFG, I_RW, I_WG, I_WU, I_WDN, I_FNG, I_MU, I_WIN, I_W0, I_W1, I_W2, I_A0, I_A1, I_A2, I_G1, I_G2, I_KK, I_KA, I_RK, I_LNG, I_LNB, I_WOUT,
       I_SCIN, I_SCCW, I_SCOUT, I_LIN, I_LCW, I_LCB, I_LWA, I_LBA, I_LWX, I_LBX, I_LLAM, I_LOUT };

__device__ __forceinline__ int lane_fresh() { int l; asm volatile("v_mbcnt_lo_u32_b32 %0, -1, 0\n\tv_mbcnt_hi_u32_b32 %0, -1, %0" : "=v"(l)); return l; }
#define TID (wv * 64 + lane_fresh())
__device__ __forceinline__ float bf2f(bf16_t v) { return __uint_as_float((unsigned)v << 16); }
__device__ __forceinline__ bf16_t f2bf(float f) { unsigned u = __float_as_uint(f); u += 0x7FFFu + ((u >> 16) & 1u); return (bf16_t)(u >> 16); }
__device__ __forceinline__ void bf4_to_f(uint2 u, float* f) { f[0] = __uint_as_float(u.x << 16); f[1] = __uint_as_float(u.x & 0xffff0000u); f[2] = __uint_as_float(u.y << 16); f[3] = __uint_as_float(u.y & 0xffff0000u); }
__device__ __forceinline__ uint2 f4_to_bf(float a, float b, float c, float d) { return make_uint2((unsigned)f2bf(a) | ((unsigned)f2bf(b) << 16), (unsigned)f2bf(c) | ((unsigned)f2bf(d) << 16)); }
constexpr float F8_SW = 64.0f, F8_SH = 4.0f, F8_SHID = 8.0f;
__device__ __forceinline__ unsigned cvt4_fp8(float a, float b, float c, float d) {
    int w = __builtin_amdgcn_cvt_pk_fp8_f32(a, b, 0, false); w = __builtin_amdgcn_cvt_pk_fp8_f32(c, d, w, true); return (unsigned)w; }
template <int CTRL> __device__ __forceinline__ float dpp_f(float x) { return __builtin_bit_cast(float, __builtin_amdgcn_update_dpp(0, __builtin_bit_cast(int, x), CTRL, 0xf, 0xf, false)); }
__device__ __forceinline__ float row_sum16(float x) { x += dpp_f<0x128>(x); x += dpp_f<0x124>(x); x += dpp_f<0x122>(x); x += dpp_f<0x121>(x); return x; }
__device__ __forceinline__ float row_max16(float x) { x = fmaxf(x, dpp_f<0x128>(x)); x = fmaxf(x, dpp_f<0x124>(x)); x = fmaxf(x, dpp_f<0x122>(x)); x = fmaxf(x, dpp_f<0x121>(x)); return x; }
__device__ __forceinline__ float lane_bcast(float x, int l) { return __builtin_bit_cast(float, __builtin_amdgcn_readlane(__builtin_bit_cast(int, x), l)); }
__device__ __forceinline__ float wave_sum(float v) { v = row_sum16(v); return (lane_bcast(v, 0) + lane_bcast(v, 16)) + (lane_bcast(v, 32) + lane_bcast(v, 48)); }
__device__ __forceinline__ void wave_sum8(float (&v)[8]) {
#pragma unroll
    for (int s = 0; s < 8; ++s) v[s] = wave_sum(v[s]);
}
__device__ __forceinline__ float quad_sum(float v) { v += dpp_f<0xB1>(v); v += dpp_f<0x4E>(v); return v; }
__device__ __forceinline__ float sigmoidf_(float x) { return __builtin_amdgcn_rcpf(1.0f + __expf(-x)); }
__device__ __forceinline__ float tanhf_(float x) { const float e = __expf(-2.0f * fabsf(x)); const float t = (1.0f - e) * __builtin_amdgcn_rcpf(1.0f + e); return x < 0.f ? -t : t; }
__device__ __forceinline__ float softplusf_(float y) { return fmaxf(y, 0.f) + log1pf(__expf(-fabsf(y))); }
__device__ __forceinline__ float gelu_tanh(float x) { const float u = 0.7978845608028654f * (x + 0.044715f * x * x * x); return 0.5f * x * (1.0f + tanhf_(u)); }

__device__ __forceinline__ void ph_norm(const int wv, const P& p, const float* xin, const bf16_t* yadd, float* xout, bool combine, const float* gamma, bf16_t* hout, const float* router_w, float* fout, float* lds, const bool h8 = false) {
    const int tid = TID, lane = tid & 63, wave = tid >> 6;
    if (router_w) {
        for (int i = tid; i < D * NE; i += NTHR) { const int d = i >> 4, e = i & 15; lds[e * D + d] = router_w[i]; }
        __syncthreads();
    }
    const bf16_t* yexp = (const bf16_t*)(p.ws + WS_YEXP); const int* slot = (const int*)(p.ws + WS_SLOT);
    float* aff = (float*)(p.ws + WS_AFF);
    const int tstep = gridDim.x * 8; int tok = blockIdx.x * 8 + wave;
    float4 xn[4]; uint2 yn[4]; int sln = -1;
#pragma unroll
    for (int i = 0; i < 4; ++i) yn[i] = make_uint2(0u, 0u);
    if (tok < T) {
#pragma unroll
        for (int i = 0; i < 4; ++i) xn[i] = ((const float4*)(xin + (size_t)tok * D))[i * 64 + lane];
        if (yadd) {
#pragma unroll
            for (int i = 0; i < 4; ++i) yn[i] = ((const uint2*)(yadd + (size_t)tok * D))[i * 64 + lane]; }
        if (combine) sln = slot[tok * NE + (lane & 15)];
    }
    for (; tok < T; tok += tstep) {
        const int b = tok / S, s = tok % S;
        float4 x[4];
#pragma unroll
        for (int i = 0; i < 4; ++i) { x[i] = xn[i]; if (yadd) { float f[4]; bf4_to_f(yn[i], f); x[i].x += f[0]; x[i].y += f[1]; x[i].z += f[2]; x[i].w += f[3]; } }
        const int slv = sln;
        if (tok + tstep < T) {
#pragma unroll
            for (int i = 0; i < 4; ++i) xn[i] = ((const float4*)(xin + (size_t)(tok + tstep) * D))[i * 64 + lane];
            if (yadd) {
#pragma unroll
                for (int i = 0; i < 4; ++i) yn[i] = ((const uint2*)(yadd + (size_t)(tok + tstep) * D))[i * 64 + lane]; }
            if (combine) sln = slot[(tok + tstep) * NE + (lane & 15)];
        }
        if (combine) {
            unsigned msk = (unsigned)(__ballot(slv >= 0) & 0xffffull);
            while (msk) {
                const int e0 = __ffs(msk) - 1; msk &= msk - 1u;
                const int e1 = msk ? (__ffs(msk) - 1) : e0; const bool two = msk != 0u; msk &= msk - 1u;
                const int s0 = __builtin_amdgcn_readlane(slv, e0), s1 = __builtin_amdgcn_readlane(slv, e1);
                const uint2* r0 = (const uint2*)(yexp + ((size_t)(e0 * NB + b) * CAP + s0) * D); const uint2* r1 = (const uint2*)(yexp + ((size_t)(e1 * NB + b) * CAP + s1) * D);
                uint2 q0[4], q1[4];
#pragma unroll
                for (int i = 0; i < 4; ++i) { q0[i] = r0[i * 64 + lane]; q1[i] = r1[i * 64 + lane]; }
#pragma unroll
                for (int i = 0; i < 4; ++i) { float f[4]; bf4_to_f(q0[i], f); x[i].x += f[0]; x[i].y += f[1]; x[i].z += f[2]; x[i].w += f[3];
                    if (two) { bf4_to_f(q1[i], f); x[i].x += f[0]; x[i].y += f[1]; x[i].z += f[2]; x[i].w += f[3]; } }
            }
        }
        if (xout) {
#pragma unroll
            for (int i = 0; i < 4; ++i) ((float4*)(xout + (size_t)tok * D))[i * 64 + lane] = x[i];
        }
        float ss = 0.f;
#pragma unroll
        for (int i = 0; i < 4; ++i) ss += x[i].x * x[i].x + x[i].y * x[i].y + x[i].z * x[i].z + x[i].w * x[i].w;
        ss = wave_sum(ss);
        const float rstd = __builtin_amdgcn_rsqf(ss * (1.0f / D) + RMS_EPS);
        float4 h[4];
#pragma unroll
        for (int i = 0; i < 4; ++i) {
            const float4 g = ((const float4*)gamma)[i * 64 + lane];
            h[i].x = x[i].x * rstd * g.x; h[i].y = x[i].y * rstd * g.y; h[i].z = x[i].z * rstd * g.z; h[i].w = x[i].w * rstd * g.w;
        }
        if (hout) {
#pragma unroll
            for (int i = 0; i < 4; ++i) { if (h8) ((unsigned*)((unsigned char*)hout + (size_t)tok * D))[i * 64 + lane] = cvt4_fp8(h[i].x * F8_SH, h[i].y * F8_SH, h[i].z * F8_SH, h[i].w * F8_SH);
                else ((uint2*)(hout + (size_t)tok * D))[i * 64 + lane] = f4_to_bf(h[i].x, h[i].y, h[i].z, h[i].w); }
        }
        if (fout) {
#pragma unroll
            for (int i = 0; i < 4; ++i) ((float4*)(fout + (size_t)tok * D))[i * 64 + lane] = h[i];
        }
        if (router_w) {
            float mylg = -3.0e38f;
#pragma unroll 1
            for (int eg = 0; eg < NE; eg += 8) {
                float a8[8];
#pragma unroll
                for (int j = 0; j < 8; ++j) {
                    float a = 0.f;
#pragma unroll
                    for (int i = 0; i < 4; ++i) { const float4 w = ((const float4*)(lds + (eg + j) * D))[i * 64 + lane]; a += h[i].x * w.x + h[i].y * w.y + h[i].z * w.z + h[i].w * w.w; }
                    a8[j] = a;
                }
                wave_sum8(a8);
#pragma unroll
                for (int j = 0; j < 8; ++j) if (lane == eg + j) mylg = a8[j];
            }
            float mx = mylg;
            mx = row_max16(mx);
            const float mine = (lane < NE) ? __expf(mylg - mx) : 0.f;
            float sum = mine;
            sum = row_sum16(sum);
            if (lane < NE) aff[((size_t)b * NE + lane) * S + s] = mine / sum;
        }
    }
}

__device__ __forceinline__ void ph_norm_xm(const int wv, const P& p, const float* xin, const bf16_t* yadd, float* xout, bool combine, const float* gamma, const float* mu, unsigned char* lds) {
    const int tid = TID, lane = tid & 63, wave = tid >> 6;
    constexpr int HP = 2064;
    const bf16_t* yexp = (const bf16_t*)(p.ws + WS_YEXP); const int* slot = (const int*)(p.ws + WS_SLOT);
    bf16_t* XM = (bf16_t*)(p.ws + WS_XM);
    for (int unit = blockIdx.x; unit < T / 32; unit += gridDim.x) {
        const int t0 = unit * 32;
        float4 xr[5][4]; uint2 yr[5][4]; int slr[5];
#pragma unroll
        for (int j = 0; j < 5; ++j) {
            const int r = wave + 8 * j, tok = t0 - 1 + r, s = (t0 % S) - 1 + r; slr[j] = -1;
#pragma unroll
            for (int i = 0; i < 4; ++i) yr[j][i] = make_uint2(0u, 0u);
            if (r < 34 && s >= 0 && s < S) {
#pragma unroll
                for (int i = 0; i < 4; ++i) xr[j][i] = ((const float4*)(xin + (size_t)tok * D))[i * 64 + lane];
                if (yadd) {
#pragma unroll
                    for (int i = 0; i < 4; ++i) yr[j][i] = ((const uint2*)(yadd + (size_t)tok * D))[i * 64 + lane]; }
                if (combine) slr[j] = slot[tok * NE + (lane & 15)];
            } else {
#pragma unroll
                for (int i = 0; i < 4; ++i) xr[j][i] = make_float4(0.f, 0.f, 0.f, 0.f);
            }
        }
#pragma unroll
        for (int j = 0; j < 5; ++j) {
            const int r = wave + 8 * j, tok = t0 - 1 + r, s = (t0 % S) - 1 + r;
            if (r >= 34) continue;
            uint2* hrow = (uint2*)(lds + r * HP);
            if (s < 0 || s >= S) {
#pragma unroll
                for (int i = 0; i < 4; ++i) hrow[i * 64 + lane] = make_uint2(0u, 0u);
                continue;
            }
            const int b = tok / S;
            float4 x[4];
#pragma unroll
            for (int i = 0; i < 4; ++i) { x[i] = xr[j][i]; if (yadd) { float f[4]; bf4_to_f(yr[j][i], f); x[i].x += f[0]; x[i].y += f[1]; x[i].z += f[2]; x[i].w += f[3]; } }
            if (combine) {
                const int slv = slr[j];
                unsigned msk = (unsigned)(__ballot(slv >= 0) & 0xffffull);
                while (msk) {
                    const int e0 = __ffs(msk) - 1; msk &= msk - 1u;
                    const int e1 = msk ? (__ffs(msk) - 1) : e0; const bool two = msk != 0u; msk &= msk - 1u;
                    const int s0 = __builtin_amdgcn_readlane(slv, e0), s1 = __builtin_amdgcn_readlane(slv, e1);
                    const uint2* r0 = (const uint2*)(yexp + ((size_t)(e0 * NB + b) * CAP + s0) * D); const uint2* r1 = (const uint2*)(yexp + ((size_t)(e1 * NB + b) * CAP + s1) * D);
                    uint2 q0[4], q1[4];
#pragma unroll
                    for (int i = 0; i < 4; ++i) { q0[i] = r0[i * 64 + lane]; q1[i] = r1[i * 64 + lane]; }
#pragma unroll
                    for (int i = 0; i < 4; ++i) { float f[4]; bf4_to_f(q0[i], f); x[i].x += f[0]; x[i].y += f[1]; x[i].z += f[2]; x[i].w += f[3];
                        if (two) { bf4_to_f(q1[i], f); x[i].x += f[0]; x[i].y += f[1]; x[i].z += f[2]; x[i].w += f[3]; } }
                }
            }
            if (r >= 1 && r <= 32) {
#pragma unroll
                for (int i = 0; i < 4; ++i) ((float4*)(xout + (size_t)tok * D))[i * 64 + lane] = x[i];
            }
            float ss = 0.f;
#pragma unroll
            for (int i = 0; i < 4; ++i) ss += x[i].x * x[i].x + x[i].y * x[i].y + x[i].z * x[i].z + x[i].w * x[i].w;
            ss = wave_sum(ss);
            const float rstd = __builtin_amdgcn_rsqf(ss * (1.0f / D) + RMS_EPS);
#pragma unroll
            for (int i = 0; i < 4; ++i) {
                const float4 gq = ((const float4*)gamma)[i * 64 + lane];
                hrow[i * 64 + lane] = f4_to_bf(x[i].x * rstd * gq.x, x[i].y * rstd * gq.y, x[i].z * rstd * gq.z, x[i].w * rstd * gq.w);
            }
        }
        __syncthreads();
        for (int r = 1 + wave; r <= 32; r += 8) {
            const int tok = t0 - 1 + r;
#pragma unroll
            for (int i = 0; i < 4; ++i) {
                const int c4 = i * 64 + lane;
                float hc[4], hp[4], hn[4];
                bf4_to_f(((const uint2*)(lds + r * HP))[c4], hc); bf4_to_f(((const uint2*)(lds + (r - 1) * HP))[c4], hp); bf4_to_f(((const uint2*)(lds + (r + 1) * HP))[c4], hn);
                float xx[4];
#pragma unroll
                for (int j = 0; j < 4; ++j) xx[j] = 0.5f * (hp[j] + hn[j]) - hc[j];
#pragma unroll
                for (int q = 0; q < 6; ++q) {
                    const float4 m = ((const float4*)(mu + q * D))[c4];
                    ((uint2*)(XM + ((size_t)q * T + tok) * D))[c4] = f4_to_bf(hc[0] + xx[0] * m.x, hc[1] + xx[1] * m.y, hc[2] + xx[2] * m.z, hc[3] + xx[3] * m.w);
                }
            }
        }
        __syncthreads();
    }
}

__device__ __forceinline__ void ph_xm(const int wv, const P& p, const float* mu) {
    const int tid = TID, lane = tid & 63, wave = tid >> 6;
    const bf16_t* H = (const bf16_t*)(p.ws + WS_H); bf16_t* XM = (bf16_t*)(p.ws + WS_XM);
    for (int tok = blockIdx.x * 8 + wave; tok < T; tok += gridDim.x * 8) {
        const int s = tok % S;
#pragma unroll
        for (int i = 0; i < 4; ++i) {
            const int c4 = i * 64 + lane;
            float hc[4], hp[4] = {0.f, 0.f, 0.f, 0.f}, hn[4] = {0.f, 0.f, 0.f, 0.f};
            bf4_to_f(((const uint2*)(H + (size_t)tok * D))[c4], hc);
            if (s > 0) bf4_to_f(((const uint2*)(H + (size_t)(tok - 1) * D))[c4], hp);
            if (s < S - 1) bf4_to_f(((const uint2*)(H + (size_t)(tok + 1) * D))[c4], hn);
            float xx[4];
#pragma unroll
            for (int j = 0; j < 4; ++j) xx[j] = 0.5f * (hp[j] + hn[j]) - hc[j];
#pragma unroll
            for (int q = 0; q < 6; ++q) {
                const float4 m = ((const float4*)(mu + q * D))[c4];
                ((uint2*)(XM + ((size_t)q * T + tok) * D))[c4] = f4_to_bf(hc[0] + xx[0] * m.x, hc[1] + xx[1] * m.y, hc[2] + xx[2] * m.z, hc[3] + xx[3] * m.w);
            }
        }
    }
}

__device__ __forceinline__ void bf16x16_load(const bf16_t* p16, float* f) {
    const uint4 a = ((const uint4*)p16)[0], b = ((const uint4*)p16)[1];
    const unsigned w[8] = {a.x, a.y, a.z, a.w, b.x, b.y, b.z, b.w};
#pragma unroll
    for (int j = 0; j < 8; ++j) { f[2 * j] = __uint_as_float(w[j] << 16); f[2 * j + 1] = __uint_as_float(w[j] & 0xffff0000u); }
}
__device__ __forceinline__ void ph_rwkv_post(const int wv, const P& p, int ia) {
    const int tid = TID, lane = tid & 63, wave = tid >> 6;
    const bf16_t* __restrict__ RKV = (const bf16_t*)(p.ws + WS_RKV); const bf16_t* __restrict__ GG = (const bf16_t*)(p.ws + WS_GG); const float* __restrict__ BON = (const float*)(p.ws + WS_BON);
    const bf16_t* __restrict__ YS = (const bf16_t*)(p.ws + WS_YS); bf16_t* __restrict__ YG = (bf16_t*)(p.ws + WS_YG);
    const float* lg = p.in[I_LNG] + ia * D; const float* lb = p.in[I_LNB] + ia * D;
#pragma unroll 2
    for (int tok = blockIdx.x * 8 + wave; tok < T; tok += gridDim.x * 8) {
        const size_t o = (size_t)tok * D + lane * 16;
        float y[16], v[16], gg[16];
        { float y1[16]; bf16x16_load(YS + o, y); bf16x16_load(YS + (size_t)T * D + o, y1);
#pragma unroll
          for (int j = 0; j < 16; ++j) y[j] += y1[j]; }
        bf16x16_load(RKV + 2 * (size_t)T * D + o, v); bf16x16_load(GG + o, gg);
        const float bon = BON[(size_t)tok * NH + (lane >> 2)] + BON[((size_t)T + tok) * NH + (lane >> 2)];
        float sm = 0.f;
#pragma unroll
        for (int j = 0; j < 16; ++j) sm += y[j];
        const float mean = quad_sum(sm) * (1.0f / 64.0f);
        float sv = 0.f;
#pragma unroll
        for (int j = 0; j < 16; ++j) { const float d = y[j] - mean; sv += d * d; }
        const float rstd = __builtin_amdgcn_rsqf(quad_sum(sv) * (1.0f / 64.0f) + LNX_EPS);
        float outv[16];
#pragma unroll
        for (int j = 0; j < 16; ++j) { const int c = lane * 16 + j; outv[j] = ((y[j] - mean) * rstd * lg[c] + lb[c] + bon * v[j]) * gg[j]; }
#pragma unroll
        for (int j = 0; j < 4; ++j) ((uint2*)(YG + o))[j] = f4_to_bf(outv[4 * j], outv[4 * j + 1], outv[4 * j + 2], outv[4 * j + 3]);
    }
}

__device__ __forceinline__ void ph_sc_mid(const int wv, const P& p) {
    const int tid = TID, lane = tid & 63, wave = tid >> 6;
    const bf16_t* __restrict__ BCU = (const bf16_t*)(p.ws + WS_RKV); bf16_t* __restrict__ BZ = (bf16_t*)(p.ws + WS_YG); const float* cw = p.in[I_SCCW];
#pragma unroll 2
    for (int tok = blockIdx.x * 8 + wave; tok < T; tok += gridDim.x * 8) {
        const int s = tok % S;
#pragma unroll
        for (int i = 0; i < 4; ++i) {
            const int c4 = i * 64 + lane;
            float z[4] = {0.f, 0.f, 0.f, 0.f};
#pragma unroll
            for (int j = 0; j < 3; ++j) {
                const int ss = s + j - 1;
                if (ss >= 0 && ss < S) {
                    const size_t ro = (size_t)(tok + j - 1) * (3 * D);
                    float c[4], u[4]; bf4_to_f(((const uint2*)(BCU + ro + D))[c4], c); bf4_to_f(((const uint2*)(BCU + ro + 2 * D))[c4], u);
                    const float4 w = ((const float4*)(cw + j * D))[c4];
                    z[0] += w.x * c[0] * u[0]; z[1] += w.y * c[1] * u[1]; z[2] += w.z * c[2] * u[2]; z[3] += w.w * c[3] * u[3];
                }
            }
            float bg[4]; bf4_to_f(((const uint2*)(BCU + (size_t)tok * (3 * D)))[c4], bg);
            ((uint2*)(BZ + (size_t)tok * D))[c4] = f4_to_bf(bg[0] * z[0], bg[1] * z[1], bg[2] * z[2], bg[3] * z[3]);
        }
    }
}

__device__ __forceinline__ void ph_lru_conv(const int wv, const P& p) {
    const int tid = TID, lane = tid & 63, wave = tid >> 6;
    const bf16_t* __restrict__ GU = (const bf16_t*)(p.ws + WS_RKV); bf16_t* __restrict__ UCB = (bf16_t*)(p.ws + WS_UCB);
    const float* cw = p.in[I_LCW]; const float* cb = p.in[I_LCB];
#pragma unroll 2
    for (int tok = blockIdx.x * 8 + wave; tok < T; tok += gridDim.x * 8) {
        const int s = tok % S;
#pragma unroll
        for (int i = 0; i < 4; ++i) {
            const int c4 = i * 64 + lane;
            float4 acc = ((const float4*)cb)[c4];
#pragma unroll
            for (int j = 0; j < 4; ++j) {
                const int ss = s + j - 2;
                if (ss >= 0 && ss < S) {
                    float u[4]; bf4_to_f(((const uint2*)(GU + (size_t)(tok + j - 2) * (2 * D) + D))[c4], u); const float4 w = ((const float4*)(cw + j * D))[c4];
                    acc.x += w.x * u[0]; acc.y += w.y * u[1]; acc.z += w.z * u[2]; acc.w += w.w * u[3];
                }
            }
            ((uint2*)(UCB + (size_t)tok * D))[c4] = f4_to_bf(acc.x, acc.y, acc.z, acc.w);
        }
    }
}

__device__ __forceinline__ void ph_lru_scan(const int wv, const P& p, float* lds) {
    const int tid = TID;
    const bf16_t* LA = (const bf16_t*)(p.ws + WS_WD); const bf16_t* LB = (const bf16_t*)(p.ws + WS_AA);
    bf16_t* HS = (bf16_t*)(p.ws + WS_YS);
    float2* segP = (float2*)lds; float2* segH = (float2*)lds + 512;
    const int cp = tid & 31, seg = tid >> 5;
    for (int unit = blockIdx.x; unit < NB * 2 * 16; unit += gridDim.x) {
        const int cg = unit & 15, z = (unit >> 4) & 1, b = unit >> 5;
        const int c = cg * 64 + cp * 2;
        const bf16_t* la = LA + (size_t)z * T * D; const bf16_t* lb = LB + (size_t)z * T * D;
        float P0 = 0.f, P1 = 0.f, h0 = 0.f, h1 = 0.f;
#pragma unroll 8
        for (int i = seg * 128; i < seg * 128 + 128; ++i) {
            const int t = z ? (S - 1 - i) : i; const size_t o = ((size_t)b * S + t) * D + c;
            const unsigned a2 = *(const unsigned*)(la + o), b2 = *(const unsigned*)(lb + o);
            const float l0 = __uint_as_float(a2 << 16), l1 = __uint_as_float(a2 & 0xffff0000u);
            h0 = __expf(l0) * h0 + __uint_as_float(b2 << 16); h1 = __expf(l1) * h1 + __uint_as_float(b2 & 0xffff0000u);
            P0 += l0; P1 += l1;
        }
        segP[seg * 32 + cp] = make_float2(__expf(P0), __expf(P1)); segH[seg * 32 + cp] = make_float2(h0, h1);
        __syncthreads();
        float c0 = 0.f, c1 = 0.f;
        for (int s2 = 0; s2 < seg; ++s2) { const float2 pp = segP[s2 * 32 + cp], hh = segH[s2 * 32 + cp]; c0 = pp.x * c0 + hh.x; c1 = pp.y * c1 + hh.y; }
        h0 = c0; h1 = c1;
#pragma unroll 8
        for (int i = seg * 128; i < seg * 128 + 128; ++i) {
            const int t = z ? (S - 1 - i) : i; const size_t o = ((size_t)b * S + t) * D + c;
            const unsigned a2 = *(const unsigned*)(la + o), b2 = *(const unsigned*)(lb + o);
            h0 = __expf(__uint_as_float(a2 << 16)) * h0 + __uint_as_float(b2 << 16); h1 = __expf(__uint_as_float(a2 & 0xffff0000u)) * h1 + __uint_as_float(b2 & 0xffff0000u);
            *(unsigned*)(HS + (size_t)z * T * D + o) = (unsigned)f2bf(h0) | ((unsigned)f2bf(h1) << 16);
        }
        __syncthreads();
    }
}

__device__ __forceinline__ void ph_lru_post(const int wv, const P& p) {
    const int tid = TID, lane = tid & 63, wave = tid >> 6;
    const bf16_t* __restrict__ GU = (const bf16_t*)(p.ws + WS_RKV); const bf16_t* __restrict__ HS = (const bf16_t*)(p.ws + WS_YS); bf16_t* __restrict__ YL = (bf16_t*)(p.ws + WS_YG);
#pragma unroll 2
    for (int tok = blockIdx.x * 8 + wave; tok < T; tok += gridDim.x * 8) {
#pragma unroll
        for (int i = 0; i < 4; ++i) {
            const int c4 = i * 64 + lane;
            float gq[4]; bf4_to_f(((const uint2*)(GU + (size_t)tok * (2 * D)))[c4], gq); const float4 g = make_float4(gq[0], gq[1], gq[2], gq[3]);
            float hq0[4], hq1[4]; bf4_to_f(((const uint2*)(HS + (size_t)tok * D))[c4], hq0); bf4_to_f(((const uint2*)(HS + (size_t)T * D + (size_t)tok * D))[c4], hq1);
            const float4 h0 = make_float4(hq0[0], hq0[1], hq0[2], hq0[3]), h1 = make_float4(hq1[0], hq1[1], hq1[2], hq1[3]);
            ((uint2*)(YL + (size_t)tok * D))[c4] = f4_to_bf((h0.x + h1.x) * gelu_tanh(g.x), (h0.y + h1.y) * gelu_tanh(g.y), (h0.z + h1.z) * gelu_tanh(g.z), (h0.w + h1.w) * gelu_tanh(g.w));
        }
    }
}

__device__ __forceinline__ int block_sum_i(const int wv, int v, int* wsum  ) {
    const int lane = lane_fresh(), wave = wv;
    v = __popcll(__ballot(v & 1)) + 2 * __popcll(__ballot(v & 2)) + 4 * __popcll(__ballot(v & 4));
    if (lane == 0) wsum[wave] = v;
    __syncthreads();
    int tot = 0;
#pragma unroll
    for (int w = 0; w < 8; ++w) tot += wsum[w];
    return tot;
}
__device__ __forceinline__ int block_excl_scan_i(const int wv, int v, int* wsum  , int& total) {
    const int lane = lane_fresh(), wave = wv;
    int inc = v;
    for (int o = 1; o < 64; o <<= 1) { const int t = __shfl_up(inc, o); if (lane >= o) inc += t; }
    if (lane == 63) wsum[wave] = inc;
    __syncthreads();
    int base = 0, tot = 0;
#pragma unroll
    for (int w = 0; w < 8; ++w) { const int x = wsum[w]; if (w < wave) base += x; tot += x; }
    total = tot;
    return base + inc - v;
}
__device__ __forceinline__ void ph_topk(const int wv, const P& p, float* ldsf) {
    const int tid = TID, lane = tid & 63, wave = tid >> 6;
    int* ldsi = (int*)ldsf;
    int* wsum = ldsi;
    int* idx_l = ldsi + 64;
    const float* aff = (const float*)(p.ws + WS_AFF); int* slot = (int*)(p.ws + WS_SLOT); float* gate = (float*)(p.ws + WS_GATE);
    const unsigned char* HF = (const unsigned char*)(p.ws + WS_H); unsigned char* XIN = (unsigned char*)(p.ws + WS_XIN);
    for (int unit2 = blockIdx.x; unit2 < 2 * NB * NE; unit2 += gridDim.x) {
        const int unit = unit2 >> 1, half = unit2 & 1;
        const int e = unit % NE, b = unit / NE;
        const float4 v4 = ((const float4*)(aff + ((size_t)b * NE + e) * S))[tid];
        const unsigned v[4] = {__float_as_uint(v4.x), __float_as_uint(v4.y), __float_as_uint(v4.z), __float_as_uint(v4.w)};
        unsigned thr = 0u;
        for (int bit = 29; bit >= 0; --bit) {
            const unsigned cand = thr | (1u << bit);
            const int cnt = (int)(v[0] >= cand) + (int)(v[1] >= cand) + (int)(v[2] >= cand) + (int)(v[3] >= cand);
            const int tot = block_sum_i(wv, cnt, wsum + (bit & 1) * 8);
            if (tot >= CAP) thr = cand;
        }
        int g4 = 0, e4 = 0;
#pragma unroll
        for (int j = 0; j < 4; ++j) { g4 += (int)(v[j] > thr); e4 += (int)(v[j] == thr); }
        const int ngt = block_sum_i(wv, g4, wsum + 16);
        const int need_eq = CAP - ngt;
        int toteq; const int eqbase = block_excl_scan_i(wv, e4, wsum + 24, toteq);
        int sel[4], nsel = 0, er = eqbase;
#pragma unroll
        for (int j = 0; j < 4; ++j) { const bool gt = v[j] > thr, eq = v[j] == thr; sel[j] = (gt || (eq && er < need_eq)) ? 1 : 0; er += eq ? 1 : 0; nsel += sel[j]; }
        __syncthreads();
        int totsel; int cpos = block_excl_scan_i(wv, nsel, wsum, totsel);
#pragma unroll
        for (int j = 0; j < 4; ++j) {
            const int t = tid * 4 + j;
            if (sel[j]) {
                if (cpos < CAP) { idx_l[cpos] = t; if (half == 0) { gate[((size_t)e * NB + b) * CAP + cpos] = __uint_as_float(v[j]); slot[((size_t)b * S + t) * NE + e] = cpos; } }
                else if (half == 0) slot[((size_t)b * S + t) * NE + e] = -1;
                ++cpos;
            } else if (half == 0) slot[((size_t)b * S + t) * NE + e] = -1;
        }
        __syncthreads();
#pragma unroll 1
        for (int cb = 0; cb < 16; cb += 4) {
            const int c = half * 128 + wave * 16 + cb;
            const uint4* s0 = (const uint4*)(HF + ((size_t)b * S + idx_l[c]) * D); const uint4* s1 = (const uint4*)(HF + ((size_t)b * S + idx_l[c + 1]) * D);
            const uint4* s2 = (const uint4*)(HF + ((size_t)b * S + idx_l[c + 2]) * D); const uint4* s3 = (const uint4*)(HF + ((size_t)b * S + idx_l[c + 3]) * D);
            const uint4 a0 = s0[lane], a1 = s1[lane], a2 = s2[lane], a3 = s3[lane];
            uint4* d0 = (uint4*)(XIN + (((size_t)e * NB + b) * CAP + c) * D);
            d0[lane] = a0; d0[64 + lane] = a1; d0[128 + lane] = a2; d0[192 + lane] = a3;
        }
        __syncthreads();
    }
}


namespace pg8 {
#define PG8_LAS __attribute__((address_space(3)))
typedef short bf16x8 __attribute__((ext_vector_type(8)));
typedef float f32x4 __attribute__((ext_vector_type(4)));
typedef unsigned u32x4 __attribute__((ext_vector_type(4)));
typedef unsigned u32x2 __attribute__((ext_vector_type(2)));
constexpr int BM = 256, BK = 64, HALF = 128, HTB = HALF * BK * 2, STAGE_BYTES = 8 * HTB;
__device__ __forceinline__ int lds_byte(int r, int c) { const int st = (r >> 4) * 2 + (c >> 5), rr = r & 15, cc = c & 31, ob = rr * 64 + cc * 2; return st * 1024 + (ob ^ (((ob >> 9) & 1) << 5)); }
__device__ __forceinline__ void stage_rc(int b, int& R, int& C) { const int st = b / 1024, sb = b % 1024, swz = sb ^ (((sb >> 9) & 1) << 5); R = (st >> 1) * 16 + swz / 64; C = (st & 1) * 32 + (swz % 64) / 2; }
__device__ __forceinline__ int perm32(int rho) { const int n = rho >> 4, i = rho & 15; return 8 * (i >> 2) + 4 * n + (i & 3); }
struct Unit { int offA, offB; int pm, pn, job; };
struct Geo { int lda, ldb, K; };
typedef float f32x2_t __attribute__((ext_vector_type(2)));
typedef __bf16 bf16x2_t __attribute__((ext_vector_type(2)));
__device__ __forceinline__ unsigned cvt_pk_bf16(float lo, float hi) { const f32x2_t v = {lo, hi}; const bf16x2_t b = __builtin_convertvector(v, bf16x2_t); return __builtin_bit_cast(unsigned, b); }

template <class Epi, class Sched>
__device__ __forceinline__ void gemm_phase(const int wv, PG8_LAS unsigned char* lds, const Geo g, const Sched& S, const Epi& E, const bool skip_epi = false) {
    const int tid = TID, wid = wv, lane = tid & 63, wr = wid >> 2, wc = wid & 3, fr = lane & 15, fq = lane >> 4;
    const int nt = g.K / BK;
    unsigned voffA[2], voffB[2];
#pragma unroll
    for (int i = 0; i < 2; ++i) { int R, C; stage_rc(tid * 16 + i * 8192, R, C); const int Rb = Epi::PERM ? ((R & ~31) + perm32(R & 31)) : R;
        voffA[i] = (unsigned)(R * g.lda + C) * 2u; voffB[i] = (unsigned)(Rb * g.ldb + C) * 2u; }
    const int kstep = BK * 2;
    const int hstepA = HALF * g.lda * 2, hstepB = HALF * g.ldb * 2;
    const unsigned ldsw = (unsigned)wid * 1024u;
    const int aoff = lds_byte(wr * 64 + fr, fq * 8), boff = lds_byte(wc * 32 + fr, fq * 8);
#define PG8_SA(b, h) (((b) * 2 + (h)) * HTB)
#define PG8_SB(b, h) ((4 + (b) * 2 + (h)) * HTB)
    const __amdgpu_buffer_rsrc_t rsA = __builtin_amdgcn_make_buffer_rsrc((void*)S.Abase, (short)0, 0x7fffffff, 0x00020000);
    const __amdgpu_buffer_rsrc_t rsB = __builtin_amdgcn_make_buffer_rsrc((void*)S.Bbase, (short)0, 0x7fffffff, 0x00020000);
#define PG8_STAGE(bufoff, rs, soff, voff) do { _Pragma("unroll") for (int _i = 0; _i < 2; ++_i) \
        __builtin_amdgcn_raw_ptr_buffer_load_lds(rs, (PG8_LAS void*)(lds + (bufoff) + ldsw + _i * 8192), 16, (int)(voff)[_i], (int)(soff), 0, 0); } while (0)
#define PG8_LDA(dst, b, h) do { _Pragma("unroll") for (int m = 0; m < 4; ++m) _Pragma("unroll") for (int k = 0; k < 2; ++k) dst[m][k] = *(const PG8_LAS bf16x8*)(lds + PG8_SA(b, h) + aoff + m * 2048 + k * 1024); } while (0)
#define PG8_LDB(dst, b, h) do { _Pragma("unroll") for (int n = 0; n < 2; ++n) _Pragma("unroll") for (int k = 0; k < 2; ++k) dst[n][k] = *(const PG8_LAS bf16x8*)(lds + PG8_SB(b, h) + boff + n * 2048 + k * 1024); } while (0)
#define PG8_MMA(ai, bj, At, Bt) do { __builtin_amdgcn_s_setprio(1); _Pragma("unroll") for (int m = 0; m < 4; ++m) _Pragma("unroll") for (int n = 0; n < 2; ++n) { \
        if constexpr (Epi::FP8) {   \
            typedef int i32x4_ __attribute__((ext_vector_type(4))); typedef int i32x8_ __attribute__((ext_vector_type(8))); \
            const i32x8_ fb = __builtin_shufflevector(__builtin_bit_cast(i32x4_, Bt[n][0]), __builtin_bit_cast(i32x4_, Bt[n][1]), 0, 1, 2, 3, 4, 5, 6, 7); \
            const i32x8_ fa = __builtin_shufflevector(__builtin_bit_cast(i32x4_, At[m][0]), __builtin_bit_cast(i32x4_, At[m][1]), 0, 1, 2, 3, 4, 5, 6, 7); \
            acc[ai][bj][m][n] = __builtin_amdgcn_mfma_scale_f32_16x16x128_f8f6f4(fb, fa, acc[ai][bj][m][n], 0, 0, 0, 0, 0, 0); \
        } else { _Pragma("unroll") for (int k = 0; k < 2; ++k) \
            acc[ai][bj][m][n] = __builtin_amdgcn_mfma_f32_16x16x32_bf16(Bt[n][k], At[m][k], acc[ai][bj][m][n], 0, 0, 0); } } \
        __builtin_amdgcn_s_setprio(0); } while (0)
#define PG8_WAIT_V(n) asm volatile("s_waitcnt vmcnt(" #n ")" ::: "memory")
#define PG8_WAIT_L(n) asm volatile("s_waitcnt lgkmcnt(" #n ")" ::: "memory")
#define PG8_BAR __builtin_amdgcn_s_barrier()
#define PG8_SCHED __builtin_amdgcn_sched_barrier(0)
    Unit cur, nxt; int ui = 0;
    if (!S.next(0, cur)) return;
    f32x4 acc[2][2][4][2];
#pragma unroll
    for (int a = 0; a < 2; ++a)
#pragma unroll
        for (int b = 0; b < 2; ++b)
#pragma unroll
            for (int m = 0; m < 4; ++m)
#pragma unroll
                for (int n = 0; n < 2; ++n) acc[a][b][m][n] = (f32x4){0.f, 0.f, 0.f, 0.f};
    bf16x8 At[4][2], B0[2][2], B1[2][2];
    int cA = cur.offA, cB = cur.offB;
    PG8_STAGE(PG8_SB(0, 0), rsB, cB, voffB); PG8_STAGE(PG8_SB(0, 1), rsB, cB + hstepB, voffB); PG8_STAGE(PG8_SA(0, 0), rsA, cA, voffA); PG8_STAGE(PG8_SA(0, 1), rsA, cA + hstepA, voffA);
    if (wr == 1) PG8_BAR;
    PG8_WAIT_V(2); PG8_BAR;
    PG8_STAGE(PG8_SB(1, 0), rsB, cB + kstep, voffB); PG8_STAGE(PG8_SA(1, 0), rsA, cA + kstep, voffA); PG8_STAGE(PG8_SB(1, 1), rsB, cB + hstepB + kstep, voffB);
    PG8_WAIT_V(6); PG8_BAR;
    for (;;) {
        const bool has_next = S.next(ui + 1, nxt);
        const int nA = has_next ? nxt.offA : cA, nB = has_next ? nxt.offB : cB;
#pragma unroll 1
        for (int t = 0; t < nt; t += 2) {
            const bool last = (t == nt - 2);
            const int a1 = cA + (t + 1) * kstep;
            const int a2 = last ? nA : cA + (t + 2) * kstep, b2 = last ? nB : cB + (t + 2) * kstep;
            const int a3 = a2 + kstep, b3 = b2 + kstep;
            PG8_LDB(B0, 0, 0); PG8_LDB(B1, 0, 1); PG8_SCHED; PG8_LDA(At, 0, 0); PG8_STAGE(PG8_SA(1, 1), rsA, a1 + hstepA, voffA);
            PG8_WAIT_V(8); PG8_WAIT_L(0); PG8_BAR; PG8_MMA(0, 0, At, B0); PG8_MMA(0, 1, At, B1); PG8_BAR; PG8_SCHED;
            PG8_LDA(At, 0, 1); PG8_STAGE(PG8_SB(0, 0), rsB, b2, voffB); PG8_STAGE(PG8_SB(0, 1), rsB, b2 + hstepB, voffB); PG8_STAGE(PG8_SA(0, 0), rsA, a2, voffA);
            PG8_WAIT_V(8); PG8_WAIT_L(0); PG8_BAR; PG8_MMA(1, 0, At, B0); PG8_MMA(1, 1, At, B1); PG8_BAR; PG8_SCHED;
            PG8_LDB(B0, 1, 0); PG8_LDB(B1, 1, 1); PG8_SCHED; PG8_LDA(At, 1, 0); PG8_STAGE(PG8_SA(0, 1), rsA, a2 + hstepA, voffA);
            PG8_WAIT_V(8); PG8_WAIT_L(0); PG8_BAR; PG8_MMA(0, 0, At, B0); PG8_MMA(0, 1, At, B1); PG8_BAR; PG8_SCHED;
            PG8_LDA(At, 1, 1); PG8_STAGE(PG8_SB(1, 0), rsB, b3, voffB); PG8_STAGE(PG8_SB(1, 1), rsB, b3 + hstepB, voffB); PG8_STAGE(PG8_SA(1, 0), rsA, a3, voffA);
            PG8_WAIT_V(8); PG8_WAIT_L(0); PG8_BAR; PG8_MMA(1, 0, At, B0); PG8_MMA(1, 1, At, B1); PG8_BAR; PG8_SCHED;
        }
        if (wr == 0) PG8_BAR;
        if (!skip_epi) { const int le = lane_fresh(); E(acc, cur, wr, wc, le & 15, le >> 4); }
        if (!has_next) break;
#pragma unroll
        for (int a = 0; a < 2; ++a)
#pragma unroll
            for (int b = 0; b < 2; ++b)
#pragma unroll
                for (int m = 0; m < 4; ++m)
#pragma unroll
                    for (int n = 0; n < 2; ++n) acc[a][b][m][n] = (f32x4){0.f, 0.f, 0.f, 0.f};
        cur = nxt; cA = nA; cB = nB; ++ui;
        if (wr == 1) PG8_BAR;
    }
    PG8_WAIT_V(0);
    PG8_BAR;
#undef PG8_SA
#undef PG8_SB
#undef PG8_STAGE
#undef PG8_LDA
#undef PG8_LDB
#undef PG8_MMA
#undef PG8_WAIT_V
#undef PG8_WAIT_L
#undef PG8_BAR
#undef PG8_SCHED
}
}


#define DIAGF 0
constexpr int CTL_DIAGW = 4096;
__device__ __forceinline__ void diag_flag(const P& p, bool badv, unsigned bit) {
    if (DIAGF && __any(badv)) { if (lane_fresh() == 0) atomicOr((unsigned*)(p.ws + WS_CTL) + CTL_DIAGW + 3, bit); }
}
__device__ __forceinline__ bool nonfin(float x) { return !(x == x) || fabsf(x) > 3.0e38f; }
__device__ __forceinline__ bool nonfin4(const pg8::f32x4& v) { return nonfin(v[0]) || nonfin(v[1]) || nonfin(v[2]) || nonfin(v[3]); }
namespace rs {
constexpr int P_TK = 144, P_KT = 80;
constexpr int O_KH = 0, O_RH = 4608, O_BT = 9216, O_KDT = 13824;
constexpr int O_BG = 18432, O_KDG = 23552, O_VM = 28672;
constexpr int O_B2 = 33792, O_AP = 36352, O_BP = 38912, O_NT = 41472;
constexpr int O_L = 44032;
constexpr int O_GAM = 48640;
constexpr int O_X = 48896;
constexpr int CHUNK_BYTES = 53760;
constexpr int O_SEGP = 2 * CHUNK_BYTES;
constexpr int O_YB = O_SEGP + 2048;
constexpr int YB_PITCH = 68;
static_assert(O_YB + 64 * YB_PITCH * 4 <= 128 * 1024, "scan LDS");
typedef pg8::bf16x8 bf16x8; typedef pg8::f32x4 f32x4; typedef pg8::u32x4 u32x4; typedef pg8::u32x2 u32x2;
__device__ __forceinline__ bf16x8 mk8(u32x2 lo, u32x2 hi) { u32x4 w; w.x = lo.x; w.y = lo.y; w.z = hi.x; w.w = hi.y; return __builtin_bit_cast(bf16x8, w); }
__device__ __forceinline__ bf16x8 cvt8(const f32x4& a, const f32x4& b) { u32x4 w; w.x = pg8::cvt_pk_bf16(a[0], a[1]); w.y = pg8::cvt_pk_bf16(a[2], a[3]); w.z = pg8::cvt_pk_bf16(b[0], b[1]); w.w = pg8::cvt_pk_bf16(b[2], b[3]); return __builtin_bit_cast(bf16x8, w); }
}
__device__ __forceinline__ void ph_scan2(const int wv, const P& p, int ia, unsigned char* lds, bf16_t* YS, const int moeL, const int var_ = 0) {
    const int var = var_ >= 100 ? var_ - 100 : 0; const bool dummy = var_ >= 100;
    using namespace rs;
#define RS_SYNC() do { if (var != 2) __syncthreads(); } while (0)
    const int lane = lane_fresh(), tid = wv * 64 + lane, l15 = lane & 15, g = lane >> 4;
    const bf16_t* RKV = (const bf16_t*)(p.ws + WS_RKV); const bf16_t* WDp = (const bf16_t*)(p.ws + WS_WD); const bf16_t* AAp = (const bf16_t*)(p.ws + WS_AA);
    for (int unit = blockIdx.x; unit < NB * NH * 2; unit += gridDim.x) {
        const int z = unit & 1, h = (unit >> 1) % NH, b = unit / (2 * NH);
        const float k_k = p.in[I_KK][ia * D + h * HD + lane], k_a = p.in[I_KA][ia * D + h * HD + lane];
        const float r_kq = p.in[I_RK][ia * D + h * HD + lane];
        f32x4 S4[4];
#pragma unroll
        for (int i = 0; i < 4; ++i) S4[i] = (f32x4){0.f, 0.f, 0.f, 0.f};
        float rr[8], kx[8], vv[8], ww[8], aa[8];
#define RS_LOAD(scx) do { _Pragma("unroll") for (int s = 0; s < 8; ++s) { \
            const int step = (scx) * 64 + (wv >> 2) * 32 + (wv & 3) * 8 + s, t = z ? (S - 1 - step) : step; \
            const size_t o = ((size_t)b * S + t) * D + h * HD + lane; \
            rr[s] = bf2f(RKV[o]); kx[s] = bf2f(RKV[(size_t)T * D + o]); vv[s] = bf2f(RKV[2 * (size_t)T * D + o]); \
            ww[s] = bf2f(WDp[(size_t)z * T * D + o]); aa[s] = bf2f(AAp[(size_t)z * T * D + o]); } } while (0)
        RS_LOAD(0);
        float fz[32]; unsigned char* fdst = nullptr; bool fon = false;
#pragma unroll
        for (int r = 0; r < 32; ++r) fz[r] = 0.f;
        const bool filler = (wv >= 4 && moeL >= 0 && unit == (int)blockIdx.x && gridDim.x == 256) && (!dummy || var >= 4);
#define RS_FILL_LOAD(J_) do { const int J = (J_); fon = J < NE * 3 * 1024; \
            if (fon) { const int mat = J >> 10, e = mat / 3, m = mat - 3 * e, jl = J & 1023; const float* fsrc; int fldw; \
                unsigned char* mb = dummy ? p.ws + WS_XM : p.ws + WB_MOE + (size_t)moeL * MOE_STRIDE; \
                if (m < 2) { const int nb = jl >> 5, kb = jl & 31, n = nb * 64 + lane; \
                    fsrc = p.in[m ? I_WU : I_WG] + (((size_t)moeL * NE + e) * D + kb * 32) * FF + n; fldw = FF; \
                    fdst = (unsigned char*)(mb + MOE_GU) + ((size_t)e * 4096 + ((n >> 7) << 8) + m * 128 + (n & 127)) * D + kb * 32; } \
                else { const int nb = jl >> 6, kb = jl & 63, n = nb * 64 + lane; \
                    fsrc = p.in[I_WDN] + (((size_t)moeL * NE + e) * FF + kb * 32) * D + n; fldw = D; \
                    fdst = (unsigned char*)(mb + MOE_DN) + ((size_t)e * D + n) * FF + kb * 32; } \
                if (var != 6) { _Pragma("unroll") for (int r = 0; r < 32; ++r) fz[r] = __builtin_nontemporal_load(fsrc + (size_t)r * fldw); } } \
            else { _Pragma("unroll") for (int r = 0; r < 32; ++r) fz[r] = 0.f; fdst = nullptr; } } while (0)
#define RS_FILL_STORE() do { if (fon && var != 5) { _Pragma("unroll") for (int c = 0; c < 2; ++c) { u32x4 w; \
            w.x = cvt4_fp8(fz[16 * c] * F8_SW, fz[16 * c + 1] * F8_SW, fz[16 * c + 2] * F8_SW, fz[16 * c + 3] * F8_SW); w.y = cvt4_fp8(fz[16 * c + 4] * F8_SW, fz[16 * c + 5] * F8_SW, fz[16 * c + 6] * F8_SW, fz[16 * c + 7] * F8_SW); \
            w.z = cvt4_fp8(fz[16 * c + 8] * F8_SW, fz[16 * c + 9] * F8_SW, fz[16 * c + 10] * F8_SW, fz[16 * c + 11] * F8_SW); w.w = cvt4_fp8(fz[16 * c + 12] * F8_SW, fz[16 * c + 13] * F8_SW, fz[16 * c + 14] * F8_SW, fz[16 * c + 15] * F8_SW); \
            *(u32x4*)(fdst + 16 * c) = w; } } } while (0)
        for (int sc = 0; sc < S / 64; ++sc) {
            {
                const int q = wv >> 2, seg = wv & 3; unsigned char* cb = lds + q * CHUNK_BYTES;
                const int lna = lane_fresh(); const int kpos = (lna & 32) | (((lna >> 2) & 3) << 3) | (((lna >> 4) & 1) << 2) | (lna & 3);
                REPEAT(REP_SA) {
                float pl[8];
                pl[0] = ww[0];
#pragma unroll
                for (int s = 1; s < 8; ++s) pl[s] = pl[s - 1] + ww[s];
                ((float*)(lds + O_SEGP))[(q * 4 + seg) * 64 + lane] = pl[7];
                float kkn[8], ssq[8];
#pragma unroll
                for (int s = 0; s < 8; ++s) { kkn[s] = kx[s] * k_k; ssq[s] = kkn[s] * kkn[s]; }
                wave_sum8(ssq);
#pragma unroll
                for (int s = 0; s < 8; ++s) kkn[s] *= __builtin_amdgcn_rsqf(fmaxf(ssq[s], 1e-24f));
                RS_SYNC();
                float prefix = 0.f, PCl = 0.f;
#pragma unroll
                for (int s2 = 0; s2 < 4; ++s2) { const float sp = ((const float*)(lds + O_SEGP))[(q * 4 + s2) * 64 + lane]; if (s2 < seg) prefix += sp; PCl += sp; }
                const float PC = __expf(PCl);
                float bgs[8], kdgs[8], bnv[8]; float Pprev = 1.f;
#pragma unroll
                for (int s = 0; s < 8; ++s) {
                    const int tt = seg * 8 + s;
                    const float cl = prefix + pl[s]; const float Pt = __expf(cl), Pm = (s == 0) ? __expf(prefix) : Pprev, inv = __builtin_amdgcn_rcpf(Pt); Pprev = Pt;
                    const float bb = kkn[s] * aa[s], kd = kx[s] * (1.0f + (aa[s] - 1.0f) * k_a);
                    const float bt = bb * inv, kdt = kd * inv;
                    bnv[s] = rr[s] * kd * r_kq;
                    const unsigned w01 = pg8::cvt_pk_bf16(kkn[s] * Pm, rr[s] * Pt), w23 = pg8::cvt_pk_bf16(bt, kdt);
                    *(bf16_t*)(cb + O_KH + tt * P_TK + kpos * 2) = (bf16_t)w01;
                    *(bf16_t*)(cb + O_RH + tt * P_TK + kpos * 2) = (bf16_t)(w01 >> 16);
                    *(bf16_t*)(cb + O_BT + tt * P_TK + kpos * 2) = (bf16_t)w23;
                    *(bf16_t*)(cb + O_KDT + tt * P_TK + kpos * 2) = (bf16_t)(w23 >> 16);
                    bgs[s] = bt * PC; kdgs[s] = kdt * PC;
                    diag_flag(p, nonfin(bt) || nonfin(kdt) || nonfin(kkn[s] * Pm) || nonfin(rr[s] * Pt) || nonfin(bgs[s]) || nonfin(kdgs[s]) || nonfin(vv[s]), 1u);
                    diag_flag(p, !(Pt > 1e-12f) || nonfin(inv), 2u);
                }
                wave_sum8(bnv);
                { float bsel = bnv[0];
#pragma unroll
                  for (int s = 1; s < 8; ++s) bsel = (lna == s) ? bnv[s] : bsel;
                  if (lna < 8) { const int step = sc * 64 + q * 32 + seg * 8 + lna, t = z ? (S - 1 - step) : step;
                      ((float*)(p.ws + WS_BON))[((size_t)z * T + (size_t)b * S + t) * NH + h] = bsel; } }
                u32x4 w;
                w.x = pg8::cvt_pk_bf16(bgs[0], bgs[1]); w.y = pg8::cvt_pk_bf16(bgs[2], bgs[3]); w.z = pg8::cvt_pk_bf16(bgs[4], bgs[5]); w.w = pg8::cvt_pk_bf16(bgs[6], bgs[7]);
                { u32x2 wl; wl.x = w.x; wl.y = w.y; u32x2 wh; wh.x = w.z; wh.y = w.w; const int pb = 16 * (seg & 1) + 4 * (seg >> 1);
                  *(u32x2*)(cb + O_BG + lane * P_KT + pb * 2) = wl; *(u32x2*)(cb + O_BG + lane * P_KT + (pb + 8) * 2) = wh; }
                w.x = pg8::cvt_pk_bf16(kdgs[0], kdgs[1]); w.y = pg8::cvt_pk_bf16(kdgs[2], kdgs[3]); w.z = pg8::cvt_pk_bf16(kdgs[4], kdgs[5]); w.w = pg8::cvt_pk_bf16(kdgs[6], kdgs[7]);
                *(u32x4*)(cb + O_KDG + lane * P_KT + seg * 16) = w;
                w.x = pg8::cvt_pk_bf16(vv[0], vv[1]); w.y = pg8::cvt_pk_bf16(vv[2], vv[3]); w.z = pg8::cvt_pk_bf16(vv[4], vv[5]); w.w = pg8::cvt_pk_bf16(vv[6], vv[7]);
                *(u32x4*)(cb + O_VM + lane * P_KT + seg * 16) = w;
                if (seg == 0) *(float*)(cb + O_GAM + lane * 4) = PC;
                }
                if (sc + 1 < S / 64 && var != 1) RS_LOAD(sc + 1);
            }
            RS_SYNC();
            {
                const int q = wv >> 2, o = wv & 3; unsigned char* cb = lds + q * CHUNK_BYTES;
                const int lnb = lane_fresh(), l15 = lnb & 15, g = lnb >> 4;
                REPEAT(REP_SB) {
                const unsigned char* Xm = cb + ((o & 1) ? O_KDT : O_BT); const unsigned char* Ym = cb + ((o >> 1) ? O_RH : O_KH);
#pragma unroll
                for (int ti = 0; ti < 2; ++ti)
#pragma unroll
                    for (int tt = 0; tt < 2; ++tt) {
                        f32x4 acc = (f32x4){0.f, 0.f, 0.f, 0.f};
                        if (tt >= ti) {
#pragma unroll
                            for (int ks = 0; ks < 2; ++ks) {
                                const bf16x8 a = *(const bf16x8*)(Xm + (16 * ti + l15) * P_TK + (32 * ks + 8 * g) * 2);
                                const bf16x8 bq = *(const bf16x8*)(Ym + (16 * tt + l15) * P_TK + (32 * ks + 8 * g) * 2);
                                acc = __builtin_amdgcn_mfma_f32_16x16x32_bf16(a, bq, acc, 0, 0, 0);
                            }
                        }
                        const int t = 16 * tt + l15, i0 = 16 * ti + 4 * g;
#pragma unroll
                        for (int r = 0; r < 4; ++r) { const int i = i0 + r; const bool keep = (o < 2) ? (i < t) : (i <= t); if (!keep) acc[r] = 0.f; }
                        diag_flag(p, nonfin4(acc), 4u);
                        if (o == 0) *(f32x4*)(cb + O_L + t * 144 + i0 * 4) = acc;
                        else { u32x2 w; w.x = pg8::cvt_pk_bf16(acc[0], acc[1]); w.y = pg8::cvt_pk_bf16(acc[2], acc[3]);
                               if (o == 2) *(u32x2*)(cb + O_AP + t * P_KT + (8 * g + 4 * ti) * 2) = w;
                               else *(u32x2*)(cb + (o == 1 ? O_B2 : O_BP) + t * P_KT + i0 * 2) = w; }
                    }
                }
            }
            RS_SYNC();
            REPEAT(REP_SC) {
            const int tid = wv * 64 + lane_fresh();
            if (tid < 64) {
                const int q = tid >> 5, d = (tid >> 4) & 1, j = tid & 15; unsigned char* cb = lds + q * CHUNK_BYTES;
                float x[16];
#pragma unroll
                for (int i = 0; i < 16; ++i) x[i] = (i == j) ? 1.f : 0.f;
                const unsigned char* Lb = cb + O_L + (16 * d) * 144 + (16 * d) * 4;
                f32x4 Lr[16][4];
#define RS_LROWS(lo, hi) do { _Pragma("unroll") for (int tl = (lo); tl < (hi); ++tl) { _Pragma("unroll") for (int c4 = 0; c4 < (tl + 3) / 4; ++c4) Lr[tl][c4] = *(const f32x4*)(Lb + tl * 144 + c4 * 16); } \
            asm volatile("s_waitcnt lgkmcnt(0)" ::: "memory"); __builtin_amdgcn_sched_barrier(0); } while (0)
#define RS_LSOLVE(lo, hi) do { _Pragma("unroll") for (int tl = (lo); tl < (hi); ++tl) { float s4[4] = {0.f, 0.f, 0.f, 0.f}; \
            _Pragma("unroll") for (int il = 0; il < tl; ++il) s4[il & 3] += Lr[tl][il >> 2][il & 3] * x[il]; \
            const float s = (s4[0] + s4[1]) + (s4[2] + s4[3]); x[tl] = (tl > j) ? -s : x[tl]; } } while (0)
                RS_LROWS(1, 10); RS_LSOLVE(1, 10);
                RS_LROWS(10, 16); RS_LSOLVE(10, 16);
#undef RS_LROWS
#undef RS_LSOLVE
#pragma unroll
                for (int tl = 0; tl < 16; ++tl) { *(float*)(cb + O_X + (16 * d + tl) * 144 + (16 * d + j) * 4) = x[tl]; diag_flag(p, nonfin(x[tl]) || fabsf(x[tl]) > 1e6f, 8u); }
            }
            if (filler) { RS_FILL_STORE(); RS_FILL_LOAD(((int)blockIdx.x * 4 + (wv - 4)) * 64 + sc * 2); }
            RS_SYNC();
            {
                const int q = tid >> 8, tl = (tid >> 4) & 15, jl = tid & 15; unsigned char* cb = lds + q * CHUNK_BYTES;
                const float* Lr = (const float*)(cb + O_L + (16 + tl) * 144);
                float s = 0.f;
#pragma unroll
                for (int i = 0; i < 16; ++i) s += Lr[i] * *(const float*)(cb + O_X + i * 144 + jl * 4);
                *(float*)(cb + O_X + tl * 144 + (16 + jl) * 4) = s;
            }
            RS_SYNC();
            {
                const int q = tid >> 8, tl = (tid >> 4) & 15, jl = tid & 15; unsigned char* cb = lds + q * CHUNK_BYTES;
                float s = 0.f;
#pragma unroll
                for (int i = 0; i < 16; ++i) s += *(const float*)(cb + O_X + (16 + tl) * 144 + (16 + i) * 4) * *(const float*)(cb + O_X + i * 144 + (16 + jl) * 4);
                diag_flag(p, nonfin(s), 16u);
                const int p0 = 8 * (jl >> 2) + (jl & 3), p1 = p0 + 4;
                *(bf16_t*)(cb + O_NT + (16 + tl) * P_KT + p0 * 2) = f2bf(s);
                *(bf16_t*)(cb + O_NT + tl * P_KT + p0 * 2) = f2bf(-*(const float*)(cb + O_X + tl * 144 + jl * 4));
                *(bf16_t*)(cb + O_NT + (16 + tl) * P_KT + p1 * 2) = f2bf(-*(const float*)(cb + O_X + (16 + tl) * 144 + (16 + jl) * 4));
                *(bf16_t*)(cb + O_NT + tl * P_KT + p1 * 2) = (bf16_t)0;
            }
            RS_SYNC();
            }
            if (wv < 4) REPEAT(REP_SD) {
                const int lnd = lane_fresh(), l15 = lnd & 15, g = lnd >> 4;
                f32x4 St[4] = {S4[0], S4[1], S4[2], S4[3]};
#pragma unroll 1
                for (int q = 0; q < 2; ++q) {
                    const unsigned char* cb = lds + q * CHUNK_BYTES;
                    bf16x8 fKH[2][2], fRH[2][2], fB2[2], fNT[2], fAP[2], fBP[2], fBG[4], fKDG[4]; f32x4 fG[4];
                    const bf16x8 vm = *(const bf16x8*)(cb + O_VM + (16 * wv + l15) * P_KT + 16 * g);
#pragma unroll
                    for (int ct = 0; ct < 2; ++ct) {
#pragma unroll
                        for (int s = 0; s < 2; ++s) fKH[ct][s] = *(const bf16x8*)(cb + O_KH + (16 * ct + l15) * P_TK + (32 * s + 8 * g) * 2);
                        fB2[ct] = *(const bf16x8*)(cb + O_B2 + (16 * ct + l15) * P_KT + 16 * g);
                        fNT[ct] = *(const bf16x8*)(cb + O_NT + (16 * ct + l15) * P_KT + 16 * g);
                    }
                    asm volatile("s_waitcnt lgkmcnt(0)" ::: "memory");
                    __builtin_amdgcn_sched_barrier(0);
                    bf16x8 sb[2]; sb[0] = cvt8(St[0], St[1]); sb[1] = cvt8(St[2], St[3]);
                    f32x4 w2[2];
#pragma unroll
                    for (int ct = 0; ct < 2; ++ct) {
                        f32x4 acc = (f32x4){0.f, 0.f, 0.f, 0.f};
                        acc = __builtin_amdgcn_mfma_f32_16x16x32_bf16(fKH[ct][0], sb[0], acc, 0, 0, 0);
                        acc = __builtin_amdgcn_mfma_f32_16x16x32_bf16(fKH[ct][1], sb[1], acc, 0, 0, 0);
                        acc = __builtin_amdgcn_mfma_f32_16x16x32_bf16(fB2[ct], vm, acc, 0, 0, 0);
                        w2[ct] = acc;
                    }
                    __builtin_amdgcn_sched_barrier(0);
#pragma unroll
                    for (int kt = 0; kt < 4; ++kt) {
                        fG[kt] = *(const f32x4*)(cb + O_GAM + (16 * kt + 4 * g) * 4);
                        fBG[kt] = *(const bf16x8*)(cb + O_BG + (16 * kt + l15) * P_KT + 16 * g);
                        fKDG[kt] = *(const bf16x8*)(cb + O_KDG + (16 * kt + l15) * P_KT + 16 * g);
                    }
                    __builtin_amdgcn_sched_barrier(0);
                    diag_flag(p, nonfin4(w2[0]) || nonfin4(w2[1]), 32u);
                    const bf16x8 wb = cvt8(w2[0], w2[1]);
                    f32x4 u2[2];
#pragma unroll
                    for (int ct = 0; ct < 2; ++ct) u2[ct] = __builtin_amdgcn_mfma_f32_16x16x32_bf16(fNT[ct], wb, (f32x4){0.f, 0.f, 0.f, 0.f}, 0, 0, 0);
                    diag_flag(p, nonfin4(u2[0]) || nonfin4(u2[1]), 64u);
                    const bf16x8 ub = cvt8(u2[0], u2[1]);
                    __builtin_amdgcn_sched_barrier(0);
#pragma unroll
                    for (int ct = 0; ct < 2; ++ct) {
#pragma unroll
                        for (int s = 0; s < 2; ++s) fRH[ct][s] = *(const bf16x8*)(cb + O_RH + (16 * ct + l15) * P_TK + (32 * s + 8 * g) * 2);
                        fBP[ct] = *(const bf16x8*)(cb + O_BP + (16 * ct + l15) * P_KT + 16 * g);
                        fAP[ct] = *(const bf16x8*)(cb + O_AP + (16 * ct + l15) * P_KT + 16 * g);
                    }
                    asm volatile("s_waitcnt lgkmcnt(8)" ::: "memory");
                    __builtin_amdgcn_sched_barrier(0);
#pragma unroll
                    for (int kt = 0; kt < 4; ++kt) {
                        f32x4 acc = St[kt] * fG[kt];
                        acc = __builtin_amdgcn_mfma_f32_16x16x32_bf16(fBG[kt], ub, acc, 0, 0, 0);
                        acc = __builtin_amdgcn_mfma_f32_16x16x32_bf16(fKDG[kt], vm, acc, 0, 0, 0);
                        St[kt] = acc; diag_flag(p, nonfin4(acc), 256u);
                    }
                    asm volatile("s_waitcnt lgkmcnt(0)" ::: "memory");
                    __builtin_amdgcn_sched_barrier(0);
#pragma unroll
                    for (int tt = 0; tt < 2; ++tt) {
                        f32x4 acc = (f32x4){0.f, 0.f, 0.f, 0.f};
                        acc = __builtin_amdgcn_mfma_f32_16x16x32_bf16(fRH[tt][0], sb[0], acc, 0, 0, 0);
                        acc = __builtin_amdgcn_mfma_f32_16x16x32_bf16(fRH[tt][1], sb[1], acc, 0, 0, 0);
                        acc = __builtin_amdgcn_mfma_f32_16x16x32_bf16(fAP[tt], ub, acc, 0, 0, 0);
                        acc = __builtin_amdgcn_mfma_f32_16x16x32_bf16(fBP[tt], vm, acc, 0, 0, 0);
                        diag_flag(p, nonfin4(acc), 128u);
                        float* yb = (float*)(lds + O_YB) + (q * 32 + 16 * tt + 4 * g) * YB_PITCH + 16 * wv + l15;
#pragma unroll
                        for (int r = 0; r < 4; ++r) yb[r * YB_PITCH] = acc[r];
                    }
                }
                if (LASTREP(REP_SD)) { S4[0] = St[0]; S4[1] = St[1]; S4[2] = St[2]; S4[3] = St[3]; }
            }
            else if (filler) {
                RS_FILL_STORE();
                RS_FILL_LOAD(((int)blockIdx.x * 4 + (wv - 4)) * 64 + sc * 2 + 1);
            }
            RS_SYNC();
            const int tido = wv * 64 + lane_fresh();
#pragma unroll
            for (int jj = 0; jj < 4; ++jj) {
                const int idx = tido + jj * NTHR, i = idx >> 5, v2 = idx & 31;
                const int step = sc * 64 + i, t = z ? (S - 1 - step) : step;
                const float2 yv = *(const float2*)((const float*)(lds + O_YB) + i * YB_PITCH + 2 * v2);
                if (var != 3) *(unsigned*)(YS + (size_t)z * T * D + ((size_t)b * S + t) * D + h * HD + 2 * v2) = pg8::cvt_pk_bf16(yv.x, yv.y);
            }
        }
        if (filler) RS_FILL_STORE();
        RS_SYNC();
    }
    __syncthreads();
}
#undef RS_SYNC
struct SchedBase { int G, c; };
struct SchedProj : SchedBase {
    const char* Abase; const char* Bbase;
    __device__ __forceinline__ bool next(int i, pg8::Unit& u) const {
        const int L = i * G + c; if (L >= 960) return false;
        if (L < 768) {
            if (G == 256) { const int x = c & 7, j = c >> 3; u.job = i; u.pm = 8 * x + (j & 7); u.pn = j >> 3; }
            else { u.job = L >> 8; const int r = L & 255; u.pm = r >> 2; u.pn = r & 3; }
            u.offB = (int)RW_RKV + (u.job * 1024 + u.pn * 256) * 1024 * 2; }
        else { const int r = L - 768; u.job = 3 + r / 64; u.pm = r % 64; u.pn = 0; u.offB = (int)RW_L1 + (u.job - 3) * 256 * 1024 * 2; }
        u.offA = (u.job * T + u.pm * 256) * D * 2;
        return true;
    }
};
struct SchedLora2 : SchedBase {
    const char* Abase; const char* Bbase;
    __device__ __forceinline__ bool next(int i, pg8::Unit& u) const {
        const int L = i * G + c; if (L >= 1280) return false;
        if (G == 256) { const int x = c & 7, j = c >> 3; u.job = i; u.pm = 8 * x + (j & 7); u.pn = j >> 3; }
        else { u.job = L >> 8; const int r = L & 255; u.pm = r >> 2; u.pn = r & 3; }
        u.offA = (u.pm * 256 * 512 + (u.job < 2 ? 0 : (u.job < 4 ? 128 : 256))) * 2;
        u.offB = (u.job * 1024 + u.pn * 256) * 128 * 2;
        return true;
    }
};
struct SchedPlain : SchedBase {
    const char* Abase; const char* Bbase; int nN, lda, ldb;
    __device__ __forceinline__ bool next(int i, pg8::Unit& u) const {
        const int L = i * G + c; if (L >= 64 * nN) return false;
        u.job = 0;
        if (G == 256) { const int x = c & 7, j = c >> 3; u.pm = 8 * x + (j & 7); u.pn = 4 * i + (j >> 3); }
        else { u.pm = L / nN; u.pn = L % nN; }
        u.offA = u.pm * 256 * lda * 2; u.offB = u.pn * 256 * ldb * 2;
        return true;
    }
};
struct SchedLruGate : SchedBase {
    const char* Abase; const char* Bbase;
    __device__ __forceinline__ bool next(int i, pg8::Unit& u) const {
        const int L = i * G + c; if (L >= 1024) return false;
        u.job = L >> 6; u.pm = L & 63; u.pn = 0;
        u.offA = (u.pm * 256 * D + ((u.job >> 1) & 3) * 256) * 2; u.offB = u.job * 256 * 256 * 2;
        return true;
    }
};
struct SchedMoe1 : SchedBase {
    const char* Abase; const char* Bbase;
    __device__ __forceinline__ bool next(int i, pg8::Unit& u) const {
        const int L = i * G + c; if (L >= 2048) return false;
        if (G == 256) { const int x = c & 7, j = c >> 3, xq = x & 3; u.job = 2 * i + (x >> 2); u.pm = (xq & 1) * 4 + (j & 3); u.pn = (xq >> 1) * 8 + (j >> 2); }
        else { u.job = L >> 7; const int r = L & 127; u.pm = r & 7; u.pn = r >> 3; }
        u.offA = (u.job * 2048 + u.pm * 256) * D; u.offB = (u.job * 4096 + u.pn * 256) * D;
        return true;
    }
};
struct SchedMoe2 : SchedBase {
    const char* Abase; const char* Bbase;
    __device__ __forceinline__ bool next(int i, pg8::Unit& u) const {
        const int L = i * G + c; if (L >= 512) return false;
        if (G == 256) { const int x = c & 7, j = c >> 3; u.job = 8 * i + x; u.pm = j & 7; u.pn = j >> 3; }
        else { u.job = L >> 5; const int r = L & 31; u.pm = r & 7; u.pn = r >> 3; }
        u.offA = (u.job * 2048 + u.pm * 256) * FF; u.offB = (u.job * 1024 + u.pn * 256) * FF;
        return true;
    }
};

#define EPI_ARGS const pg8::f32x4 (&acc)[2][2][4][2], const pg8::Unit& u, int wr, int wc, int fr, int fq
#define EPI_ROWS for (int ai = 0; ai < 2; ++ai) _Pragma("unroll") for (int m = 0; m < 4; ++m)
#define EPI_COLS for (int bj = 0; bj < 2; ++bj) _Pragma("unroll") for (int n = 0; n < 2; ++n)
struct EpiProj {
    static constexpr bool PERM = true; static constexpr bool FP8 = false;
    bf16_t* RKVb; bf16_t* L1b;
    __device__ __forceinline__ void operator()(EPI_ARGS) const {
        const int row0 = u.pm * 256 + wr * 64 + fr;
        if (u.job < 3) {
            bf16_t* C = RKVb + (size_t)u.job * T * D; const int col0 = u.pn * 256 + wc * 32 + 8 * fq;
#pragma unroll
            EPI_ROWS { bf16_t* rowp = C + (size_t)(row0 + ai * 128 + m * 16) * D + col0;
#pragma unroll
                for (int bj = 0; bj < 2; ++bj) { const pg8::f32x4 v0 = acc[ai][bj][m][0], v1 = acc[ai][bj][m][1]; pg8::u32x4 w;
                    w.x = pg8::cvt_pk_bf16(v0[0], v0[1]); w.y = pg8::cvt_pk_bf16(v0[2], v0[3]); w.z = pg8::cvt_pk_bf16(v1[0], v1[1]); w.w = pg8::cvt_pk_bf16(v1[2], v1[3]);
                    *(pg8::u32x4*)(rowp + bj * 128) = w; } }
        } else {
            const int col0 = (u.job - 3) * 128 + wc * 32 + 8 * fq; const int act = u.job;
#pragma unroll
            EPI_ROWS { bf16_t* rowp = L1b + (size_t)(row0 + ai * 128 + m * 16) * 512 + col0;
                pg8::f32x4 v0 = acc[ai][0][m][0], v1 = acc[ai][0][m][1];
                if (act == 3) {
#pragma unroll
                    for (int j = 0; j < 4; ++j) { v0[j] = tanhf_(v0[j]); v1[j] = tanhf_(v1[j]); } }
                else if (act == 5) {
#pragma unroll
                    for (int j = 0; j < 4; ++j) { v0[j] = sigmoidf_(v0[j]); v1[j] = sigmoidf_(v1[j]); } }
                pg8::u32x4 w; w.x = pg8::cvt_pk_bf16(v0[0], v0[1]); w.y = pg8::cvt_pk_bf16(v0[2], v0[3]); w.z = pg8::cvt_pk_bf16(v1[0], v1[1]); w.w = pg8::cvt_pk_bf16(v1[2], v1[3]);
                *(pg8::u32x4*)rowp = w;
                if (act == 5) { pg8::u32x4 zz; zz.x = 0u; zz.y = 0u; zz.z = 0u; zz.w = 0u; *(pg8::u32x4*)(rowp + 128) = zz; }
            }
        }
    }
};
struct EpiLora2 {
    static constexpr bool PERM = true; static constexpr bool FP8 = false;
    bf16_t* WDL; bf16_t* AAb; bf16_t* GGb; const float* w0; const float* a0;
    __device__ __forceinline__ void operator()(EPI_ARGS) const {
        const int row0 = u.pm * 256 + wr * 64 + fr, col0 = u.pn * 256 + wc * 32 + 8 * fq, job = u.job;
        bf16_t* C = job < 2 ? WDL + (size_t)job * T * D : (job < 4 ? AAb + (size_t)(job - 2) * T * D : GGb);
        const float* bias = job < 2 ? w0 + job * D : a0 + (job < 4 ? job - 2 : 0) * D;
        const float sc = job < 2 ? -0.6065306597126334f : 1.0f;
#pragma unroll
        for (int bj = 0; bj < 2; ++bj) {
            const pg8::f32x4 b0 = *(const pg8::f32x4*)(bias + col0 + bj * 128), b1 = *(const pg8::f32x4*)(bias + col0 + bj * 128 + 4);
#pragma unroll
            EPI_ROWS { pg8::f32x4 v0 = acc[ai][bj][m][0], v1 = acc[ai][bj][m][1];
                if (job < 4) { v0 = v0 + b0; v1 = v1 + b1;
#pragma unroll
                    for (int j = 0; j < 4; ++j) { v0[j] = sc * sigmoidf_(v0[j]); v1[j] = sc * sigmoidf_(v1[j]); } }
                pg8::u32x4 w; w.x = pg8::cvt_pk_bf16(v0[0], v0[1]); w.y = pg8::cvt_pk_bf16(v0[2], v0[3]); w.z = pg8::cvt_pk_bf16(v1[0], v1[1]); w.w = pg8::cvt_pk_bf16(v1[2], v1[3]);
                *(pg8::u32x4*)(C + (size_t)(row0 + ai * 128 + m * 16) * D + col0 + bj * 128) = w; }
        }
    }
};
struct EpiStoreF32 {
    static constexpr bool PERM = false; static constexpr bool FP8 = false;
    float* C; int ldc;
    __device__ __forceinline__ void operator()(EPI_ARGS) const {
        const int row0 = u.pm * 256 + wr * 64 + fr, col0 = u.pn * 256 + wc * 32 + 4 * fq;
#pragma unroll
        EPI_ROWS { float* rowp = C + (size_t)(row0 + ai * 128 + m * 16) * ldc + col0;
#pragma unroll
            EPI_COLS *(pg8::f32x4*)(rowp + bj * 128 + n * 16) = acc[ai][bj][m][n]; }
    }
};
struct EpiAddX {
    static constexpr bool PERM = false; static constexpr bool FP8 = false;
    float* X;
    __device__ __forceinline__ void operator()(EPI_ARGS) const {
        const int row0 = u.pm * 256 + wr * 64 + fr, col0 = u.pn * 256 + wc * 32 + 4 * fq;
#pragma unroll
        EPI_ROWS { float* rowp = X + (size_t)(row0 + ai * 128 + m * 16) * D + col0;
#pragma unroll
            EPI_COLS { pg8::f32x4* q = (pg8::f32x4*)(rowp + bj * 128 + n * 16); *q = *q + acc[ai][bj][m][n]; } }
    }
};
struct EpiLruGate {
    static constexpr bool PERM = true; static constexpr bool FP8 = false;
    bf16_t* LA; bf16_t* LB; const bf16_t* UCB; const float* ba; const float* bx; const float* lam;
    __device__ __forceinline__ void operator()(EPI_ARGS) const {
        const int z = u.job >> 3, h = (u.job >> 1) & 3, half = u.job & 1;
        const int row0 = u.pm * 256 + wr * 64 + fr, c0 = h * 256 + half * 128 + wc * 32 + 8 * fq;
        bf16_t* la = LA + (size_t)z * T * D; bf16_t* lb = LB + (size_t)z * T * D;
#pragma unroll
        for (int n = 0; n < 2; ++n) {
            const int c4 = c0 + 4 * n;
            const pg8::f32x4 lm = *(const pg8::f32x4*)(lam + z * D + c4), ba4 = *(const pg8::f32x4*)(ba + z * D + c4), bx4 = *(const pg8::f32x4*)(bx + z * D + c4);
            pg8::f32x4 sp4;
#pragma unroll
            for (int j = 0; j < 4; ++j) sp4[j] = -8.0f * softplusf_(-lm[j]);
#pragma unroll
            EPI_ROWS { const size_t o = (size_t)(row0 + ai * 128 + m * 16) * D + c4;
                const uint2 uu = *(const uint2*)(UCB + o); float uv[4]; bf4_to_f(uu, uv);
                float lo[4], bo[4];
#pragma unroll
                for (int j = 0; j < 4; ++j) { const float ra = acc[ai][0][m][n][j] + ba4[j], ix = acc[ai][1][m][n][j] + bx4[j];
                    const float l = sp4[j] * sigmoidf_(ra); lo[j] = l; const float x2 = 2.0f * l;   const float om = -x2 * (1.0f + x2 * (0.5f + x2 * (0.16666667f + x2 * (0.041666668f + x2 * 0.008333334f)))); bo[j] = __builtin_amdgcn_sqrtf(fmaxf(om, 0.f)) * sigmoidf_(ix) * uv[j]; }
                pg8::u32x2 w; w.x = pg8::cvt_pk_bf16(lo[0], lo[1]); w.y = pg8::cvt_pk_bf16(lo[2], lo[3]); *(pg8::u32x2*)(la + o) = w;
                w.x = pg8::cvt_pk_bf16(bo[0], bo[1]); w.y = pg8::cvt_pk_bf16(bo[2], bo[3]); *(pg8::u32x2*)(lb + o) = w; }
        }
    }
};
struct EpiSwiglu {
    static constexpr bool PERM = true; static constexpr bool FP8 = true;
    unsigned char* HID;
    __device__ __forceinline__ void operator()(EPI_ARGS) const {
        unsigned char* base = HID + (size_t)u.job * 2048 * FF; const int row0 = u.pm * 256 + wr * 64 + fr, col0 = u.pn * 128 + wc * 32 + 8 * fq;
        constexpr float ds = 1.0f / (F8_SH * F8_SW);
#pragma unroll
        EPI_ROWS { float o[8];
#pragma unroll
            for (int n = 0; n < 2; ++n)
#pragma unroll
                for (int j = 0; j < 4; ++j) { const float gt = acc[ai][0][m][n][j] * ds, up = acc[ai][1][m][n][j] * (ds * F8_SHID); o[n * 4 + j] = gt * sigmoidf_(gt) * up; }
            pg8::u32x2 w; w.x = cvt4_fp8(o[0], o[1], o[2], o[3]); w.y = cvt4_fp8(o[4], o[5], o[6], o[7]);
            *(pg8::u32x2*)(base + (size_t)(row0 + ai * 128 + m * 16) * FF + col0) = w; }
    }
};
struct EpiDown {
    static constexpr bool PERM = true; static constexpr bool FP8 = true;
    bf16_t* YEXP; const float* GATE;
    __device__ __forceinline__ void operator()(EPI_ARGS) const {
        const int row0 = u.pm * 256 + wr * 64 + fr, col0 = u.pn * 256 + wc * 32 + 8 * fq;
        bf16_t* C = YEXP + (size_t)u.job * 2048 * D; const float* gt = GATE + (size_t)u.job * 2048;
#pragma unroll
        EPI_ROWS { const int row = row0 + ai * 128 + m * 16; const float gs = gt[row] * (1.0f / (F8_SHID * F8_SW));
#pragma unroll
            for (int bj = 0; bj < 2; ++bj) { const pg8::f32x4 v0 = acc[ai][bj][m][0] * gs, v1 = acc[ai][bj][m][1] * gs; pg8::u32x4 w;
                w.x = pg8::cvt_pk_bf16(v0[0], v0[1]); w.y = pg8::cvt_pk_bf16(v0[2], v0[3]); w.z = pg8::cvt_pk_bf16(v1[0], v1[1]); w.w = pg8::cvt_pk_bf16(v1[2], v1[3]);
                *(pg8::u32x4*)(C + (size_t)row * D + col0 + bj * 128) = w; } }
    }
};
struct EpiStoreBf16 {
    static constexpr bool PERM = true; static constexpr bool FP8 = false;
    bf16_t* O; int ldc;
    __device__ __forceinline__ void operator()(EPI_ARGS) const {
        const int row0 = u.pm * 256 + wr * 64 + fr, col0 = u.pn * 256 + wc * 32 + 8 * fq;
#pragma unroll
        EPI_ROWS { bf16_t* rowp = O + (size_t)(row0 + ai * 128 + m * 16) * ldc + col0;
#pragma unroll
            for (int bj = 0; bj < 2; ++bj) { const pg8::f32x4 v0 = acc[ai][bj][m][0], v1 = acc[ai][bj][m][1]; pg8::u32x4 w;
                w.x = pg8::cvt_pk_bf16(v0[0], v0[1]); w.y = pg8::cvt_pk_bf16(v0[2], v0[3]); w.z = pg8::cvt_pk_bf16(v1[0], v1[1]); w.w = pg8::cvt_pk_bf16(v1[2], v1[3]);
                *(pg8::u32x4*)(rowp + bj * 128) = w; } }
    }
};

struct RmId { __device__ __forceinline__ int operator()(int n) const { return n; } };
struct RmGU { int off; __device__ __forceinline__ int operator()(int n) const { return ((n >> 7) << 8) + off + (n & 127); } };
template <class RM, bool F8 = false>
__device__ __forceinline__ void tconv(const int wv, const float* W, int ldw, int K, int N, bf16_t* dst, int ldb, int koff, const RM rm, float* lds, int& rot) {
    const int tid = TID, G = gridDim.x, tn = N >> 7, ntiles = (K >> 6) * tn;
    const int lr = tid >> 5, lc = (tid & 31) * 4;
    const int sn = tid >> 3, sk = (tid & 7) * 8;
    int t = (int)(((unsigned)blockIdx.x + (unsigned)G - (unsigned)(rot % G)) % (unsigned)G);
    float4 cur[4], nx[4];
    if (t < ntiles) { const int k0 = (t / tn) << 6, n0 = (t % tn) << 7;
#pragma unroll
        for (int i = 0; i < 4; ++i) { const pg8::f32x4 t4 = __builtin_nontemporal_load((const pg8::f32x4*)(W + (size_t)(k0 + lr + 16 * i) * ldw + n0 + lc)); cur[i] = make_float4(t4[0], t4[1], t4[2], t4[3]); } }
    for (; t < ntiles; t += G) {
        const int k0 = (t / tn) << 6, n0 = (t % tn) << 7; const int t2 = t + G;
        if (t2 < ntiles) { const int k2 = (t2 / tn) << 6, n2 = (t2 % tn) << 7;
#pragma unroll
            for (int i = 0; i < 4; ++i) { const pg8::f32x4 t4 = __builtin_nontemporal_load((const pg8::f32x4*)(W + (size_t)(k2 + lr + 16 * i) * ldw + n2 + lc)); nx[i] = make_float4(t4[0], t4[1], t4[2], t4[3]); } }
        __syncthreads();
#pragma unroll
        for (int i = 0; i < 4; ++i) { float* q = lds + (lr + 16 * i) * 129 + lc; q[0] = cur[i].x; q[1] = cur[i].y; q[2] = cur[i].z; q[3] = cur[i].w; }
        __syncthreads();
#pragma unroll
        for (int i = 0; i < 2; ++i) { const int n = sn + 64 * i; float f[8];
#pragma unroll
            for (int j = 0; j < 8; ++j) f[j] = lds[(sk + j) * 129 + n];
            pg8::u32x4 w; w.x = pg8::cvt_pk_bf16(f[0], f[1]); w.y = pg8::cvt_pk_bf16(f[2], f[3]); w.z = pg8::cvt_pk_bf16(f[4], f[5]); w.w = pg8::cvt_pk_bf16(f[6], f[7]);
            if constexpr (F8) { pg8::u32x2 w8; w8.x = cvt4_fp8(f[0] * F8_SW, f[1] * F8_SW, f[2] * F8_SW, f[3] * F8_SW); w8.y = cvt4_fp8(f[4] * F8_SW, f[5] * F8_SW, f[6] * F8_SW, f[7] * F8_SW);
                *(pg8::u32x2*)((unsigned char*)dst + (size_t)rm(n0 + n) * ldb + koff + k0 + sk) = w8; }
            else *(pg8::u32x4*)(dst + (size_t)rm(n0 + n) * ldb + koff + k0 + sk) = w; }
#pragma unroll
        for (int i = 0; i < 4; ++i) cur[i] = nx[i];
    }
    rot += ntiles;
}
__device__ __forceinline__ void tconv_small(const int wv, const float* W, int K, int N, bf16_t* dst, int ldb, int noff) {
    for (int i = blockIdx.x * NTHR + TID; i < K * N; i += gridDim.x * NTHR) { const int k = i / N, n = i - k * N; dst[(size_t)(n + noff) * ldb + k] = f2bf(W[i]); }
}
__device__ __forceinline__ void zfill(const int wv, bf16_t* dst, int ldb, int r0, int r1, int c0, int c1) {
    const int w8 = (c1 - c0) >> 3, tot = (r1 - r0) * w8;
    for (int i = blockIdx.x * NTHR + TID; i < tot; i += gridDim.x * NTHR) { const int r = r0 + i / w8, c = c0 + (i % w8) * 8; *(uint4*)(dst + (size_t)r * ldb + c) = make_uint4(0u, 0u, 0u, 0u); }
}
__device__ __forceinline__ void ph_prologue(const int wv, const P& p, float* lds) {
    int rot = 0;
    unsigned char* ws = p.ws;
    for (int L = 0; L < DEPTH; ++L) {
        if (gridDim.x == 256 && (L % 3) == 0) continue;
        for (int e = 0; e < NE; ++e) {
            bf16_t* gu = (bf16_t*)(ws + WB_MOE + (size_t)L * MOE_STRIDE + MOE_GU + (size_t)e * 4096 * D);
            bf16_t* dn = (bf16_t*)(ws + WB_MOE + (size_t)L * MOE_STRIDE + MOE_DN + (size_t)e * D * FF);
            RmGU rg; rg.off = 0; RmGU ru; ru.off = 128;
            tconv<RmGU, true>(wv, p.in[I_WG] + ((size_t)L * NE + e) * D * FF, FF, D, FF, gu, D, 0, rg, lds, rot);
            tconv<RmGU, true>(wv, p.in[I_WU] + ((size_t)L * NE + e) * D * FF, FF, D, FF, gu, D, 0, ru, lds, rot);
            tconv<RmId, true>(wv, p.in[I_WDN] + ((size_t)L * NE + e) * FF * D, D, FF, D, dn, FF, 0, RmId(), lds, rot);
        }
    }
    for (int ia = 0; ia < 2; ++ia) {
        unsigned char* rb = ws + WB_RW + (size_t)ia * RW_STRIDE;
        for (int q = 0; q < 3; ++q) tconv(wv, p.in[I_WIN] + ((size_t)ia * 3 + q) * D * D, D, D, D, (bf16_t*)(rb + RW_RKV) + (size_t)q * D * D, D, 0, RmId(), lds, rot);
        tconv(wv, p.in[I_WOUT] + (size_t)ia * D * D, D, D, D, (bf16_t*)(rb + RW_OUT), D, 0, RmId(), lds, rot);
        bf16_t* l1 = (bf16_t*)(rb + RW_L1);
        for (int z = 0; z < 2; ++z) { tconv_small(wv, p.in[I_W1] + ((size_t)ia * 2 + z) * D * 64, D, 64, l1, D, z * 64); tconv_small(wv, p.in[I_A1] + ((size_t)ia * 2 + z) * D * 64, D, 64, l1 + 256 * D, D, z * 64); }
        tconv(wv, p.in[I_G1] + (size_t)ia * D * 128, 128, D, 128, l1 + 2 * 256 * D, D, 0, RmId(), lds, rot);
        for (int q = 0; q < 3; ++q) zfill(wv, l1 + (size_t)q * 256 * D, D, 128, 256, 0, D);
        bf16_t* l2 = (bf16_t*)(rb + RW_L2);
        for (int z = 0; z < 2; ++z) {
            tconv(wv, p.in[I_W2] + ((size_t)ia * 2 + z) * 64 * D, D, 64, D, l2 + (size_t)z * 1024 * 128, 128, z * 64, RmId(), lds, rot);
            tconv(wv, p.in[I_A2] + ((size_t)ia * 2 + z) * 64 * D, D, 64, D, l2 + (size_t)(2 + z) * 1024 * 128, 128, z * 64, RmId(), lds, rot);
            zfill(wv, l2 + (size_t)z * 1024 * 128, 128, 0, 1024, (1 - z) * 64, (1 - z) * 64 + 64);
            zfill(wv, l2 + (size_t)(2 + z) * 1024 * 128, 128, 0, 1024, (1 - z) * 64, (1 - z) * 64 + 64);
        }
        tconv(wv, p.in[I_G2] + (size_t)ia * 128 * D, D, 128, D, l2 + (size_t)4 * 1024 * 128, 128, 0, RmId(), lds, rot);
    }
    tconv(wv, p.in[I_SCIN], 3 * D, D, 3 * D, (bf16_t*)(ws + WB_SC + SC_IN), D, 0, RmId(), lds, rot);
    tconv(wv, p.in[I_SCOUT], D, D, D, (bf16_t*)(ws + WB_SC + SC_OUT), D, 0, RmId(), lds, rot);
    tconv(wv, p.in[I_LIN], 2 * D, D, 2 * D, (bf16_t*)(ws + WB_LRU + LRU_IN), D, 0, RmId(), lds, rot);
    tconv(wv, p.in[I_LOUT], D, D, D, (bf16_t*)(ws + WB_LRU + LRU_OUT), D, 0, RmId(), lds, rot);
    for (int zh = 0; zh < 8; ++zh) {
        bf16_t* gt = (bf16_t*)(ws + WB_LRU + LRU_G) + (size_t)zh * 2 * 256 * 256;
        RmGU ra; ra.off = 0; RmGU rx; rx.off = 128;
        tconv(wv, p.in[I_LWA] + (size_t)zh * 256 * 256, 256, 256, 256, gt, 256, 0, ra, lds, rot);
        tconv(wv, p.in[I_LWX] + (size_t)zh * 256 * 256, 256, 256, 256, gt, 256, 0, rx, lds, rot);
    }
}


#define XB_TMO      128
#define XB_XCNT(j)  (256  + 64 * (j))
#define XB_XSUB(j)  (1280 + 64 * (j))
#define XB_XGEN(j)  (2304 + 64 * (j))
#define XB_TOP      3328
#define XB_TOPGEN   3392
#define XCD_BAR_WORDS 3456
#define XB_SPIN_CAP (1u << 22)
#define LAS __attribute__((address_space(3)))
__device__ __forceinline__ unsigned xb_ld(unsigned* p)              { return __hip_atomic_load(p, __ATOMIC_RELAXED, __HIP_MEMORY_SCOPE_AGENT); }
__device__ __forceinline__ unsigned xb_add(unsigned* p, unsigned v) { return __hip_atomic_fetch_add(p, v, __ATOMIC_RELAXED, __HIP_MEMORY_SCOPE_AGENT); }
__device__ __forceinline__ unsigned xb_xcc_id() { return (unsigned)__builtin_amdgcn_s_getreg((3 << 11) | 20) & 0xFu; }
#define XB_SPIN(cond, bar) do { unsigned _sp = 0; while (cond) { __builtin_amdgcn_s_sleep(1); \
    if ((++_sp & 255u) == 0u) { if (xb_ld(&(bar)[XB_TMO])) break; if (_sp > XB_SPIN_CAP) { atomicAdd(&(bar)[XB_TMO], 1u); break; } } } } while (0)
struct XcdBarrier { unsigned* bar; unsigned x; volatile LAS unsigned* st; };
__device__ __forceinline__ XcdBarrier xcd_barrier_post(const int wv, unsigned* bar, volatile LAS unsigned* st) {
    XcdBarrier b; b.bar = bar; b.x = xb_xcc_id(); b.st = st;
    if (TID == 0) (void)xb_add(&bar[XB_XCNT(b.x)], 1u);
    return b;
}
__device__ __forceinline__ void xcd_barrier_complete(unsigned* bar, unsigned x, unsigned& nloc, unsigned& nx) {
    const unsigned G = gridDim.x * gridDim.y * gridDim.z;
    unsigned sum, cnt, mine, sp = 0u;
    for (;;) {
        sum = 0u; cnt = 0u; mine = 0u;
#pragma unroll
        for (unsigned j = 0; j < 16; ++j) { const unsigned c = xb_ld(&bar[XB_XCNT(j)]); sum += c; cnt += (c > 0u) ? 1u : 0u; mine = (j == x) ? c : mine; }
        if (sum == G) break;
        __builtin_amdgcn_s_sleep(1);
        if ((++sp & 255u) == 0u) { if (xb_ld(&bar[XB_TMO])) break; if (sp > XB_SPIN_CAP) { atomicAdd(&bar[XB_TMO], 1u); break; } }
    }
    nloc = mine > 0u ? mine : 1u; nx = cnt > 0u ? cnt : 1u;
}
__device__ __forceinline__ void xcd_barrier(const int wv, const XcdBarrier& b) {
    asm volatile("s_waitcnt vmcnt(0)" ::: "memory");
    __syncthreads();
    if (TID == 0) {
        unsigned* bar = b.bar;
        __builtin_amdgcn_s_waitcnt(0);
        unsigned nloc = b.st[0], nx = b.st[1];
        if (nloc == 0u) { xcd_barrier_complete(bar, b.x, nloc, nx); b.st[0] = nloc; b.st[1] = nx; }
        const unsigned old = xb_add(&bar[XB_XSUB(b.x)], 1u);
        const unsigned gen = old / nloc;
        if (old + 1u == (gen + 1u) * nloc) {
            __builtin_amdgcn_fence(__ATOMIC_RELEASE, "agent");
            asm volatile("s_waitcnt vmcnt(0)" ::: "memory");
            const unsigned og = xb_add(&bar[XB_TOP], 1u);
            const unsigned tg = og / nx;
            if (og + 1u == (tg + 1u) * nx) xb_add(&bar[XB_TOPGEN], 1u);
            else XB_SPIN(xb_ld(&bar[XB_TOPGEN]) == tg, bar);
            __builtin_amdgcn_fence(__ATOMIC_ACQUIRE, "agent");
            xb_add(&bar[XB_XGEN(b.x)], 1u);
            asm volatile("s_waitcnt vmcnt(0)" ::: "memory");
        } else {
            XB_SPIN(xb_ld(&bar[XB_XGEN(b.x)]) == gen, bar);
            __builtin_amdgcn_fence(__ATOMIC_ACQUIRE, "agent");
            asm volatile("s_waitcnt vmcnt(0)" ::: "memory");
        }
    }
    __syncthreads();
}
struct PhaseCtl { XcdBarrier bar; int lo, hi; bool did; };
__device__ __forceinline__ bool phase_enter(const int wv, PhaseCtl& c, int k) {
    if (k < c.lo || k >= c.hi) return false;
    if (c.did) REPEAT(REP_BAR) xcd_barrier(wv, c.bar);
    c.did = true;
    return true;
}

#define DIAG 0
constexpr int CTL_DIAG = 4096;
__device__ __forceinline__ void diag_compare(const int wv, const P& p, const float* A, const float* Bq, size_t n) {
    float e = 0.f, r = 0.f; int bad = 0;
    for (size_t i = (size_t)blockIdx.x * NTHR + TID; i < n; i += (size_t)gridDim.x * NTHR) { const float a = A[i], b = Bq[i]; const float d = a - b; e += d * d; r += a * a; if (!(d == d) || fabsf(d) > 3.0e38f) bad = 1; }
    e = wave_sum(e); r = wave_sum(r); bad = __any(bad);
    if (lane_fresh() == 0) { float* c = (float*)(p.ws + WS_CTL) + CTL_DIAG; atomicAdd(c, e); atomicAdd(c + 1, r); if (bad) atomicAdd((unsigned*)(c + 2), 1u); }
}
__device__ __forceinline__ void diag_delay(const int wv, const P& p) {
    if (blockIdx.x == 0 && TID == 0) {
        float* c = (float*)(p.ws + WS_CTL) + CTL_DIAG;
        const float e = __hip_atomic_load(c, __ATOMIC_RELAXED, __HIP_MEMORY_SCOPE_AGENT), r = __hip_atomic_load(c + 1, __ATOMIC_RELAXED, __HIP_MEMORY_SCOPE_AGENT);
        const unsigned bad = __hip_atomic_load((unsigned*)(c + 2), __ATOMIC_RELAXED, __HIP_MEMORY_SCOPE_AGENT);
        const unsigned mask = __hip_atomic_load((unsigned*)(c + 3), __ATOMIC_RELAXED, __HIP_MEMORY_SCOPE_AGENT);
        float ms;
        if (bad) ms = 12.f; else if (!(r > 0.f)) ms = 14.f; else { const float rel = sqrtf(e / r); float lg = log10f(fmaxf(rel, 1e-8f)) + 8.f; lg = fminf(fmaxf(lg, 0.f), 10.f); ms = 1.f + lg; }
        if (DIAGF) { ms = 1.f; if (mask) ms = 2.f + (float)__ffs(mask); if (bad) ms += 10.f; }
        const unsigned long long t0 = __builtin_amdgcn_s_memrealtime(); const unsigned long long ticks = (unsigned long long)(ms * 100000.f);
        while (__builtin_amdgcn_s_memrealtime() - t0 < ticks) __builtin_amdgcn_s_sleep(32);
    }
}
constexpr int LDS_BYTES = 128 * 1024 + 1024;
constexpr int PH_PER_LAYER = 16, PH_FINAL = 1 + DEPTH * PH_PER_LAYER, PH_TOTAL = PH_FINAL + 1;

#define IN(k) phase_enter(wv, pc, (k))
template <int L>
__device__ __forceinline__ void run_layer(const int wv, const P& p, float* lds, PhaseCtl& pc) {
    constexpr int m = L % 3, base = 1 + L * PH_PER_LAYER, ia = L / 3;
    PG8_LAS unsigned char* glds = (PG8_LAS unsigned char*)lds;
    unsigned char* ws = p.ws;
    float* X = (float*)(ws + (L == 3 ? WS_X2 : WS_X)); bf16_t* H = (bf16_t*)(ws + WS_H);
    float* RKV = (float*)(ws + WS_RKV);
    float* WDp = (float*)(ws + WS_WD); float* AAp = (float*)(ws + WS_AA); float* GG = (float*)(ws + WS_GG);
    SchedBase sb; sb.G = gridDim.x; sb.c = blockIdx.x;
    if constexpr (m == 0) {
        if (IN(base + 0)) REPEAT(REP_NORM_MIX) ph_norm_xm(wv, p, L == 0 ? p.in[I_X] : (const float*)(ws + WS_X), L == 0 ? nullptr : (const bf16_t*)(ws + WS_UCB), X, L > 0, p.in[I_NMG] + L * D, p.in[I_MU] + ia * 6 * D, (unsigned char*)lds);
    } else {
    if (IN(base + 0)) REPEAT(REP_NORM_MIX) ph_norm(wv, p, L == 0 ? p.in[I_X] : X, L == 0 ? nullptr : (const bf16_t*)(ws + WS_UCB), LASTREP(REP_NORM_MIX) ? X : (float*)(ws + WS_YS), L > 0, p.in[I_NMG] + L * D, LASTREP(REP_NORM_MIX) ? H : (bf16_t*)(ws + WS_YS + 64 * MiB), nullptr, nullptr, lds);
    }
    if constexpr (m == 0) {
        const unsigned char* rb = ws + WB_RW + (size_t)ia * RW_STRIDE;
        if (IN(base + 2)) {
            SchedProj S; S.G = sb.G; S.c = sb.c; S.Abase = (const char*)(ws + WS_XM); S.Bbase = (const char*)rb;
            EpiProj E; E.RKVb = (bf16_t*)(ws + WS_RKV); E.L1b = (bf16_t*)(ws + WS_L1);
            pg8::Geo g; g.lda = D; g.ldb = D; g.K = D;
            REPEAT(REP_PROJ) pg8::gemm_phase(wv, glds, g, S, E);
        }
        if (IN(base + 3)) {
            SchedLora2 S; S.G = sb.G; S.c = sb.c; S.Abase = (const char*)(ws + WS_L1); S.Bbase = (const char*)(rb + RW_L2);
            EpiLora2 E; E.WDL = (bf16_t*)(ws + WS_WD); E.AAb = (bf16_t*)(ws + WS_AA); E.GGb = (bf16_t*)(ws + WS_GG); E.w0 = p.in[I_W0] + (size_t)ia * 2 * D; E.a0 = p.in[I_A0] + (size_t)ia * 2 * D;
            pg8::Geo g; g.lda = 512; g.ldb = 128; g.K = 128;
            REPEAT(REP_LORA2) pg8::gemm_phase(wv, glds, g, S, E);
        }
        if (IN(base + 4)) {
            REPEAT(REP_SCAN) ph_scan2(wv, p, ia, (unsigned char*)lds, (bf16_t*)(ws + WS_YS), L, LASTREP(REP_SCAN) ? 0 : 100 + SVAR);
        }
        if (DIAG) { if (IN(base + 11)) diag_compare(wv, p, (const float*)(ws + WS_YS), (const float*)(ws + WS_XM), (size_t)2 * T * D); }
        if (IN(base + 5)) REPEAT(REP_RPOST) ph_rwkv_post(wv, p, ia);
        if (IN(base + 6)) {
            SchedPlain S; S.G = sb.G; S.c = sb.c; S.Abase = (const char*)(ws + WS_YG); S.Bbase = (const char*)(rb + RW_OUT); S.nN = 4; S.lda = D; S.ldb = D;
            pg8::Geo g; g.lda = D; g.ldb = D; g.K = D;
            REPEAT(REP_OUT) { EpiStoreBf16 E; E.O = (bf16_t*)(ws + WS_UCB); E.ldc = D; pg8::gemm_phase(wv, glds, g, S, E); }
        }
    } else if constexpr (m == 1) {
        if (IN(base + 1)) {
            SchedPlain S; S.G = sb.G; S.c = sb.c; S.Abase = (const char*)H; S.Bbase = (const char*)(ws + WB_SC + SC_IN); S.nN = 12; S.lda = D; S.ldb = D;
            EpiStoreBf16 E; E.O = (bf16_t*)(ws + WS_RKV); E.ldc = 3 * D; pg8::Geo g; g.lda = D; g.ldb = D; g.K = D;
            REPEAT(REP_SCIN) pg8::gemm_phase(wv, glds, g, S, E);
        }
        if (IN(base + 2)) REPEAT(REP_SCMID) ph_sc_mid(wv, p);
        if (IN(base + 3)) {
            SchedPlain S; S.G = sb.G; S.c = sb.c; S.Abase = (const char*)(ws + WS_YG); S.Bbase = (const char*)(ws + WB_SC + SC_OUT); S.nN = 4; S.lda = D; S.ldb = D;
            pg8::Geo g; g.lda = D; g.ldb = D; g.K = D;
            REPEAT(REP_OUT) { EpiStoreBf16 E; E.O = (bf16_t*)(ws + WS_UCB); E.ldc = D; pg8::gemm_phase(wv, glds, g, S, E); }
        }
    } else {
        if (IN(base + 1)) {
            SchedPlain S; S.G = sb.G; S.c = sb.c; S.Abase = (const char*)H; S.Bbase = (const char*)(ws + WB_LRU + LRU_IN); S.nN = 8; S.lda = D; S.ldb = D;
            EpiStoreBf16 E; E.O = (bf16_t*)(ws + WS_RKV); E.ldc = 2 * D; pg8::Geo g; g.lda = D; g.ldb = D; g.K = D;
            REPEAT(REP_LIN) pg8::gemm_phase(wv, glds, g, S, E);
        }
        if (IN(base + 2)) REPEAT(REP_LCONV) ph_lru_conv(wv, p);
        if (IN(base + 3)) {
            SchedLruGate S; S.G = sb.G; S.c = sb.c; S.Abase = (const char*)(ws + WS_UCB); S.Bbase = (const char*)(ws + WB_LRU + LRU_G);
            EpiLruGate E; E.LA = (bf16_t*)(ws + WS_WD); E.LB = (bf16_t*)(ws + WS_AA); E.UCB = (const bf16_t*)(ws + WS_UCB); E.ba = p.in[I_LBA]; E.bx = p.in[I_LBX]; E.lam = p.in[I_LLAM];
            pg8::Geo g; g.lda = D; g.ldb = 256; g.K = 256;
            REPEAT(REP_LGATE) pg8::gemm_phase(wv, glds, g, S, E);
        }
        if (IN(base + 4)) REPEAT(REP_LSCAN) ph_lru_scan(wv, p, lds);
        if (IN(base + 5)) REPEAT(REP_LPOST) ph_lru_post(wv, p);
        if (IN(base + 6)) {
            SchedPlain S; S.G = sb.G; S.c = sb.c; S.Abase = (const char*)(ws + WS_YG); S.Bbase = (const char*)(ws + WB_LRU + LRU_OUT); S.nN = 4; S.lda = D; S.ldb = D;
            pg8::Geo g; g.lda = D; g.ldb = D; g.K = D;
            REPEAT(REP_OUT) { EpiStoreBf16 E; E.O = (bf16_t*)(ws + WS_UCB); E.ldc = D; pg8::gemm_phase(wv, glds, g, S, E); }
        }
    }
    if (IN(base + 7)) REPEAT(REP_NORM_FFN) ph_norm(wv, p, X, (const bf16_t*)(ws + WS_UCB), nullptr, false, p.in[I_NFG] + L * D, H, p.in[I_RW] + (size_t)L * D * NE, nullptr, lds, true);
    if (IN(base + 8)) REPEAT(REP_TOPK) ph_topk(wv, p, lds);
    if (IN(base + 9)) {
        SchedMoe1 S; S.G = sb.G; S.c = sb.c; S.Abase = (const char*)(ws + WS_XIN); S.Bbase = (const char*)(ws + WB_MOE + (size_t)L * MOE_STRIDE + MOE_GU);
        EpiSwiglu E; E.HID = (unsigned char*)(ws + WS_HID); pg8::Geo g; g.lda = D / 2; g.ldb = D / 2; g.K = D / 2;
        REPEAT(REP_MOE1) pg8::gemm_phase(wv, glds, g, S, E, !LASTREP(REP_MOE1) && GVAR == 1);
    }
    if (IN(base + 10)) {
        SchedMoe2 S; S.G = sb.G; S.c = sb.c; S.Abase = (const char*)(ws + WS_HID); S.Bbase = (const char*)(ws + WB_MOE + (size_t)L * MOE_STRIDE + MOE_DN);
        EpiDown E; E.YEXP = (bf16_t*)(ws + WS_YEXP); E.GATE = (const float*)(ws + WS_GATE); pg8::Geo g; g.lda = FF / 2; g.ldb = FF / 2; g.K = FF / 2;
        REPEAT(REP_MOE2) pg8::gemm_phase(wv, glds, g, S, E, !LASTREP(REP_MOE2) && GVAR == 1);
    }
}

__global__ void __launch_bounds__(NTHR, 2) mega(P p_unused) {
    extern __shared__ __attribute__((aligned(16))) unsigned char lds_raw[];
    const P& p = *(const P*)__builtin_amdgcn_kernarg_segment_ptr();
    float* lds = (float*)lds_raw;
    volatile LAS unsigned* xbw = (volatile LAS unsigned*)(lds_raw + LDS_BYTES - 16);
    const int wv = __builtin_amdgcn_readfirstlane((int)(threadIdx.x >> 6));
    if (threadIdx.x == 0) { xbw[0] = 0u; xbw[1] = 0u; xbw[2] = 0u; xbw[3] = 0u; }
    __syncthreads();
    PhaseCtl pc; pc.lo = p.ph_lo; pc.hi = p.ph_hi; pc.did = false;
    pc.bar = xcd_barrier_post(wv, (unsigned*)(p.ws + WS_CTL), xbw);
    if (IN(0)) REPEAT(REP_PROLOGUE) ph_prologue(wv, p, lds);
    run_layer<0>(wv, p, lds, pc);
    run_layer<1>(wv, p, lds, pc);
    run_layer<2>(wv, p, lds, pc);
    run_layer<3>(wv, p, lds, pc);
    if (IN(PH_FINAL)) ph_norm(wv, p, (const float*)(p.ws + WS_X2), (const bf16_t*)(p.ws + WS_UCB), nullptr, true, p.in[I_FNG], nullptr, nullptr, p.out, lds);
    if (DIAG) { xcd_barrier(wv, pc.bar); diag_delay(wv, p); }
}
#undef IN

}

extern "C" void kernel_launch(void* const* d_in, const int* in_sizes, int n_in, void* d_out, int out_size, void* d_ws, size_t ws_size, hipStream_t stream) {
    static int ready = 0, grid = 256;
    if (!ready) {
        if (n_in != 36 || out_size != T * D || ws_size < WS_END) { fprintf(stderr, "kernel_launch: unexpected problem (n_in %d out %d ws %zu need %zu)\n", n_in, out_size, ws_size, (size_t)WS_END); ready = -1; return; }
        if (hipFuncSetAttribute((const void*)mega, hipFuncAttributeMaxDynamicSharedMemorySize, LDS_BYTES) != hipSuccess) { fprintf(stderr, "kernel_launch: hipFuncSetAttribute failed\n"); ready = -1; return; }
        { int dev = 0, cus = 0; if (hipGetDevice(&dev) == hipSuccess && hipDeviceGetAttribute(&cus, hipDeviceAttributeMultiprocessorCount, dev) == hipSuccess && cus > 0) grid = cus < 256 ? cus : 256; }
        ready = 1;
    }
    if (ready < 0) return;
    (void)in_sizes;
    P p{};
    for (int i = 0; i < 36; ++i) p.in[i] = (const float*)d_in[i];
    p.out = (float*)d_out; p.ws = (unsigned char*)d_ws;
    if (hipMemsetAsync((char*)d_ws + WS_CTL, 0, 32768, stream) != hipSuccess) { fprintf(stderr, "kernel_launch: memset failed\n"); return; }
    p.ph_lo = 0; p.ph_hi = PH_TOTAL;
    hipLaunchKernelGGL(mega, dim3(grid), dim3(NTHR), LDS_BYTES, stream, p);
}
```
